# Optimizing an MI355X kernel written in HIP

```python
import math
import jax
import jax.numpy as jnp
from jax import lax
import numpy as np

D_MODEL = 1024
BATCH = 8
SEQ = 4096
DEPTH = 2

CTX_LEN = 256
GRID_W = 64
RMS_EPS = 1e-6

MLA_HEADS = 8
MLA_Q_LORA = 384
MLA_KV_LORA = 256
MLA_NOPE = 64
MLA_ROPE = 32
MLA_V = 64
MLA_QK = MLA_NOPE + MLA_ROPE
ROPE_PAIRS = MLA_ROPE // 4
ROPE_BASE = 10000.0
Q_BLOCK = 128

LRU_WIDTH = 512
LRU_BLOCKS = 8
LRU_BLOCK_DIM = LRU_WIDTH // LRU_BLOCKS
LRU_C = 8.0
LRU_CONV = 4

EVEN_SPLITS = (MLA_Q_LORA, MLA_Q_LORA + MLA_KV_LORA, MLA_Q_LORA + MLA_KV_LORA + MLA_ROPE, MLA_Q_LORA + MLA_KV_LORA + MLA_ROPE + LRU_WIDTH)
EVEN_IN = MLA_Q_LORA + MLA_KV_LORA + MLA_ROPE + 2 * LRU_WIDTH
EVEN_MIX = MLA_HEADS * MLA_V + LRU_WIDTH

HY_WIDTH = D_MODEL
HY_ORDER = 2
HY_CONV = 3
HY_BANDS = 16
HY_EMB = 2 * HY_BANDS + 1
HY_HIDDEN = 64

N_EXPERTS = 16
N_GROUPS = 4
EXPERTS_PER_GROUP = N_EXPERTS // N_GROUPS
TOP_K = 2
EXPERT_FF = 512

N_EVEN = (DEPTH + 1) // 2
N_ODD = DEPTH // 2

kernel_name = 'hybrid_mla_rglru_hyena_moe_dit'


def rms_norm(x, g):
    xf = x.astype(jnp.float32)
    y = xf * lax.rsqrt(jnp.mean(xf * xf, axis=-1, keepdims=True) + RMS_EPS)
    return (y * g.astype(jnp.float32)).astype(x.dtype)


def modulate(h, shift, scale):
    return h * (1.0 + scale) + shift


def grid_rope_tables(rows):
    row = jnp.repeat(jnp.arange(rows), GRID_W)
    col = jnp.tile(jnp.arange(GRID_W), rows)
    inv_freq = ROPE_BASE ** (-jnp.arange(ROPE_PAIRS, dtype=jnp.float32) / ROPE_PAIRS)
    ang = jnp.stack([row, col], axis=-1).astype(jnp.float32)[:, :, None] * inv_freq
    return jnp.cos(ang), jnp.sin(ang)


def apply_rope_2d(x, cos, sin):
    xr = x.astype(jnp.float32).reshape(*x.shape[:-1], 2, 2, ROPE_PAIRS)
    xa, xb = xr[..., 0, :], xr[..., 1, :]
    out = jnp.stack([xa * cos - xb * sin, xa * sin + xb * cos], axis=-2)
    return out.reshape(x.shape).astype(x.dtype)


def attend(q, k, v):
    s = jnp.einsum('bqhd,bkhd->bhqk', q, k).astype(jnp.float32) * (MLA_QK ** -0.5)
    p = jax.nn.softmax(s, axis=-1).astype(v.dtype)
    return jnp.einsum('bhqk,bkhd->bqhd', p, v)


def blocked_attend(q, k, v):
    bsz, n, heads, dk = q.shape
    nb = n // Q_BLOCK
    qb = q.reshape(bsz, nb, Q_BLOCK, heads, dk).transpose(1, 0, 2, 3, 4)
    ob = lax.map(lambda qi: attend(qi, k, v), qb)
    return ob.transpose(1, 0, 2, 3, 4).reshape(bsz, n, heads, v.shape[-1])


def depthwise_conv(x, w, b, pad_left, pad_right):
    y = lax.conv_general_dilated(x, w[:, None, :].astype(x.dtype), window_strides=(1,),
                                 padding=[(pad_left, pad_right)],
                                 dimension_numbers=('NWC', 'WIO', 'NWC'),
                                 feature_group_count=x.shape[-1])
    return y + b.astype(x.dtype)


def linear_scan(a, b, h0):
    def combine(left, right):
        a_l, b_l = left
        a_r, b_r = right
        return a_l * a_r, a_r * b_l + b_r
    a_cum, b_cum = lax.associative_scan(combine, (a, b), axis=1)
    return a_cum * h0[:, None, :] + b_cum


def rglru_coeffs(u, w_a, b_a, w_x, b_x, lam):
    bsz, n, width = u.shape
    ub = u.reshape(bsz, n, LRU_BLOCKS, LRU_BLOCK_DIM)
    gate_a = jnp.einsum('bnhi,hij->bnhj', ub, w_a).reshape(bsz, n, width) + b_a
    gate_x = jnp.einsum('bnhi,hij->bnhj', ub, w_x).reshape(bsz, n, width) + b_x
    r = jax.nn.sigmoid(gate_a.astype(jnp.float32))
    i = jax.nn.sigmoid(gate_x.astype(jnp.float32))
    log_a = -LRU_C * r * jax.nn.softplus(-lam.astype(jnp.float32))
    a = jnp.exp(log_a)
    b = jnp.sqrt(-jnp.expm1(2.0 * log_a)) * (i * u.astype(jnp.float32))
    return a, b


def maybe_flip(t, reverse):
    return jnp.flip(t, axis=1) if reverse else t


def rglru_bidirectional(u_ctx, u_lat, w_a, b_a, w_x, b_x, lam):
    zero = jnp.zeros((u_lat.shape[0], u_lat.shape[-1]), jnp.float32)
    outs = []
    for d in range(2):
        rev = d == 1
        a_c, b_c = rglru_coeffs(maybe_flip(u_ctx, rev), w_a[d], b_a[d], w_x[d], b_x[d], lam[d])
        h_c = linear_scan(a_c, b_c, zero)
        a_l, b_l = rglru_coeffs(maybe_flip(u_lat, rev), w_a[d], b_a[d], w_x[d], b_x[d], lam[d])
        h_l = linear_scan(a_l, b_l, h_c[:, -1])
        outs.append((maybe_flip(h_c, rev), maybe_flip(h_l, rev)))
    return outs[0][0] + outs[1][0], outs[0][1] + outs[1][1]


def mla_up(cq, ckv, q_norm_g, kv_norm_g, w_uq, w_ukv):
    lead = cq.shape[:-1]
    q = (rms_norm(cq, q_norm_g) @ w_uq).reshape(*lead, MLA_HEADS, MLA_QK)
    kv = (rms_norm(ckv, kv_norm_g) @ w_ukv).reshape(*lead, MLA_HEADS, MLA_NOPE + MLA_V)
    return q, kv[..., :MLA_NOPE], kv[..., MLA_NOPE:]


def mla_rglru_mixer(h_ctx, h_lat, cos, sin, w_in, q_norm_g, kv_norm_g, w_uq, w_ukv,
                    conv_w, conv_b, w_a, b_a, w_x, b_x, lam, w_out, need_ctx):
    bsz, n_lat, _ = h_lat.shape
    n_ctx = h_ctx.shape[1]
    cq_c, ckv_c, kr_c, ux_c, ug_c = jnp.split(h_ctx @ w_in, EVEN_SPLITS, axis=-1)
    cq_l, ckv_l, kr_l, ux_l, ug_l = jnp.split(h_lat @ w_in, EVEN_SPLITS, axis=-1)

    q_c, kn_c, v_c = mla_up(cq_c, ckv_c, q_norm_g, kv_norm_g, w_uq, w_ukv)
    q_l, kn_l, v_l = mla_up(cq_l, ckv_l, q_norm_g, kv_norm_g, w_uq, w_ukv)
    k_c = jnp.concatenate([kn_c, jnp.broadcast_to(kr_c[:, :, None, :], (bsz, n_ctx, MLA_HEADS, MLA_ROPE))], axis=-1)
    kr_l = apply_rope_2d(kr_l, cos, sin)
    k_l = jnp.concatenate([kn_l, jnp.broadcast_to(kr_l[:, :, None, :], (bsz, n_lat, MLA_HEADS, MLA_ROPE))], axis=-1)
    q_l = jnp.concatenate([q_l[..., :MLA_NOPE], apply_rope_2d(q_l[..., MLA_NOPE:], cos[:, None], sin[:, None])], axis=-1)
    k_all = jnp.concatenate([k_c, k_l], axis=1)
    v_all = jnp.concatenate([v_c, v_l], axis=1)
    att_l = blocked_attend(q_l, k_all, v_all).reshape(bsz, n_lat, MLA_HEADS * MLA_V)

    u_c = depthwise_conv(ux_c, conv_w, conv_b, 2, 1)
    u_l = depthwise_conv(ux_l, conv_w, conv_b, 2, 1)
    y_c, y_l = rglru_bidirectional(u_c, u_l, w_a, b_a, w_x, b_x, lam)
    lru_l = (y_l * jax.nn.gelu(ug_l.astype(jnp.float32))).astype(h_lat.dtype)
    out_l = jnp.concatenate([att_l, lru_l], axis=-1) @ w_out
    if not need_ctx:
        return None, out_l
    att_c = attend(q_c, k_c, v_c).reshape(bsz, n_ctx, MLA_HEADS * MLA_V)
    lru_c = (y_c * jax.nn.gelu(ug_c.astype(jnp.float32))).astype(h_ctx.dtype)
    out_c = jnp.concatenate([att_c, lru_c], axis=-1) @ w_out
    return out_c, out_l


def hyena_filters(n, w1, b1, f1, w2, b2, f2, w3, decay):
    t = jnp.linspace(0.0, 1.0, n, dtype=jnp.float32)[:, None]
    w = (2.0 * math.pi / n) * jnp.arange(n, dtype=jnp.float32)[:, None]
    f = jnp.linspace(1e-4, HY_BANDS - 1, HY_BANDS, dtype=jnp.float32)[None, :]
    z = jnp.concatenate([t, jnp.cos(f * w), -jnp.sin(f * w)], axis=-1)
    a = jnp.sin(f1.astype(jnp.float32) * (z @ w1.astype(jnp.float32) + b1.astype(jnp.float32)))
    a = jnp.sin(f2.astype(jnp.float32) * (a @ w2.astype(jnp.float32) + b2.astype(jnp.float32)))
    h = (a @ w3.astype(jnp.float32)).reshape(n, 2 * HY_ORDER, HY_WIDTH)
    h = h * jnp.exp(-t[:, :, None] * jnp.abs(decay.astype(jnp.float32)))
    h = h.reshape(n, HY_ORDER, 2, HY_WIDTH)
    return h / (jnp.sum(jnp.abs(h), axis=(0, 2), keepdims=True) + 1e-6)


def two_sided_fftconv(u, h_fwd, h_bwd, skip):
    n = u.shape[1]
    u32 = u.astype(jnp.float32)
    spec_u = jnp.fft.rfft(u32, n=2 * n, axis=1)
    spec_h = jnp.fft.rfft(h_fwd, n=2 * n, axis=0) + jnp.conj(jnp.fft.rfft(h_bwd, n=2 * n, axis=0))
    y = jnp.fft.irfft(spec_u * spec_h[None], n=2 * n, axis=1)[:, :n]
    return (y + u32 * skip.astype(jnp.float32)).astype(u.dtype)


def hyena_operator(h, w_in, conv_w, conv_b, w1, b1, f1, w2, b2, f2, w3, decay, skip, w_out):
    n = h.shape[1]
    p = depthwise_conv(h @ w_in, conv_w, conv_b, 1, 1)
    v, x1, x2 = jnp.split(p, 3, axis=-1)
    filt = hyena_filters(n, w1, b1, f1, w2, b2, f2, w3, decay)
    z = v
    for order, gate in enumerate((x1, x2)):
        z = gate * two_sided_fftconv(z, filt[:, order, 0], filt[:, order, 1], skip[order])
    return z @ w_out


def grouped_moe(h, router_w, router_b, w1, w3, w2):
    s = jax.nn.sigmoid(jnp.einsum('bld,de->ble', h, router_w).astype(jnp.float32))
    sel = s + router_b.astype(jnp.float32)
    sel_g = sel.reshape(*sel.shape[:-1], N_GROUPS, EXPERTS_PER_GROUP)
    group_score = jnp.sum(lax.top_k(sel_g, 2)[0], axis=-1)
    g_idx = jnp.argmax(group_score, axis=-1)
    in_group = (jnp.arange(N_EXPERTS) // EXPERTS_PER_GROUP) == g_idx[..., None]
    _, e_idx = lax.top_k(jnp.where(in_group, sel, -jnp.inf), TOP_K)
    w_sel = jnp.take_along_axis(s, e_idx, axis=-1)
    w_sel = w_sel / jnp.sum(w_sel, axis=-1, keepdims=True)
    gates = jnp.sum(jax.nn.one_hot(e_idx, N_EXPERTS, dtype=jnp.float32) * w_sel[..., None], axis=-2).astype(h.dtype)
    y = jnp.zeros_like(h)
    for e in range(N_EXPERTS):
        act = jax.nn.silu(h @ w1[e]) * (h @ w3[e])
        y = y + gates[..., e:e + 1] * (act @ w2[e])
    return y


def setup_inputs(seed: int = 0) -> dict:
    key = jax.random.key(seed)
    keys = iter(jax.random.split(key, 64))

    def normal(shape, scale):
        return jax.random.normal(next(keys), shape, jnp.float32) * scale

    def gain(shape):
        return 1.0 + normal(shape, 0.02)

    d = D_MODEL
    u = jax.random.uniform(next(keys), (N_EVEN, 2, LRU_WIDTH), jnp.float32, 0.9, 0.999)
    a_base = u ** (1.0 / LRU_C)
    lru_lambda = jnp.log(a_base) - jnp.log1p(-a_base)
    decay_base = jnp.linspace(math.log(100.0) / 1.5, math.log(100.0) / 0.3, HY_WIDTH, dtype=jnp.float32)
    hy_decay = decay_base * (1.0 + normal((N_ODD, 2 * HY_ORDER, HY_WIDTH), 0.05))
    return {
        'x': normal((BATCH, SEQ, d), 1.0),
        'c': normal((BATCH, d), 1.0),
        'ctx': normal((BATCH, CTX_LEN, d), 1.0),
        'c_ctx': normal((d,), 1.0),
        'ada_w': normal((DEPTH, d, 6 * d), 0.5 * d ** -0.5),
        'ada_b': normal((DEPTH, 6 * d), 0.02),
        'norm1_g': gain((DEPTH, d)),
        'norm2_g': gain((DEPTH, d)),
        'final_g': gain((d,)),
        'ev_w_in': normal((N_EVEN, d, EVEN_IN), d ** -0.5),
        'mla_q_norm_g': gain((N_EVEN, MLA_Q_LORA)),
        'mla_kv_norm_g': gain((N_EVEN, MLA_KV_LORA)),
        'mla_w_uq': normal((N_EVEN, MLA_Q_LORA, MLA_HEADS * MLA_QK), MLA_Q_LORA ** -0.5),
        'mla_w_ukv': normal((N_EVEN, MLA_KV_LORA, MLA_HEADS * (MLA_NOPE + MLA_V)), MLA_KV_LORA ** -0.5),
        'lru_conv_w': normal((N_EVEN, LRU_CONV, LRU_WIDTH), LRU_CONV ** -0.5),
        'lru_conv_b': normal((N_EVEN, LRU_WIDTH), 0.02),
        'lru_w_a': normal((N_EVEN, 2, LRU_BLOCKS, LRU_BLOCK_DIM, LRU_BLOCK_DIM), LRU_BLOCK_DIM ** -0.5),
        'lru_b_a': normal((N_EVEN, 2, LRU_WIDTH), 0.02),
        'lru_w_x': normal((N_EVEN, 2, LRU_BLOCKS, LRU_BLOCK_DIM, LRU_BLOCK_DIM), LRU_BLOCK_DIM ** -0.5),
        'lru_b_x': normal((N_EVEN, 2, LRU_WIDTH), 0.02),
        'lru_lambda': lru_lambda,
        'ev_w_out': normal((N_EVEN, EVEN_MIX, d), EVEN_MIX ** -0.5),
        'od_w_in': normal((N_ODD, d, 3 * HY_WIDTH), d ** -0.5),
        'hy_conv_w': normal((N_ODD, HY_CONV, 3 * HY_WIDTH), HY_CONV ** -0.5),
        'hy_conv_b': normal((N_ODD, 3 * HY_WIDTH), 0.02),
        'hy_w1': normal((N_ODD, HY_EMB, HY_HIDDEN), HY_EMB ** -0.5),
        'hy_b1': normal((N_ODD, HY_HIDDEN), 0.1),
        'hy_freq1': 1.0 + normal((N_ODD, HY_HIDDEN), 0.05),
        'hy_w2': normal((N_ODD, HY_HIDDEN, HY_HIDDEN), HY_HIDDEN ** -0.5),
        'hy_b2': normal((N_ODD, HY_HIDDEN), 0.1),
        'hy_freq2': 1.0 + normal((N_ODD, HY_HIDDEN), 0.05),
        'hy_w3': normal((N_ODD, HY_HIDDEN, 2 * HY_ORDER * HY_WIDTH), HY_HIDDEN ** -0.5),
        'hy_decay': hy_decay,
        'hy_skip': normal((N_ODD, HY_ORDER, HY_WIDTH), 1.0),
        'od_w_out': normal((N_ODD, HY_WIDTH, d), HY_WIDTH ** -0.5),
        'router_w': normal((d, N_EXPERTS), d ** -0.5),
        'router_b': normal((N_EXPERTS,), 0.01),
        'moe_w1': normal((DEPTH, N_EXPERTS, d, EXPERT_FF), d ** -0.5),
        'moe_w3': normal((DEPTH, N_EXPERTS, d, EXPERT_FF), d ** -0.5),
        'moe_w2': normal((DEPTH, N_EXPERTS, EXPERT_FF, d), EXPERT_FF ** -0.5),
    }


def reference(x, c, ctx, c_ctx, ada_w, ada_b, norm1_g, norm2_g, final_g,
              ev_w_in, mla_q_norm_g, mla_kv_norm_g, mla_w_uq, mla_w_ukv,
              lru_conv_w, lru_conv_b, lru_w_a, lru_b_a, lru_w_x, lru_b_x, lru_lambda, ev_w_out,
              od_w_in, hy_conv_w, hy_conv_b, hy_w1, hy_b1, hy_freq1, hy_w2, hy_b2, hy_freq2,
              hy_w3, hy_decay, hy_skip, od_w_out,
              router_w, router_b, moe_w1, moe_w3, moe_w2):
    n_lat = x.shape[1]
    n_ctx = ctx.shape[1]
    rows = n_lat // GRID_W
    cos, sin = grid_rope_tables(rows)
    silu_c = jax.nn.silu(c)
    silu_cc = jax.nn.silu(c_ctx)
    xc = ctx
    for layer in range(DEPTH):
        need_ctx = layer < DEPTH - 1
        is_even = layer % 2 == 0
        idx = layer // 2
        mod = (silu_c @ ada_w[layer] + ada_b[layer])[:, None, :]
        sh1, sc1, g1, sh2, sc2, g2 = jnp.split(mod, 6, axis=-1)
        h_lat = modulate(rms_norm(x, norm1_g[layer]), sh1, sc1)
        h_ctx = None
        if need_ctx or is_even:
            mod_c = silu_cc @ ada_w[layer] + ada_b[layer]
            csh1, csc1, cg1, csh2, csc2, cg2 = jnp.split(mod_c, 6, axis=-1)
            h_ctx = modulate(rms_norm(xc, norm1_g[layer]), csh1, csc1)
        if is_even:
            o_ctx, o_lat = mla_rglru_mixer(h_ctx, h_lat, cos, sin, ev_w_in[idx], mla_q_norm_g[idx],
                                           mla_kv_norm_g[idx], mla_w_uq[idx], mla_w_ukv[idx],
                                           lru_conv_w[idx], lru_conv_b[idx], lru_w_a[idx], lru_b_a[idx],
                                           lru_w_x[idx], lru_b_x[idx], lru_lambda[idx], ev_w_out[idx],
                                           need_ctx)
        else:
            hy_params = (od_w_in[idx], hy_conv_w[idx], hy_conv_b[idx], hy_w1[idx], hy_b1[idx],
                         hy_freq1[idx], hy_w2[idx], hy_b2[idx], hy_freq2[idx], hy_w3[idx],
                         hy_decay[idx], hy_skip[idx], od_w_out[idx])
            o_lat = hyena_operator(h_lat, *hy_params)
            o_ctx = hyena_operator(h_ctx, *hy_params) if need_ctx else None
        x = x + g1 * o_lat
        h_lat = modulate(rms_norm(x, norm2_g[layer]), sh2, sc2)
        if need_ctx:
            xc = xc + cg1 * o_ctx
            h_ctx = modulate(rms_norm(xc, norm2_g[layer]), csh2, csc2)
            m = grouped_moe(jnp.concatenate([h_ctx, h_lat], axis=1), router_w, router_b,
                            moe_w1[layer], moe_w3[layer], moe_w2[layer])
            xc = xc + cg2 * m[:, :n_ctx]
            m_lat = m[:, n_ctx:]
        else:
            m_lat = grouped_moe(h_lat, router_w, router_b, moe_w1[layer], moe_w3[layer], moe_w2[layer])
        x = x + g2 * m_lat
    return rms_norm(x, final_g)
```

```cpp
#include <hip/hip_runtime.h>
#include <cstdio>
#include <cstdint>

#ifndef MK_ONE_LAUNCH
#define MK_ONE_LAUNCH 1
#endif

#define LAS __attribute__((address_space(3)))
#define GAS __attribute__((address_space(1)))
typedef unsigned short bf16;
typedef short bf16x8 __attribute__((ext_vector_type(8)));
typedef short s16x4 __attribute__((ext_vector_type(4)));
typedef float f32x2 __attribute__((ext_vector_type(2)));
typedef float f32x4 __attribute__((ext_vector_type(4)));
typedef float f32x16 __attribute__((ext_vector_type(16)));
typedef unsigned u32x2 __attribute__((ext_vector_type(2)));
typedef unsigned u32x4 __attribute__((ext_vector_type(4)));
#define LDS_WAIT() asm volatile("s_waitcnt lgkmcnt(0)" ::: "memory")
#define VM_WAIT() asm volatile("s_waitcnt vmcnt(0)" ::: "memory")

__device__ __forceinline__ unsigned f2bf(float f) { unsigned u = __builtin_bit_cast(unsigned, f); return (u + 0x7fffu + ((u >> 16) & 1u)) >> 16; }
__device__ __forceinline__ unsigned pk2(float lo, float hi) { return f2bf(lo) | (f2bf(hi) << 16); }
__device__ __forceinline__ float bf2f(unsigned b) { return __builtin_bit_cast(float, b << 16); }
__device__ __forceinline__ float bflo(unsigned w) { return __builtin_bit_cast(float, w << 16); }
__device__ __forceinline__ float bfhi(unsigned w) { return __builtin_bit_cast(float, w & 0xffff0000u); }
__device__ __forceinline__ float wave_sum(float v) {
#pragma unroll
    for (int o = 1; o < 64; o <<= 1) v += __shfl_xor(v, o);
    return v;
}
__device__ __forceinline__ float sigm(float x) { return 1.f / (1.f + expf(-x)); }

namespace pg8 {
#define PG8_LAS __attribute__((address_space(3)))
typedef unsigned short bf16_t;
constexpr int BM = 256, BK = 64, HALF = 128, HTB = HALF * BK * 2, STAGE_BYTES = 8 * HTB, NXCD = 8, WGM = 8;
__host__ __device__ __forceinline__ int lds_byte(int r, int c) { const int st = (r >> 4) * 2 + (c >> 5), rr = r & 15, cc = c & 31, ob = rr * 64 + cc * 2; return st * 1024 + (ob ^ (((ob >> 9) & 1) << 5)); }
__host__ __device__ __forceinline__ void stage_rc(int b, int& R, int& C) { const int st = b / 1024, sb = b % 1024, swz = sb ^ (((sb >> 9) & 1) << 5); R = (st >> 1) * 16 + swz / 64; C = (st & 1) * 32 + (swz % 64) / 2; }
__host__ __device__ __forceinline__ int perm32(int rho) { const int n = rho >> 4, i = rho & 15; return 8 * (i >> 2) + 4 * n + (i & 3); }

struct Unit { int pm, pn, bz; };
struct Gemm { const bf16_t* A; const bf16_t* Bt; int lda, ldb, K; size_t bz_stride; };

struct StaticOrder {
    int nM, nN, nwg, G, c;
    __host__ __device__ void init(int nM_, int nN_, int G_, int c_) { nM = nM_; nN = nN_; nwg = nM * nN; G = G_; c = c_; }
    __host__ __device__ bool next(int i, Unit& u) const {
        const long L = (long)i * G + c; if (L >= nwg) return false;
        int wgid = (int)L; { const int q = nwg / NXCD, r = nwg % NXCD, xcd = wgid % NXCD, off = wgid / NXCD; wgid = (xcd < r ? xcd * (q + 1) : r * (q + 1) + (xcd - r) * q) + off; }
        const int nig = WGM * nN, gid = wgid / nig, fm = gid * WGM, gsz = (nM - fm) < WGM ? (nM - fm) : WGM;
        u.pm = fm + ((wgid % nig) % gsz); u.pn = (wgid % nig) / gsz; u.bz = 0; return true;
    }
    __device__ __forceinline__ void a_ready(const Unit&) const {}
    __device__ __forceinline__ void done(const Unit&) const {}
};
struct MoeOrder {
    int nM, G, c; const int* tile_e;
    __device__ bool next(int i, Unit& u) const {
        const long L = (long)i * G + c; if (L >= (long)nM * 4) return false;
        u.pm = (int)(L >> 2); u.pn = (int)(L & 3); u.bz = tile_e[u.pm]; return true;
    }
    __device__ __forceinline__ void a_ready(const Unit&) const {}
    __device__ __forceinline__ void done(const Unit&) const {}
};

__device__ __forceinline__ unsigned cvt_pk_bf16(float lo, float hi) { unsigned r; asm volatile("v_cvt_pk_bf16_f32 %0, %1, %2" : "=v"(r) : "v"(lo), "v"(hi)); return r; }

template <class Epi, class Sched, bool ALIGN_EPI = false, bool SP2 = false>
__device__ __forceinline__ void gemm_phase(PG8_LAS unsigned char* lds, const Gemm g, const Sched& S, const Epi& E) {
    const int tid = threadIdx.x, wid = __builtin_amdgcn_readfirstlane(tid >> 6), lane = tid & 63, wr = wid >> 2, wc = wid & 3, fr = lane & 15, fq = lane >> 4;
    const int K = g.K, nt = K / BK;
    unsigned voffA[2], voffB[2];
#pragma unroll
    for (int i = 0; i < 2; ++i) { int R, C; stage_rc(tid * 16 + i * 8192, R, C); const int Rb = Epi::PERM ? ((R & ~31) + perm32(R & 31)) : R;
        voffA[i] = (unsigned)(R * g.lda + C) * 2u; voffB[i] = (unsigned)(Rb * g.ldb + C) * 2u; }
    const size_t kstep = (size_t)(BK * 2);
    const size_t hstepA = (size_t)HALF * g.lda * 2, hstepB = (size_t)HALF * g.ldb * 2;
    const size_t tstepA = 2 * hstepA, tstepB = 2 * hstepB;
    const unsigned ldsw = (unsigned)wid * 1024u;
    const int aoff = lds_byte(wr * 64 + fr, fq * 8), boff = lds_byte(wc * 32 + fr, fq * 8);
#define PG8_SA(b, h) (((b) * 2 + (h)) * HTB)
#define PG8_SB(b, h) ((4 + (b) * 2 + (h)) * HTB)
#define PG8_STAGE(bufoff, gbase, voff) do { _Pragma("unroll") for (int _i = 0; _i < 2; ++_i) \
        __builtin_amdgcn_global_load_lds((const unsigned*)((const char*)(gbase) + (voff)[_i]), (PG8_LAS unsigned*)(lds + (bufoff) + ldsw + _i * 8192), 16, 0, 0); } while (0)
#define PG8_LDA(dst, b, h) do { _Pragma("unroll") for (int m = 0; m < 4; ++m) _Pragma("unroll") for (int k = 0; k < 2; ++k) dst[m][k] = *(const PG8_LAS bf16x8*)(lds + PG8_SA(b, h) + aoff + m * 2048 + k * 1024); } while (0)
#define PG8_LDB(dst, b, h) do { _Pragma("unroll") for (int n = 0; n < 2; ++n) _Pragma("unroll") for (int k = 0; k < 2; ++k) dst[n][k] = *(const PG8_LAS bf16x8*)(lds + PG8_SB(b, h) + boff + n * 2048 + k * 1024); } while (0)
#define PG8_MMA(ai, bj, At, Bt) do { __builtin_amdgcn_s_setprio(1); _Pragma("unroll") for (int m = 0; m < 4; ++m) _Pragma("unroll") for (int n = 0; n < 2; ++n) _Pragma("unroll") for (int k = 0; k < 2; ++k) \
        acc[ai][bj][m][n] = __builtin_amdgcn_mfma_f32_16x16x32_bf16(Bt[n][k], At[m][k], acc[ai][bj][m][n], 0, 0, 0); __builtin_amdgcn_s_setprio(0); } while (0)
#define PG8_WAIT_V(n) asm volatile("s_waitcnt vmcnt(" #n ")" ::: "memory")
#define PG8_WAIT_L(n) asm volatile("s_waitcnt lgkmcnt(" #n ")" ::: "memory")
#define PG8_BAR __builtin_amdgcn_s_barrier()
#define PG8_SCHED __builtin_amdgcn_sched_barrier(0)
    Unit cur, nxt; int ui = 0;
    if (!S.next(0, cur)) return;
    f32x4 acc[2][2][4][2];
#pragma unroll
    for (int a = 0; a < 2; ++a)
#pragma unroll
        for (int b = 0; b < 2; ++b)
#pragma unroll
            for (int m = 0; m < 4; ++m)
#pragma unroll
                for (int n = 0; n < 2; ++n) acc[a][b][m][n] = (f32x4){0.f, 0.f, 0.f, 0.f};
    bf16x8 At[4][2], B0[2][2], B1[2][2];
    const char* cA = (const char*)g.A + (size_t)cur.pm * tstepA; const char* cB = (const char*)g.Bt + (size_t)cur.bz * g.bz_stride + (size_t)cur.pn * tstepB;
    S.a_ready(cur);
    if constexpr (SP2) {
        PG8_STAGE(PG8_SB(0, 0), cB, voffB); PG8_STAGE(PG8_SB(0, 1), cB + hstepB, voffB); PG8_STAGE(PG8_SA(0, 0), cA, voffA); PG8_STAGE(PG8_SA(0, 1), cA + hstepA, voffA);
        if (wr == 1) PG8_BAR;
        PG8_WAIT_V(2); PG8_BAR;
        PG8_STAGE(PG8_SB(1, 0), cB + kstep, voffB); PG8_STAGE(PG8_SA(1, 0), cA + kstep, voffA); PG8_STAGE(PG8_SB(1, 1), cB + hstepB + kstep, voffB);
        PG8_WAIT_V(6); PG8_BAR;
    } else {
        PG8_STAGE(PG8_SB(0, 0), cB, voffB); PG8_STAGE(PG8_SA(0, 0), cA, voffA); PG8_STAGE(PG8_SB(0, 1), cB + hstepB, voffB); PG8_STAGE(PG8_SA(0, 1), cA + hstepA, voffA);
        if (wr == 1) PG8_BAR;
        PG8_WAIT_V(4); PG8_BAR;
        PG8_STAGE(PG8_SB(1, 0), cB + kstep, voffB); PG8_STAGE(PG8_SA(1, 0), cA + kstep, voffA); PG8_STAGE(PG8_SB(1, 1), cB + hstepB + kstep, voffB);
        PG8_WAIT_V(6); PG8_BAR;
    }
    for (;;) {
        const bool has_next = S.next(ui + 1, nxt);
        const char* nA = has_next ? (const char*)g.A + (size_t)nxt.pm * tstepA : cA;
        const char* nB = has_next ? (const char*)g.Bt + (size_t)nxt.bz * g.bz_stride + (size_t)nxt.pn * tstepB : cB;
#pragma unroll 1
        for (int t = 0; t < nt; t += 2) {
            const bool last = (t == nt - 2);
            const char* a1 = cA + (size_t)(t + 1) * kstep;
            const char* a2 = last ? nA : cA + (size_t)(t + 2) * kstep; const char* b2 = last ? nB : cB + (size_t)(t + 2) * kstep;
            const char* a3 = a2 + kstep; const char* b3 = b2 + kstep;
            if (last && has_next) S.a_ready(nxt);
            if constexpr (SP2) {
            PG8_LDB(B0, 0, 0); PG8_LDB(B1, 0, 1); PG8_SCHED; PG8_LDA(At, 0, 0); PG8_STAGE(PG8_SA(1, 1), a1 + hstepA, voffA);
            PG8_WAIT_V(8); PG8_WAIT_L(0); PG8_BAR; PG8_MMA(0, 0, At, B0); PG8_MMA(0, 1, At, B1); PG8_BAR; PG8_SCHED;
            PG8_LDA(At, 0, 1); PG8_STAGE(PG8_SB(0, 0), b2, voffB); PG8_STAGE(PG8_SB(0, 1), b2 + hstepB, voffB); PG8_STAGE(PG8_SA(0, 0), a2, voffA);
            PG8_WAIT_V(8); PG8_WAIT_L(0); PG8_BAR; PG8_MMA(1, 0, At, B0); PG8_MMA(1, 1, At, B1); PG8_BAR; PG8_SCHED;
            PG8_LDB(B0, 1, 0); PG8_LDB(B1, 1, 1); PG8_SCHED; PG8_LDA(At, 1, 0); PG8_STAGE(PG8_SA(0, 1), a2 + hstepA, voffA);
            PG8_WAIT_V(8); PG8_WAIT_L(0); PG8_BAR; PG8_MMA(0, 0, At, B0); PG8_MMA(0, 1, At, B1); PG8_BAR; PG8_SCHED;
            PG8_LDA(At, 1, 1); PG8_STAGE(PG8_SB(1, 0), b3, voffB); PG8_STAGE(PG8_SB(1, 1), b3 + hstepB, voffB); PG8_STAGE(PG8_SA(1, 0), a3, voffA);
            PG8_WAIT_V(8); PG8_WAIT_L(0); PG8_BAR; PG8_MMA(1, 0, At, B0); PG8_MMA(1, 1, At, B1); PG8_BAR; PG8_SCHED;
            } else {
            PG8_LDB(B0, 0, 0); PG8_SCHED; PG8_LDA(At, 0, 0); PG8_STAGE(PG8_SA(1, 1), a1 + hstepA, voffA);
            PG8_WAIT_L(8); PG8_BAR; PG8_WAIT_L(0); PG8_MMA(0, 0, At, B0); PG8_BAR; PG8_SCHED;
            PG8_LDB(B1, 0, 1); PG8_STAGE(PG8_SB(0, 0), b2, voffB);
            PG8_BAR; PG8_WAIT_L(0); PG8_MMA(0, 1, At, B1); PG8_BAR;
            PG8_LDA(At, 0, 1); PG8_STAGE(PG8_SA(0, 0), a2, voffA);
            PG8_BAR; PG8_WAIT_L(0); PG8_MMA(1, 0, At, B0); PG8_BAR; PG8_SCHED;
            PG8_STAGE(PG8_SB(0, 1), b2 + hstepB, voffB);
            PG8_WAIT_V(6); PG8_BAR; PG8_MMA(1, 1, At, B1); PG8_BAR;
            PG8_LDB(B0, 1, 0); PG8_SCHED; PG8_LDA(At, 1, 0); PG8_STAGE(PG8_SA(0, 1), a2 + hstepA, voffA);
            PG8_WAIT_L(8); PG8_BAR; PG8_WAIT_L(0); PG8_MMA(0, 0, At, B0); PG8_BAR; PG8_SCHED;
            PG8_LDB(B1, 1, 1); PG8_STAGE(PG8_SB(1, 0), b3, voffB);
            PG8_BAR; PG8_WAIT_L(0); PG8_MMA(0, 1, At, B1); PG8_BAR;
            PG8_LDA(At, 1, 1); PG8_STAGE(PG8_SA(1, 0), a3, voffA);
            PG8_BAR; PG8_WAIT_L(0); PG8_MMA(1, 0, At, B0); PG8_BAR; PG8_SCHED;
            PG8_STAGE(PG8_SB(1, 1), b3 + hstepB, voffB);
            PG8_WAIT_V(6); PG8_BAR; PG8_MMA(1, 1, At, B1); PG8_BAR;
            }
        }
        if constexpr (ALIGN_EPI) { if (wr == 0) PG8_BAR; }
        E(acc, cur, wr, wc, fr, fq); S.done(cur);
        if (!has_next) break;
#pragma unroll
        for (int a = 0; a < 2; ++a)
#pragma unroll
            for (int b = 0; b < 2; ++b)
#pragma unroll
                for (int m = 0; m < 4; ++m)
#pragma unroll
                    for (int n = 0; n < 2; ++n) acc[a][b][m][n] = (f32x4){0.f, 0.f, 0.f, 0.f};
        cur = nxt; cA = nA; cB = nB; ++ui;
        if constexpr (ALIGN_EPI) { if (wr == 1) PG8_BAR; }
    }
    PG8_WAIT_V(0);
    if constexpr (!ALIGN_EPI) { if (wr == 0) PG8_BAR; }
    PG8_BAR;
#undef PG8_SA
#undef PG8_SB
#undef PG8_STAGE
#undef PG8_LDA
#undef PG8_LDB
#undef PG8_MMA
#undef PG8_WAIT_V
#undef PG8_WAIT_L
#undef PG8_BAR
#undef PG8_SCHED
}
}
#define GP_ALIGN true
#define GP_SP2 true

constexpr int DM = 1024, NB = 8, SEQ = 4096, CTXL = 256, TC = SEQ + CTXL  ;
constexpr int M0 = NB * TC  , M1 = NB * SEQ  ;
constexpr int NEXP = 16;
constexpr float RMS_EPS = 1e-6f;
constexpr int NCHUNK = 256;
constexpr int MAXTILES = 288;
constexpr int LCH = 68;

enum { I_X = 0, I_C, I_CTX, I_CCTX, I_ADAW, I_ADAB, I_N1G, I_N2G, I_FING, I_EVWIN, I_QNG, I_KVNG, I_WUQ, I_WUKV, I_LCW, I_LCB, I_LWA, I_LBA, I_LWX, I_LBX, I_LLAM, I_EVWOUT,
       I_ODWIN, I_HCW, I_HCB, I_HW1, I_HB1, I_HF1, I_HW2, I_HB2, I_HF2, I_HW3, I_HDEC, I_HSKIP, I_ODWOUT, I_RW, I_RB, I_MW1, I_MW3, I_MW2, N_IN };

constexpr size_t MiB = 1u << 20;
constexpr size_t WS_CTL = 0, CTL_ZERO_BYTES = 1 * MiB;
constexpr size_t WS_MOD = 1 * MiB;
constexpr size_t WS_RQ = WS_MOD + 2 * 9 * 6144 * 4;
constexpr size_t WS_RKV = WS_RQ + (size_t)M0 * 4;
constexpr size_t WS_A2 = 2 * MiB;
constexpr size_t WS_ROUTE_E = 3 * MiB;
constexpr size_t WS_ROUTE_W = WS_ROUTE_E + (size_t)M0 * 4;
constexpr size_t WS_ROUTE_S = WS_ROUTE_W + (size_t)M0 * 8;
constexpr size_t WS_CNT = WS_ROUTE_S + (size_t)M0 * 8;
constexpr size_t WS_TILEE = WS_CNT + 256 * 16 * 4;
static_assert(WS_TILEE + (MAXTILES + 64) * 4 <= 4 * MiB, "route region");
constexpr size_t WS_CP = 4 * MiB;
constexpr size_t WS_CS = WS_CP + (size_t)2 * 8 * LCH * 512 * 4;
static_assert(WS_CS + (size_t)2 * 8 * LCH * 512 * 4 <= 10 * MiB, "lru carries");
constexpr size_t WS_WIN = 10 * MiB;
constexpr size_t WS_WUQ = 14 * MiB;
constexpr size_t WS_WUKV = 15 * MiB;
constexpr size_t WS_WOUT = 16 * MiB;
constexpr size_t WS_WHIN = 18 * MiB;
constexpr size_t WS_WHOUT = 24 * MiB;
constexpr size_t WS_WG = 26 * MiB;
constexpr size_t WS_W13 = 27 * MiB;
constexpr size_t WS_W2 = 91 * MiB;
constexpr size_t WS_RH = 124 * MiB;
constexpr size_t WS_XC = 192 * MiB;
constexpr size_t WS_R2 = 200 * MiB;
constexpr size_t WS_CQ = WS_R2;
constexpr size_t WS_CKV = WS_R2 + 26 * MiB;
constexpr size_t WS_UX = WS_R2 + 43 * MiB;
constexpr size_t WS_UG = WS_R2 + 77 * MiB;
constexpr size_t WS_Q = WS_R2 + 111 * MiB;
constexpr size_t WS_K = WS_R2 + 162 * MiB;
constexpr size_t WS_V = WS_R2 + 213 * MiB;
constexpr size_t WS_HPERM = WS_R2;
constexpr size_t WS_ACT = WS_R2 + 144 * MiB;
constexpr size_t WS_PT = WS_R2;
constexpr size_t WS_ZT = WS_R2 + 192 * MiB;
constexpr size_t WS_Z = WS_R2;
constexpr size_t WS_HSPEC = 456 * MiB;
constexpr size_t WS_END = 488 * MiB;
static_assert(WS_V + (size_t)M0 * 512 * 2 <= WS_HSPEC && WS_ZT + (size_t)1024 * 32768 * 2 <= WS_HSPEC && WS_ACT + (size_t)73728 * 512 * 2 <= WS_HSPEC, "ws map");

constexpr int CW_TMO = 0, CW_BAR = 4096;

constexpr int RING_BYTES = 131072, LDS_BYTES = 155648, LDSCTL_OFF = LDS_BYTES - 1024, MISC_OFF = LDSCTL_OFF + 320;

#define XB_TMO      128
#define XB_XCNT(j)  (256  + 64 * (j))
#define XB_XSUB(j)  (1280 + 64 * (j))
#define XB_XGEN(j)  (2304 + 64 * (j))
#define XB_TOP      3328
#define XB_TOPGEN   3392
#define XCD_BAR_WORDS 3456
#define XB_SPIN_CAP (1u << 18)
__device__ __forceinline__ unsigned xb_ld(unsigned* p)              { return __hip_atomic_load(p, __ATOMIC_RELAXED, __HIP_MEMORY_SCOPE_AGENT); }
__device__ __forceinline__ unsigned xb_add(unsigned* p, unsigned v) { return __hip_atomic_fetch_add(p, v, __ATOMIC_RELAXED, __HIP_MEMORY_SCOPE_AGENT); }
__device__ __forceinline__ unsigned xb_xcc_id() { return (unsigned)__builtin_amdgcn_s_getreg((3 << 11) | 20) & 0xFu; }
#define XB_SPIN(cond, bar) do { unsigned _sp = 0; while (cond) { __builtin_amdgcn_s_sleep(1); \
    if ((++_sp & 255u) == 0u) { if (xb_ld(&(bar)[XB_TMO])) break; if (_sp > XB_SPIN_CAP) { atomicAdd(&(bar)[XB_TMO], 1u); break; } } } } while (0)
struct XcdBarrier { unsigned* bar; unsigned x; volatile LAS unsigned* st; };
__device__ __forceinline__ XcdBarrier xcd_barrier_post(unsigned* bar, volatile LAS unsigned* st) {
    XcdBarrier b; b.bar = bar; b.x = xb_xcc_id(); b.st = st;
    if (threadIdx.x == 0) (void)xb_add(&bar[XB_XCNT(b.x)], 1u);
    return b;
}
__device__ __forceinline__ void xcd_barrier_complete(unsigned* bar, unsigned x, unsigned& nloc, unsigned& nx) {
    const unsigned G = gridDim.x * gridDim.y * gridDim.z;
    unsigned sum, cnt, mine, sp = 0u;
    for (;;) {
        sum = 0u; cnt = 0u; mine = 0u;
#pragma unroll
        for (unsigned j = 0; j < 16; ++j) { const unsigned c = xb_ld(&bar[XB_XCNT(j)]); sum += c; cnt += (c > 0u) ? 1u : 0u; mine = (j == x) ? c : mine; }
        if (sum == G) break;
        __builtin_amdgcn_s_sleep(1);
        if ((++sp & 255u) == 0u) { if (xb_ld(&bar[XB_TMO])) break; if (sp > XB_SPIN_CAP) { atomicAdd(&bar[XB_TMO], 1u); break; } }
    }
    nloc = mine > 0u ? mine : 1u; nx = cnt > 0u ? cnt : 1u;
}
__device__ __forceinline__ void xcd_barrier(const XcdBarrier& b) {
    asm volatile("s_waitcnt vmcnt(0)" ::: "memory");
    __syncthreads();
    if (threadIdx.x == 0) {
        unsigned* bar = b.bar;
        __builtin_amdgcn_s_waitcnt(0);
        unsigned nloc = b.st[0], nx = b.st[1];
        if (nloc == 0u) { xcd_barrier_complete(bar, b.x, nloc, nx); b.st[0] = nloc; b.st[1] = nx; }
        const unsigned old = xb_add(&bar[XB_XSUB(b.x)], 1u);
        const unsigned gen = old / nloc;
        if (old + 1u == (gen + 1u) * nloc) {
            __builtin_amdgcn_fence(__ATOMIC_RELEASE, "agent");
            asm volatile("s_waitcnt vmcnt(0)" ::: "memory");
            const unsigned og = xb_add(&bar[XB_TOP], 1u);
            const unsigned tg = og / nx;
            if (og + 1u == (tg + 1u) * nx) xb_add(&bar[XB_TOPGEN], 1u);
            else XB_SPIN(xb_ld(&bar[XB_TOPGEN]) == tg, bar);
            __builtin_amdgcn_fence(__ATOMIC_ACQUIRE, "agent");
            xb_add(&bar[XB_XGEN(b.x)], 1u);
            asm volatile("s_waitcnt vmcnt(0)" ::: "memory");
        } else {
            XB_SPIN(xb_ld(&bar[XB_XGEN(b.x)]) == gen, bar);
            __builtin_amdgcn_fence(__ATOMIC_ACQUIRE, "agent");
            asm volatile("s_waitcnt vmcnt(0)" ::: "memory");
        }
    }
    __syncthreads();
}

struct Params { const float* in[N_IN]; float* out; unsigned char* ws; int ph_lo, ph_hi; };

__device__ __forceinline__ u32x4 pack8(const f32x4 a, const f32x4 b) {
    u32x4 w; w.x = pg8::cvt_pk_bf16(a[0], a[1]); w.y = pg8::cvt_pk_bf16(a[2], a[3]); w.z = pg8::cvt_pk_bf16(b[0], b[1]); w.w = pg8::cvt_pk_bf16(b[2], b[3]); return w;
}
__device__ __forceinline__ void rope8(f32x4& v0, f32x4& v1, int fq, int tt  , bool on) {
    const int axis = fq >> 1, half = fq & 1; const float pos = (float)(axis == 0 ? (tt >> 6) : (tt & 63)) * 0.15915494309189535f;
    constexpr float IF[8] = {1.0f, 0.316227766f, 0.1f, 0.0316227766f, 0.01f, 0.00316227766f, 0.001f, 0.000316227766f};
#pragma unroll
    for (int i = 0; i < 4; ++i) {
        { const float x = v0[i], other = __shfl_xor(x, 16); const float sn = __builtin_amdgcn_sinf(pos * IF[i]), cs = __builtin_amdgcn_cosf(pos * IF[i]);
          const float r = half == 0 ? x * cs - other * sn : other * sn + x * cs; v0[i] = on ? r : x; }
        { const float x = v1[i], other = __shfl_xor(x, 16); const float sn = __builtin_amdgcn_sinf(pos * IF[4 + i]), cs = __builtin_amdgcn_cosf(pos * IF[4 + i]);
          const float r = half == 0 ? x * cs - other * sn : other * sn + x * cs; v1[i] = on ? r : x; }
    }
}

struct EpiIn {
    static constexpr bool PERM = true;
    bf16 *CQ, *CKV, *UX, *UG, *KB;
    __device__ __forceinline__ void operator()(const f32x4 (&acc)[2][2][4][2], const pg8::Unit& u, int wr, int wc, int fr, int fq) const {
        const int row0 = u.pm * 256 + wr * 64 + fr;
        const bool is_ctx = (u.pm % 17) == 0; const int bb = u.pm / 17;
#pragma unroll
        for (int bj = 0; bj < 2; ++bj) {
            const int blk = u.pn * 2 + bj;
            if (blk < 13) {
                bf16* dst; int ld, cb;
                if (blk < 3) { dst = CQ; ld = 384; cb = blk * 128; }
                else if (blk < 5) { dst = CKV; ld = 256; cb = (blk - 3) * 128; }
                else if (blk < 9) { dst = UX; ld = 512; cb = (blk - 5) * 128; }
                else { dst = UG; ld = 512; cb = (blk - 9) * 128; }
                const int col = cb + wc * 32 + 8 * fq;
#pragma unroll
                for (int ai = 0; ai < 2; ++ai)
#pragma unroll
                    for (int m = 0; m < 4; ++m) { const int row = row0 + ai * 128 + m * 16;
                        *(u32x4*)(dst + (size_t)row * ld + col) = pack8(acc[ai][bj][m][0], acc[ai][bj][m][1]); }
            } else if (wc == 0) {
#pragma unroll
                for (int ai = 0; ai < 2; ++ai)
#pragma unroll
                    for (int m = 0; m < 4; ++m) { const int row = row0 + ai * 128 + m * 16; const int tt = row - bb * TC - CTXL;
                        f32x4 v0 = acc[ai][bj][m][0], v1 = acc[ai][bj][m][1];
                        rope8(v0, v1, fq, tt, !is_ctx);
                        const u32x4 w = pack8(v0, v1);
#pragma unroll
                        for (int h = 0; h < 8; ++h) *(u32x4*)(KB + (size_t)row * 768 + h * 96 + 64 + 8 * fq) = w; }
            }
        }
    }
};
struct EpiQ {
    static constexpr bool PERM = true;
    bf16* Q; const float* rq;
    __device__ __forceinline__ void operator()(const f32x4 (&acc)[2][2][4][2], const pg8::Unit& u, int wr, int wc, int fr, int fq) const {
        const int row0 = u.pm * 256 + wr * 64 + fr;
#pragma unroll
        for (int ai = 0; ai < 2; ++ai)
#pragma unroll
            for (int m = 0; m < 4; ++m) { const int row = row0 + ai * 128 + m * 16; const float s = rq[row];
#pragma unroll
                for (int bj = 0; bj < 2; ++bj) {
                    const u32x4 w = pack8(acc[ai][bj][m][0] * s, acc[ai][bj][m][1] * s);
                    int off;
                    if (u.pn < 2) { const int c = u.pn * 256 + bj * 128 + wc * 32 + 8 * fq; off = (c >> 6) * 96 + (c & 63); }
                    else off = (4 * bj + wc) * 96 + 64 + 8 * fq;
                    *(u32x4*)(Q + (size_t)row * 768 + off) = w;
                } }
    }
};
struct EpiKV {
    static constexpr bool PERM = true;
    bf16 *K, *V; const float* rkv;
    __device__ __forceinline__ void operator()(const f32x4 (&acc)[2][2][4][2], const pg8::Unit& u, int wr, int wc, int fr, int fq) const {
        const int row0 = u.pm * 256 + wr * 64 + fr;
#pragma unroll
        for (int ai = 0; ai < 2; ++ai)
#pragma unroll
            for (int m = 0; m < 4; ++m) { const int row = row0 + ai * 128 + m * 16; const float s = rkv[row];
#pragma unroll
                for (int bj = 0; bj < 2; ++bj) { const int h = u.pn * 2 + bj;
                    const u32x4 w = pack8(acc[ai][bj][m][0] * s, acc[ai][bj][m][1] * s);
                    if (wc < 2) *(u32x4*)(K + (size_t)row * 768 + h * 96 + wc * 32 + 8 * fq) = w;
                    else *(u32x4*)(V + (size_t)row * 512 + h * 64 + (wc - 2) * 32 + 8 * fq) = w; } }
    }
};
template <int LAYER> struct EpiRes {
    static constexpr bool PERM = false;
    const float *x, *ctx, *mod; float *out, *xc;
    __device__ __forceinline__ void operator()(const f32x4 (&acc)[2][2][4][2], const pg8::Unit& u, int wr, int wc, int fr, int fq) const {
        const int row0 = u.pm * 256 + wr * 64 + fr, col0 = u.pn * 256 + wc * 32 + 4 * fq;
        const bool is_ctx = LAYER == 0 && (u.pm % 17) == 0; const int bb = LAYER == 0 ? u.pm / 17 : u.pm / 16;
        const float* g = mod + (size_t)(LAYER * 9 + (is_ctx ? 8 : bb)) * 6144 + 2048;
        f32x4 gv[2][2];
#pragma unroll
        for (int bj = 0; bj < 2; ++bj)
#pragma unroll
            for (int n = 0; n < 2; ++n) gv[bj][n] = *(const f32x4*)(g + col0 + bj * 128 + n * 16);
#pragma unroll
        for (int ai = 0; ai < 2; ++ai)
#pragma unroll
            for (int m = 0; m < 4; ++m) { const int row = row0 + ai * 128 + m * 16;
                const float* res; float* dst;
                if (LAYER == 0) { const int t = row - bb * TC;
                    if (is_ctx) { res = ctx + (size_t)(bb * CTXL + t) * DM; dst = xc + (size_t)(bb * CTXL + t) * DM; }
                    else { res = x + (size_t)(bb * SEQ + t - CTXL) * DM; dst = out + (size_t)(bb * SEQ + t - CTXL) * DM; } }
                else { res = out + (size_t)row * DM; dst = out + (size_t)row * DM; }
#pragma unroll
                for (int bj = 0; bj < 2; ++bj)
#pragma unroll
                    for (int n = 0; n < 2; ++n) { const int c = col0 + bj * 128 + n * 16;
                        *(f32x4*)(dst + c) = *(const f32x4*)(res + c) + gv[bj][n] * acc[ai][bj][m][n]; } }
    }
};
struct EpiMoe1 {
    static constexpr bool PERM = true;
    bf16* ACT;
    __device__ __forceinline__ void operator()(const f32x4 (&acc)[2][2][4][2], const pg8::Unit& u, int wr, int wc, int fr, int fq) const {
        const int row0 = u.pm * 256 + wr * 64 + fr, col = u.pn * 128 + wc * 32 + 8 * fq;
#pragma unroll
        for (int ai = 0; ai < 2; ++ai)
#pragma unroll
            for (int m = 0; m < 4; ++m) { const int row = row0 + ai * 128 + m * 16;
                f32x4 r[2];
#pragma unroll
                for (int n = 0; n < 2; ++n)
#pragma unroll
                    for (int i = 0; i < 4; ++i) { const float a = acc[ai][0][m][n][i], b = acc[ai][1][m][n][i]; r[n][i] = a / (1.f + __expf(-a)) * b; }
                *(u32x4*)(ACT + (size_t)row * 512 + col) = pack8(r[0], r[1]); }
    }
};
struct EpiStore {
    static constexpr bool PERM = true;
    bf16* O; int ldc;
    __device__ __forceinline__ void operator()(const f32x4 (&acc)[2][2][4][2], const pg8::Unit& u, int wr, int wc, int fr, int fq) const {
        const int row0 = u.pm * 256 + wr * 64 + fr, col0 = u.pn * 256 + wc * 32 + 8 * fq;
#pragma unroll
        for (int ai = 0; ai < 2; ++ai)
#pragma unroll
            for (int m = 0; m < 4; ++m) { bf16* rowp = O + (size_t)(row0 + ai * 128 + m * 16) * ldc + col0;
#pragma unroll
                for (int bj = 0; bj < 2; ++bj) *(u32x4*)(rowp + bj * 128) = pack8(acc[ai][bj][m][0], acc[ai][bj][m][1]); }
    }
};

__device__ __forceinline__ void cvt_item(const float* W, int ldw, int col0, const float* gk, bf16* WTrow0, int ldk, int k0, float* scr, int lane) {
    if (col0 >= 0) {
#pragma unroll 8
        for (int i = 0; i < 32; ++i) { const int kk = 2 * i + (lane >> 5); float v = W[(size_t)(k0 + kk) * ldw + col0 + (lane & 31)]; if (gk) v *= gk[k0 + kk]; scr[kk * 33 + (lane & 31)] = v; }
    } else {
#pragma unroll 8
        for (int i = 0; i < 32; ++i) { const int kk = 2 * i + (lane >> 5); scr[kk * 33 + (lane & 31)] = 0.f; }
    }
    LDS_WAIT(); asm volatile("" ::: "memory");
    const int c = lane & 7;
#pragma unroll
    for (int j = 0; j < 4; ++j) { const int n = (lane >> 3) + 8 * j; const float* s = scr + (8 * c) * 33 + n;
        u32x4 o; o.x = pk2(s[0 * 33], s[1 * 33]); o.y = pk2(s[2 * 33], s[3 * 33]); o.z = pk2(s[4 * 33], s[5 * 33]); o.w = pk2(s[6 * 33], s[7 * 33]);
        *(u32x4*)(WTrow0 + (size_t)n * ldk + k0 + 8 * c) = o; }
    LDS_WAIT(); asm volatile("" ::: "memory");
}

__device__ __forceinline__ void phase_prologue(const Params& P, unsigned char* lds, int tid, int lane, int wave, int G) {
    unsigned char* ws = P.ws;
    {
        float* sl = (float*)lds;
        float* red = (float*)(lds + 40960);
        float* mod = (float*)(ws + WS_MOD);
        bool loaded = false;
        for (int u = blockIdx.x; u < 192; u += G) {
            if (!loaded) { for (int i = tid; i < 9 * 1024; i += 512) { const float v = i < 8192 ? P.in[I_C][i] : P.in[I_CCTX][i - 8192]; sl[i] = v / (1.f + expf(-v)); } loaded = true; __syncthreads(); }
            const int l = u / 96, col = (u % 96) * 64 + lane;
            const float* W = P.in[I_ADAW] + (size_t)l * 1024 * 6144 + col;
            float a[9];
#pragma unroll
            for (int b = 0; b < 9; ++b) a[b] = 0.f;
            const int kb = wave * 128;
#pragma unroll 4
            for (int k = 0; k < 128; ++k) { const float w = W[(size_t)(kb + k) * 6144];
#pragma unroll
                for (int b = 0; b < 9; ++b) a[b] += sl[b * 1024 + kb + k] * w; }
#pragma unroll
            for (int b = 0; b < 9; ++b) red[(wave * 9 + b) * 64 + lane] = a[b];
            __syncthreads();
            for (int i = tid; i < 9 * 64; i += 512) { const int b = i >> 6, cc = i & 63; float s = 0.f;
#pragma unroll
                for (int w = 0; w < 8; ++w) s += red[(w * 9 + b) * 64 + cc];
                const int c2 = (u % 96) * 64 + cc;
                mod[(size_t)(l * 9 + b) * 6144 + c2] = s + P.in[I_ADAB][l * 6144 + c2]; }
            __syncthreads();
        }
        __syncthreads();
    }
    {
        float* scr = (float*)(lds + wave * 16384);
        const int gw = blockIdx.x * 8 + wave, NGW = G * 8;
        constexpr int I_WIN = 16 * 56, I_UQ = 6 * 24, I_UKV = 4 * 32, I_OUT = 16 * 32, I_HIN = 16 * 96, I_HOUT = 16 * 32, I_WG = 64, I_M13 = 32 * 512, I_M2 = 32 * 256;
        constexpr int NITEMS = I_WIN + I_UQ + I_UKV + I_OUT + I_HIN + I_HOUT + I_WG + I_M13 + I_M2;
        for (int it = gw; it < NITEMS; it += NGW) {
            int r = it;
            if (r < I_M13) { const int le = r >> 9, q = r & 511, kb = q >> 5, nb = q & 31, n0 = 32 * nb, pn = n0 >> 8, j = n0 & 255;
                const float* src = (j < 128 ? P.in[I_MW1] : P.in[I_MW3]) + (size_t)le * 1024 * 512;
                cvt_item(src, 512, 128 * pn + (j & 127), nullptr, (bf16*)(ws + WS_W13) + ((size_t)le * 1024 + n0) * 1024, 1024, 64 * kb, scr, lane); continue; } r -= I_M13;
            if (r < I_M2) { const int le = r >> 8, q = r & 255, kb = q >> 5, nb = q & 31, n0 = 32 * nb;
                cvt_item(P.in[I_MW2] + (size_t)le * 512 * 1024, 1024, n0, nullptr, (bf16*)(ws + WS_W2) + ((size_t)le * 1024 + n0) * 512, 512, 64 * kb, scr, lane); continue; } r -= I_M2;
            if (r < I_WIN) { const int kb = r / 56, nb = r % 56, n0 = 32 * nb; const int col0 = n0 < 640 ? n0 : (n0 < 1664 ? n0 + 32 : (n0 < 1696 ? n0 - 1024 : -1));
                cvt_item(P.in[I_EVWIN], 1696, col0, nullptr, (bf16*)(ws + WS_WIN) + (size_t)n0 * 1024, 1024, 64 * kb, scr, lane); continue; } r -= I_WIN;
            if (r < I_UQ) { const int kb = r / 24, nb = r % 24, n0 = 32 * nb; const int col0 = n0 < 512 ? (n0 >> 6) * 96 + (n0 & 63) : ((n0 - 512) >> 5) * 96 + 64;
                cvt_item(P.in[I_WUQ], 768, col0, P.in[I_QNG], (bf16*)(ws + WS_WUQ) + (size_t)n0 * 384, 384, 64 * kb, scr, lane); continue; } r -= I_UQ;
            if (r < I_UKV) { const int kb = r / 32, nb = r % 32, n0 = 32 * nb;
                cvt_item(P.in[I_WUKV], 1024, n0, P.in[I_KVNG], (bf16*)(ws + WS_WUKV) + (size_t)n0 * 256, 256, 64 * kb, scr, lane); continue; } r -= I_UKV;
            if (r < I_OUT) { const int kb = r / 32, nb = r % 32, n0 = 32 * nb;
                cvt_item(P.in[I_EVWOUT], 1024, n0, nullptr, (bf16*)(ws + WS_WOUT) + (size_t)n0 * 1024, 1024, 64 * kb, scr, lane); continue; } r -= I_OUT;
            if (r < I_HIN) { const int kb = r / 96, nb = r % 96, n0 = 32 * nb;
                cvt_item(P.in[I_ODWIN], 3072, n0, nullptr, (bf16*)(ws + WS_WHIN) + (size_t)n0 * 1024, 1024, 64 * kb, scr, lane); continue; } r -= I_HIN;
            if (r < I_HOUT) { const int kb = r / 32, nb = r % 32, n0 = 32 * nb;
                cvt_item(P.in[I_ODWOUT], 1024, n0, nullptr, (bf16*)(ws + WS_WHOUT) + (size_t)n0 * 1024, 1024, 64 * kb, scr, lane); continue; } r -= I_HOUT;
            { const int mat = r >> 1, nb = r & 1, d = mat >> 4, gsel = (mat >> 3) & 1, h = mat & 7;
                const float* src = (gsel ? P.in[I_LWX] : P.in[I_LWA]) + (size_t)(d * 8 + h) * 4096;
                cvt_item(src, 64, 32 * nb, nullptr, (bf16*)(ws + WS_WG) + (size_t)(h * 256 + d * 128 + gsel * 64 + 32 * nb) * 64, 64, 0, scr, lane); }
        }
    }
    {
        const int gw = blockIdx.x * 8 + wave, NGW = G * 8;
        float* a2 = (float*)(ws + WS_A2);
        const float *w1 = P.in[I_HW1], *b1 = P.in[I_HB1], *f1 = P.in[I_HF1], *w2 = P.in[I_HW2], *b2 = P.in[I_HB2], *f2 = P.in[I_HF2];
        for (int t = gw; t < 4096; t += NGW) {
            const float tl = (float)t / 4095.f, w = (6.283185307179586f / 4096.f) * (float)t;
            float zi = 0.f;
            if (lane == 0) zi = tl;
            else if (lane <= 16) { const float f = 1e-4f + (float)(lane - 1) * ((15.f - 1e-4f) / 15.f); zi = cosf(f * w); }
            else if (lane <= 32) { const float f = 1e-4f + (float)(lane - 17) * ((15.f - 1e-4f) / 15.f); zi = -sinf(f * w); }
            float acc = b1[lane];
            for (int i = 0; i < 33; ++i) acc += __shfl(zi, i) * w1[i * 64 + lane];
            const float a1 = sinf(f1[lane] * acc);
            float acc2 = b2[lane];
            for (int i = 0; i < 64; ++i) acc2 += __shfl(a1, i) * w2[i * 64 + lane];
            a2[(size_t)lane * 4096 + t] = sinf(f2[lane] * acc2);
        }
    }
}

__device__ __forceinline__ void store_row_bf16(bf16* orow, const f32x4 (&v)[4], int lane) {
    unsigned long long* o8 = (unsigned long long*)orow + lane;
#pragma unroll
    for (int j = 0; j < 4; ++j) o8[64 * j] = (unsigned long long)pk2(v[j][0], v[j][1]) | ((unsigned long long)pk2(v[j][2], v[j][3]) << 32);
}
__device__ __forceinline__ void norm_mod(f32x4 (&v)[4], const float* g, const float* sh, const float* sc, int lane) {
    float ss = 0.f;
#pragma unroll
    for (int j = 0; j < 4; ++j) ss += (v[j][0] * v[j][0] + v[j][1] * v[j][1]) + (v[j][2] * v[j][2] + v[j][3] * v[j][3]);
    const float rr = rsqrtf(wave_sum(ss) * (1.f / 1024.f) + RMS_EPS);
#pragma unroll
    for (int j = 0; j < 4; ++j) { const f32x4 gg = ((const f32x4*)g)[lane + 64 * j], s1 = ((const f32x4*)sc)[lane + 64 * j], s0 = ((const f32x4*)sh)[lane + 64 * j];
        v[j] = (v[j] * rr * gg) * (1.f + s1) + s0; }
}
__device__ __forceinline__ void moe_combine(f32x4 (&v)[4], const bf16* Y, const int* rs, const float* rw, int r, const float* g2, int lane) {
    const int s0 = rs[2 * r], s1 = rs[2 * r + 1]; const float w0 = rw[2 * r], w1 = rw[2 * r + 1];
    const u32x2* y0 = (const u32x2*)(Y + (size_t)s0 * 1024) + lane; const u32x2* y1 = (const u32x2*)(Y + (size_t)s1 * 1024) + lane;
#pragma unroll
    for (int j = 0; j < 4; ++j) { const u32x2 a = y0[64 * j], b = y1[64 * j]; const f32x4 gg = ((const f32x4*)g2)[lane + 64 * j];
        f32x4 m; m[0] = w0 * bflo(a.x) + w1 * bflo(b.x); m[1] = w0 * bfhi(a.x) + w1 * bfhi(b.x); m[2] = w0 * bflo(a.y) + w1 * bflo(b.y); m[3] = w0 * bfhi(a.y) + w1 * bfhi(b.y);
        v[j] = v[j] + gg * m; }
}
__device__ __forceinline__ void route_row(const f32x4 (&v)[4], const float* rwT  , const float* rb, int lane, int& e0o, int& e1o, float& w0o, float& w1o) {
    float s[16];
#pragma unroll
    for (int e = 0; e < 16; ++e) { float p = 0.f;
#pragma unroll
        for (int j = 0; j < 4; ++j) { const f32x4 w = ((const f32x4*)(rwT + e * 1024))[lane + 64 * j]; p += (v[j][0] * w[0] + v[j][1] * w[1]) + (v[j][2] * w[2] + v[j][3] * w[3]); }
        s[e] = sigm(wave_sum(p)); }
    float sel[16];
#pragma unroll
    for (int e = 0; e < 16; ++e) sel[e] = s[e] + rb[e];
    float gbest = -1e30f; int gi = 0;
#pragma unroll
    for (int g = 0; g < 4; ++g) { float m1 = -1e30f, m2 = -1e30f;
#pragma unroll
        for (int i = 0; i < 4; ++i) { const float x = sel[4 * g + i]; if (x > m1) { m2 = m1; m1 = x; } else if (x > m2) m2 = x; }
        const float gs = m1 + m2; if (gs > gbest) { gbest = gs; gi = g; } }
    float b0 = -1e30f, b1 = -1e30f; int e0 = 0, e1 = 0; float s0 = 0.f, s1 = 0.f;
#pragma unroll
    for (int e = 0; e < 16; ++e) { const bool in = (e >> 2) == gi; const float x = sel[e];
        if (in && x > b0) { b1 = b0; e1 = e0; s1 = s0; b0 = x; e0 = e; s0 = s[e]; } else if (in && x > b1) { b1 = x; e1 = e; s1 = s[e]; } }
    e0o = e0; e1o = e1; const float den = s0 + s1; w0o = s0 / den; w1o = s1 / den;
}

__device__ __forceinline__ void phase_norm1_l0(const Params& P, int lane, int wave, int G) {
    const float* mod = (const float*)(P.ws + WS_MOD); bf16* H = (bf16*)(P.ws + WS_RH);
    for (int row = blockIdx.x * 8 + wave; row < M0; row += G * 8) {
        const int b = row / TC, t = row - b * TC;
        const float* xr = t < CTXL ? P.in[I_CTX] + (size_t)(b * CTXL + t) * DM : P.in[I_X] + (size_t)(b * SEQ + t - CTXL) * DM;
        const float* md = mod + (size_t)(t < CTXL ? 8 : b) * 6144;
        f32x4 v[4];
#pragma unroll
        for (int j = 0; j < 4; ++j) v[j] = ((const f32x4*)xr)[lane + 64 * j];
        norm_mod(v, P.in[I_N1G], md, md + 1024, lane);
        store_row_bf16(H + (size_t)row * DM, v, lane);
    }
}
template <int LAYER> __device__ __forceinline__ void phase_norm2_route(const Params& P, unsigned char* lds, int tid, int lane, int wave, int G) {
    constexpr int ROWS = LAYER == 0 ? 136 : 128;
    float* rwT = (float*)lds;
    int* cntl = (int*)(lds + 65536);
    const float* mod = (const float*)(P.ws + WS_MOD) + (size_t)LAYER * 9 * 6144; bf16* H = (bf16*)(P.ws + WS_RH);
    int* route_e = (int*)(P.ws + WS_ROUTE_E); float* route_w = (float*)(P.ws + WS_ROUTE_W); int* cnt = (int*)(P.ws + WS_CNT);
    for (int i = tid; i < 16384; i += 512) { const int k = i >> 4, e = i & 15; rwT[e * 1024 + k] = P.in[I_RW][i]; }
    for (int ch = blockIdx.x; ch < NCHUNK; ch += G) {
        if (tid < 16) cntl[tid] = 0;
        __syncthreads();
        for (int rl = wave; rl < ROWS; rl += 8) {
            const int row = ch * ROWS + rl; const float* xr; const float* md;
            if (LAYER == 0) { const int b = row / TC, t = row - b * TC;
                xr = t < CTXL ? (const float*)(P.ws + WS_XC) + (size_t)(b * CTXL + t) * DM : P.out + (size_t)(b * SEQ + t - CTXL) * DM; md = mod + (size_t)(t < CTXL ? 8 : b) * 6144; }
            else { xr = P.out + (size_t)row * DM; md = mod + (size_t)(row >> 12) * 6144; }
            f32x4 v[4];
#pragma unroll
            for (int j = 0; j < 4; ++j) v[j] = ((const f32x4*)xr)[lane + 64 * j];
            norm_mod(v, P.in[I_N2G] + LAYER * 1024, md + 3072, md + 4096, lane);
            store_row_bf16(H + (size_t)row * DM, v, lane);
            int e0, e1; float w0, w1; route_row(v, rwT, P.in[I_RB], lane, e0, e1, w0, w1);
            if (lane == 0) { route_e[row] = e0 | (e1 << 8); route_w[2 * row] = w0; route_w[2 * row + 1] = w1; atomicAdd(&cntl[e0], 1); atomicAdd(&cntl[e1], 1); }
        }
        __syncthreads();
        if (tid < 16) cnt[ch * 16 + tid] = cntl[tid];
        __syncthreads();
    }
}
template <int LAYER> __device__ __forceinline__ void phase_permute(const Params& P, unsigned char* lds, int tid, int lane, int wave, int G) {
    constexpr int ROWS = LAYER == 0 ? 136 : 128;
    int* part_tot = (int*)lds;
    int* part_base = part_tot + 512;
    int* slot0 = part_base + 512;
    int* loc = slot0 + 16;
    int* slots = loc + 16;
    int* tstart = slots + 2 * 136;
    const int* cnt = (const int*)(P.ws + WS_CNT); const int* route_e = (const int*)(P.ws + WS_ROUTE_E); int* route_s = (int*)(P.ws + WS_ROUTE_S);
    int* tile_e = (int*)(P.ws + WS_TILEE);
    const bf16* H = (const bf16*)(P.ws + WS_RH); bf16* HP = (bf16*)(P.ws + WS_HPERM);
    for (int ch = blockIdx.x; ch < NCHUNK; ch += G) {
        { const int e = tid & 15, part = tid >> 4; int tot = 0, bs = 0;
#pragma unroll
          for (int i = 0; i < 8; ++i) { const int c = part * 8 + i; const int x = cnt[c * 16 + e]; tot += x; bs += (c < ch) ? x : 0; }
          part_tot[part * 16 + e] = tot; part_base[part * 16 + e] = bs; }
        __syncthreads();
        if (tid == 0) {
            int ts = 0;
            for (int e = 0; e < 16; ++e) { int tot = 0, bs = 0; for (int p = 0; p < 32; ++p) { tot += part_tot[p * 16 + e]; bs += part_base[p * 16 + e]; }
                tstart[e] = ts; slot0[e] = ts * 256 + bs; loc[e] = 0; ts += (tot + 255) >> 8; }
            tstart[16] = ts;
            if (ch == 0) { for (int e = 0; e < 16; ++e) for (int i = tstart[e]; i < tstart[e + 1]; ++i) tile_e[i] = e; tile_e[MAXTILES] = ts; }
            for (int rl = 0; rl < ROWS; ++rl) { const int row = ch * ROWS + rl; const int ee = route_e[row]; const int e0 = ee & 255, e1 = ee >> 8;
                const int s0 = slot0[e0] + loc[e0]; loc[e0] = loc[e0] + 1; const int s1 = slot0[e1] + loc[e1]; loc[e1] = loc[e1] + 1;
                slots[2 * rl] = s0; slots[2 * rl + 1] = s1; route_s[2 * row] = s0; route_s[2 * row + 1] = s1; }
        }
        __syncthreads();
        for (int rl = wave; rl < ROWS; rl += 8) { const int row = ch * ROWS + rl; const int s0 = slots[2 * rl], s1 = slots[2 * rl + 1];
            const u32x4* src = (const u32x4*)(H + (size_t)row * DM) + lane; u32x4* d0 = (u32x4*)(HP + (size_t)s0 * DM) + lane; u32x4* d1 = (u32x4*)(HP + (size_t)s1 * DM) + lane;
            const u32x4 a = src[0], b = src[64]; d0[0] = a; d0[64] = b; d1[0] = a; d1[64] = b; }
        __syncthreads();
    }
}
__device__ __forceinline__ void phase_combine_norm1_l1(const Params& P, int lane, int wave, int G) {
    const float* mod = (const float*)(P.ws + WS_MOD); bf16* H = (bf16*)(P.ws + WS_RH); const bf16* Y = (const bf16*)(P.ws + WS_HPERM);
    const int* rs = (const int*)(P.ws + WS_ROUTE_S); const float* rw = (const float*)(P.ws + WS_ROUTE_W);
    for (int row = blockIdx.x * 8 + wave; row < M1; row += G * 8) {
        const int b = row >> 12, t = row & 4095, r0 = b * TC + CTXL + t;
        float* xr = P.out + (size_t)row * DM;
        f32x4 v[4];
#pragma unroll
        for (int j = 0; j < 4; ++j) v[j] = ((const f32x4*)xr)[lane + 64 * j];
        moe_combine(v, Y, rs, rw, r0, mod + (size_t)b * 6144 + 5120, lane);
#pragma unroll
        for (int j = 0; j < 4; ++j) ((f32x4*)xr)[lane + 64 * j] = v[j];
        const float* md = mod + (size_t)(9 + b) * 6144;
        norm_mod(v, P.in[I_N1G] + 1024, md, md + 1024, lane);
        store_row_bf16(H + (size_t)row * DM, v, lane);
    }
}
__device__ __forceinline__ void phase_final(const Params& P, int lane, int wave, int G) {
    const float* mod = (const float*)(P.ws + WS_MOD); const bf16* Y = (const bf16*)(P.ws + WS_HPERM);
    const int* rs = (const int*)(P.ws + WS_ROUTE_S); const float* rw = (const float*)(P.ws + WS_ROUTE_W);
    for (int row = blockIdx.x * 8 + wave; row < M1; row += G * 8) {
        const int b = row >> 12;
        float* xr = P.out + (size_t)row * DM;
        f32x4 v[4];
#pragma unroll
        for (int j = 0; j < 4; ++j) v[j] = ((const f32x4*)xr)[lane + 64 * j];
        moe_combine(v, Y, rs, rw, row, mod + (size_t)(9 + b) * 6144 + 5120, lane);
        float ss = 0.f;
#pragma unroll
        for (int j = 0; j < 4; ++j) ss += (v[j][0] * v[j][0] + v[j][1] * v[j][1]) + (v[j][2] * v[j][2] + v[j][3] * v[j][3]);
        const float rr = rsqrtf(wave_sum(ss) * (1.f / 1024.f) + RMS_EPS);
#pragma unroll
        for (int j = 0; j < 4; ++j) ((f32x4*)xr)[lane + 64 * j] = v[j] * rr * ((const f32x4*)P.in[I_FING])[lane + 64 * j];
    }
}
__device__ __forceinline__ void phase_rowstat(const Params& P, int lane, int wave, int G) {
    const bf16* CQ = (const bf16*)(P.ws + WS_CQ); const bf16* CKV = (const bf16*)(P.ws + WS_CKV); float* rq = (float*)(P.ws + WS_RQ); float* rkv = (float*)(P.ws + WS_RKV);
    for (int row = blockIdx.x * 8 + wave; row < M0; row += G * 8) {
        float sq = 0.f, sk = 0.f;
        if (lane < 48) { const u32x4 a = ((const u32x4*)(CQ + (size_t)row * 384))[lane];
            sq = (bflo(a.x) * bflo(a.x) + bfhi(a.x) * bfhi(a.x)) + (bflo(a.y) * bflo(a.y) + bfhi(a.y) * bfhi(a.y)) + (bflo(a.z) * bflo(a.z) + bfhi(a.z) * bfhi(a.z)) + (bflo(a.w) * bflo(a.w) + bfhi(a.w) * bfhi(a.w)); }
        if (lane < 32) { const u32x4 a = ((const u32x4*)(CKV + (size_t)row * 256))[lane];
            sk = (bflo(a.x) * bflo(a.x) + bfhi(a.x) * bfhi(a.x)) + (bflo(a.y) * bflo(a.y) + bfhi(a.y) * bfhi(a.y)) + (bflo(a.z) * bflo(a.z) + bfhi(a.z) * bfhi(a.z)) + (bflo(a.w) * bflo(a.w) + bfhi(a.w) * bfhi(a.w)); }
        sq = wave_sum(sq); sk = wave_sum(sk);
        if (lane == 0) { rq[row] = rsqrtf(sq * (1.f / 384.f) + RMS_EPS); rkv[row] = rsqrtf(sk * (1.f / 256.f) + RMS_EPS); }
    }
}

constexpr int LRU_UXF = 0;
constexpr int LRU_UF = 17408;
constexpr int LRU_UB = LRU_UF + 16384;
constexpr int LRU_G = LRU_UB + 8192;
__device__ __forceinline__ int crow32(int r, int hi) { return (r & 3) + 8 * (r >> 2) + 4 * hi; }
__device__ __forceinline__ void lru_coeffs(const Params& P, unsigned char* lds, int b, int ck, int h, int tid, int lane, int wave) {
    float* uxf = (float*)(lds + LRU_UXF); float* uf = (float*)(lds + LRU_UF); bf16* ub = (bf16*)(lds + LRU_UB); float* Gm = (float*)(lds + LRU_G);
    const bf16* UX = (const bf16*)(P.ws + WS_UX);
    const int seg_lo = ck < 4 ? 0 : CTXL, seg_hi = ck < 4 ? CTXL : TC, p0 = ck * 64 - 2;
    for (int i = tid; i < 67 * 8; i += 512) { const int r = i >> 3, c8 = (i & 7) * 8, pos = p0 + r;
        u32x4 a = {0u, 0u, 0u, 0u};
        if (pos >= seg_lo && pos < seg_hi) a = *(const u32x4*)(UX + (size_t)(b * TC + pos) * 512 + h * 64 + c8);
        float* d = uxf + r * 64 + c8;
        d[0] = bflo(a.x); d[1] = bfhi(a.x); d[2] = bflo(a.y); d[3] = bfhi(a.y); d[4] = bflo(a.z); d[5] = bfhi(a.z); d[6] = bflo(a.w); d[7] = bfhi(a.w); }
    __syncthreads();
    { const int t = tid >> 3, c0 = (tid & 7) * 8; const float* cw = P.in[I_LCW]; const float* cb = P.in[I_LCB];
#pragma unroll
      for (int i = 0; i < 8; ++i) { const int c = c0 + i, ch = h * 64 + c; float u = cb[ch];
#pragma unroll
          for (int j = 0; j < 4; ++j) u += cw[j * 512 + ch] * uxf[(t + j) * 64 + c];
          uf[t * 64 + c] = u; ub[t * 64 + c] = (bf16)f2bf(u); } }
    __syncthreads();
    {
        const bf16* WgT = (const bf16*)(P.ws + WS_WG) + (size_t)h * 256 * 64; const int r32 = lane & 31, hi = lane >> 5, n = wave * 32 + r32;
        f32x16 acc0 = {}, acc1 = {};
#pragma unroll
        for (int ks = 0; ks < 4; ++ks) {
            const bf16x8 bf = *(const bf16x8*)(WgT + (size_t)n * 64 + 16 * ks + 8 * hi);
            const bf16x8 a0 = *(const bf16x8*)(ub + (r32) * 64 + 16 * ks + 8 * hi), a1 = *(const bf16x8*)(ub + (32 + r32) * 64 + 16 * ks + 8 * hi);
            acc0 = __builtin_amdgcn_mfma_f32_32x32x16_bf16(a0, bf, acc0, 0, 0, 0);
            acc1 = __builtin_amdgcn_mfma_f32_32x32x16_bf16(a1, bf, acc1, 0, 0, 0);
        }
#pragma unroll
        for (int r = 0; r < 16; ++r) { Gm[crow32(r, hi) * 256 + n] = acc0[r]; Gm[(32 + crow32(r, hi)) * 256 + n] = acc1[r]; }
    }
    __syncthreads();
    { const int c = tid & 63, d = (tid >> 6) & 1, tg = tid >> 7, ch = h * 64 + c;
      const float ba = P.in[I_LBA][d * 512 + ch], bx = P.in[I_LBX][d * 512 + ch], lam = P.in[I_LLAM][d * 512 + ch];
      const float sp = log1pf(expf(-lam));
#pragma unroll 4
      for (int i = 0; i < 16; ++i) { const int t = tg * 16 + i;
          const float ga = Gm[t * 256 + d * 128 + c] + ba, gx = Gm[t * 256 + d * 128 + 64 + c] + bx;
          const float r = sigm(ga), ii = sigm(gx), la = -8.f * r * sp;
          const float a = expf(la), bb = sqrtf(-expm1f(2.f * la)) * (ii * uf[t * 64 + c]);
          Gm[t * 256 + d * 128 + c] = a; Gm[t * 256 + d * 128 + 64 + c] = bb; } }
    __syncthreads();
}
__device__ __forceinline__ void phase_lru_f1(const Params& P, unsigned char* lds, int tid, int lane, int wave, int G) {
    float* Gm = (float*)(lds + LRU_G); float* CP = (float*)(P.ws + WS_CP); float* CS = (float*)(P.ws + WS_CS);
    for (int u = blockIdx.x; u < NB * LCH * 8; u += G) {
        const int h = u & 7, ck = (u >> 3) % LCH, b = u / (8 * LCH);
        lru_coeffs(P, lds, b, ck, h, tid, lane, wave);
        if (tid < 128) { const int d = tid >> 6, c = tid & 63; float hh = 0.f, pp = 1.f;
            for (int i = 0; i < 64; ++i) { const int t = d == 0 ? i : 63 - i; const float a = Gm[t * 256 + d * 128 + c], bb = Gm[t * 256 + d * 128 + 64 + c]; hh = a * hh + bb; pp *= a; }
            const size_t o = ((size_t)(d * 8 + b) * LCH + ck) * 512 + h * 64 + c; CP[o] = pp; CS[o] = hh; }
        __syncthreads();
    }
}
__device__ __forceinline__ float gelu_tanh(float x) { const float u = 0.7978845608028654f * (x + 0.044715f * x * x * x); return 0.5f * x * (1.f + tanhf(u)); }
__device__ __forceinline__ void phase_lru_f3(const Params& P, unsigned char* lds, int tid, int lane, int wave, int G) {
    float* Gm = (float*)(lds + LRU_G); const float* CP = (const float*)(P.ws + WS_CP); const float* CS = (const float*)(P.ws + WS_CS);
    const bf16* UG = (const bf16*)(P.ws + WS_UG); bf16* MIX = (bf16*)(P.ws + WS_RH);
    for (int u = blockIdx.x; u < NB * LCH * 8; u += G) {
        const int h = u & 7, ck = (u >> 3) % LCH, b = u / (8 * LCH);
        lru_coeffs(P, lds, b, ck, h, tid, lane, wave);
        if (tid < 128) { const int d = tid >> 6, c = tid & 63; float hh = 0.f;
            const size_t base = ((size_t)(d * 8 + b) * LCH) * 512 + h * 64 + c;
            if (d == 0) { for (int q = 0; q < ck; ++q) hh = CP[base + (size_t)q * 512] * hh + CS[base + (size_t)q * 512]; }
            else { for (int q = 3; q > (ck < 4 ? ck : -1); --q) hh = CP[base + (size_t)q * 512] * hh + CS[base + (size_t)q * 512];
                   if (ck >= 4) for (int q = LCH - 1; q > ck; --q) hh = CP[base + (size_t)q * 512] * hh + CS[base + (size_t)q * 512]; }
            for (int i = 0; i < 64; ++i) { const int t = d == 0 ? i : 63 - i; const float a = Gm[t * 256 + d * 128 + c], bb = Gm[t * 256 + d * 128 + 64 + c]; hh = a * hh + bb; Gm[t * 256 + d * 128 + c] = hh; } }
        __syncthreads();
        { const int t = tid >> 3, c0 = (tid & 7) * 8; const size_t row = (size_t)b * TC + ck * 64 + t;
          const u32x4 g = *(const u32x4*)(UG + row * 512 + h * 64 + c0);
          const float gv[8] = {bflo(g.x), bfhi(g.x), bflo(g.y), bfhi(g.y), bflo(g.z), bfhi(g.z), bflo(g.w), bfhi(g.w)};
          float o[8];
#pragma unroll
          for (int i = 0; i < 8; ++i) o[i] = (Gm[t * 256 + c0 + i] + Gm[t * 256 + 128 + c0 + i]) * gelu_tanh(gv[i]);
          u32x4 w; w.x = pk2(o[0], o[1]); w.y = pk2(o[2], o[3]); w.z = pk2(o[4], o[5]); w.w = pk2(o[6], o[7]);
          *(u32x4*)(MIX + row * 1024 + 512 + h * 64 + c0) = w; }
        __syncthreads();
    }
}

namespace att {
constexpr int NW = 8, QBLK = 32, KVBLK = 64;
constexpr float SCALE = 0.10206207261596575f;
constexpr float THR = 8.f;
constexpr int LDQ = 768, LDK = 768, LDV = 512, LDO = 1024;
constexpr int SHM_V = 16384, SHM_K = 16384, SHM_ATTN = 2 * SHM_V + 2 * SHM_K + NW * 64 * 4;
#define KSWZ(row, colB) ((row) * 256 + ((colB) ^ (((row) & 7) << 4)))
#define SBAR() __builtin_amdgcn_sched_barrier(0)
__device__ __forceinline__ int crow(int r, int hi) { return (r & 3) + 8 * (r >> 2) + 4 * hi; }
__device__ __forceinline__ unsigned cvtpk(float lo, float hi) { unsigned r; asm volatile("v_cvt_pk_bf16_f32 %0, %1, %2" : "=v"(r) : "v"(lo), "v"(hi)); return r; }
__device__ __forceinline__ void partialSM(f32x16& p0, f32x16& p1, float& m_reg, float& mn, float& alpha) {
  constexpr float C = SCALE * 1.4426950408889634f;
  float pmax = p0[0];
#pragma unroll
  for (int r = 1; r < 16; ++r) pmax = fmaxf(pmax, p0[r]);
#pragma unroll
  for (int r = 0; r < 16; ++r) pmax = fmaxf(pmax, p1[r]);
  { auto rr = __builtin_amdgcn_permlane32_swap(__float_as_uint(pmax), __float_as_uint(pmax), false, false);
    pmax = fmaxf(__uint_as_float(rr[0]), __uint_as_float(rr[1])); }
  if (__builtin_expect(__all(pmax - m_reg <= THR / SCALE), 1)) { mn = m_reg; alpha = 1.f; }
  else { mn = fmaxf(m_reg, pmax); alpha = __builtin_amdgcn_exp2f((m_reg - mn) * C); m_reg = mn; }
  float mnC = -mn * C;
#pragma unroll
  for (int r = 0; r < 16; ++r) p0[r] = fmaf(p0[r], C, mnC);
#pragma unroll
  for (int r = 0; r < 16; ++r) p1[r] = fmaf(p1[r], C, mnC);
#pragma unroll
  for (int r = 0; r < 16; ++r) p0[r] = __builtin_amdgcn_exp2f(p0[r]);
}
__device__ __forceinline__ void finishSM(f32x16& p0, f32x16& p1, float alpha, float& l_reg, bf16x8& pa0, bf16x8& pa1, bf16x8& pa2, bf16x8& pa3) {
#pragma unroll
  for (int r = 0; r < 16; ++r) p1[r] = __builtin_amdgcn_exp2f(p1[r]);
  float ps = 0;
#pragma unroll
  for (int r = 0; r < 16; ++r) ps += p0[r];
#pragma unroll
  for (int r = 0; r < 16; ++r) ps += p1[r];
  { auto rr = __builtin_amdgcn_permlane32_swap(__float_as_uint(ps), __float_as_uint(ps), false, false);
    ps = __uint_as_float(rr[0]) + __uint_as_float(rr[1]); }
  l_reg = l_reg * alpha + ps;
#define PK4(P, BASE, OUT) do { unsigned a0 = cvtpk(P[BASE + 0], P[BASE + 1]), a1 = cvtpk(P[BASE + 2], P[BASE + 3]);   \
    unsigned b0 = cvtpk(P[BASE + 4], P[BASE + 5]), b1 = cvtpk(P[BASE + 6], P[BASE + 7]);                              \
    auto r0 = __builtin_amdgcn_permlane32_swap(a0, b0, false, false); auto r1 = __builtin_amdgcn_permlane32_swap(a1, b1, false, false); \
    u32x4 w = {r0[0], r1[0], r0[1], r1[1]}; OUT = *reinterpret_cast<bf16x8*>(&w); } while (0)
  PK4(p0, 0, pa0); PK4(p0, 8, pa1); PK4(p1, 0, pa2); PK4(p1, 8, pa3);
#undef PK4
}
__device__ __forceinline__ void qkt(f32x16& p0, f32x16& p1, const bf16* Ks, const bf16x8* qr, int r32, int hi) {
  p0 = f32x16{}; p1 = f32x16{};
#pragma unroll
  for (int d0 = 0; d0 < 6; ++d0) { int cb = (d0 * 16 + hi * 8) * 2;
    bf16x8 b0 = *reinterpret_cast<const bf16x8*>((const char*)Ks + KSWZ(r32, cb));
    bf16x8 b1 = *reinterpret_cast<const bf16x8*>((const char*)Ks + KSWZ(32 + r32, cb));
    p0 = __builtin_amdgcn_mfma_f32_32x32x16_bf16(b0, qr[d0], p0, 0, 0, 0);
    p1 = __builtin_amdgcn_mfma_f32_32x32x16_bf16(b1, qr[d0], p1, 0, 0, 0); }
}
__device__ __forceinline__ int v_st(int k, int c) { const int kk = (k & ~0xC) | ((k & 4) << 1) | ((k & 8) >> 1); return ((kk >> 3) * 4 + (c >> 5)) * 512 + ((kk & 7) * 32 + (c & 31)) * 2; }
__device__ __forceinline__ int v_rd_base(int lane) { return ((lane & 3) << 3) | (((lane >> 2) & 3) << 6) | (((lane >> 4) & 1) << 5) | (((lane >> 5) & 1) << 8); }
constexpr int v_rd_off(int d0, int ks, int half) { return d0 * 512 + ks * 4096 + half * 2048; }
template <int OFF> __device__ __forceinline__ s16x4 tr_read(int vb) {
  s16x4 r; asm volatile("ds_read_b64_tr_b16 %0, %1 offset:%2" : "=&v"(r) : "v"(vb), "i"(OFF) : "memory"); return r;
}
template <int D0> __device__ __forceinline__ void pv_one(f32x16& od, int vb, bf16x8 pa0, bf16x8 pa1, bf16x8 pa2, bf16x8 pa3) {
  const s16x4 l0 = tr_read<v_rd_off(D0, 0, 0)>(vb), h0 = tr_read<v_rd_off(D0, 0, 1)>(vb), l1 = tr_read<v_rd_off(D0, 1, 0)>(vb), h1 = tr_read<v_rd_off(D0, 1, 1)>(vb);
  const s16x4 l2 = tr_read<v_rd_off(D0, 2, 0)>(vb), h2 = tr_read<v_rd_off(D0, 2, 1)>(vb), l3 = tr_read<v_rd_off(D0, 3, 0)>(vb), h3 = tr_read<v_rd_off(D0, 3, 1)>(vb);
  asm volatile("s_waitcnt lgkmcnt(0)" ::: "memory"); SBAR();
#define PK(L, H) (bf16x8){L[0], L[1], L[2], L[3], H[0], H[1], H[2], H[3]}
  od = __builtin_amdgcn_mfma_f32_32x32x16_bf16(pa0, PK(l0, h0), od, 0, 0, 0);
  od = __builtin_amdgcn_mfma_f32_32x32x16_bf16(pa1, PK(l1, h1), od, 0, 0, 0);
  od = __builtin_amdgcn_mfma_f32_32x32x16_bf16(pa2, PK(l2, h2), od, 0, 0, 0);
  od = __builtin_amdgcn_mfma_f32_32x32x16_bf16(pa3, PK(l3, h3), od, 0, 0, 0);
#undef PK
}
__device__ __forceinline__ void pv_d0(f32x16* o, int vb, bf16x8 pa0, bf16x8 pa1, bf16x8 pa2, bf16x8 pa3) {
  pv_one<0>(o[0], vb, pa0, pa1, pa2, pa3); pv_one<1>(o[1], vb, pa0, pa1, pa2, pa3);
}
__device__ __forceinline__ void attn_dense_body(const bf16* __restrict__ Qb, const bf16* __restrict__ Kh, const bf16* __restrict__ Vh, bf16* __restrict__ Ob, int seq, int tq0  , char* lds) {
  const int tid = threadIdx.x, wid = tid >> 6, lane = tid & 63, r32 = lane & 31, hi = lane >> 5;
  bf16* V_lds = (bf16*)lds; bf16* K_lds = (bf16*)(lds + 2 * SHM_V);
  float* ws = (float*)(lds + 2 * SHM_V + 2 * SHM_K) + wid * 64; float* li_l = ws; float* al_l = ws + 32;
  float m_reg = -1e30f, l_reg = 0; f32x16 o[2] = {}; bf16x8 qr[6];
  const bf16* Qw = Qb + (long)(wid * QBLK + r32) * LDQ + hi * 8;
#pragma unroll
  for (int d0 = 0; d0 < 6; ++d0) qr[d0] = *reinterpret_cast<const bf16x8*>(Qw + d0 * 16);
  {
    const int tq = tq0 + wid * QBLK + r32; const bool on = tq0 >= 0;
    constexpr float IF[8] = {1.0f, 0.316227766f, 0.1f, 0.0316227766f, 0.01f, 0.00316227766f, 0.001f, 0.000316227766f};
#pragma unroll
    for (int ax = 0; ax < 2; ++ax) { const float pos = (float)(ax == 0 ? (tq >> 6) : (tq & 63)) * 0.15915494309189535f;
      bf16x8 qv = qr[4 + ax]; bf16x8 qo;
#pragma unroll
      for (int i = 0; i < 8; ++i) { const float x = __uint_as_float(((unsigned)(unsigned short)qv[i]) << 16); const float other = __shfl_xor(x, 32);
        const float sn = __builtin_amdgcn_sinf(pos * IF[i]), cs = __builtin_amdgcn_cosf(pos * IF[i]);
        const float r = hi == 0 ? x * cs - other * sn : other * sn + x * cs;
        unsigned u = __float_as_uint(on ? r : x); u = (u + 0x7fffu + ((u >> 16) & 1u)) >> 16; qo[i] = (short)u; }
      qr[4 + ax] = qo; }
  }
  const int sr = tid >> 3, sc = (tid & 7) * 8, vst = v_st(sr, sc), kr2 = (tid >> 2) & 63, kc2 = 64 + (tid & 3) * 8; const bool kb2 = tid < 256;
  const int vb0 = (int)(uintptr_t)V_lds + v_rd_base(lane);
  struct { bf16x8 vs, ka, kb; } sr_[2];
#define SLOAD(i, k0) do { sr_[i].vs = *reinterpret_cast<const bf16x8*>(&Vh[(long)((k0) + sr) * LDV + sc]); \
    sr_[i].ka = *reinterpret_cast<const bf16x8*>(&Kh[(long)((k0) + sr) * LDK + sc]); \
    if (kb2) sr_[i].kb = *reinterpret_cast<const bf16x8*>(&Kh[(long)((k0) + kr2) * LDK + kc2]); } while (0)
#define SWRITE(b, i) do { *(bf16x8*)((char*)V_lds + (b) * SHM_V + vst) = sr_[i].vs;          \
    *(bf16x8*)((char*)K_lds + (b) * SHM_K + KSWZ(sr, sc * 2)) = sr_[i].ka;                       \
    if (kb2) *(bf16x8*)((char*)K_lds + (b) * SHM_K + KSWZ(kr2, kc2 * 2)) = sr_[i].kb; } while (0)
#define SWAIT() asm volatile("s_waitcnt vmcnt(3)" ::: "memory")
#define RESC(a) do { if (__any((a) < 1.f)) { if (hi == 0) al_l[r32] = (a); asm volatile("s_waitcnt lgkmcnt(0)" ::: "memory"); \
    _Pragma("unroll") for (int d = 0; d < 2; ++d) _Pragma("unroll") for (int r = 0; r < 16; ++r) o[d][r] *= al_l[crow(r, hi)]; } } while (0)
  f32x16 pA0, pA1, pB0, pB1; float mnA, mnB, alA, alB; bf16x8 pa0, pa1, pa2, pa3; const int NT = seq / KVBLK;
  constexpr int SE = 0, SO = 1;
  SLOAD(SE, 0); asm volatile("s_waitcnt vmcnt(0)" ::: "memory"); SWRITE(0, SE); __syncthreads();
  qkt(pA0, pA1, K_lds, qr, r32, hi); partialSM(pA0, pA1, m_reg, mnA, alA);
  SLOAD(SO, KVBLK); if (2 < NT) SLOAD(SE, 2 * KVBLK);
  SWAIT(); SWRITE(1, SO); __syncthreads();
  for (int j = 1; j + 1 < NT; j += 2) {
    SBAR(); qkt(pB0, pB1, (bf16*)((char*)K_lds + SHM_K), qr, r32, hi);
    finishSM(pA0, pA1, alA, l_reg, pa0, pa1, pa2, pa3); SBAR();
    SLOAD(SO, (j + 2) * KVBLK); SBAR();
    pv_d0(o, vb0, pa0, pa1, pa2, pa3); partialSM(pB0, pB1, m_reg, mnB, alB);
    __syncthreads(); SWAIT(); SWRITE(0, SE);
    RESC(alB); __syncthreads();
    SBAR(); qkt(pA0, pA1, K_lds, qr, r32, hi);
    finishSM(pB0, pB1, alB, l_reg, pa0, pa1, pa2, pa3); SBAR();
    if (j + 3 < NT) SLOAD(SE, (j + 3) * KVBLK); SBAR();
    pv_d0(o, vb0 + (int)SHM_V, pa0, pa1, pa2, pa3); partialSM(pA0, pA1, m_reg, mnA, alA);
    __syncthreads(); SWAIT(); SWRITE(1, SO);
    RESC(alA); __syncthreads();
  }
  SBAR(); qkt(pB0, pB1, (bf16*)((char*)K_lds + SHM_K), qr, r32, hi);
  finishSM(pA0, pA1, alA, l_reg, pa0, pa1, pa2, pa3); SBAR();
  pv_d0(o, vb0, pa0, pa1, pa2, pa3); partialSM(pB0, pB1, m_reg, mnB, alB);
  __syncthreads(); RESC(alB);
  finishSM(pB0, pB1, alB, l_reg, pa0, pa1, pa2, pa3); SBAR();
  pv_d0(o, vb0 + (int)SHM_V, pa0, pa1, pa2, pa3);
  if (hi == 0) li_l[r32] = l_reg; asm volatile("s_waitcnt lgkmcnt(0)" ::: "memory");
  float rli[16];
#pragma unroll
  for (int r = 0; r < 16; ++r) rli[r] = __builtin_amdgcn_rcpf(li_l[crow(r, hi)]);
  bf16* Ow = Ob + (long)(wid * QBLK) * LDO;
#pragma unroll
  for (int r = 0; r < 16; ++r) { int orow = crow(r, hi);
#pragma unroll
    for (int d0 = 0; d0 < 2; ++d0) Ow[(long)orow * LDO + d0 * 32 + r32] = (bf16)f2bf(o[d0][r] * rli[r]); }
#undef SLOAD
#undef SWRITE
#undef SWAIT
#undef RESC
}
}

__device__ __forceinline__ void phase_attention(const Params& P, unsigned char* lds, int G) {
    const bf16* Q = (const bf16*)(P.ws + WS_Q); const bf16* K = (const bf16*)(P.ws + WS_K); const bf16* V = (const bf16*)(P.ws + WS_V); bf16* MIX = (bf16*)(P.ws + WS_RH);
    for (int idx = blockIdx.x; idx < 1024 + 64; idx += G) {
        int b, h, seq; size_t qrow;
        if (idx < 1024) { const int bh = idx >> 4, qb = idx & 15; b = bh >> 3; h = bh & 7; qrow = (size_t)b * TC + CTXL + qb * 256; seq = TC; }
        else { const int j = idx - 1024; b = j >> 3; h = j & 7; qrow = (size_t)b * TC; seq = CTXL; }
        att::attn_dense_body(Q + qrow * 768 + h * 96, K + (size_t)b * TC * 768 + h * 96, V + (size_t)b * TC * 512 + h * 64, MIX + qrow * 1024 + h * 64, seq, idx < 1024 ? (idx & 15) * 256 : -1, (char*)lds);
        __syncthreads();
    }
}

struct cf { float x, y; };
__device__ __forceinline__ cf cmul(cf a, cf b) { return cf{a.x * b.x - a.y * b.y, a.x * b.y + a.y * b.x}; }
__device__ __forceinline__ cf cis_rev(float rev) { return cf{__builtin_amdgcn_cosf(rev), __builtin_amdgcn_sinf(rev)}; }
template <int S> __device__ __forceinline__ void dft4(cf& a, cf& b, cf& c, cf& d) {
    const cf t0{a.x + c.x, a.y + c.y}, t1{a.x - c.x, a.y - c.y}, t2{b.x + d.x, b.y + d.y}, t3{b.x - d.x, b.y - d.y};
    const cf t3i{-(float)S * t3.y, (float)S * t3.x};
    a = cf{t0.x + t2.x, t0.y + t2.y}; c = cf{t0.x - t2.x, t0.y - t2.y}; b = cf{t1.x + t3i.x, t1.y + t3i.y}; d = cf{t1.x - t3i.x, t1.y - t3i.y};
}
template <int S> __device__ __forceinline__ void dft16(cf (&v)[16]) {
#pragma unroll
    for (int j0 = 0; j0 < 4; ++j0) dft4<S>(v[j0], v[j0 + 4], v[j0 + 8], v[j0 + 12]);
    constexpr float C1 = 0.9238795325112867f, S1 = 0.3826834323650898f, C2 = 0.7071067811865476f;
    v[5] = cmul(v[5], cf{C1, S * S1}); v[9] = cmul(v[9], cf{C2, S * C2}); v[13] = cmul(v[13], cf{S1, S * C1});
    v[6] = cmul(v[6], cf{C2, S * C2}); v[10] = cf{-(float)S * v[10].y, (float)S * v[10].x}; v[14] = cmul(v[14], cf{-C2, S * C2});
    v[7] = cmul(v[7], cf{S1, S * C1}); v[11] = cmul(v[11], cf{-C2, S * C2}); v[15] = cmul(v[15], cf{-C1, -S * S1});
#pragma unroll
    for (int k1 = 0; k1 < 4; ++k1) dft4<S>(v[4 * k1], v[4 * k1 + 1], v[4 * k1 + 2], v[4 * k1 + 3]);
}
#define REV4(k) ((((k) >> 2) | (((k) & 3) << 2)))
__device__ __forceinline__ int fphys(int L) { return L + (L >> 4); }
constexpr int FFT_BUF = 4352 * 8;
constexpr int FFT_ZB = 2 * FFT_BUF;
constexpr int FFT_HB1 = FFT_ZB + 32768;
constexpr int FFT_W3 = FFT_HB1 + 32768;
constexpr int FFT_RED = FFT_W3 + 1024;
static_assert(FFT_RED + 64 <= LDSCTL_OFF, "fft lds");
template <int PAT> __device__ __forceinline__ int fbase(int tp) {
    if (PAT == 0) return tp + (tp >> 4);
    if (PAT == 1) return (tp & 15) + 272 * (tp >> 4);
    return 17 * (tp & 15) + 272 * (tp >> 4);
}
template <int PAT> struct FStr { static constexpr int v = PAT == 0 ? 272 : (PAT == 1 ? 17 : 1); };
__device__ __forceinline__ int hide(int x) { asm volatile("" : "+v"(x)); return x; }
template <int PAT> __device__ __forceinline__ void fload(cf (&v)[16], const cf* buf, int tp) {
    const cf* p = buf + fbase<PAT>(tp);
#pragma unroll
    for (int j = 0; j < 16; ++j) v[j] = p[FStr<PAT>::v * j];
}
template <int PAT, int S, bool TW> __device__ __forceinline__ void fstore(cf (&v)[16], cf* buf, int tp, float base_rev) {
    cf* p = buf + fbase<PAT>(tp);
#pragma unroll
    for (int k = 0; k < 16; ++k) { cf x = v[REV4(k)]; if (TW && k > 0) x = cmul(x, cis_rev((float)S * base_rev * (float)k)); p[FStr<PAT>::v * k] = x; }
}
__device__ __forceinline__ void fft_fwd_pass2(cf* buf, int tp0) {
    const int tp = hide(tp0);
    cf v[16]; fload<1>(v, buf, tp); dft16<-1>(v);
    const int n0 = tp & 15, k2 = tp >> 4; const cf w0 = cis_rev(-(float)(n0 * k2) * (1.f / 4096.f));
    cf* p = buf + fbase<1>(tp);
#pragma unroll
    for (int k = 0; k < 16; ++k) { cf x = cmul(v[REV4(k)], w0); if (k > 0) x = cmul(x, cis_rev(-(float)(n0 * k) * (1.f / 256.f))); p[17 * k] = x; }
}
__device__ __forceinline__ void fft_inv_pass2(cf* buf, int tp0) {
    const int tp = hide(tp0);
    cf v[16]; fload<1>(v, buf, tp); dft16<1>(v);
    fstore<1, 1, true>(v, buf, tp, (float)(tp >> 4) * (1.f / 256.f));
}

__device__ __forceinline__ void load_row8(const bf16* rowp, int n0, float (&r)[10]) {
    const u32x4 a = *(const u32x4*)(rowp + n0);
    r[1] = bflo(a.x); r[2] = bfhi(a.x); r[3] = bflo(a.y); r[4] = bfhi(a.y); r[5] = bflo(a.z); r[6] = bfhi(a.z); r[7] = bflo(a.w); r[8] = bfhi(a.w);
    r[0] = n0 > 0 ? bf2f(rowp[n0 - 1]) : 0.f; r[9] = n0 + 8 < 4096 ? bf2f(rowp[n0 + 8]) : 0.f;
}

__device__ __forceinline__ void phase_hyena_fft(const Params& P, unsigned char* lds, int tid, int lane, int wave, int G) {
    cf* bufE = (cf*)lds; cf* bufO = (cf*)(lds + FFT_BUF); cf* zbuf = (cf*)(lds + FFT_ZB);
    float* w3c = (float*)(lds + FFT_W3); float* red = (float*)(lds + FFT_RED);
    const int str = tid >> 8, tp0 = tid & 255; cf* buf = str ? bufO : bufE;
    const bf16* Pt = (const bf16*)(P.ws + WS_PT); bf16* Zt = (bf16*)(P.ws + WS_ZT);
    cf* Hs = (cf*)(P.ws + WS_HSPEC) + (size_t)blockIdx.x * 4 * 4096;
    const float* a2T = (const float*)(P.ws + WS_A2);
#pragma unroll 1
    for (int c = blockIdx.x; c < 1024; c += G) {
        __syncthreads();
        if (tid < 256) w3c[tid] = P.in[I_HW3][(size_t)(tid & 63) * 4096 + (tid >> 6) * 1024 + c];
        __syncthreads();
        {
            float d[8][4];
#pragma unroll
            for (int j = 0; j < 8; ++j) { d[j][0] = 0.f; d[j][1] = 0.f; d[j][2] = 0.f; d[j][3] = 0.f; }
#pragma unroll 2
            for (int i = 0; i < 64; ++i) { const float w0 = w3c[i], w1 = w3c[64 + i], w2 = w3c[128 + i], w3 = w3c[192 + i]; const float* ar = a2T + (size_t)i * 4096 + tid;
#pragma unroll
                for (int j = 0; j < 8; ++j) { const float a = ar[512 * j]; d[j][0] += a * w0; d[j][1] += a * w1; d[j][2] += a * w2; d[j][3] += a * w3; } }
            float dec[4];
#pragma unroll
            for (int q = 0; q < 4; ++q) dec[q] = fabsf(P.in[I_HDEC][q * 1024 + c]);
            float as0 = 0.f, as1 = 0.f;
#pragma unroll
            for (int j = 0; j < 8; ++j) { const int t = tid + 512 * j; const float tl = (float)t / 4095.f;
                const float h0 = d[j][0] * expf(-tl * dec[0]), h1 = d[j][1] * expf(-tl * dec[1]), h2 = d[j][2] * expf(-tl * dec[2]), h3 = d[j][3] * expf(-tl * dec[3]);
                float* hb0 = (float*)(lds + FFT_ZB); float* hb1 = (float*)(lds + FFT_HB1);
                hb0[t] = h0; hb0[4096 + t] = h1; hb1[t] = h2; hb1[4096 + t] = h3; as0 += fabsf(h0) + fabsf(h1); as1 += fabsf(h2) + fabsf(h3); }
            as0 = wave_sum(as0); as1 = wave_sum(as1); if (lane == 0) { red[wave] = as0; red[8 + wave] = as1; }
        }
        __syncthreads();
#pragma unroll 1
        for (int o = 0; o < 2; ++o) {
            const float* hbuf = (const float*)(lds + (o == 0 ? FFT_ZB : FFT_HB1));
            float tot = 0.f;
#pragma unroll
            for (int w = 0; w < 8; ++w) tot += red[8 * o + w];
            const float inv = 1.f / ((tot + 1e-6f) * 8192.f);
            { const int tp = hide(tp0); cf v[16];
#pragma unroll
              for (int j = 0; j < 16; ++j) { const int n = tp + 256 * j; const float ta = (hbuf[n] + (n == 0 ? hbuf[4096] : 0.f)) * inv, tb = (n == 0 ? 0.f : hbuf[4096 + 4096 - n]) * inv;
                  if (str == 0) v[j] = cf{ta + tb, 0.f}; else { const cf w = cis_rev(-(float)n * (1.f / 8192.f)); v[j] = cf{(ta - tb) * w.x, (ta - tb) * w.y}; } }
              dft16<-1>(v); fstore<0, -1, true>(v, buf, tp, (float)(tp >> 4) * (1.f / 256.f)); }
            __syncthreads();
            fft_fwd_pass2(buf, tp0);
            __syncthreads();
            { const int tp = hide(tp0); cf v[16]; fload<2>(v, buf, tp); dft16<-1>(v);
              cf* hp = Hs + (size_t)(o * 2 + str) * 4096 + tp;
#pragma unroll
              for (int k = 0; k < 16; ++k) hp[k * 256] = v[REV4(k)]; }
            __syncthreads();
        }
#pragma unroll 1
        for (int pr = 0; pr < 4; ++pr) {
            { const int n0 = hide(tid) * 8; float ra[10], rb[10]; load_row8(Pt + (size_t)c * 32768 + (2 * pr) * 4096, n0, ra); load_row8(Pt + (size_t)c * 32768 + (2 * pr + 1) * 4096, n0, rb);
              const float w0 = P.in[I_HCW][c], w1 = P.in[I_HCW][3072 + c], w2 = P.in[I_HCW][6144 + c], bb = P.in[I_HCB][c];
#pragma unroll
              for (int i = 0; i < 8; ++i) zbuf[n0 + i] = cf{w0 * ra[i] + w1 * ra[i + 1] + w2 * ra[i + 2] + bb, w0 * rb[i] + w1 * rb[i + 1] + w2 * rb[i + 2] + bb}; }
            __syncthreads();
#pragma unroll 1
            for (int o = 0; o < 2; ++o) {
                { const int tp = hide(tp0); cf v[16];
#pragma unroll
                  for (int j = 0; j < 16; ++j) { const int n = tp + 256 * j; const cf z = zbuf[n]; v[j] = str == 0 ? z : cmul(z, cis_rev(-(float)n * (1.f / 8192.f))); }
                  dft16<-1>(v); fstore<0, -1, true>(v, buf, tp, (float)(tp >> 4) * (1.f / 256.f)); }
                __syncthreads();
                fft_fwd_pass2(buf, tp0);
                __syncthreads();
                { const int tp = hide(tp0); cf v[16]; fload<2>(v, buf, tp); dft16<-1>(v);
                  const cf* hp = Hs + (size_t)(o * 2 + str) * 4096 + tp;
                  cf y[16];
#pragma unroll
                  for (int k = 0; k < 16; ++k) y[k] = cmul(v[REV4(k)], hp[k * 256]);
                  dft16<1>(y);
                  fstore<2, 1, true>(y, buf, tp, (float)((tp >> 4) + 16 * (tp & 15)) * (1.f / 4096.f)); }
                __syncthreads();
                fft_inv_pass2(buf, tp0);
                __syncthreads();
                { const int tp = hide(tp0); cf v[16]; fload<0>(v, buf, tp); dft16<1>(v);
                  cf* p = buf + fbase<0>(tp);
#pragma unroll
                  for (int k = 0; k < 16; ++k) { cf x = v[REV4(k)]; if (str == 1) x = cmul(x, cis_rev((float)(tp + 256 * k) * (1.f / 8192.f))); p[272 * k] = x; } }
                __syncthreads();
                { const int n0 = hide(tid) * 8; float ga[10], gb[10]; const size_t grow = (size_t)((o + 1) * 1024 + c) * 32768;
                  load_row8(Pt + grow + (2 * pr) * 4096, n0, ga); load_row8(Pt + grow + (2 * pr + 1) * 4096, n0, gb);
                  const int gc = (o + 1) * 1024 + c;
                  const float w0 = P.in[I_HCW][gc], w1 = P.in[I_HCW][3072 + gc], w2 = P.in[I_HCW][6144 + gc], bb = P.in[I_HCB][gc];
                  const float sk = P.in[I_HSKIP][o * 1024 + c]; float oa[8], ob[8];
#pragma unroll
                  for (int i = 0; i < 8; ++i) { const int n = n0 + i; const cf e = bufE[fphys(n)], q = bufO[fphys(n)], z = zbuf[n];
                      const float g0 = w0 * ga[i] + w1 * ga[i + 1] + w2 * ga[i + 2] + bb;
                      const float g1 = w0 * gb[i] + w1 * gb[i + 1] + w2 * gb[i + 2] + bb;
                      oa[i] = (e.x + q.x + sk * z.x) * g0; ob[i] = (e.y + q.y + sk * z.y) * g1; }
                  if (o == 0) {
#pragma unroll
                      for (int i = 0; i < 8; ++i) zbuf[n0 + i] = cf{oa[i], ob[i]};
                  } else {
                      u32x4 wa, wb; wa.x = pk2(oa[0], oa[1]); wa.y = pk2(oa[2], oa[3]); wa.z = pk2(oa[4], oa[5]); wa.w = pk2(oa[6], oa[7]);
                      wb.x = pk2(ob[0], ob[1]); wb.y = pk2(ob[2], ob[3]); wb.z = pk2(ob[4], ob[5]); wb.w = pk2(ob[6], ob[7]);
                      *(u32x4*)(Zt + (size_t)c * 32768 + (2 * pr) * 4096 + n0) = wa; *(u32x4*)(Zt + (size_t)c * 32768 + (2 * pr + 1) * 4096 + n0) = wb;
                  } }
                __syncthreads();
            }
        }
    }
}
__device__ __forceinline__ void phase_transpose(const Params& P, unsigned char* lds, int lane, int wave, int G) {
    bf16* tile = (bf16*)(lds + wave * 16384);
    const bf16* Zt = (const bf16*)(P.ws + WS_ZT); bf16* Z = (bf16*)(P.ws + WS_Z);
    for (int it = blockIdx.x * 8 + wave; it < 16 * 512; it += G * 8) {
        const int cb = it & 15, tb = it >> 4, c0 = cb * 64, t0 = tb * 64;
#pragma unroll
        for (int i = 0; i < 8; ++i) { const int ch = i * 8 + (lane >> 3), tq = (lane & 7) * 8;
            const u32x4 a = *(const u32x4*)(Zt + (size_t)(c0 + ch) * 32768 + t0 + tq);
            unsigned* d = (unsigned*)(tile + ch * 66 + tq); d[0] = a.x; d[1] = a.y; d[2] = a.z; d[3] = a.w; }
        LDS_WAIT(); asm volatile("" ::: "memory");
#pragma unroll
        for (int i = 0; i < 8; ++i) { const int tk = i * 8 + (lane >> 3), cq = (lane & 7) * 8;
            unsigned short e[8];
#pragma unroll
            for (int j = 0; j < 8; ++j) e[j] = tile[(cq + j) * 66 + tk];
            u32x4 w; w.x = e[0] | ((unsigned)e[1] << 16); w.y = e[2] | ((unsigned)e[3] << 16); w.z = e[4] | ((unsigned)e[5] << 16); w.w = e[6] | ((unsigned)e[7] << 16);
            *(u32x4*)(Z + (size_t)(t0 + tk) * 1024 + c0 + cq) = w; }
        LDS_WAIT(); asm volatile("" ::: "memory");
    }
}

constexpr int N_PHASES = 21;
__global__ void __launch_bounds__(512, 2) fwd_kernel(Params P) {
    extern __shared__ __attribute__((aligned(16))) unsigned char lds[];
    const int tid = threadIdx.x, lane = tid & 63, wave = __builtin_amdgcn_readfirstlane(tid >> 6), G = gridDim.x;
    unsigned char* ws = P.ws;
    PG8_LAS unsigned char* ldsl = (PG8_LAS unsigned char*)lds;
    for (int u = tid; u < (LDS_BYTES - LDSCTL_OFF) / 4; u += 512) ((unsigned*)(lds + LDSCTL_OFF))[u] = 0u;
    __syncthreads();
#if MK_ONE_LAUNCH
    XcdBarrier bar = xcd_barrier_post((unsigned*)(ws + WS_CTL) + CW_BAR, (volatile LAS unsigned*)(ldsl + MISC_OFF) + 8);
#define GRID_BAR() xcd_barrier(bar)
#else
#define GRID_BAR() do { } while (0)
#endif
    const int lo = P.ph_lo, hi = P.ph_hi;
#ifndef PHASE_MASK
#define PHASE_MASK 0xFFFFFFFFu
#endif
#define IN(k) ((((PHASE_MASK) >> (k)) & 1u) && lo <= (k) && (k) < hi)
#define SEAM(k) do { if (IN(k) && IN((k) + 1)) GRID_BAR(); } while (0)

    if (IN(0)) { phase_prologue(P, lds, tid, lane, wave, G); } SEAM(0);
    if (IN(1)) { phase_norm1_l0(P, lane, wave, G); } SEAM(1);
    if (IN(2)) {
        pg8::Gemm g{(const bf16*)(ws + WS_RH), (const bf16*)(ws + WS_WIN), 1024, 1024, 1024, 0}; pg8::StaticOrder S; S.init(M0 / 256, 7, G, (int)blockIdx.x);
        EpiIn E{(bf16*)(ws + WS_CQ), (bf16*)(ws + WS_CKV), (bf16*)(ws + WS_UX), (bf16*)(ws + WS_UG), (bf16*)(ws + WS_K)};
        pg8::gemm_phase<EpiIn, pg8::StaticOrder, GP_ALIGN, GP_SP2>(ldsl, g, S, E);
    } SEAM(2);
    if (IN(3)) { phase_rowstat(P, lane, wave, G); phase_lru_f1(P, lds, tid, lane, wave, G); } SEAM(3);
    if (IN(4)) {
#ifndef NO_QUP
        { pg8::Gemm g{(const bf16*)(ws + WS_CQ), (const bf16*)(ws + WS_WUQ), 384, 384, 384, 0}; pg8::StaticOrder S; S.init(M0 / 256, 3, G, (int)blockIdx.x);
          EpiQ E{(bf16*)(ws + WS_Q), (const float*)(ws + WS_RQ)};
          pg8::gemm_phase<EpiQ, pg8::StaticOrder, GP_ALIGN, GP_SP2>(ldsl, g, S, E); }
#endif
        __syncthreads();
        { pg8::Gemm g{(const bf16*)(ws + WS_CKV), (const bf16*)(ws + WS_WUKV), 256, 256, 256, 0}; pg8::StaticOrder S; S.init(M0 / 256, 4, G, (int)blockIdx.x);
          EpiKV E{(bf16*)(ws + WS_K), (bf16*)(ws + WS_V), (const float*)(ws + WS_RKV)};
          pg8::gemm_phase<EpiKV, pg8::StaticOrder, GP_ALIGN, GP_SP2>(ldsl, g, S, E); }
        __syncthreads();
#ifndef NO_F3
        phase_lru_f3(P, lds, tid, lane, wave, G);
#endif
    } SEAM(4);
    if (IN(5)) { phase_attention(P, lds, G); } SEAM(5);
    if (IN(6)) {
        pg8::Gemm g{(const bf16*)(ws + WS_RH), (const bf16*)(ws + WS_WOUT), 1024, 1024, 1024, 0}; pg8::StaticOrder S; S.init(M0 / 256, 4, G, (int)blockIdx.x);
        EpiRes<0> E{P.in[I_X], P.in[I_CTX], (const float*)(ws + WS_MOD), P.out, (float*)(ws + WS_XC)};
        pg8::gemm_phase<EpiRes<0>, pg8::StaticOrder, GP_ALIGN, GP_SP2>(ldsl, g, S, E);
    } SEAM(6);
    if (IN(7)) { phase_norm2_route<0>(P, lds, tid, lane, wave, G); } SEAM(7);
    if (IN(8)) { phase_permute<0>(P, lds, tid, lane, wave, G); } SEAM(8);
    if (IN(9)) {
        const int* te = (const int*)(ws + WS_TILEE);
        pg8::Gemm g{(const bf16*)(ws + WS_HPERM), (const bf16*)(ws + WS_W13), 1024, 1024, 1024, (size_t)1024 * 1024 * 2}; pg8::MoeOrder S{te[MAXTILES], G, (int)blockIdx.x, te};
        EpiMoe1 E{(bf16*)(ws + WS_ACT)};
        pg8::gemm_phase<EpiMoe1, pg8::MoeOrder, GP_ALIGN, GP_SP2>(ldsl, g, S, E);
    } SEAM(9);
    if (IN(10)) {
        const int* te = (const int*)(ws + WS_TILEE);
        pg8::Gemm g{(const bf16*)(ws + WS_ACT), (const bf16*)(ws + WS_W2), 512, 512, 512, (size_t)1024 * 512 * 2}; pg8::MoeOrder S{te[MAXTILES], G, (int)blockIdx.x, te};
        EpiStore E{(bf16*)(ws + WS_HPERM), 1024};
        pg8::gemm_phase<EpiStore, pg8::MoeOrder, GP_ALIGN, GP_SP2>(ldsl, g, S, E);
    } SEAM(10);
    if (IN(11)) { phase_combine_norm1_l1(P, lane, wave, G); } SEAM(11);
    if (IN(12)) {
        pg8::Gemm g{(const bf16*)(ws + WS_WHIN), (const bf16*)(ws + WS_RH), 1024, 1024, 1024, 0}; pg8::StaticOrder S; S.init(3072 / 256, M1 / 256, G, (int)blockIdx.x);
        EpiStore E{(bf16*)(ws + WS_PT), 32768};
        pg8::gemm_phase<EpiStore, pg8::StaticOrder, GP_ALIGN, GP_SP2>(ldsl, g, S, E);
    } SEAM(12);
    if (IN(13)) { phase_hyena_fft(P, lds, tid, lane, wave, G); } SEAM(13);
    if (IN(14)) { phase_transpose(P, lds, lane, wave, G); } SEAM(14);
    if (IN(15)) {
        pg8::Gemm g{(const bf16*)(ws + WS_Z), (const bf16*)(ws + WS_WHOUT), 1024, 1024, 1024, 0}; pg8::StaticOrder S; S.init(M1 / 256, 4, G, (int)blockIdx.x);
        EpiRes<1> E{nullptr, nullptr, (const float*)(ws + WS_MOD), P.out, nullptr};
        pg8::gemm_phase<EpiRes<1>, pg8::StaticOrder, GP_ALIGN, GP_SP2>(ldsl, g, S, E);
    } SEAM(15);
    if (IN(16)) { phase_norm2_route<1>(P, lds, tid, lane, wave, G); } SEAM(16);
    if (IN(17)) { phase_permute<1>(P, lds, tid, lane, wave, G); } SEAM(17);
    if (IN(18)) {
        const int* te = (const int*)(ws + WS_TILEE);
        pg8::Gemm g{(const bf16*)(ws + WS_HPERM), (const bf16*)(ws + WS_W13) + (size_t)16 * 1024 * 1024, 1024, 1024, 1024, (size_t)1024 * 1024 * 2}; pg8::MoeOrder S{te[MAXTILES], G, (int)blockIdx.x, te};
        EpiMoe1 E{(bf16*)(ws + WS_ACT)};
        pg8::gemm_phase<EpiMoe1, pg8::MoeOrder, GP_ALIGN, GP_SP2>(ldsl, g, S, E);
    } SEAM(18);
    if (IN(19)) {
        const int* te = (const int*)(ws + WS_TILEE);
        pg8::Gemm g{(const bf16*)(ws + WS_ACT), (const bf16*)(ws + WS_W2) + (size_t)16 * 1024 * 512, 512, 512, 512, (size_t)1024 * 512 * 2}; pg8::MoeOrder S{te[MAXTILES], G, (int)blockIdx.x, te};
        EpiStore E{(bf16*)(ws + WS_HPERM), 1024};
        pg8::gemm_phase<EpiStore, pg8::MoeOrder, GP_ALIGN, GP_SP2>(ldsl, g, S, E);
    } SEAM(19);
    if (IN(20)) { phase_final(P, lane, wave, G); }
#undef IN
#undef SEAM
}

extern "C" void kernel_launch(void* const* d_in, const int* in_sizes, int n_in, void* d_out, int out_size, void* d_ws, size_t ws_size, hipStream_t stream) {
    static int grid = 0;
    if (grid == 0) {
        if (n_in != N_IN || out_size != M1 * DM || ws_size < WS_END) { fprintf(stderr, "kernel_launch: unexpected shapes (n_in %d out %d ws %zu)\n", n_in, out_size, ws_size); grid = -1; return; }
        int dev = 0, cus = 0;
        if (hipGetDevice(&dev) != hipSuccess || hipDeviceGetAttribute(&cus, hipDeviceAttributeMultiprocessorCount, dev) != hipSuccess) { grid = -1; return; }
        if (hipFuncSetAttribute((const void*)fwd_kernel, hipFuncAttributeMaxDynamicSharedMemorySize, LDS_BYTES) != hipSuccess) { fprintf(stderr, "kernel_launch: hipFuncSetAttribute failed\n"); grid = -1; return; }
        int per_cu = 0;
        if (hipOccupancyMaxActiveBlocksPerMultiprocessor(&per_cu, (const void*)fwd_kernel, 512, LDS_BYTES) != hipSuccess || per_cu < 1) fprintf(stderr, "kernel_launch: occupancy query reports %d\n", per_cu);
        (void)hipGetLastError();
        grid = cus;
    }
    if (grid < 0) return;
    (void)hipMemsetAsync((char*)d_ws + WS_CTL, 0, CTL_ZERO_BYTES, stream);
    Params p{};
    for (int i = 0; i < N_IN; ++i) p.in[i] = (const float*)d_in[i];
    p.out = (float*)d_out; p.ws = (unsigned char*)d_ws;
#if MK_ONE_LAUNCH
    p.ph_lo = 0; p.ph_hi = N_PHASES;
    hipLaunchKernelGGL(fwd_kernel, dim3(grid), dim3(512), LDS_BYTES, stream, p);
#else
    for (int k = 0; k < N_PHASES; ++k) { p.ph_lo = k; p.ph_hi = k + 1; hipLaunchKernelGGL(fwd_kernel, dim3(grid), dim3(512), LDS_BYTES, stream, p); }
#endif
}
```

```cpp
#include <hip/hip_runtime.h>
#include <cstdio>
#include <cstdint>

#ifndef MK_ONE_LAUNCH
#define MK_ONE_LAUNCH 1
#endif

#define LAS __attribute__((address_space(3)))
#define GAS __attribute__((address_space(1)))
typedef unsigned short bf16;
typedef short bf16x8 __attribute__((ext_vector_type(8)));
typedef short s16x4 __attribute__((ext_vector_type(4)));
typedef float f32x2 __attribute__((ext_vector_type(2)));
typedef float f32x4 __attribute__((ext_vector_type(4)));
typedef float f32x16 __attribute__((ext_vector_type(16)));
typedef unsigned u32x2 __attribute__((ext_vector_type(2)));
typedef unsigned u32x4 __attribute__((ext_vector_type(4)));
#define LDS_WAIT() asm volatile("s_waitcnt lgkmcnt(0)" ::: "memory")
#define VM_WAIT() asm volatile("s_waitcnt vmcnt(0)" ::: "memory")

__device__ __forceinline__ unsigned f2bf(float f) { unsigned u = __builtin_bit_cast(unsigned, f); return (u + 0x7fffu + ((u >> 16) & 1u)) >> 16; }
__device__ __forceinline__ unsigned pk2(float lo, float hi) { return f2bf(lo) | (f2bf(hi) << 16); }
__device__ __forceinline__ float bf2f(unsigned b) { return __builtin_bit_cast(float, b << 16); }
__device__ __forceinline__ float bflo(unsigned w) { return __builtin_bit_cast(float, w << 16); }
__device__ __forceinline__ float bfhi(unsigned w) { return __builtin_bit_cast(float, w & 0xffff0000u); }
__device__ __forceinline__ float wave_sum(float v) {
#pragma unroll
    for (int o = 1; o < 64; o <<= 1) v += __shfl_xor(v, o);
    return v;
}
__device__ __forceinline__ float sigm(float x) { return 1.f / (1.f + expf(-x)); }

namespace pg8 {
#define PG8_LAS __attribute__((address_space(3)))
typedef unsigned short bf16_t;
constexpr int BM = 256, BK = 64, HALF = 128, HTB = HALF * BK * 2, STAGE_BYTES = 8 * HTB, NXCD = 8, WGM = 8;
__host__ __device__ __forceinline__ int lds_byte(int r, int c) { const int st = (r >> 4) * 2 + (c >> 5), rr = r & 15, cc = c & 31, ob = rr * 64 + cc * 2; return st * 1024 + (ob ^ (((ob >> 9) & 1) << 5)); }
__host__ __device__ __forceinline__ void stage_rc(int b, int& R, int& C) { const int st = b / 1024, sb = b % 1024, swz = sb ^ (((sb >> 9) & 1) << 5); R = (st >> 1) * 16 + swz / 64; C = (st & 1) * 32 + (swz % 64) / 2; }
__host__ __device__ __forceinline__ int perm32(int rho) { const int n = rho >> 4, i = rho & 15; return 8 * (i >> 2) + 4 * n + (i & 3); }

struct Unit { int pm, pn, bz; };
struct Gemm { const bf16_t* A; const bf16_t* Bt; int lda, ldb, K; size_t bz_stride; };

struct StaticOrder {
    int nM, nN, nwg, G, c;
    __host__ __device__ void init(int nM_, int nN_, int G_, int c_) { nM = nM_; nN = nN_; nwg = nM * nN; G = G_; c = c_; }
    __host__ __device__ bool next(int i, Unit& u) const {
        const long L = (long)i * G + c; if (L >= nwg) return false;
        int wgid = (int)L; { const int q = nwg / NXCD, r = nwg % NXCD, xcd = wgid % NXCD, off = wgid / NXCD; wgid = (xcd < r ? xcd * (q + 1) : r * (q + 1) + (xcd - r) * q) + off; }
        const int nig = WGM * nN, gid = wgid / nig, fm = gid * WGM, gsz = (nM - fm) < WGM ? (nM - fm) : WGM;
        u.pm = fm + ((wgid % nig) % gsz); u.pn = (wgid % nig) / gsz; u.bz = 0; return true;
    }
    __device__ __forceinline__ void a_ready(const Unit&) const {}
    __device__ __forceinline__ void done(const Unit&) const {}
};
struct MoeOrder {
    int nM, G, c; const int* tile_e;
    __device__ bool next(int i, Unit& u) const {
        const long L = (long)i * G + c; if (L >= (long)nM * 4) return false;
        u.pm = (int)(L >> 2); u.pn = (int)(L & 3); u.bz = tile_e[u.pm]; return true;
    }
    __device__ __forceinline__ void a_ready(const Unit&) const {}
    __device__ __forceinline__ void done(const Unit&) const {}
};

__device__ __forceinline__ unsigned cvt_pk_bf16(float lo, float hi) { unsigned r; asm volatile("v_cvt_pk_bf16_f32 %0, %1, %2" : "=v"(r) : "v"(lo), "v"(hi)); return r; }

template <class Epi, class Sched, bool ALIGN_EPI = false, bool SP2 = false>
__device__ __forceinline__ void gemm_phase(PG8_LAS unsigned char* lds, const Gemm g, const Sched& S, const Epi& E) {
    const int tid = threadIdx.x, wid = __builtin_amdgcn_readfirstlane(tid >> 6), lane = tid & 63, wr = wid >> 2, wc = wid & 3, fr = lane & 15, fq = lane >> 4;
    const int K = g.K, nt = K / BK;
    unsigned voffA[2], voffB[2];
#pragma unroll
    for (int i = 0; i < 2; ++i) { int R, C; stage_rc(tid * 16 + i * 8192, R, C); const int Rb = Epi::PERM ? ((R & ~31) + perm32(R & 31)) : R;
        voffA[i] = (unsigned)(R * g.lda + C) * 2u; voffB[i] = (unsigned)(Rb * g.ldb + C) * 2u; }
    const size_t kstep = (size_t)(BK * 2);
    const size_t hstepA = (size_t)HALF * g.lda * 2, hstepB = (size_t)HALF * g.ldb * 2;
    const size_t tstepA = 2 * hstepA, tstepB = 2 * hstepB;
    const unsigned ldsw = (unsigned)wid * 1024u;
    const int aoff = lds_byte(wr * 64 + fr, fq * 8), boff = lds_byte(wc * 32 + fr, fq * 8);
#define PG8_SA(b, h) (((b) * 2 + (h)) * HTB)
#define PG8_SB(b, h) ((4 + (b) * 2 + (h)) * HTB)
#define PG8_STAGE(bufoff, gbase, voff) do { _Pragma("unroll") for (int _i = 0; _i < 2; ++_i) \
        __builtin_amdgcn_global_load_lds((const unsigned*)((const char*)(gbase) + (voff)[_i]), (PG8_LAS unsigned*)(lds + (bufoff) + ldsw + _i * 8192), 16, 0, 0); } while (0)
#define PG8_LDA(dst, b, h) do { _Pragma("unroll") for (int m = 0; m < 4; ++m) _Pragma("unroll") for (int k = 0; k < 2; ++k) dst[m][k] = *(const PG8_LAS bf16x8*)(lds + PG8_SA(b, h) + aoff + m * 2048 + k * 1024); } while (0)
#define PG8_LDB(dst, b, h) do { _Pragma("unroll") for (int n = 0; n < 2; ++n) _Pragma("unroll") for (int k = 0; k < 2; ++k) dst[n][k] = *(const PG8_LAS bf16x8*)(lds + PG8_SB(b, h) + boff + n * 2048 + k * 1024); } while (0)
#define PG8_MMA(ai, bj, At, Bt) do { __builtin_amdgcn_s_setprio(1); _Pragma("unroll") for (int m = 0; m < 4; ++m) _Pragma("unroll") for (int n = 0; n < 2; ++n) _Pragma("unroll") for (int k = 0; k < 2; ++k) \
        acc[ai][bj][m][n] = __builtin_amdgcn_mfma_f32_16x16x32_bf16(Bt[n][k], At[m][k], acc[ai][bj][m][n], 0, 0, 0); __builtin_amdgcn_s_setprio(0); } while (0)
#define PG8_WAIT_V(n) asm volatile("s_waitcnt vmcnt(" #n ")" ::: "memory")
#define PG8_WAIT_L(n) asm volatile("s_waitcnt lgkmcnt(" #n ")" ::: "memory")
#define PG8_BAR __builtin_amdgcn_s_barrier()
#define PG8_SCHED __builtin_amdgcn_sched_barrier(0)
    Unit cur, nxt; int ui = 0;
    if (!S.next(0, cur)) return;
    f32x4 acc[2][2][4][2];
#pragma unroll
    for (int a = 0; a < 2; ++a)
#pragma unroll
        for (int b = 0; b < 2; ++b)
#pragma unroll
            for (int m = 0; m < 4; ++m)
#pragma unroll
                for (int n = 0; n < 2; ++n) acc[a][b][m][n] = (f32x4){0.f, 0.f, 0.f, 0.f};
    bf16x8 At[4][2], B0[2][2], B1[2][2];
    const char* cA = (const char*)g.A + (size_t)cur.pm * tstepA; const char* cB = (const char*)g.Bt + (size_t)cur.bz * g.bz_stride + (size_t)cur.pn * tstepB;
    S.a_ready(cur);
    if constexpr (SP2) {
        PG8_STAGE(PG8_SB(0, 0), cB, voffB); PG8_STAGE(PG8_SB(0, 1), cB + hstepB, voffB); PG8_STAGE(PG8_SA(0, 0), cA, voffA); PG8_STAGE(PG8_SA(0, 1), cA + hstepA, voffA);
        if (wr == 1) PG8_BAR;
        PG8_WAIT_V(2); PG8_BAR;
        PG8_STAGE(PG8_SB(1, 0), cB + kstep, voffB); PG8_STAGE(PG8_SA(1, 0), cA + kstep, voffA); PG8_STAGE(PG8_SB(1, 1), cB + hstepB + kstep, voffB);
        PG8_WAIT_V(6); PG8_BAR;
    } else {
        PG8_STAGE(PG8_SB(0, 0), cB, voffB); PG8_STAGE(PG8_SA(0, 0), cA, voffA); PG8_STAGE(PG8_SB(0, 1), cB + hstepB, voffB); PG8_STAGE(PG8_SA(0, 1), cA + hstepA, voffA);
        if (wr == 1) PG8_BAR;
        PG8_WAIT_V(4); PG8_BAR;
        PG8_STAGE(PG8_SB(1, 0), cB + kstep, voffB); PG8_STAGE(PG8_SA(1, 0), cA + kstep, voffA); PG8_STAGE(PG8_SB(1, 1), cB + hstepB + kstep, voffB);
        PG8_WAIT_V(6); PG8_BAR;
    }
    for (;;) {
        const bool has_next = S.next(ui + 1, nxt);
        const char* nA = has_next ? (const char*)g.A + (size_t)nxt.pm * tstepA : cA;
        const char* nB = has_next ? (const char*)g.Bt + (size_t)nxt.bz * g.bz_stride + (size_t)nxt.pn * tstepB : cB;
#pragma unroll 1
        for (int t = 0; t < nt; t += 2) {
            const bool last = (t == nt - 2);
            const char* a1 = cA + (size_t)(t + 1) * kstep;
            const char* a2 = last ? nA : cA + (size_t)(t + 2) * kstep; const char* b2 = last ? nB : cB + (size_t)(t + 2) * kstep;
            const char* a3 = a2 + kstep; const char* b3 = b2 + kstep;
            if (last && has_next) S.a_ready(nxt);
            if constexpr (SP2) {
            PG8_LDB(B0, 0, 0); PG8_LDB(B1, 0, 1); PG8_SCHED; PG8_LDA(At, 0, 0); PG8_STAGE(PG8_SA(1, 1), a1 + hstepA, voffA);
            PG8_WAIT_V(8); PG8_WAIT_L(0); PG8_BAR; PG8_MMA(0, 0, At, B0); PG8_MMA(0, 1, At, B1); PG8_BAR; PG8_SCHED;
            PG8_LDA(At, 0, 1); PG8_STAGE(PG8_SB(0, 0), b2, voffB); PG8_STAGE(PG8_SB(0, 1), b2 + hstepB, voffB); PG8_STAGE(PG8_SA(0, 0), a2, voffA);
            PG8_WAIT_V(8); PG8_WAIT_L(0); PG8_BAR; PG8_MMA(1, 0, At, B0); PG8_MMA(1, 1, At, B1); PG8_BAR; PG8_SCHED;
            PG8_LDB(B0, 1, 0); PG8_LDB(B1, 1, 1); PG8_SCHED; PG8_LDA(At, 1, 0); PG8_STAGE(PG8_SA(0, 1), a2 + hstepA, voffA);
            PG8_WAIT_V(8); PG8_WAIT_L(0); PG8_BAR; PG8_MMA(0, 0, At, B0); PG8_MMA(0, 1, At, B1); PG8_BAR; PG8_SCHED;
            PG8_LDA(At, 1, 1); PG8_STAGE(PG8_SB(1, 0), b3, voffB); PG8_STAGE(PG8_SB(1, 1), b3 + hstepB, voffB); PG8_STAGE(PG8_SA(1, 0), a3, voffA);
            PG8_WAIT_V(8); PG8_WAIT_L(0); PG8_BAR; PG8_MMA(1, 0, At, B0); PG8_MMA(1, 1, At, B1); PG8_BAR; PG8_SCHED;
            } else {
            PG8_LDB(B0, 0, 0); PG8_SCHED; PG8_LDA(At, 0, 0); PG8_STAGE(PG8_SA(1, 1), a1 + hstepA, voffA);
            PG8_WAIT_L(8); PG8_BAR; PG8_WAIT_L(0); PG8_MMA(0, 0, At, B0); PG8_BAR; PG8_SCHED;
            PG8_LDB(B1, 0, 1); PG8_STAGE(PG8_SB(0, 0), b2, voffB);
            PG8_BAR; PG8_WAIT_L(0); PG8_MMA(0, 1, At, B1); PG8_BAR;
            PG8_LDA(At, 0, 1); PG8_STAGE(PG8_SA(0, 0), a2, voffA);
            PG8_BAR; PG8_WAIT_L(0); PG8_MMA(1, 0, At, B0); PG8_BAR; PG8_SCHED;
            PG8_STAGE(PG8_SB(0, 1), b2 + hstepB, voffB);
            PG8_WAIT_V(6); PG8_BAR; PG8_MMA(1, 1, At, B1); PG8_BAR;
            PG8_LDB(B0, 1, 0); PG8_SCHED; PG8_LDA(At, 1, 0); PG8_STAGE(PG8_SA(0, 1), a2 + hstepA, voffA);
            PG8_WAIT_L(8); PG8_BAR; PG8_WAIT_L(0); PG8_MMA(0, 0, At, B0); PG8_BAR; PG8_SCHED;
            PG8_LDB(B1, 1, 1); PG8_STAGE(PG8_SB(1, 0), b3, voffB);
            PG8_BAR; PG8_WAIT_L(0); PG8_MMA(0, 1, At, B1); PG8_BAR;
            PG8_LDA(At, 1, 1); PG8_STAGE(PG8_SA(1, 0), a3, voffA);
            PG8_BAR; PG8_WAIT_L(0); PG8_MMA(1, 0, At, B0); PG8_BAR; PG8_SCHED;
            PG8_STAGE(PG8_SB(1, 1), b3 + hstepB, voffB);
            PG8_WAIT_V(6); PG8_BAR; PG8_MMA(1, 1, At, B1); PG8_BAR;
            }
        }
        if constexpr (ALIGN_EPI) { if (wr == 0) PG8_BAR; }
        E(acc, cur, wr, wc, fr, fq); S.done(cur);
        if (!has_next) break;
#pragma unroll
        for (int a = 0; a < 2; ++a)
#pragma unroll
            for (int b = 0; b < 2; ++b)
#pragma unroll
                for (int m = 0; m < 4; ++m)
#pragma unroll
                    for (int n = 0; n < 2; ++n) acc[a][b][m][n] = (f32x4){0.f, 0.f, 0.f, 0.f};
        cur = nxt; cA = nA; cB = nB; ++ui;
        if constexpr (ALIGN_EPI) { if (wr == 1) PG8_BAR; }
    }
    PG8_WAIT_V(0);
    if constexpr (!ALIGN_EPI) { if (wr == 0) PG8_BAR; }
    PG8_BAR;
#undef PG8_SA
#undef PG8_SB
#undef PG8_STAGE
#undef PG8_LDA
#undef PG8_LDB
#undef PG8_MMA
#undef PG8_WAIT_V
#undef PG8_WAIT_L
#undef PG8_BAR
#undef PG8_SCHED
}
}
#define GP_ALIGN true
#define GP_SP2 true

constexpr int DM = 1024, NB = 8, SEQ = 4096, CTXL = 256, TC = SEQ + CTXL  ;
constexpr int M0 = NB * TC  , M1 = NB * SEQ  ;
constexpr int NEXP = 16;
constexpr float RMS_EPS = 1e-6f;
constexpr int NCHUNK = 256;
constexpr int MAXTILES = 288;
constexpr int LCH = 68;

enum { I_X = 0, I_C, I_CTX, I_CCTX, I_ADAW, I_ADAB, I_N1G, I_N2G, I_FING, I_EVWIN, I_QNG, I_KVNG, I_WUQ, I_WUKV, I_LCW, I_LCB, I_LWA, I_LBA, I_LWX, I_LBX, I_LLAM, I_EVWOUT,
       I_ODWIN, I_HCW, I_HCB, I_HW1, I_HB1, I_HF1, I_HW2, I_HB2, I_HF2, I_HW3, I_HDEC, I_HSKIP, I_ODWOUT, I_RW, I_RB, I_MW1, I_MW3, I_MW2, N_IN };

constexpr size_t MiB = 1u << 20;
constexpr size_t WS_CTL = 0, CTL_ZERO_BYTES = 1 * MiB;
constexpr size_t WS_MOD = 1 * MiB;
constexpr size_t WS_RQ = WS_MOD + 2 * 9 * 6144 * 4;
constexpr size_t WS_RKV = WS_RQ + (size_t)M0 * 4;
constexpr size_t WS_A2 = 2 * MiB;
constexpr size_t WS_ROUTE_E = 3 * MiB;
constexpr size_t WS_ROUTE_W = WS_ROUTE_E + (size_t)M0 * 4;
constexpr size_t WS_ROUTE_S = WS_ROUTE_W + (size_t)M0 * 8;
constexpr size_t WS_CNT = WS_ROUTE_S + (size_t)M0 * 8;
constexpr size_t WS_TILEE = WS_CNT + 256 * 16 * 4;
static_assert(WS_TILEE + (MAXTILES + 64) * 4 <= 4 * MiB, "route region");
constexpr size_t WS_CP = 4 * MiB;
constexpr size_t WS_CS = WS_CP + (size_t)2 * 8 * LCH * 512 * 4;
static_assert(WS_CS + (size_t)2 * 8 * LCH * 512 * 4 <= 10 * MiB, "lru carries");
constexpr size_t WS_WIN = 10 * MiB;
constexpr size_t WS_WUQ = 14 * MiB;
constexpr size_t WS_WUKV = 15 * MiB;
constexpr size_t WS_WOUT = 16 * MiB;
constexpr size_t WS_WHIN = 18 * MiB;
constexpr size_t WS_WHOUT = 24 * MiB;
constexpr size_t WS_WG = 26 * MiB;
constexpr size_t WS_W13 = 27 * MiB;
constexpr size_t WS_W2 = 91 * MiB;
constexpr size_t WS_RH = 124 * MiB;
constexpr size_t WS_XC = 192 * MiB;
constexpr size_t WS_R2 = 200 * MiB;
constexpr size_t WS_CQ = WS_R2;
constexpr size_t WS_CKV = WS_R2 + 26 * MiB;
constexpr size_t WS_UX = WS_R2 + 43 * MiB;
constexpr size_t WS_UG = WS_R2 + 77 * MiB;
constexpr size_t WS_Q = WS_R2 + 111 * MiB;
constexpr size_t WS_K = WS_R2 + 162 * MiB;
constexpr size_t WS_V = WS_R2 + 213 * MiB;
constexpr size_t WS_HPERM = WS_R2;
constexpr size_t WS_ACT = WS_R2 + 144 * MiB;
constexpr size_t WS_PT = WS_R2;
constexpr size_t WS_ZT = WS_R2 + 192 * MiB;
constexpr size_t WS_Z = WS_R2;
constexpr size_t WS_HSPEC = 456 * MiB;
constexpr size_t WS_HIN = 488 * MiB;
constexpr size_t WS_END = 491 * MiB;
static_assert(WS_V + (size_t)M0 * 512 * 2 <= WS_HSPEC && WS_ZT + (size_t)1024 * 32768 * 2 <= WS_HSPEC && WS_ACT + (size_t)73728 * 512 * 2 <= WS_HSPEC, "ws map");

constexpr int CW_TMO = 0, CW_BAR = 4096;

constexpr int RING_BYTES = 131072, LDS_BYTES = 155648, LDSCTL_OFF = LDS_BYTES - 1024, MISC_OFF = LDSCTL_OFF + 320;

#define XB_TMO      128
#define XB_XCNT(j)  (256  + 64 * (j))
#define XB_XSUB(j)  (1280 + 64 * (j))
#define XB_XGEN(j)  (2304 + 64 * (j))
#define XB_TOP      3328
#define XB_TOPGEN   3392
#define XCD_BAR_WORDS 3456
#define XB_SPIN_CAP (1u << 18)
__device__ __forceinline__ unsigned xb_ld(unsigned* p)              { return __hip_atomic_load(p, __ATOMIC_RELAXED, __HIP_MEMORY_SCOPE_AGENT); }
__device__ __forceinline__ unsigned xb_add(unsigned* p, unsigned v) { return __hip_atomic_fetch_add(p, v, __ATOMIC_RELAXED, __HIP_MEMORY_SCOPE_AGENT); }
__device__ __forceinline__ unsigned xb_xcc_id() { return (unsigned)__builtin_amdgcn_s_getreg((3 << 11) | 20) & 0xFu; }
#define XB_SPIN(cond, bar) do { unsigned _sp = 0; while (cond) { __builtin_amdgcn_s_sleep(1); \
    if ((++_sp & 255u) == 0u) { if (xb_ld(&(bar)[XB_TMO])) break; if (_sp > XB_SPIN_CAP) { atomicAdd(&(bar)[XB_TMO], 1u); break; } } } } while (0)
struct XcdBarrier { unsigned* bar; unsigned x; volatile LAS unsigned* st; };
__device__ __forceinline__ XcdBarrier xcd_barrier_post(unsigned* bar, volatile LAS unsigned* st) {
    XcdBarrier b; b.bar = bar; b.x = xb_xcc_id(); b.st = st;
    if (threadIdx.x == 0) (void)xb_add(&bar[XB_XCNT(b.x)], 1u);
    return b;
}
__device__ __forceinline__ void xcd_barrier_complete(unsigned* bar, unsigned x, unsigned& nloc, unsigned& nx) {
    const unsigned G = gridDim.x * gridDim.y * gridDim.z;
    unsigned sum, cnt, mine, sp = 0u;
    for (;;) {
        sum = 0u; cnt = 0u; mine = 0u;
#pragma unroll
        for (unsigned j = 0; j < 16; ++j) { const unsigned c = xb_ld(&bar[XB_XCNT(j)]); sum += c; cnt += (c > 0u) ? 1u : 0u; mine = (j == x) ? c : mine; }
        if (sum == G) break;
        __builtin_amdgcn_s_sleep(1);
        if ((++sp & 255u) == 0u) { if (xb_ld(&bar[XB_TMO])) break; if (sp > XB_SPIN_CAP) { atomicAdd(&bar[XB_TMO], 1u); break; } }
    }
    nloc = mine > 0u ? mine : 1u; nx = cnt > 0u ? cnt : 1u;
}
__device__ __forceinline__ void xcd_barrier(const XcdBarrier& b) {
    asm volatile("s_waitcnt vmcnt(0)" ::: "memory");
    __syncthreads();
    if (threadIdx.x == 0) {
        unsigned* bar = b.bar;
        __builtin_amdgcn_s_waitcnt(0);
        unsigned nloc = b.st[0], nx = b.st[1];
        if (nloc == 0u) { xcd_barrier_complete(bar, b.x, nloc, nx); b.st[0] = nloc; b.st[1] = nx; }
        const unsigned old = xb_add(&bar[XB_XSUB(b.x)], 1u);
        const unsigned gen = old / nloc;
        if (old + 1u == (gen + 1u) * nloc) {
            __builtin_amdgcn_fence(__ATOMIC_RELEASE, "agent");
            asm volatile("s_waitcnt vmcnt(0)" ::: "memory");
            const unsigned og = xb_add(&bar[XB_TOP], 1u);
            const unsigned tg = og / nx;
            if (og + 1u == (tg + 1u) * nx) xb_add(&bar[XB_TOPGEN], 1u);
            else XB_SPIN(xb_ld(&bar[XB_TOPGEN]) == tg, bar);
            __builtin_amdgcn_fence(__ATOMIC_ACQUIRE, "agent");
            xb_add(&bar[XB_XGEN(b.x)], 1u);
            asm volatile("s_waitcnt vmcnt(0)" ::: "memory");
        } else {
            XB_SPIN(xb_ld(&bar[XB_XGEN(b.x)]) == gen, bar);
            __builtin_amdgcn_fence(__ATOMIC_ACQUIRE, "agent");
            asm volatile("s_waitcnt vmcnt(0)" ::: "memory");
        }
    }
    __syncthreads();
}

struct Params { const float* in[N_IN]; float* out; unsigned char* ws; int ph_lo, ph_hi; };
typedef const __attribute__((address_space(4))) Params* ParamsK;
__device__ __forceinline__ Params load_params() {
#if defined(__HIP_DEVICE_COMPILE__)
    unsigned long long v = (unsigned long long)__builtin_amdgcn_kernarg_segment_ptr(); asm volatile("" : "+s"(v)); return *(ParamsK)v;
#else
    return Params{};
#endif
}

__device__ __forceinline__ u32x4 pack8(const f32x4 a, const f32x4 b) {
    u32x4 w; w.x = pg8::cvt_pk_bf16(a[0], a[1]); w.y = pg8::cvt_pk_bf16(a[2], a[3]); w.z = pg8::cvt_pk_bf16(b[0], b[1]); w.w = pg8::cvt_pk_bf16(b[2], b[3]); return w;
}
__device__ __forceinline__ void rope8(f32x4& v0, f32x4& v1, int fq, int tt  , bool on) {
    const int axis = fq >> 1, half = fq & 1; const float pos = (float)(axis == 0 ? (tt >> 6) : (tt & 63)) * 0.15915494309189535f;
    constexpr float IF[8] = {1.0f, 0.316227766f, 0.1f, 0.0316227766f, 0.01f, 0.00316227766f, 0.001f, 0.000316227766f};
#pragma unroll
    for (int i = 0; i < 4; ++i) {
        { const float x = v0[i], other = __shfl_xor(x, 16); const float sn = __builtin_amdgcn_sinf(pos * IF[i]), cs = __builtin_amdgcn_cosf(pos * IF[i]);
          const float r = half == 0 ? x * cs - other * sn : other * sn + x * cs; v0[i] = on ? r : x; }
        { const float x = v1[i], other = __shfl_xor(x, 16); const float sn = __builtin_amdgcn_sinf(pos * IF[4 + i]), cs = __builtin_amdgcn_cosf(pos * IF[4 + i]);
          const float r = half == 0 ? x * cs - other * sn : other * sn + x * cs; v1[i] = on ? r : x; }
    }
}

struct EpiIn {
    static constexpr bool PERM = true;
    bf16 *CQ, *CKV, *UX, *UG, *KB;
    __device__ __forceinline__ void operator()(const f32x4 (&acc)[2][2][4][2], const pg8::Unit& u, int wr, int wc, int fr, int fq) const {
        const int row0 = u.pm * 256 + wr * 64 + fr;
        const bool is_ctx = (u.pm % 17) == 0; const int bb = u.pm / 17;
#pragma unroll
        for (int bj = 0; bj < 2; ++bj) {
            const int blk = u.pn * 2 + bj;
            if (blk < 13) {
                bf16* dst; int ld, cb;
                if (blk < 3) { dst = CQ; ld = 384; cb = blk * 128; }
                else if (blk < 5) { dst = CKV; ld = 256; cb = (blk - 3) * 128; }
                else if (blk < 9) { dst = UX; ld = 512; cb = (blk - 5) * 128; }
                else { dst = UG; ld = 512; cb = (blk - 9) * 128; }
                const int col = cb + wc * 32 + 8 * fq;
#pragma unroll
                for (int ai = 0; ai < 2; ++ai)
#pragma unroll
                    for (int m = 0; m < 4; ++m) { const int row = row0 + ai * 128 + m * 16;
                        *(u32x4*)(dst + (size_t)row * ld + col) = pack8(acc[ai][bj][m][0], acc[ai][bj][m][1]); }
            } else if (wc == 0) {
#pragma unroll
                for (int ai = 0; ai < 2; ++ai)
#pragma unroll
                    for (int m = 0; m < 4; ++m) { const int row = row0 + ai * 128 + m * 16; const int tt = row - bb * TC - CTXL;
                        f32x4 v0 = acc[ai][bj][m][0], v1 = acc[ai][bj][m][1];
                        rope8(v0, v1, fq, tt, !is_ctx);
                        const u32x4 w = pack8(v0, v1);
#pragma unroll
                        for (int h = 0; h < 8; ++h) *(u32x4*)(KB + (size_t)row * 768 + h * 96 + 64 + 8 * fq) = w; }
            }
        }
    }
};
struct EpiQ {
    static constexpr bool PERM = true;
    bf16* Q; const float* rq;
    __device__ __forceinline__ void operator()(const f32x4 (&acc)[2][2][4][2], const pg8::Unit& u, int wr, int wc, int fr, int fq) const {
        const int row0 = u.pm * 256 + wr * 64 + fr;
#pragma unroll
        for (int ai = 0; ai < 2; ++ai)
#pragma unroll
            for (int m = 0; m < 4; ++m) { const int row = row0 + ai * 128 + m * 16; const float s = rq[row];
#pragma unroll
                for (int bj = 0; bj < 2; ++bj) {
                    const u32x4 w = pack8(acc[ai][bj][m][0] * s, acc[ai][bj][m][1] * s);
                    int off;
                    if (u.pn < 2) { const int c = u.pn * 256 + bj * 128 + wc * 32 + 8 * fq; off = (c >> 6) * 96 + (c & 63); }
                    else off = (4 * bj + wc) * 96 + 64 + 8 * fq;
                    *(u32x4*)(Q + (size_t)row * 768 + off) = w;
                } }
    }
};
struct EpiKV {
    static constexpr bool PERM = true;
    bf16 *K, *V; const float* rkv;
    __device__ __forceinline__ void operator()(const f32x4 (&acc)[2][2][4][2], const pg8::Unit& u, int wr, int wc, int fr, int fq) const {
        const int row0 = u.pm * 256 + wr * 64 + fr;
#pragma unroll
        for (int ai = 0; ai < 2; ++ai)
#pragma unroll
            for (int m = 0; m < 4; ++m) { const int row = row0 + ai * 128 + m * 16; const float s = rkv[row];
#pragma unroll
                for (int bj = 0; bj < 2; ++bj) { const int h = u.pn * 2 + bj;
                    const u32x4 w = pack8(acc[ai][bj][m][0] * s, acc[ai][bj][m][1] * s);
                    if (wc < 2) *(u32x4*)(K + (size_t)row * 768 + h * 96 + wc * 32 + 8 * fq) = w;
                    else *(u32x4*)(V + (size_t)row * 512 + h * 64 + (wc - 2) * 32 + 8 * fq) = w; } }
    }
};
template <int LAYER> struct EpiRes {
    static constexpr bool PERM = false;
    const float *x, *ctx, *mod; float *out, *xc;
    __device__ __forceinline__ void operator()(const f32x4 (&acc)[2][2][4][2], const pg8::Unit& u, int wr, int wc, int fr, int fq) const {
        const int row0 = u.pm * 256 + wr * 64 + fr, col0 = u.pn * 256 + wc * 32 + 4 * fq;
        const bool is_ctx = LAYER == 0 && (u.pm % 17) == 0; const int bb = LAYER == 0 ? u.pm / 17 : u.pm / 16;
        const float* g = mod + (size_t)(LAYER * 9 + (is_ctx ? 8 : bb)) * 6144 + 2048;
        f32x4 gv[2][2];
#pragma unroll
        for (int bj = 0; bj < 2; ++bj)
#pragma unroll
            for (int n = 0; n < 2; ++n) gv[bj][n] = *(const f32x4*)(g + col0 + bj * 128 + n * 16);
#pragma unroll
        for (int ai = 0; ai < 2; ++ai)
#pragma unroll
            for (int m = 0; m < 4; ++m) { const int row = row0 + ai * 128 + m * 16;
                const float* res; float* dst;
                if (LAYER == 0) { const int t = row - bb * TC;
                    if (is_ctx) { res = ctx + (size_t)(bb * CTXL + t) * DM; dst = xc + (size_t)(bb * CTXL + t) * DM; }
                    else { res = x + (size_t)(bb * SEQ + t - CTXL) * DM; dst = out + (size_t)(bb * SEQ + t - CTXL) * DM; } }
                else { res = out + (size_t)row * DM; dst = out + (size_t)row * DM; }
#pragma unroll
                for (int bj = 0; bj < 2; ++bj)
#pragma unroll
                    for (int n = 0; n < 2; ++n) { const int c = col0 + bj * 128 + n * 16;
                        *(f32x4*)(dst + c) = *(const f32x4*)(res + c) + gv[bj][n] * acc[ai][bj][m][n]; } }
    }
};
struct EpiMoe1 {
    static constexpr bool PERM = true;
    bf16* ACT;
    __device__ __forceinline__ void operator()(const f32x4 (&acc)[2][2][4][2], const pg8::Unit& u, int wr, int wc, int fr, int fq) const {
        const int row0 = u.pm * 256 + wr * 64 + fr, col = u.pn * 128 + wc * 32 + 8 * fq;
#pragma unroll
        for (int ai = 0; ai < 2; ++ai)
#pragma unroll
            for (int m = 0; m < 4; ++m) { const int row = row0 + ai * 128 + m * 16;
                f32x4 r[2];
#pragma unroll
                for (int n = 0; n < 2; ++n)
#pragma unroll
                    for (int i = 0; i < 4; ++i) { const float a = acc[ai][0][m][n][i], b = acc[ai][1][m][n][i]; r[n][i] = a / (1.f + __expf(-a)) * b; }
                *(u32x4*)(ACT + (size_t)row * 512 + col) = pack8(r[0], r[1]); }
    }
};
struct EpiStore {
    static constexpr bool PERM = true;
    bf16* O; int ldc;
    __device__ __forceinline__ void operator()(const f32x4 (&acc)[2][2][4][2], const pg8::Unit& u, int wr, int wc, int fr, int fq) const {
        const int row0 = u.pm * 256 + wr * 64 + fr, col0 = u.pn * 256 + wc * 32 + 8 * fq;
#pragma unroll
        for (int ai = 0; ai < 2; ++ai)
#pragma unroll
            for (int m = 0; m < 4; ++m) { bf16* rowp = O + (size_t)(row0 + ai * 128 + m * 16) * ldc + col0;
#pragma unroll
                for (int bj = 0; bj < 2; ++bj) *(u32x4*)(rowp + bj * 128) = pack8(acc[ai][bj][m][0], acc[ai][bj][m][1]); }
    }
};

__device__ __forceinline__ void cvt_item(const float* W, int ldw, int col0, const float* gk, bf16* WTrow0, int ldk, int k0, float* scr, int lane) {
    if (col0 >= 0) {
#pragma unroll 8
        for (int i = 0; i < 32; ++i) { const int kk = 2 * i + (lane >> 5); float v = W[(size_t)(k0 + kk) * ldw + col0 + (lane & 31)]; if (gk) v *= gk[k0 + kk]; scr[kk * 33 + (lane & 31)] = v; }
    } else {
#pragma unroll 8
        for (int i = 0; i < 32; ++i) { const int kk = 2 * i + (lane >> 5); scr[kk * 33 + (lane & 31)] = 0.f; }
    }
    LDS_WAIT(); asm volatile("" ::: "memory");
    const int c = lane & 7;
#pragma unroll
    for (int j = 0; j < 4; ++j) { const int n = (lane >> 3) + 8 * j; const float* s = scr + (8 * c) * 33 + n;
        u32x4 o; o.x = pk2(s[0 * 33], s[1 * 33]); o.y = pk2(s[2 * 33], s[3 * 33]); o.z = pk2(s[4 * 33], s[5 * 33]); o.w = pk2(s[6 * 33], s[7 * 33]);
        *(u32x4*)(WTrow0 + (size_t)n * ldk + k0 + 8 * c) = o; }
    LDS_WAIT(); asm volatile("" ::: "memory");
}

__device__ __forceinline__ void phase_prologue(const Params& P, unsigned char* lds, int tid, int lane, int wave, int G) {
    unsigned char* ws = P.ws;
    __syncthreads();
    {
        float* sl = (float*)lds;
        float* red = (float*)(lds + 40960);
        float* mod = (float*)(ws + WS_MOD);
        bool loaded = false;
        for (int u = blockIdx.x; u < 192; u += G) {
            if (!loaded) { for (int i = tid; i < 9 * 1024; i += 512) { const float v = i < 8192 ? P.in[I_C][i] : P.in[I_CCTX][i - 8192]; sl[i] = v / (1.f + expf(-v)); } loaded = true; __syncthreads(); }
            const int l = u / 96, col = (u % 96) * 64 + lane;
            const float* W = P.in[I_ADAW] + (size_t)l * 1024 * 6144 + col;
            float a[9];
#pragma unroll
            for (int b = 0; b < 9; ++b) a[b] = 0.f;
            const int kb = wave * 128;
#pragma unroll 4
            for (int k = 0; k < 128; ++k) { const float w = W[(size_t)(kb + k) * 6144];
#pragma unroll
                for (int b = 0; b < 9; ++b) a[b] += sl[b * 1024 + kb + k] * w; }
#pragma unroll
            for (int b = 0; b < 9; ++b) red[(wave * 9 + b) * 64 + lane] = a[b];
            __syncthreads();
            for (int i = tid; i < 9 * 64; i += 512) { const int b = i >> 6, cc = i & 63; float s = 0.f;
#pragma unroll
                for (int w = 0; w < 8; ++w) s += red[(w * 9 + b) * 64 + cc];
                const int c2 = (u % 96) * 64 + cc;
                mod[(size_t)(l * 9 + b) * 6144 + c2] = s + P.in[I_ADAB][l * 6144 + c2]; }
            __syncthreads();
        }
        __syncthreads();
    }
    {
        float* scr = (float*)(lds + wave * 16384);
        const int gw = blockIdx.x * 8 + wave, NGW = G * 8;
        constexpr int I_WIN = 16 * 56, I_UQ = 6 * 24, I_UKV = 4 * 32, I_OUT = 16 * 32, I_HIN = 16 * 96, I_HOUT = 16 * 32, I_WG = 64, I_M13 = 32 * 512, I_M2 = 32 * 256;
        constexpr int NITEMS = I_WIN + I_UQ + I_UKV + I_OUT + I_HIN + I_HOUT + I_WG + I_M13 + I_M2;
        for (int it = gw; it < NITEMS; it += NGW) {
            int r = it;
            if (r < I_M13) { const int le = r >> 9, q = r & 511, kb = q >> 5, nb = q & 31, n0 = 32 * nb, pn = n0 >> 8, j = n0 & 255;
                const float* src = (j < 128 ? P.in[I_MW1] : P.in[I_MW3]) + (size_t)le * 1024 * 512;
                cvt_item(src, 512, 128 * pn + (j & 127), nullptr, (bf16*)(ws + WS_W13) + ((size_t)le * 1024 + n0) * 1024, 1024, 64 * kb, scr, lane); continue; } r -= I_M13;
            if (r < I_M2) { const int le = r >> 8, q = r & 255, kb = q >> 5, nb = q & 31, n0 = 32 * nb;
                cvt_item(P.in[I_MW2] + (size_t)le * 512 * 1024, 1024, n0, nullptr, (bf16*)(ws + WS_W2) + ((size_t)le * 1024 + n0) * 512, 512, 64 * kb, scr, lane); continue; } r -= I_M2;
            if (r < I_WIN) { const int kb = r / 56, nb = r % 56, n0 = 32 * nb; const int col0 = n0 < 640 ? n0 : (n0 < 1664 ? n0 + 32 : (n0 < 1696 ? n0 - 1024 : -1));
                cvt_item(P.in[I_EVWIN], 1696, col0, nullptr, (bf16*)(ws + WS_WIN) + (size_t)n0 * 1024, 1024, 64 * kb, scr, lane); continue; } r -= I_WIN;
            if (r < I_UQ) { const int kb = r / 24, nb = r % 24, n0 = 32 * nb; const int col0 = n0 < 512 ? (n0 >> 6) * 96 + (n0 & 63) : ((n0 - 512) >> 5) * 96 + 64;
                cvt_item(P.in[I_WUQ], 768, col0, P.in[I_QNG], (bf16*)(ws + WS_WUQ) + (size_t)n0 * 384, 384, 64 * kb, scr, lane); continue; } r -= I_UQ;
            if (r < I_UKV) { const int kb = r / 32, nb = r % 32, n0 = 32 * nb;
                cvt_item(P.in[I_WUKV], 1024, n0, P.in[I_KVNG], (bf16*)(ws + WS_WUKV) + (size_t)n0 * 256, 256, 64 * kb, scr, lane); continue; } r -= I_UKV;
            if (r < I_OUT) { const int kb = r / 32, nb = r % 32, n0 = 32 * nb;
                cvt_item(P.in[I_EVWOUT], 1024, n0, nullptr, (bf16*)(ws + WS_WOUT) + (size_t)n0 * 1024, 1024, 64 * kb, scr, lane); continue; } r -= I_OUT;
            if (r < I_HIN) { const int kb = r / 96, nb = r % 96, n0 = 32 * nb;
                cvt_item(P.in[I_ODWIN], 3072, n0, nullptr, (bf16*)(ws + WS_WHIN) + (size_t)n0 * 1024, 1024, 64 * kb, scr, lane); continue; } r -= I_HIN;
            if (r < I_HOUT) { const int kb = r / 32, nb = r % 32, n0 = 32 * nb;
                cvt_item(P.in[I_ODWOUT], 1024, n0, nullptr, (bf16*)(ws + WS_WHOUT) + (size_t)n0 * 1024, 1024, 64 * kb, scr, lane); continue; } r -= I_HOUT;
            { const int mat = r >> 1, nb = r & 1, d = mat >> 4, gsel = (mat >> 3) & 1, h = mat & 7;
                const float* src = (gsel ? P.in[I_LWX] : P.in[I_LWA]) + (size_t)(d * 8 + h) * 4096;
                cvt_item(src, 64, 32 * nb, nullptr, (bf16*)(ws + WS_WG) + (size_t)(h * 256 + d * 128 + gsel * 64 + 32 * nb) * 64, 64, 0, scr, lane); }
        }
    }
    {
        const int gw = blockIdx.x * 8 + wave, NGW = G * 8;
        float* a2 = (float*)(ws + WS_A2);
        const float *w1 = P.in[I_HW1], *b1 = P.in[I_HB1], *f1 = P.in[I_HF1], *w2 = P.in[I_HW2], *b2 = P.in[I_HB2], *f2 = P.in[I_HF2];
        for (int t = gw; t < 4096; t += NGW) {
            const float tl = (float)t / 4095.f, w = (6.283185307179586f / 4096.f) * (float)t;
            float zi = 0.f;
            if (lane == 0) zi = tl;
            else if (lane <= 16) { const float f = 1e-4f + (float)(lane - 1) * ((15.f - 1e-4f) / 15.f); zi = cosf(f * w); }
            else if (lane <= 32) { const float f = 1e-4f + (float)(lane - 17) * ((15.f - 1e-4f) / 15.f); zi = -sinf(f * w); }
            float acc = b1[lane];
            for (int i = 0; i < 33; ++i) acc += __shfl(zi, i) * w1[i * 64 + lane];
            const float a1 = sinf(f1[lane] * acc);
            float acc2 = b2[lane];
            for (int i = 0; i < 64; ++i) acc2 += __shfl(a1, i) * w2[i * 64 + lane];
            a2[(size_t)lane * 4096 + t] = sinf(f2[lane] * acc2);
        }
    }
}

__device__ __forceinline__ void store_row_bf16(bf16* orow, const f32x4 (&v)[4], int lane) {
    unsigned long long* o8 = (unsigned long long*)orow + lane;
#pragma unroll
    for (int j = 0; j < 4; ++j) o8[64 * j] = (unsigned long long)pk2(v[j][0], v[j][1]) | ((unsigned long long)pk2(v[j][2], v[j][3]) << 32);
}
__device__ __forceinline__ void norm_mod(f32x4 (&v)[4], const float* g, const float* sh, const float* sc, int lane) {
    float ss = 0.f;
#pragma unroll
    for (int j = 0; j < 4; ++j) ss += (v[j][0] * v[j][0] + v[j][1] * v[j][1]) + (v[j][2] * v[j][2] + v[j][3] * v[j][3]);
    const float rr = rsqrtf(wave_sum(ss) * (1.f / 1024.f) + RMS_EPS);
#pragma unroll
    for (int j = 0; j < 4; ++j) { const f32x4 gg = ((const f32x4*)g)[lane + 64 * j], s1 = ((const f32x4*)sc)[lane + 64 * j], s0 = ((const f32x4*)sh)[lane + 64 * j];
        v[j] = (v[j] * rr * gg) * (1.f + s1) + s0; }
}
__device__ __forceinline__ void moe_combine(f32x4 (&v)[4], const bf16* Y, const int* rs, const float* rw, int r, const float* g2, int lane) {
    const int s0 = rs[2 * r], s1 = rs[2 * r + 1]; const float w0 = rw[2 * r], w1 = rw[2 * r + 1];
    const u32x2* y0 = (const u32x2*)(Y + (size_t)s0 * 1024) + lane; const u32x2* y1 = (const u32x2*)(Y + (size_t)s1 * 1024) + lane;
#pragma unroll
    for (int j = 0; j < 4; ++j) { const u32x2 a = y0[64 * j], b = y1[64 * j]; const f32x4 gg = ((const f32x4*)g2)[lane + 64 * j];
        f32x4 m; m[0] = w0 * bflo(a.x) + w1 * bflo(b.x); m[1] = w0 * bfhi(a.x) + w1 * bfhi(b.x); m[2] = w0 * bflo(a.y) + w1 * bflo(b.y); m[3] = w0 * bfhi(a.y) + w1 * bfhi(b.y);
        v[j] = v[j] + gg * m; }
}
__device__ __forceinline__ void route_row(const f32x4 (&v)[4], const float* rwT  , const float* rb, int lane, int& e0o, int& e1o, float& w0o, float& w1o) {
    float s[16];
#pragma unroll
    for (int e = 0; e < 16; ++e) { float p = 0.f;
#pragma unroll
        for (int j = 0; j < 4; ++j) { const f32x4 w = ((const f32x4*)(rwT + e * 1024))[lane + 64 * j]; p += (v[j][0] * w[0] + v[j][1] * w[1]) + (v[j][2] * w[2] + v[j][3] * w[3]); }
        s[e] = sigm(wave_sum(p)); }
    float sel[16];
#pragma unroll
    for (int e = 0; e < 16; ++e) sel[e] = s[e] + rb[e];
    float gbest = -1e30f; int gi = 0;
#pragma unroll
    for (int g = 0; g < 4; ++g) { float m1 = -1e30f, m2 = -1e30f;
#pragma unroll
        for (int i = 0; i < 4; ++i) { const float x = sel[4 * g + i]; if (x > m1) { m2 = m1; m1 = x; } else if (x > m2) m2 = x; }
        const float gs = m1 + m2; if (gs > gbest) { gbest = gs; gi = g; } }
    float b0 = -1e30f, b1 = -1e30f; int e0 = 0, e1 = 0; float s0 = 0.f, s1 = 0.f;
#pragma unroll
    for (int e = 0; e < 16; ++e) { const bool in = (e >> 2) == gi; const float x = sel[e];
        if (in && x > b0) { b1 = b0; e1 = e0; s1 = s0; b0 = x; e0 = e; s0 = s[e]; } else if (in && x > b1) { b1 = x; e1 = e; s1 = s[e]; } }
    e0o = e0; e1o = e1; const float den = s0 + s1; w0o = s0 / den; w1o = s1 / den;
}

__device__ __forceinline__ void phase_norm1_l0(const Params& P, int lane, int wave, int G) {
    const float* mod = (const float*)(P.ws + WS_MOD); bf16* H = (bf16*)(P.ws + WS_RH);
    for (int row = blockIdx.x * 8 + wave; row < M0; row += G * 8) {
        const int b = row / TC, t = row - b * TC;
        const float* xr = t < CTXL ? P.in[I_CTX] + (size_t)(b * CTXL + t) * DM : P.in[I_X] + (size_t)(b * SEQ + t - CTXL) * DM;
        const float* md = mod + (size_t)(t < CTXL ? 8 : b) * 6144;
        f32x4 v[4];
#pragma unroll
        for (int j = 0; j < 4; ++j) v[j] = ((const f32x4*)xr)[lane + 64 * j];
        norm_mod(v, P.in[I_N1G], md, md + 1024, lane);
        store_row_bf16(H + (size_t)row * DM, v, lane);
    }
}
template <int LAYER> __device__ __forceinline__ void phase_norm2_route(const Params& P, unsigned char* lds, int tid, int lane, int wave, int G) {
    constexpr int ROWS = LAYER == 0 ? 136 : 128;
    float* rwT = (float*)lds;
    int* cntl = (int*)(lds + 65536);
    const float* mod = (const float*)(P.ws + WS_MOD) + (size_t)LAYER * 9 * 6144; bf16* H = (bf16*)(P.ws + WS_RH);
    int* route_e = (int*)(P.ws + WS_ROUTE_E); float* route_w = (float*)(P.ws + WS_ROUTE_W); int* cnt = (int*)(P.ws + WS_CNT);
    for (int i = tid; i < 16384; i += 512) { const int k = i >> 4, e = i & 15; rwT[e * 1024 + k] = P.in[I_RW][i]; }
    for (int ch = blockIdx.x; ch < NCHUNK; ch += G) {
        if (tid < 16) cntl[tid] = 0;
        __syncthreads();
        for (int rl = wave; rl < ROWS; rl += 8) {
            const int row = ch * ROWS + rl; const float* xr; const float* md;
            if (LAYER == 0) { const int b = row / TC, t = row - b * TC;
                xr = t < CTXL ? (const float*)(P.ws + WS_XC) + (size_t)(b * CTXL + t) * DM : P.out + (size_t)(b * SEQ + t - CTXL) * DM; md = mod + (size_t)(t < CTXL ? 8 : b) * 6144; }
            else { xr = P.out + (size_t)row * DM; md = mod + (size_t)(row >> 12) * 6144; }
            f32x4 v[4];
#pragma unroll
            for (int j = 0; j < 4; ++j) v[j] = ((const f32x4*)xr)[lane + 64 * j];
            norm_mod(v, P.in[I_N2G] + LAYER * 1024, md + 3072, md + 4096, lane);
            store_row_bf16(H + (size_t)row * DM, v, lane);
            int e0, e1; float w0, w1; route_row(v, rwT, P.in[I_RB], lane, e0, e1, w0, w1);
            if (lane == 0) { route_e[row] = e0 | (e1 << 8); route_w[2 * row] = w0; route_w[2 * row + 1] = w1; atomicAdd(&cntl[e0], 1); atomicAdd(&cntl[e1], 1); }
        }
        __syncthreads();
        if (tid < 16) cnt[ch * 16 + tid] = cntl[tid];
        __syncthreads();
    }
}
template <int LAYER> __device__ __forceinline__ void phase_permute(const Params& P, unsigned char* lds, int tid, int lane, int wave, int G) {
    constexpr int ROWS = LAYER == 0 ? 136 : 128;
    int* part_tot = (int*)lds;
    int* part_base = part_tot + 512;
    int* slot0 = part_base + 512;
    int* loc = slot0 + 16;
    int* slots = loc + 16;
    int* tstart = slots + 2 * 136;
    int* rel = tstart + 32;
    const int* cnt = (const int*)(P.ws + WS_CNT); const int* route_e = (const int*)(P.ws + WS_ROUTE_E); int* route_s = (int*)(P.ws + WS_ROUTE_S);
    int* tile_e = (int*)(P.ws + WS_TILEE);
    const bf16* H = (const bf16*)(P.ws + WS_RH); bf16* HP = (bf16*)(P.ws + WS_HPERM);
    for (int ch = blockIdx.x; ch < NCHUNK; ch += G) {
        { const int e = tid & 15, part = tid >> 4; int tot = 0, bs = 0;
#pragma unroll
          for (int i = 0; i < 8; ++i) { const int c = part * 8 + i; const int x = cnt[c * 16 + e]; tot += x; bs += (c < ch) ? x : 0; }
          part_tot[part * 16 + e] = tot; part_base[part * 16 + e] = bs; }
        if (tid < ROWS) rel[tid] = route_e[ch * ROWS + tid];
        __syncthreads();
        if (tid == 0) {
            int ts = 0;
            for (int e = 0; e < 16; ++e) { int tot = 0, bs = 0; for (int p = 0; p < 32; ++p) { tot += part_tot[p * 16 + e]; bs += part_base[p * 16 + e]; }
                tstart[e] = ts; slot0[e] = ts * 256 + bs; loc[e] = 0; ts += (tot + 255) >> 8; }
            tstart[16] = ts;
            if (ch == 0) { for (int e = 0; e < 16; ++e) for (int i = tstart[e]; i < tstart[e + 1]; ++i) tile_e[i] = e; tile_e[MAXTILES] = ts; }
            for (int rl = 0; rl < ROWS; ++rl) { const int row = ch * ROWS + rl; const int ee = rel[rl]; const int e0 = ee & 255, e1 = ee >> 8;
                const int s0 = slot0[e0] + loc[e0]; loc[e0] = loc[e0] + 1; const int s1 = slot0[e1] + loc[e1]; loc[e1] = loc[e1] + 1;
                slots[2 * rl] = s0; slots[2 * rl + 1] = s1; route_s[2 * row] = s0; route_s[2 * row + 1] = s1; }
        }
        __syncthreads();
        for (int rl = wave; rl < ROWS; rl += 8) { const int row = ch * ROWS + rl; const int s0 = slots[2 * rl], s1 = slots[2 * rl + 1];
            const u32x4* src = (const u32x4*)(H + (size_t)row * DM) + lane; u32x4* d0 = (u32x4*)(HP + (size_t)s0 * DM) + lane; u32x4* d1 = (u32x4*)(HP + (size_t)s1 * DM) + lane;
            const u32x4 a = src[0], b = src[64]; d0[0] = a; d0[64] = b; d1[0] = a; d1[64] = b; }
        __syncthreads();
    }
}
__device__ __forceinline__ void phase_combine_norm1_l1(const Params& P, int lane, int wave, int G) {
    const float* mod = (const float*)(P.ws + WS_MOD); bf16* H = (bf16*)(P.ws + WS_RH); const bf16* Y = (const bf16*)(P.ws + WS_HPERM);
    const int* rs = (const int*)(P.ws + WS_ROUTE_S); const float* rw = (const float*)(P.ws + WS_ROUTE_W);
    for (int row = blockIdx.x * 8 + wave; row < M1; row += G * 8) {
        const int b = row >> 12, t = row & 4095, r0 = b * TC + CTXL + t;
        float* xr = P.out + (size_t)row * DM;
        f32x4 v[4];
#pragma unroll
        for (int j = 0; j < 4; ++j) v[j] = ((const f32x4*)xr)[lane + 64 * j];
        moe_combine(v, Y, rs, rw, r0, mod + (size_t)b * 6144 + 5120, lane);
#pragma unroll
        for (int j = 0; j < 4; ++j) ((f32x4*)xr)[lane + 64 * j] = v[j];
        const float* md = mod + (size_t)(9 + b) * 6144;
        norm_mod(v, P.in[I_N1G] + 1024, md, md + 1024, lane);
        store_row_bf16(H + (size_t)row * DM, v, lane);
    }
}
__device__ __forceinline__ void phase_final(const Params& P, int lane, int wave, int G) {
    const float* mod = (const float*)(P.ws + WS_MOD); const bf16* Y = (const bf16*)(P.ws + WS_HPERM);
    const int* rs = (const int*)(P.ws + WS_ROUTE_S); const float* rw = (const float*)(P.ws + WS_ROUTE_W);
    for (int row = blockIdx.x * 8 + wave; row < M1; row += G * 8) {
        const int b = row >> 12;
        float* xr = P.out + (size_t)row * DM;
        f32x4 v[4];
#pragma unroll
        for (int j = 0; j < 4; ++j) v[j] = ((const f32x4*)xr)[lane + 64 * j];
        moe_combine(v, Y, rs, rw, row, mod + (size_t)(9 + b) * 6144 + 5120, lane);
        float ss = 0.f;
#pragma unroll
        for (int j = 0; j < 4; ++j) ss += (v[j][0] * v[j][0] + v[j][1] * v[j][1]) + (v[j][2] * v[j][2] + v[j][3] * v[j][3]);
        const float rr = rsqrtf(wave_sum(ss) * (1.f / 1024.f) + RMS_EPS);
#pragma unroll
        for (int j = 0; j < 4; ++j) ((f32x4*)xr)[lane + 64 * j] = v[j] * rr * ((const f32x4*)P.in[I_FING])[lane + 64 * j];
    }
}
__device__ __forceinline__ void phase_rowstat(const Params& P, int lane, int wave, int G) {
    const bf16* CQ = (const bf16*)(P.ws + WS_CQ); const bf16* CKV = (const bf16*)(P.ws + WS_CKV); float* rq = (float*)(P.ws + WS_RQ); float* rkv = (float*)(P.ws + WS_RKV);
    for (int row = blockIdx.x * 8 + wave; row < M0; row += G * 8) {
        float sq = 0.f, sk = 0.f;
        if (lane < 48) { const u32x4 a = ((const u32x4*)(CQ + (size_t)row * 384))[lane];
            sq = (bflo(a.x) * bflo(a.x) + bfhi(a.x) * bfhi(a.x)) + (bflo(a.y) * bflo(a.y) + bfhi(a.y) * bfhi(a.y)) + (bflo(a.z) * bflo(a.z) + bfhi(a.z) * bfhi(a.z)) + (bflo(a.w) * bflo(a.w) + bfhi(a.w) * bfhi(a.w)); }
        if (lane < 32) { const u32x4 a = ((const u32x4*)(CKV + (size_t)row * 256))[lane];
            sk = (bflo(a.x) * bflo(a.x) + bfhi(a.x) * bfhi(a.x)) + (bflo(a.y) * bflo(a.y) + bfhi(a.y) * bfhi(a.y)) + (bflo(a.z) * bflo(a.z) + bfhi(a.z) * bfhi(a.z)) + (bflo(a.w) * bflo(a.w) + bfhi(a.w) * bfhi(a.w)); }
        sq = wave_sum(sq); sk = wave_sum(sk);
        if (lane == 0) { rq[row] = rsqrtf(sq * (1.f / 384.f) + RMS_EPS); rkv[row] = rsqrtf(sk * (1.f / 256.f) + RMS_EPS); }
    }
}

constexpr int LRU_UXF = 0;
constexpr int LRU_UF = 17408;
constexpr int LRU_UB = LRU_UF + 16384;
constexpr int LRU_G = LRU_UB + 8192;
__device__ __forceinline__ int crow32(int r, int hi) { return (r & 3) + 8 * (r >> 2) + 4 * hi; }
__device__ __forceinline__ void lru_coeffs(const Params& P, unsigned char* lds, int b, int ck, int h, int tid, int lane, int wave) {
    float* uxf = (float*)(lds + LRU_UXF); float* uf = (float*)(lds + LRU_UF); bf16* ub = (bf16*)(lds + LRU_UB); float* Gm = (float*)(lds + LRU_G);
    const bf16* UX = (const bf16*)(P.ws + WS_UX);
    const int seg_lo = ck < 4 ? 0 : CTXL, seg_hi = ck < 4 ? CTXL : TC, p0 = ck * 64 - 2;
    for (int i = tid; i < 67 * 8; i += 512) { const int r = i >> 3, c8 = (i & 7) * 8, pos = p0 + r;
        u32x4 a = {0u, 0u, 0u, 0u};
        if (pos >= seg_lo && pos < seg_hi) a = *(const u32x4*)(UX + (size_t)(b * TC + pos) * 512 + h * 64 + c8);
        float* d = uxf + r * 64 + c8;
        d[0] = bflo(a.x); d[1] = bfhi(a.x); d[2] = bflo(a.y); d[3] = bfhi(a.y); d[4] = bflo(a.z); d[5] = bfhi(a.z); d[6] = bflo(a.w); d[7] = bfhi(a.w); }
    __syncthreads();
    { const int t = tid >> 3, c0 = (tid & 7) * 8; const float* cw = P.in[I_LCW]; const float* cb = P.in[I_LCB];
#pragma unroll
      for (int i = 0; i < 8; ++i) { const int c = c0 + i, ch = h * 64 + c; float u = cb[ch];
#pragma unroll
          for (int j = 0; j < 4; ++j) u += cw[j * 512 + ch] * uxf[(t + j) * 64 + c];
          uf[t * 64 + c] = u; ub[t * 64 + c] = (bf16)f2bf(u); } }
    __syncthreads();
    {
        const bf16* WgT = (const bf16*)(P.ws + WS_WG) + (size_t)h * 256 * 64; const int r32 = lane & 31, hi = lane >> 5, n = wave * 32 + r32;
        f32x16 acc0 = {}, acc1 = {};
#pragma unroll
        for (int ks = 0; ks < 4; ++ks) {
            const bf16x8 bf = *(const bf16x8*)(WgT + (size_t)n * 64 + 16 * ks + 8 * hi);
            const bf16x8 a0 = *(const bf16x8*)(ub + (r32) * 64 + 16 * ks + 8 * hi), a1 = *(const bf16x8*)(ub + (32 + r32) * 64 + 16 * ks + 8 * hi);
            acc0 = __builtin_amdgcn_mfma_f32_32x32x16_bf16(a0, bf, acc0, 0, 0, 0);
            acc1 = __builtin_amdgcn_mfma_f32_32x32x16_bf16(a1, bf, acc1, 0, 0, 0);
        }
#pragma unroll
        for (int r = 0; r < 16; ++r) { Gm[crow32(r, hi) * 256 + n] = acc0[r]; Gm[(32 + crow32(r, hi)) * 256 + n] = acc1[r]; }
    }
    __syncthreads();
    { const int c = tid & 63, d = (tid >> 6) & 1, tg = tid >> 7, ch = h * 64 + c;
      const float ba = P.in[I_LBA][d * 512 + ch], bx = P.in[I_LBX][d * 512 + ch], lam = P.in[I_LLAM][d * 512 + ch];
      const float sp = log1pf(expf(-lam));
#pragma unroll 4
      for (int i = 0; i < 16; ++i) { const int t = tg * 16 + i;
          const float ga = Gm[t * 256 + d * 128 + c] + ba, gx = Gm[t * 256 + d * 128 + 64 + c] + bx;
          const float r = __builtin_amdgcn_rcpf(1.f + __expf(-ga)), ii = __builtin_amdgcn_rcpf(1.f + __expf(-gx)), la = -8.f * r * sp;
          const float a = __expf(la), x2 = 2.f * la;
          const float em = -x2 * (1.f + x2 * (0.5f + x2 * (0.16666667f + x2 * (0.041666668f + x2 * 0.0083333333f))));
          const float bb = sqrtf(em) * (ii * uf[t * 64 + c]);
          Gm[t * 256 + d * 128 + c] = a; Gm[t * 256 + d * 128 + 64 + c] = bb; } }
    __syncthreads();
}
__device__ __forceinline__ void phase_lru_f1(const Params& P, unsigned char* lds, int tid, int lane, int wave, int G) {
    float* Gm = (float*)(lds + LRU_G); float* CP = (float*)(P.ws + WS_CP); float* CS = (float*)(P.ws + WS_CS);
    for (int u = blockIdx.x; u < NB * LCH * 8; u += G) {
        const int h = u & 7, ck = (u >> 3) % LCH, b = u / (8 * LCH);
        lru_coeffs(P, lds, b, ck, h, tid, lane, wave);
        if (tid < 128) { const int d = tid >> 6, c = tid & 63; float hh = 0.f, pp = 1.f;
#pragma unroll 8
            for (int i = 0; i < 64; ++i) { const int t = d == 0 ? i : 63 - i; const float a = Gm[t * 256 + d * 128 + c], bb = Gm[t * 256 + d * 128 + 64 + c]; hh = a * hh + bb; pp *= a; }
            const size_t o = ((size_t)(d * 8 + b) * LCH + ck) * 512 + h * 64 + c; CP[o] = pp; CS[o] = hh; }
        __syncthreads();
    }
}
__device__ __forceinline__ void phase_lru_carry(const Params& P, int lane, int wave, int G) {
    const float* CP = (const float*)(P.ws + WS_CP); const float* CS = (const float*)(P.ws + WS_CS); float* HIN = (float*)(P.ws + WS_HIN);
    if (wave != 0) return;
    for (int sb = blockIdx.x; sb < 128; sb += G) {
        const int s = sb * 64 + lane, d = s >> 12, b = (s >> 9) & 7, ch = s & 511; const size_t base = ((size_t)(d * 8 + b) * LCH) * 512 + ch;
        float hh = 0.f;
#pragma unroll 1
        for (int st = 0; st < LCH; st += 4) { float cp[4], cs[4]; int q[4];
#pragma unroll
            for (int i = 0; i < 4; ++i) { const int step = st + i; q[i] = d == 0 ? step : (step < 4 ? 3 - step : 71 - step); cp[i] = CP[base + (size_t)q[i] * 512]; cs[i] = CS[base + (size_t)q[i] * 512]; }
#pragma unroll
            for (int i = 0; i < 4; ++i) { HIN[base + (size_t)q[i] * 512] = hh; hh = cp[i] * hh + cs[i]; } }
    }
}
__device__ __forceinline__ float gelu_tanh(float x) { const float u = 0.7978845608028654f * (x + 0.044715f * x * x * x); return x * __builtin_amdgcn_rcpf(1.f + __expf(-2.f * u)); }
__device__ __forceinline__ void phase_lru_f3(const Params& P, unsigned char* lds, int tid, int lane, int wave, int G) {
    float* Gm = (float*)(lds + LRU_G);
    const bf16* UG = (const bf16*)(P.ws + WS_UG); bf16* MIX = (bf16*)(P.ws + WS_RH);
    for (int u = blockIdx.x; u < NB * LCH * 8; u += G) {
        const int h = u & 7, ck = (u >> 3) % LCH, b = u / (8 * LCH);
        lru_coeffs(P, lds, b, ck, h, tid, lane, wave);
        if (tid < 128) { const int d = tid >> 6, c = tid & 63;
            float hh = ((const float*)(P.ws + WS_HIN))[((size_t)(d * 8 + b) * LCH + ck) * 512 + h * 64 + c];
#pragma unroll 8
            for (int i = 0; i < 64; ++i) { const int t = d == 0 ? i : 63 - i; const float a = Gm[t * 256 + d * 128 + c], bb = Gm[t * 256 + d * 128 + 64 + c]; hh = a * hh + bb; Gm[t * 256 + d * 128 + c] = hh; } }
        __syncthreads();
        { const int t = tid >> 3, c0 = (tid & 7) * 8; const size_t row = (size_t)b * TC + ck * 64 + t;
          const u32x4 g = *(const u32x4*)(UG + row * 512 + h * 64 + c0);
          const float gv[8] = {bflo(g.x), bfhi(g.x), bflo(g.y), bfhi(g.y), bflo(g.z), bfhi(g.z), bflo(g.w), bfhi(g.w)};
          float o[8];
#pragma unroll
          for (int i = 0; i < 8; ++i) o[i] = (Gm[t * 256 + c0 + i] + Gm[t * 256 + 128 + c0 + i]) * gelu_tanh(gv[i]);
          u32x4 w; w.x = pk2(o[0], o[1]); w.y = pk2(o[2], o[3]); w.z = pk2(o[4], o[5]); w.w = pk2(o[6], o[7]);
          *(u32x4*)(MIX + row * 1024 + 512 + h * 64 + c0) = w; }
        __syncthreads();
    }
}

namespace att {
constexpr int NW = 8, QBLK = 32, KVBLK = 64;
constexpr float SCALE = 0.10206207261596575f;
constexpr float THR = 8.f;
constexpr int LDQ = 768, LDK = 768, LDV = 512, LDO = 1024;
constexpr int SHM_V = 16384, SHM_K = 16384, SHM_ATTN = 2 * SHM_V + 2 * SHM_K + NW * 64 * 4;
#define KSWZ(row, colB) ((row) * 256 + ((colB) ^ (((row) & 7) << 4)))
#define SBAR() __builtin_amdgcn_sched_barrier(0)
__device__ __forceinline__ int crow(int r, int hi) { return (r & 3) + 8 * (r >> 2) + 4 * hi; }
__device__ __forceinline__ unsigned cvtpk(float lo, float hi) { unsigned r; asm volatile("v_cvt_pk_bf16_f32 %0, %1, %2" : "=v"(r) : "v"(lo), "v"(hi)); return r; }
__device__ __forceinline__ void partialSM(f32x16& p0, f32x16& p1, float& m_reg, float& mn, float& alpha) {
  constexpr float C = SCALE * 1.4426950408889634f;
  float pmax = p0[0];
#pragma unroll
  for (int r = 1; r < 16; ++r) pmax = fmaxf(pmax, p0[r]);
#pragma unroll
  for (int r = 0; r < 16; ++r) pmax = fmaxf(pmax, p1[r]);
  { auto rr = __builtin_amdgcn_permlane32_swap(__float_as_uint(pmax), __float_as_uint(pmax), false, false);
    pmax = fmaxf(__uint_as_float(rr[0]), __uint_as_float(rr[1])); }
  if (__builtin_expect(__all(pmax - m_reg <= THR / SCALE), 1)) { mn = m_reg; alpha = 1.f; }
  else { mn = fmaxf(m_reg, pmax); alpha = __builtin_amdgcn_exp2f((m_reg - mn) * C); m_reg = mn; }
  float mnC = -mn * C;
#pragma unroll
  for (int r = 0; r < 16; ++r) p0[r] = fmaf(p0[r], C, mnC);
#pragma unroll
  for (int r = 0; r < 16; ++r) p1[r] = fmaf(p1[r], C, mnC);
#pragma unroll
  for (int r = 0; r < 16; ++r) p0[r] = __builtin_amdgcn_exp2f(p0[r]);
}
__device__ __forceinline__ void finishSM(f32x16& p0, f32x16& p1, float alpha, float& l_reg, bf16x8& pa0, bf16x8& pa1, bf16x8& pa2, bf16x8& pa3) {
#pragma unroll
  for (int r = 0; r < 16; ++r) p1[r] = __builtin_amdgcn_exp2f(p1[r]);
  float ps = 0;
#pragma unroll
  for (int r = 0; r < 16; ++r) ps += p0[r];
#pragma unroll
  for (int r = 0; r < 16; ++r) ps += p1[r];
  { auto rr = __builtin_amdgcn_permlane32_swap(__float_as_uint(ps), __float_as_uint(ps), false, false);
    ps = __uint_as_float(rr[0]) + __uint_as_float(rr[1]); }
  l_reg = l_reg * alpha + ps;
#define PK4(P, BASE, OUT) do { unsigned a0 = cvtpk(P[BASE + 0], P[BASE + 1]), a1 = cvtpk(P[BASE + 2], P[BASE + 3]);   \
    unsigned b0 = cvtpk(P[BASE + 4], P[BASE + 5]), b1 = cvtpk(P[BASE + 6], P[BASE + 7]);                              \
    auto r0 = __builtin_amdgcn_permlane32_swap(a0, b0, false, false); auto r1 = __builtin_amdgcn_permlane32_swap(a1, b1, false, false); \
    u32x4 w = {r0[0], r1[0], r0[1], r1[1]}; OUT = *reinterpret_cast<bf16x8*>(&w); } while (0)
  PK4(p0, 0, pa0); PK4(p0, 8, pa1); PK4(p1, 0, pa2); PK4(p1, 8, pa3);
#undef PK4
}
__device__ __forceinline__ void qkt(f32x16& p0, f32x16& p1, const bf16* Ks, const bf16x8* qr, int r32, int hi) {
  p0 = f32x16{}; p1 = f32x16{};
#pragma unroll
  for (int d0 = 0; d0 < 6; ++d0) { int cb = (d0 * 16 + hi * 8) * 2;
    bf16x8 b0 = *reinterpret_cast<const bf16x8*>((const char*)Ks + KSWZ(r32, cb));
    bf16x8 b1 = *reinterpret_cast<const bf16x8*>((const char*)Ks + KSWZ(32 + r32, cb));
    p0 = __builtin_amdgcn_mfma_f32_32x32x16_bf16(b0, qr[d0], p0, 0, 0, 0);
    p1 = __builtin_amdgcn_mfma_f32_32x32x16_bf16(b1, qr[d0], p1, 0, 0, 0); }
}
__device__ __forceinline__ int v_st(int k, int c) { const int kk = (k & ~0xC) | ((k & 4) << 1) | ((k & 8) >> 1); return ((kk >> 3) * 4 + (c >> 5)) * 512 + ((kk & 7) * 32 + (c & 31)) * 2; }
__device__ __forceinline__ int v_rd_base(int lane) { return ((lane & 3) << 3) | (((lane >> 2) & 3) << 6) | (((lane >> 4) & 1) << 5) | (((lane >> 5) & 1) << 8); }
constexpr int v_rd_off(int d0, int ks, int half) { return d0 * 512 + ks * 4096 + half * 2048; }
template <int OFF> __device__ __forceinline__ s16x4 tr_read(int vb) {
  s16x4 r; asm volatile("ds_read_b64_tr_b16 %0, %1 offset:%2" : "=&v"(r) : "v"(vb), "i"(OFF) : "memory"); return r;
}
template <int D0> __device__ __forceinline__ void pv_one(f32x16& od, int vb, bf16x8 pa0, bf16x8 pa1, bf16x8 pa2, bf16x8 pa3) {
  const s16x4 l0 = tr_read<v_rd_off(D0, 0, 0)>(vb), h0 = tr_read<v_rd_off(D0, 0, 1)>(vb), l1 = tr_read<v_rd_off(D0, 1, 0)>(vb), h1 = tr_read<v_rd_off(D0, 1, 1)>(vb);
  const s16x4 l2 = tr_read<v_rd_off(D0, 2, 0)>(vb), h2 = tr_read<v_rd_off(D0, 2, 1)>(vb), l3 = tr_read<v_rd_off(D0, 3, 0)>(vb), h3 = tr_read<v_rd_off(D0, 3, 1)>(vb);
  asm volatile("s_waitcnt lgkmcnt(0)" ::: "memory"); SBAR();
#define PK(L, H) (bf16x8){L[0], L[1], L[2], L[3], H[0], H[1], H[2], H[3]}
  od = __builtin_amdgcn_mfma_f32_32x32x16_bf16(pa0, PK(l0, h0), od, 0, 0, 0);
  od = __builtin_amdgcn_mfma_f32_32x32x16_bf16(pa1, PK(l1, h1), od, 0, 0, 0);
  od = __builtin_amdgcn_mfma_f32_32x32x16_bf16(pa2, PK(l2, h2), od, 0, 0, 0);
  od = __builtin_amdgcn_mfma_f32_32x32x16_bf16(pa3, PK(l3, h3), od, 0, 0, 0);
#undef PK
}
__device__ __forceinline__ void pv_d0(f32x16* o, int vb, bf16x8 pa0, bf16x8 pa1, bf16x8 pa2, bf16x8 pa3) {
  pv_one<0>(o[0], vb, pa0, pa1, pa2, pa3); pv_one<1>(o[1], vb, pa0, pa1, pa2, pa3);
}
__device__ __forceinline__ void attn_dense_body(const bf16* __restrict__ Qb, const bf16* __restrict__ Kh, const bf16* __restrict__ Vh, bf16* __restrict__ Ob, int seq, int tq0  , char* lds) {
  const int tid = threadIdx.x, wid = tid >> 6, lane = tid & 63, r32 = lane & 31, hi = lane >> 5;
  bf16* V_lds = (bf16*)lds; bf16* K_lds = (bf16*)(lds + 2 * SHM_V);
  float* ws = (float*)(lds + 2 * SHM_V + 2 * SHM_K) + wid * 64; float* li_l = ws; float* al_l = ws + 32;
  float m_reg = -1e30f, l_reg = 0; f32x16 o[2] = {}; bf16x8 qr[6];
  const bf16* Qw = Qb + (long)(wid * QBLK + r32) * LDQ + hi * 8;
#pragma unroll
  for (int d0 = 0; d0 < 6; ++d0) qr[d0] = *reinterpret_cast<const bf16x8*>(Qw + d0 * 16);
  {
    const int tq = tq0 + wid * QBLK + r32; const bool on = tq0 >= 0;
    constexpr float IF[8] = {1.0f, 0.316227766f, 0.1f, 0.0316227766f, 0.01f, 0.00316227766f, 0.001f, 0.000316227766f};
#pragma unroll
    for (int ax = 0; ax < 2; ++ax) { const float pos = (float)(ax == 0 ? (tq >> 6) : (tq & 63)) * 0.15915494309189535f;
      bf16x8 qv = qr[4 + ax]; bf16x8 qo;
#pragma unroll
      for (int i = 0; i < 8; ++i) { const float x = __uint_as_float(((unsigned)(unsigned short)qv[i]) << 16); const float other = __shfl_xor(x, 32);
        const float sn = __builtin_amdgcn_sinf(pos * IF[i]), cs = __builtin_amdgcn_cosf(pos * IF[i]);
        const float r = hi == 0 ? x * cs - other * sn : other * sn + x * cs;
        unsigned u = __float_as_uint(on ? r : x); u = (u + 0x7fffu + ((u >> 16) & 1u)) >> 16; qo[i] = (short)u; }
      qr[4 + ax] = qo; }
  }
  const int sr = tid >> 3, sc = (tid & 7) * 8, vst = v_st(sr, sc), kr2 = (tid >> 2) & 63, kc2 = 64 + (tid & 3) * 8; const bool kb2 = tid < 256;
  const int vb0 = (int)(uintptr_t)V_lds + v_rd_base(lane);
  struct { bf16x8 vs, ka, kb; } sr_[2];
#define SLOAD(i, k0) do { sr_[i].vs = *reinterpret_cast<const bf16x8*>(&Vh[(long)((k0) + sr) * LDV + sc]); \
    sr_[i].ka = *reinterpret_cast<const bf16x8*>(&Kh[(long)((k0) + sr) * LDK + sc]); \
    if (kb2) sr_[i].kb = *reinterpret_cast<const bf16x8*>(&Kh[(long)((k0) + kr2) * LDK + kc2]); } while (0)
#define SWRITE(b, i) do { *(bf16x8*)((char*)V_lds + (b) * SHM_V + vst) = sr_[i].vs;          \
    *(bf16x8*)((char*)K_lds + (b) * SHM_K + KSWZ(sr, sc * 2)) = sr_[i].ka;                       \
    if (kb2) *(bf16x8*)((char*)K_lds + (b) * SHM_K + KSWZ(kr2, kc2 * 2)) = sr_[i].kb; } while (0)
#define SWAIT() asm volatile("s_waitcnt vmcnt(3)" ::: "memory")
#define RESC(a) do { if (__any((a) < 1.f)) { if (hi == 0) al_l[r32] = (a); asm volatile("s_waitcnt lgkmcnt(0)" ::: "memory"); \
    _Pragma("unroll") for (int d = 0; d < 2; ++d) _Pragma("unroll") for (int r = 0; r < 16; ++r) o[d][r] *= al_l[crow(r, hi)]; } } while (0)
  f32x16 pA0, pA1, pB0, pB1; float mnA, mnB, alA, alB; bf16x8 pa0, pa1, pa2, pa3; const int NT = seq / KVBLK;
  constexpr int SE = 0, SO = 1;
  SLOAD(SE, 0); asm volatile("s_waitcnt vmcnt(0)" ::: "memory"); SWRITE(0, SE); __syncthreads();
  qkt(pA0, pA1, K_lds, qr, r32, hi); partialSM(pA0, pA1, m_reg, mnA, alA);
  SLOAD(SO, KVBLK); if (2 < NT) SLOAD(SE, 2 * KVBLK);
  SWAIT(); SWRITE(1, SO); __syncthreads();
  for (int j = 1; j + 1 < NT; j += 2) {
    SBAR(); qkt(pB0, pB1, (bf16*)((char*)K_lds + SHM_K), qr, r32, hi);
    finishSM(pA0, pA1, alA, l_reg, pa0, pa1, pa2, pa3); SBAR();
    SLOAD(SO, (j + 2) * KVBLK); SBAR();
    pv_d0(o, vb0, pa0, pa1, pa2, pa3); partialSM(pB0, pB1, m_reg, mnB, alB);
    __syncthreads(); SWAIT(); SWRITE(0, SE);
    RESC(alB); __syncthreads();
    SBAR(); qkt(pA0, pA1, K_lds, qr, r32, hi);
    finishSM(pB0, pB1, alB, l_reg, pa0, pa1, pa2, pa3); SBAR();
    if (j + 3 < NT) SLOAD(SE, (j + 3) * KVBLK); SBAR();
    pv_d0(o, vb0 + (int)SHM_V, pa0, pa1, pa2, pa3); partialSM(pA0, pA1, m_reg, mnA, alA);
    __syncthreads(); SWAIT(); SWRITE(1, SO);
    RESC(alA); __syncthreads();
  }
  SBAR(); qkt(pB0, pB1, (bf16*)((char*)K_lds + SHM_K), qr, r32, hi);
  finishSM(pA0, pA1, alA, l_reg, pa0, pa1, pa2, pa3); SBAR();
  pv_d0(o, vb0, pa0, pa1, pa2, pa3); partialSM(pB0, pB1, m_reg, mnB, alB);
  __syncthreads(); RESC(alB);
  finishSM(pB0, pB1, alB, l_reg, pa0, pa1, pa2, pa3); SBAR();
  pv_d0(o, vb0 + (int)SHM_V, pa0, pa1, pa2, pa3);
  if (hi == 0) li_l[r32] = l_reg; asm volatile("s_waitcnt lgkmcnt(0)" ::: "memory");
  float rli[16];
#pragma unroll
  for (int r = 0; r < 16; ++r) rli[r] = __builtin_amdgcn_rcpf(li_l[crow(r, hi)]);
  bf16* Ow = Ob + (long)(wid * QBLK) * LDO;
#pragma unroll
  for (int r = 0; r < 16; ++r) { int orow = crow(r, hi);
#pragma unroll
    for (int d0 = 0; d0 < 2; ++d0) Ow[(long)orow * LDO + d0 * 32 + r32] = (bf16)f2bf(o[d0][r] * rli[r]); }
#undef SLOAD
#undef SWRITE
#undef SWAIT
#undef RESC
}
}

__device__ __forceinline__ void phase_attention(const Params& P, unsigned char* lds, int G) {
    const bf16* Q = (const bf16*)(P.ws + WS_Q); const bf16* K = (const bf16*)(P.ws + WS_K); const bf16* V = (const bf16*)(P.ws + WS_V); bf16* MIX = (bf16*)(P.ws + WS_RH);
    for (int idx = blockIdx.x; idx < 1024 + 64; idx += G) {
        int b, h, seq; size_t qrow;
        if (idx < 1024) { const int bh = idx >> 4, qb = idx & 15; b = bh >> 3; h = bh & 7; qrow = (size_t)b * TC + CTXL + qb * 256; seq = TC; }
        else { const int j = idx - 1024; b = j >> 3; h = j & 7; qrow = (size_t)b * TC; seq = CTXL; }
        att::attn_dense_body(Q + qrow * 768 + h * 96, K + (size_t)b * TC * 768 + h * 96, V + (size_t)b * TC * 512 + h * 64, MIX + qrow * 1024 + h * 64, seq, idx < 1024 ? (idx & 15) * 256 : -1, (char*)lds);
        __syncthreads();
    }
}

struct cf { float x, y; };
__device__ __forceinline__ cf cmul(cf a, cf b) { return cf{a.x * b.x - a.y * b.y, a.x * b.y + a.y * b.x}; }
__device__ __forceinline__ cf cis_rev(float rev) { return cf{__builtin_amdgcn_cosf(rev), __builtin_amdgcn_sinf(rev)}; }
template <int S> __device__ __forceinline__ void dft4(cf& a, cf& b, cf& c, cf& d) {
    const cf t0{a.x + c.x, a.y + c.y}, t1{a.x - c.x, a.y - c.y}, t2{b.x + d.x, b.y + d.y}, t3{b.x - d.x, b.y - d.y};
    const cf t3i{-(float)S * t3.y, (float)S * t3.x};
    a = cf{t0.x + t2.x, t0.y + t2.y}; c = cf{t0.x - t2.x, t0.y - t2.y}; b = cf{t1.x + t3i.x, t1.y + t3i.y}; d = cf{t1.x - t3i.x, t1.y - t3i.y};
}
template <int S> __device__ __forceinline__ void dft16(cf (&v)[16]) {
#pragma unroll
    for (int j0 = 0; j0 < 4; ++j0) dft4<S>(v[j0], v[j0 + 4], v[j0 + 8], v[j0 + 12]);
    constexpr float C1 = 0.9238795325112867f, S1 = 0.3826834323650898f, C2 = 0.7071067811865476f;
    v[5] = cmul(v[5], cf{C1, S * S1}); v[9] = cmul(v[9], cf{C2, S * C2}); v[13] = cmul(v[13], cf{S1, S * C1});
    v[6] = cmul(v[6], cf{C2, S * C2}); v[10] = cf{-(float)S * v[10].y, (float)S * v[10].x}; v[14] = cmul(v[14], cf{-C2, S * C2});
    v[7] = cmul(v[7], cf{S1, S * C1}); v[11] = cmul(v[11], cf{-C2, S * C2}); v[15] = cmul(v[15], cf{-C1, -S * S1});
#pragma unroll
    for (int k1 = 0; k1 < 4; ++k1) dft4<S>(v[4 * k1], v[4 * k1 + 1], v[4 * k1 + 2], v[4 * k1 + 3]);
}
#define REV4(k) ((((k) >> 2) | (((k) & 3) << 2)))
__device__ __forceinline__ int fphys(int L) { return L + (L >> 4); }
constexpr int FFT_BUF = 4352 * 8;
constexpr int FFT_ZB = 2 * FFT_BUF;
constexpr int FFT_HB1 = FFT_ZB + 32768;
constexpr int FFT_W3 = FFT_HB1 + 32768;
constexpr int FFT_RED = FFT_W3 + 1024;
static_assert(FFT_RED + 64 <= LDSCTL_OFF, "fft lds");
template <int PAT> __device__ __forceinline__ int fbase(int tp) {
    if (PAT == 0) return tp + (tp >> 4);
    if (PAT == 1) return (tp & 15) + 272 * (tp >> 4);
    return 17 * (tp & 15) + 272 * (tp >> 4);
}
template <int PAT> struct FStr { static constexpr int v = PAT == 0 ? 272 : (PAT == 1 ? 17 : 1); };
__device__ __forceinline__ int hide(int x) { asm volatile("" : "+v"(x)); return x; }
template <int PAT> __device__ __forceinline__ void fload(cf (&v)[16], const cf* buf, int tp) {
    const cf* p = buf + fbase<PAT>(tp);
#pragma unroll
    for (int j = 0; j < 16; ++j) v[j] = p[FStr<PAT>::v * j];
}
template <int PAT, int S, bool TW> __device__ __forceinline__ void fstore(cf (&v)[16], cf* buf, int tp, float base_rev) {
    cf* p = buf + fbase<PAT>(tp);
#pragma unroll
    for (int k = 0; k < 16; ++k) { cf x = v[REV4(k)]; if (TW && k > 0) x = cmul(x, cis_rev((float)S * base_rev * (float)k)); p[FStr<PAT>::v * k] = x; }
}
__device__ __forceinline__ void fft_fwd_pass2(cf* buf, int tp0) {
    const int tp = hide(tp0);
    cf v[16]; fload<1>(v, buf, tp); dft16<-1>(v);
    const int n0 = tp & 15, k2 = tp >> 4; const cf w0 = cis_rev(-(float)(n0 * k2) * (1.f / 4096.f));
    cf* p = buf + fbase<1>(tp);
#pragma unroll
    for (int k = 0; k < 16; ++k) { cf x = cmul(v[REV4(k)], w0); if (k > 0) x = cmul(x, cis_rev(-(float)(n0 * k) * (1.f / 256.f))); p[17 * k] = x; }
}
__device__ __forceinline__ void fft_inv_pass2(cf* buf, int tp0) {
    const int tp = hide(tp0);
    cf v[16]; fload<1>(v, buf, tp); dft16<1>(v);
    fstore<1, 1, true>(v, buf, tp, (float)(tp >> 4) * (1.f / 256.f));
}

__device__ __forceinline__ void load_row8(const bf16* rowp, int n0, float (&r)[10]) {
    const u32x4 a = *(const u32x4*)(rowp + n0);
    r[1] = bflo(a.x); r[2] = bfhi(a.x); r[3] = bflo(a.y); r[4] = bfhi(a.y); r[5] = bflo(a.z); r[6] = bfhi(a.z); r[7] = bflo(a.w); r[8] = bfhi(a.w);
    r[0] = n0 > 0 ? bf2f(rowp[n0 - 1]) : 0.f; r[9] = n0 + 8 < 4096 ? bf2f(rowp[n0 + 8]) : 0.f;
}

__device__ __forceinline__ void phase_hyena_fft(const Params& P, unsigned char* lds, int tid, int lane, int wave, int G) {
    cf* bufE = (cf*)lds; cf* bufO = (cf*)(lds + FFT_BUF); cf* zbuf = (cf*)(lds + FFT_ZB);
    float* w3c = (float*)(lds + FFT_W3); float* red = (float*)(lds + FFT_RED);
    const int str = tid >> 8, tp0 = tid & 255; cf* buf = str ? bufO : bufE;
    const bf16* Pt = (const bf16*)(P.ws + WS_PT); bf16* Zt = (bf16*)(P.ws + WS_ZT);
    cf* Hs = (cf*)(P.ws + WS_HSPEC) + (size_t)blockIdx.x * 4 * 4096;
    const float* a2T = (const float*)(P.ws + WS_A2);
#pragma unroll 1
    for (int c = blockIdx.x; c < 1024; c += G) {
        __syncthreads();
        if (tid < 256) w3c[tid] = P.in[I_HW3][(size_t)(tid & 63) * 4096 + (tid >> 6) * 1024 + c];
        __syncthreads();
        {
            float d[8][4];
#pragma unroll
            for (int j = 0; j < 8; ++j) { d[j][0] = 0.f; d[j][1] = 0.f; d[j][2] = 0.f; d[j][3] = 0.f; }
#pragma unroll 2
            for (int i = 0; i < 64; ++i) { const float w0 = w3c[i], w1 = w3c[64 + i], w2 = w3c[128 + i], w3 = w3c[192 + i]; const float* ar = a2T + (size_t)i * 4096 + tid;
#pragma unroll
                for (int j = 0; j < 8; ++j) { const float a = ar[512 * j]; d[j][0] += a * w0; d[j][1] += a * w1; d[j][2] += a * w2; d[j][3] += a * w3; } }
            float dec[4];
#pragma unroll
            for (int q = 0; q < 4; ++q) dec[q] = fabsf(P.in[I_HDEC][q * 1024 + c]);
            float as0 = 0.f, as1 = 0.f;
#pragma unroll
            for (int j = 0; j < 8; ++j) { const int t = tid + 512 * j; const float tl = (float)t / 4095.f;
                const float h0 = d[j][0] * expf(-tl * dec[0]), h1 = d[j][1] * expf(-tl * dec[1]), h2 = d[j][2] * expf(-tl * dec[2]), h3 = d[j][3] * expf(-tl * dec[3]);
                float* hb0 = (float*)(lds + FFT_ZB); float* hb1 = (float*)(lds + FFT_HB1);
                hb0[t] = h0; hb0[4096 + t] = h1; hb1[t] = h2; hb1[4096 + t] = h3; as0 += fabsf(h0) + fabsf(h1); as1 += fabsf(h2) + fabsf(h3); }
            as0 = wave_sum(as0); as1 = wave_sum(as1); if (lane == 0) { red[wave] = as0; red[8 + wave] = as1; }
        }
        __syncthreads();
#pragma unroll 1
        for (int o = 0; o < 2; ++o) {
            const float* hbuf = (const float*)(lds + (o == 0 ? FFT_ZB : FFT_HB1));
            float tot = 0.f;
#pragma unroll
            for (int w = 0; w < 8; ++w) tot += red[8 * o + w];
            const float inv = 1.f / ((tot + 1e-6f) * 8192.f);
            { const int tp = hide(tp0); cf v[16];
#pragma unroll
              for (int j = 0; j < 16; ++j) { const int n = tp + 256 * j; const float ta = (hbuf[n] + (n == 0 ? hbuf[4096] : 0.f)) * inv, tb = (n == 0 ? 0.f : hbuf[4096 + 4096 - n]) * inv;
                  if (str == 0) v[j] = cf{ta + tb, 0.f}; else { const cf w = cis_rev(-(float)n * (1.f / 8192.f)); v[j] = cf{(ta - tb) * w.x, (ta - tb) * w.y}; } }
              dft16<-1>(v); fstore<0, -1, true>(v, buf, tp, (float)(tp >> 4) * (1.f / 256.f)); }
            __syncthreads();
            fft_fwd_pass2(buf, tp0);
            __syncthreads();
            { const int tp = hide(tp0); cf v[16]; fload<2>(v, buf, tp); dft16<-1>(v);
              cf* hp = Hs + (size_t)(o * 2 + str) * 4096 + tp;
#pragma unroll
              for (int k = 0; k < 16; ++k) hp[k * 256] = v[REV4(k)]; }
            __syncthreads();
        }
#pragma unroll 1
        for (int pr = 0; pr < 4; ++pr) {
            { const int n0 = hide(tid) * 8; float ra[10], rb[10]; load_row8(Pt + (size_t)c * 32768 + (2 * pr) * 4096, n0, ra); load_row8(Pt + (size_t)c * 32768 + (2 * pr + 1) * 4096, n0, rb);
              const float w0 = P.in[I_HCW][c], w1 = P.in[I_HCW][3072 + c], w2 = P.in[I_HCW][6144 + c], bb = P.in[I_HCB][c];
#pragma unroll
              for (int i = 0; i < 8; ++i) zbuf[n0 + i] = cf{w0 * ra[i] + w1 * ra[i + 1] + w2 * ra[i + 2] + bb, w0 * rb[i] + w1 * rb[i + 1] + w2 * rb[i + 2] + bb}; }
            __syncthreads();
#pragma unroll 1
            for (int o = 0; o < 2; ++o) {
                { const int tp = hide(tp0); cf v[16];
#pragma unroll
                  for (int j = 0; j < 16; ++j) { const int n = tp + 256 * j; const cf z = zbuf[n]; v[j] = str == 0 ? z : cmul(z, cis_rev(-(float)n * (1.f / 8192.f))); }
                  dft16<-1>(v); fstore<0, -1, true>(v, buf, tp, (float)(tp >> 4) * (1.f / 256.f)); }
                __syncthreads();
                fft_fwd_pass2(buf, tp0);
                __syncthreads();
                { const int tp = hide(tp0); cf v[16]; fload<2>(v, buf, tp); dft16<-1>(v);
                  const cf* hp = Hs + (size_t)(o * 2 + str) * 4096 + tp;
                  cf y[16];
#pragma unroll
                  for (int k = 0; k < 16; ++k) y[k] = cmul(v[REV4(k)], hp[k * 256]);
                  dft16<1>(y);
                  fstore<2, 1, true>(y, buf, tp, (float)((tp >> 4) + 16 * (tp & 15)) * (1.f / 4096.f)); }
                __syncthreads();
                fft_inv_pass2(buf, tp0);
                __syncthreads();
                { const int tp = hide(tp0); cf v[16]; fload<0>(v, buf, tp); dft16<1>(v);
                  cf* p = buf + fbase<0>(tp);
#pragma unroll
                  for (int k = 0; k < 16; ++k) { cf x = v[REV4(k)]; if (str == 1) x = cmul(x, cis_rev((float)(tp + 256 * k) * (1.f / 8192.f))); p[272 * k] = x; } }
                __syncthreads();
                { const int n0 = hide(tid) * 8; float ga[10], gb[10]; const size_t grow = (size_t)((o + 1) * 1024 + c) * 32768;
                  load_row8(Pt + grow + (2 * pr) * 4096, n0, ga); load_row8(Pt + grow + (2 * pr + 1) * 4096, n0, gb);
                  const int gc = (o + 1) * 1024 + c;
                  const float w0 = P.in[I_HCW][gc], w1 = P.in[I_HCW][3072 + gc], w2 = P.in[I_HCW][6144 + gc], bb = P.in[I_HCB][gc];
                  const float sk = P.in[I_HSKIP][o * 1024 + c]; float oa[8], ob[8];
#pragma unroll
                  for (int i = 0; i < 8; ++i) { const int n = n0 + i; const cf e = bufE[fphys(n)], q = bufO[fphys(n)], z = zbuf[n];
                      const float g0 = w0 * ga[i] + w1 * ga[i + 1] + w2 * ga[i + 2] + bb;
                      const float g1 = w0 * gb[i] + w1 * gb[i + 1] + w2 * gb[i + 2] + bb;
                      oa[i] = (e.x + q.x + sk * z.x) * g0; ob[i] = (e.y + q.y + sk * z.y) * g1; }
                  if (o == 0) {
#pragma unroll
                      for (int i = 0; i < 8; ++i) zbuf[n0 + i] = cf{oa[i], ob[i]};
                  } else {
                      u32x4 wa, wb; wa.x = pk2(oa[0], oa[1]); wa.y = pk2(oa[2], oa[3]); wa.z = pk2(oa[4], oa[5]); wa.w = pk2(oa[6], oa[7]);
                      wb.x = pk2(ob[0], ob[1]); wb.y = pk2(ob[2], ob[3]); wb.z = pk2(ob[4], ob[5]); wb.w = pk2(ob[6], ob[7]);
                      *(u32x4*)(Zt + (size_t)c * 32768 + (2 * pr) * 4096 + n0) = wa; *(u32x4*)(Zt + (size_t)c * 32768 + (2 * pr + 1) * 4096 + n0) = wb;
                  } }
                __syncthreads();
            }
        }
    }
}
__device__ __forceinline__ void phase_transpose(const Params& P, unsigned char* lds, int lane, int wave, int G) {
    bf16* tile = (bf16*)(lds + wave * 16384);
    const bf16* Zt = (const bf16*)(P.ws + WS_ZT); bf16* Z = (bf16*)(P.ws + WS_Z);
    for (int it = blockIdx.x * 8 + wave; it < 16 * 512; it += G * 8) {
        const int cb = it & 15, tb = it >> 4, c0 = cb * 64, t0 = tb * 64;
#pragma unroll
        for (int i = 0; i < 8; ++i) { const int ch = i * 8 + (lane >> 3), tq = (lane & 7) * 8;
            const u32x4 a = *(const u32x4*)(Zt + (size_t)(c0 + ch) * 32768 + t0 + tq);
            unsigned* d = (unsigned*)(tile + ch * 66 + tq); d[0] = a.x; d[1] = a.y; d[2] = a.z; d[3] = a.w; }
        LDS_WAIT(); asm volatile("" ::: "memory");
#pragma unroll
        for (int i = 0; i < 8; ++i) { const int tk = i * 8 + (lane >> 3), cq = (lane & 7) * 8;
            unsigned short e[8];
#pragma unroll
            for (int j = 0; j < 8; ++j) e[j] = tile[(cq + j) * 66 + tk];
            u32x4 w; w.x = e[0] | ((unsigned)e[1] << 16); w.y = e[2] | ((unsigned)e[3] << 16); w.z = e[4] | ((unsigned)e[5] << 16); w.w = e[6] | ((unsigned)e[7] << 16);
            *(u32x4*)(Z + (size_t)(t0 + tk) * 1024 + c0 + cq) = w; }
        LDS_WAIT(); asm volatile("" ::: "memory");
    }
}

constexpr int N_PHASES = 21;
__global__ void __launch_bounds__(512, 2) fwd_kernel(Params P0) {
    extern __shared__ __attribute__((aligned(16))) unsigned char lds[];
    const int tid = threadIdx.x, lane = tid & 63, wave = __builtin_amdgcn_readfirstlane(tid >> 6), G = gridDim.x;
    PG8_LAS unsigned char* ldsl = (PG8_LAS unsigned char*)lds;
    for (int u = tid; u < (LDS_BYTES - LDSCTL_OFF) / 4; u += 512) ((unsigned*)(lds + LDSCTL_OFF))[u] = 0u;
    __syncthreads();
#if MK_ONE_LAUNCH
    XcdBarrier bar = xcd_barrier_post((unsigned*)(P0.ws + WS_CTL) + CW_BAR, (volatile LAS unsigned*)(ldsl + MISC_OFF) + 8);
#define GRID_BAR() xcd_barrier(bar)
#else
#define GRID_BAR() do { } while (0)
#endif
    const int lo = P0.ph_lo, hi = P0.ph_hi;
#ifndef PHASE_MASK
#define PHASE_MASK 0xFFFFFFFFu
#endif
#define IN(k) ((((PHASE_MASK) >> (k)) & 1u) && lo <= (k) && (k) < hi)
#define SEAM(k) do { if (IN(k) && IN((k) + 1)) GRID_BAR(); } while (0)
#ifndef REPEAT_MASK
#define REPEAT_MASK 0u
#endif
#ifndef REPEAT_SUB
#define REPEAT_SUB 0u
#endif
#define REPS(k) for (int reps_ = 0; reps_ < ((((REPEAT_SUB) >> (k)) & 1u) ? 2 : 1); ++reps_)
#define REP(k) for (int rep_ = 0; rep_ < ((((REPEAT_MASK) >> (k)) & 1u) ? 2 : 1); ++rep_)

    if (IN(0)) REP(0) { const Params P = load_params(); unsigned char* ws = P.ws; phase_prologue(P, lds, tid, lane, wave, G); } SEAM(0);
    if (IN(1)) REP(1) { const Params P = load_params(); unsigned char* ws = P.ws; phase_norm1_l0(P, lane, wave, G); } SEAM(1);
    if (IN(2)) REP(2) { const Params P = load_params(); unsigned char* ws = P.ws;
        pg8::Gemm g{(const bf16*)(ws + WS_RH), (const bf16*)(ws + WS_WIN), 1024, 1024, 1024, 0}; pg8::StaticOrder S; S.init(M0 / 256, 7, G, (int)blockIdx.x);
        EpiIn E{(bf16*)(ws + WS_CQ), (bf16*)(ws + WS_CKV), (bf16*)(ws + WS_UX), (bf16*)(ws + WS_UG), (bf16*)(ws + WS_K)};
        pg8::gemm_phase<EpiIn, pg8::StaticOrder, GP_ALIGN, GP_SP2>(ldsl, g, S, E);
    } SEAM(2);
    if (IN(3)) REP(3) { const Params P = load_params(); unsigned char* ws = P.ws; phase_rowstat(P, lane, wave, G); phase_lru_f1(P, lds, tid, lane, wave, G); } SEAM(3);
    if (IN(4)) REP(4) { const Params P = load_params(); unsigned char* ws = P.ws;
        phase_lru_carry(P, lane, wave, G);
        __syncthreads();
#ifndef NO_QUP
        REPS(0) { pg8::Gemm g{(const bf16*)(ws + WS_CQ), (const bf16*)(ws + WS_WUQ), 384, 384, 384, 0}; pg8::StaticOrder S; S.init(M0 / 256, 3, G, (int)blockIdx.x);
          EpiQ E{(bf16*)(ws + WS_Q), (const float*)(ws + WS_RQ)};
          pg8::gemm_phase<EpiQ, pg8::StaticOrder, GP_ALIGN, GP_SP2>(ldsl, g, S, E); }
#endif
        __syncthreads();
        REPS(1) { pg8::Gemm g{(const bf16*)(ws + WS_CKV), (const bf16*)(ws + WS_WUKV), 256, 256, 256, 0}; pg8::StaticOrder S; S.init(M0 / 256, 4, G, (int)blockIdx.x);
          EpiKV E{(bf16*)(ws + WS_K), (bf16*)(ws + WS_V), (const float*)(ws + WS_RKV)};
          pg8::gemm_phase<EpiKV, pg8::StaticOrder, GP_ALIGN, GP_SP2>(ldsl, g, S, E); }
        __syncthreads();
    } SEAM(4);
    if (IN(5)) REP(5) { const Params P = load_params(); unsigned char* ws = P.ws; REPS(2) phase_lru_f3(P, lds, tid, lane, wave, G); REPS(3) phase_attention(P, lds, G); } SEAM(5);
    if (IN(6)) REP(6) { const Params P = load_params(); unsigned char* ws = P.ws;
        pg8::Gemm g{(const bf16*)(ws + WS_RH), (const bf16*)(ws + WS_WOUT), 1024, 1024, 1024, 0}; pg8::StaticOrder S; S.init(M0 / 256, 4, G, (int)blockIdx.x);
        EpiRes<0> E{P.in[I_X], P.in[I_CTX], (const float*)(ws + WS_MOD), P.out, (float*)(ws + WS_XC)};
        pg8::gemm_phase<EpiRes<0>, pg8::StaticOrder, GP_ALIGN, GP_SP2>(ldsl, g, S, E);
    } SEAM(6);
    if (IN(7)) REP(7) { const Params P = load_params(); unsigned char* ws = P.ws; phase_norm2_route<0>(P, lds, tid, lane, wave, G); } SEAM(7);
    if (IN(8)) REP(8) { const Params P = load_params(); unsigned char* ws = P.ws; phase_permute<0>(P, lds, tid, lane, wave, G); } SEAM(8);
    if (IN(9)) REP(9) { const Params P = load_params(); unsigned char* ws = P.ws;
        const int* te = (const int*)(ws + WS_TILEE);
        pg8::Gemm g{(const bf16*)(ws + WS_HPERM), (const bf16*)(ws + WS_W13), 1024, 1024, 1024, (size_t)1024 * 1024 * 2}; pg8::MoeOrder S{te[MAXTILES], G, (int)blockIdx.x, te};
        EpiMoe1 E{(bf16*)(ws + WS_ACT)};
        pg8::gemm_phase<EpiMoe1, pg8::MoeOrder, GP_ALIGN, GP_SP2>(ldsl, g, S, E);
    } SEAM(9);
    if (IN(10)) REP(10) { const Params P = load_params(); unsigned char* ws = P.ws;
        const int* te = (const int*)(ws + WS_TILEE);
        pg8::Gemm g{(const bf16*)(ws + WS_ACT), (const bf16*)(ws + WS_W2), 512, 512, 512, (size_t)1024 * 512 * 2}; pg8::MoeOrder S{te[MAXTILES], G, (int)blockIdx.x, te};
        EpiStore E{(bf16*)(ws + WS_HPERM), 1024};
        pg8::gemm_phase<EpiStore, pg8::MoeOrder, GP_ALIGN, GP_SP2>(ldsl, g, S, E);
    } SEAM(10);
    if (IN(11)) REP(11) { const Params P = load_params(); unsigned char* ws = P.ws; phase_combine_norm1_l1(P, lane, wave, G); } SEAM(11);
    if (IN(12)) REP(12) { const Params P = load_params(); unsigned char* ws = P.ws;
        pg8::Gemm g{(const bf16*)(ws + WS_WHIN), (const bf16*)(ws + WS_RH), 1024, 1024, 1024, 0}; pg8::StaticOrder S; S.init(3072 / 256, M1 / 256, G, (int)blockIdx.x);
        EpiStore E{(bf16*)(ws + WS_PT), 32768};
        pg8::gemm_phase<EpiStore, pg8::StaticOrder, GP_ALIGN, GP_SP2>(ldsl, g, S, E);
    } SEAM(12);
    if (IN(13)) REP(13) { const Params P = load_params(); unsigned char* ws = P.ws; phase_hyena_fft(P, lds, tid, lane, wave, G); } SEAM(13);
    if (IN(14)) REP(14) { const Params P = load_params(); unsigned char* ws = P.ws; phase_transpose(P, lds, lane, wave, G); } SEAM(14);
    if (IN(15)) REP(15) { const Params P = load_params(); unsigned char* ws = P.ws;
        pg8::Gemm g{(const bf16*)(ws + WS_Z), (const bf16*)(ws + WS_WHOUT), 1024, 1024, 1024, 0}; pg8::StaticOrder S; S.init(M1 / 256, 4, G, (int)blockIdx.x);
        EpiRes<1> E{nullptr, nullptr, (const float*)(ws + WS_MOD), P.out, nullptr};
        pg8::gemm_phase<EpiRes<1>, pg8::StaticOrder, GP_ALIGN, GP_SP2>(ldsl, g, S, E);
    } SEAM(15);
    if (IN(16)) REP(16) { const Params P = load_params(); unsigned char* ws = P.ws; phase_norm2_route<1>(P, lds, tid, lane, wave, G); } SEAM(16);
    if (IN(17)) REP(17) { const Params P = load_params(); unsigned char* ws = P.ws; phase_permute<1>(P, lds, tid, lane, wave, G); } SEAM(17);
    if (IN(18)) REP(18) { const Params P = load_params(); unsigned char* ws = P.ws;
        const int* te = (const int*)(ws + WS_TILEE);
        pg8::Gemm g{(const bf16*)(ws + WS_HPERM), (const bf16*)(ws + WS_W13) + (size_t)16 * 1024 * 1024, 1024, 1024, 1024, (size_t)1024 * 1024 * 2}; pg8::MoeOrder S{te[MAXTILES], G, (int)blockIdx.x, te};
        EpiMoe1 E{(bf16*)(ws + WS_ACT)};
        pg8::gemm_phase<EpiMoe1, pg8::MoeOrder, GP_ALIGN, GP_SP2>(ldsl, g, S, E);
    } SEAM(18);
    if (IN(19)) REP(19) { const Params P = load_params(); unsigned char* ws = P.ws;
        const int* te = (const int*)(ws + WS_TILEE);
        pg8::Gemm g{(const bf16*)(ws + WS_ACT), (const bf16*)(ws + WS_W2) + (size_t)16 * 1024 * 512, 512, 512, 512, (size_t)1024 * 512 * 2}; pg8::MoeOrder S{te[MAXTILES], G, (int)blockIdx.x, te};
        EpiStore E{(bf16*)(ws + WS_HPERM), 1024};
        pg8::gemm_phase<EpiStore, pg8::MoeOrder, GP_ALIGN, GP_SP2>(ldsl, g, S, E);
    } SEAM(19);
    if (IN(20)) REP(20) { const Params P = load_params(); unsigned char* ws = P.ws; phase_final(P, lane, wave, G); }
#undef IN
#undef SEAM
}

extern "C" void kernel_launch(void* const* d_in, const int* in_sizes, int n_in, void* d_out, int out_size, void* d_ws, size_t ws_size, hipStream_t stream) {
    static int grid = 0;
    if (grid == 0) {
        if (n_in != N_IN || out_size != M1 * DM || ws_size < WS_END) { fprintf(stderr, "kernel_launch: unexpected shapes (n_in %d out %d ws %zu)\n", n_in, out_size, ws_size); grid = -1; return; }
        int dev = 0, cus = 0;
        if (hipGetDevice(&dev) != hipSuccess || hipDeviceGetAttribute(&cus, hipDeviceAttributeMultiprocessorCount, dev) != hipSuccess) { grid = -1; return; }
        if (hipFuncSetAttribute((const void*)fwd_kernel, hipFuncAttributeMaxDynamicSharedMemorySize, LDS_BYTES) != hipSuccess) { fprintf(stderr, "kernel_launch: hipFuncSetAttribute failed\n"); grid = -1; return; }
        int per_cu = 0;
        if (hipOccupancyMaxActiveBlocksPerMultiprocessor(&per_cu, (const void*)fwd_kernel, 512, LDS_BYTES) != hipSuccess || per_cu < 1) fprintf(stderr, "kernel_launch: occupancy query reports %d\n", per_cu);
        (void)hipGetLastError();
        grid = cus;
    }
    if (grid < 0) return;
    (void)hipMemsetAsync((char*)d_ws + WS_CTL, 0, CTL_ZERO_BYTES, stream);
    Params p{};
    for (int i = 0; i < N_IN; ++i) p.in[i] = (const float*)d_in[i];
    p.out = (float*)d_out; p.ws = (unsigned char*)d_ws;
#if MK_ONE_LAUNCH
    p.ph_lo = 0; p.ph_hi = N_PHASES;
    hipLaunchKernelGGL(fwd_kernel, dim3(grid), dim3(512), LDS_BYTES, stream, p);
#else
    for (int k = 0; k < N_PHASES; ++k) { p.ph_lo = k; p.ph_hi = k + 1; hipLaunchKernelGGL(fwd_kernel, dim3(grid), dim3(512), LDS_BYTES, stream, p); }
#endif
}
```

```cpp
#include <hip/hip_runtime.h>
#include <cstdio>
#include <cstdint>

#ifndef MK_ONE_LAUNCH
#define MK_ONE_LAUNCH 1
#endif

#define LAS __attribute__((address_space(3)))
#define GAS __attribute__((address_space(1)))
typedef unsigned short bf16;
typedef short bf16x8 __attribute__((ext_vector_type(8)));
typedef short s16x4 __attribute__((ext_vector_type(4)));
typedef float f32x2 __attribute__((ext_vector_type(2)));
typedef float f32x4 __attribute__((ext_vector_type(4)));
typedef float f32x16 __attribute__((ext_vector_type(16)));
typedef unsigned u32x2 __attribute__((ext_vector_type(2)));
typedef unsigned u32x4 __attribute__((ext_vector_type(4)));
#define LDS_WAIT() asm volatile("s_waitcnt lgkmcnt(0)" ::: "memory")
#define VM_WAIT() asm volatile("s_waitcnt vmcnt(0)" ::: "memory")

__device__ __forceinline__ unsigned f2bf(float f) { unsigned u = __builtin_bit_cast(unsigned, f); return (u + 0x7fffu + ((u >> 16) & 1u)) >> 16; }
__device__ __forceinline__ unsigned pk2(float lo, float hi) { return f2bf(lo) | (f2bf(hi) << 16); }
__device__ __forceinline__ float bf2f(unsigned b) { return __builtin_bit_cast(float, b << 16); }
__device__ __forceinline__ float bflo(unsigned w) { return __builtin_bit_cast(float, w << 16); }
__device__ __forceinline__ float bfhi(unsigned w) { return __builtin_bit_cast(float, w & 0xffff0000u); }
__device__ __forceinline__ float wave_sum(float v) {
#pragma unroll
    for (int o = 1; o < 64; o <<= 1) v += __shfl_xor(v, o);
    return v;
}
__device__ __forceinline__ float sigm(float x) { return 1.f / (1.f + expf(-x)); }

namespace pg8 {
#define PG8_LAS __attribute__((address_space(3)))
typedef unsigned short bf16_t;
constexpr int BM = 256, BK = 64, HALF = 128, HTB = HALF * BK * 2, STAGE_BYTES = 8 * HTB, NXCD = 8, WGM = 8;
__host__ __device__ __forceinline__ int lds_byte(int r, int c) { const int st = (r >> 4) * 2 + (c >> 5), rr = r & 15, cc = c & 31, ob = rr * 64 + cc * 2; return st * 1024 + (ob ^ (((ob >> 9) & 1) << 5)); }
__host__ __device__ __forceinline__ void stage_rc(int b, int& R, int& C) { const int st = b / 1024, sb = b % 1024, swz = sb ^ (((sb >> 9) & 1) << 5); R = (st >> 1) * 16 + swz / 64; C = (st & 1) * 32 + (swz % 64) / 2; }
__host__ __device__ __forceinline__ int perm32(int rho) { const int n = rho >> 4, i = rho & 15; return 8 * (i >> 2) + 4 * n + (i & 3); }

struct Unit { int pm, pn, bz; };
struct Gemm { const bf16_t* A; const bf16_t* Bt; int lda, ldb, K; size_t bz_stride; int gidx_off; };

struct StaticOrder {
    int nM, nN, nwg, G, c;
    __host__ __device__ void init(int nM_, int nN_, int G_, int c_) { nM = nM_; nN = nN_; nwg = nM * nN; G = G_; c = c_; }
    __host__ __device__ bool next(int i, Unit& u) const {
        const long L = (long)i * G + c; if (L >= nwg) return false;
        int wgid = (int)L; { const int q = nwg / NXCD, r = nwg % NXCD, xcd = wgid % NXCD, off = wgid / NXCD; wgid = (xcd < r ? xcd * (q + 1) : r * (q + 1) + (xcd - r) * q) + off; }
        const int nig = WGM * nN, gid = wgid / nig, fm = gid * WGM, gsz = (nM - fm) < WGM ? (nM - fm) : WGM;
        u.pm = fm + ((wgid % nig) % gsz); u.pn = (wgid % nig) / gsz; u.bz = 0; return true;
    }
    __device__ __forceinline__ void a_ready(const Unit&) const {}
    __device__ __forceinline__ void done(const Unit&) const {}
};
struct MoeOrder {
    int nM, G, c; const int* tile_e;
    __device__ bool next(int i, Unit& u) const {
        const long L = (long)i * G + c; if (L >= (long)nM * 4) return false;
        u.pm = (int)(L >> 2); u.pn = (int)(L & 3); u.bz = tile_e[u.pm]; return true;
    }
    __device__ __forceinline__ void a_ready(const Unit&) const {}
    __device__ __forceinline__ void done(const Unit&) const {}
};

__device__ __forceinline__ unsigned cvt_pk_bf16(float lo, float hi) { unsigned r; asm volatile("v_cvt_pk_bf16_f32 %0, %1, %2" : "=v"(r) : "v"(lo), "v"(hi)); return r; }

template <class Epi, class Sched, bool ALIGN_EPI = false, bool SP2 = false, bool GATHER = false>
__device__ __forceinline__ void gemm_phase(PG8_LAS unsigned char* lds, const Gemm g, const Sched& S, const Epi& E) {
    const int tid = threadIdx.x, wid = __builtin_amdgcn_readfirstlane(tid >> 6), lane = tid & 63, wr = wid >> 2, wc = wid & 3, fr = lane & 15, fq = lane >> 4;
    const int K = g.K, nt = K / BK;
    unsigned voffA[2], voffB[2];
#pragma unroll
    for (int i = 0; i < 2; ++i) { int R, C; stage_rc(tid * 16 + i * 8192, R, C); const int Rb = Epi::PERM ? ((R & ~31) + perm32(R & 31)) : R;
        voffA[i] = (unsigned)(R * g.lda + C) * 2u; voffB[i] = (unsigned)(Rb * g.ldb + C) * 2u; }
    unsigned vc0[2], vc1[2], vn0[2], vn1[2];
    const PG8_LAS int* gl = (const PG8_LAS int*)(lds + g.gidx_off);
#define PG8_GIDX(uix, v0, v1) do { _Pragma("unroll") for (int _i = 0; _i < 2; ++_i) { int _R, _C; stage_rc(tid * 16 + _i * 8192, _R, _C); \
        v0[_i] = (unsigned)(gl[(uix) * 256 + _R] * g.lda + _C) * 2u; v1[_i] = (unsigned)(gl[(uix) * 256 + 128 + _R] * g.lda + _C) * 2u; } } while (0)
    const size_t kstep = (size_t)(BK * 2);
    const size_t hstepA = (size_t)HALF * g.lda * 2, hstepB = (size_t)HALF * g.ldb * 2;
    const size_t tstepA = GATHER ? 0 : 2 * hstepA, tstepB = 2 * hstepB;
    const unsigned ldsw = (unsigned)wid * 1024u;
    const int aoff = lds_byte(wr * 64 + fr, fq * 8), boff = lds_byte(wc * 32 + fr, fq * 8);
#define PG8_SA(b, h) (((b) * 2 + (h)) * HTB)
#define PG8_SB(b, h) ((4 + (b) * 2 + (h)) * HTB)
#define PG8_STAGE(bufoff, gbase, voff) do { _Pragma("unroll") for (int _i = 0; _i < 2; ++_i) \
        __builtin_amdgcn_global_load_lds((const unsigned*)((const char*)(gbase) + (voff)[_i]), (PG8_LAS unsigned*)(lds + (bufoff) + ldsw + _i * 8192), 16, 0, 0); } while (0)
#define PG8_LDA(dst, b, h) do { _Pragma("unroll") for (int m = 0; m < 4; ++m) _Pragma("unroll") for (int k = 0; k < 2; ++k) dst[m][k] = *(const PG8_LAS bf16x8*)(lds + PG8_SA(b, h) + aoff + m * 2048 + k * 1024); } while (0)
#define PG8_LDB(dst, b, h) do { _Pragma("unroll") for (int n = 0; n < 2; ++n) _Pragma("unroll") for (int k = 0; k < 2; ++k) dst[n][k] = *(const PG8_LAS bf16x8*)(lds + PG8_SB(b, h) + boff + n * 2048 + k * 1024); } while (0)
#define PG8_MMA(ai, bj, At, Bt) do { __builtin_amdgcn_s_setprio(1); _Pragma("unroll") for (int m = 0; m < 4; ++m) _Pragma("unroll") for (int n = 0; n < 2; ++n) _Pragma("unroll") for (int k = 0; k < 2; ++k) \
        acc[ai][bj][m][n] = __builtin_amdgcn_mfma_f32_16x16x32_bf16(Bt[n][k], At[m][k], acc[ai][bj][m][n], 0, 0, 0); __builtin_amdgcn_s_setprio(0); } while (0)
#define PG8_WAIT_V(n) asm volatile("s_waitcnt vmcnt(" #n ")" ::: "memory")
#define PG8_WAIT_L(n) asm volatile("s_waitcnt lgkmcnt(" #n ")" ::: "memory")
#define PG8_BAR __builtin_amdgcn_s_barrier()
#define PG8_SCHED __builtin_amdgcn_sched_barrier(0)
    Unit cur, nxt; int ui = 0;
    if (!S.next(0, cur)) return;
    f32x4 acc[2][2][4][2];
#pragma unroll
    for (int a = 0; a < 2; ++a)
#pragma unroll
        for (int b = 0; b < 2; ++b)
#pragma unroll
            for (int m = 0; m < 4; ++m)
#pragma unroll
                for (int n = 0; n < 2; ++n) acc[a][b][m][n] = (f32x4){0.f, 0.f, 0.f, 0.f};
    bf16x8 At[4][2], B0[2][2], B1[2][2];
    const char* cA = (const char*)g.A + (size_t)cur.pm * tstepA; const char* cB = (const char*)g.Bt + (size_t)cur.bz * g.bz_stride + (size_t)cur.pn * tstepB;
    S.a_ready(cur);
    if constexpr (GATHER) { PG8_GIDX(0, vc0, vc1); vn0[0] = vc0[0]; vn0[1] = vc0[1]; vn1[0] = vc1[0]; vn1[1] = vc1[1]; }
#define PG8_STAGE_A0(bufoff, p, NX) do { if constexpr (GATHER) { unsigned _v[2] = {(NX) ? vn0[0] : vc0[0], (NX) ? vn0[1] : vc0[1]}; PG8_STAGE(bufoff, p, _v); } else PG8_STAGE(bufoff, p, voffA); } while (0)
#define PG8_STAGE_A1(bufoff, p, NX) do { if constexpr (GATHER) { unsigned _v[2] = {(NX) ? vn1[0] : vc1[0], (NX) ? vn1[1] : vc1[1]}; PG8_STAGE(bufoff, p, _v); } else PG8_STAGE(bufoff, (p) + hstepA, voffA); } while (0)
    if constexpr (SP2) {
        PG8_STAGE(PG8_SB(0, 0), cB, voffB); PG8_STAGE(PG8_SB(0, 1), cB + hstepB, voffB); PG8_STAGE_A0(PG8_SA(0, 0), cA, false); PG8_STAGE_A1(PG8_SA(0, 1), cA, false);
        if (wr == 1) PG8_BAR;
        PG8_WAIT_V(2); PG8_BAR;
        PG8_STAGE(PG8_SB(1, 0), cB + kstep, voffB); PG8_STAGE_A0(PG8_SA(1, 0), cA + kstep, false); PG8_STAGE(PG8_SB(1, 1), cB + hstepB + kstep, voffB);
        PG8_WAIT_V(6); PG8_BAR;
    } else {
        PG8_STAGE(PG8_SB(0, 0), cB, voffB); PG8_STAGE_A0(PG8_SA(0, 0), cA, false); PG8_STAGE(PG8_SB(0, 1), cB + hstepB, voffB); PG8_STAGE_A1(PG8_SA(0, 1), cA, false);
        if (wr == 1) PG8_BAR;
        PG8_WAIT_V(4); PG8_BAR;
        PG8_STAGE(PG8_SB(1, 0), cB + kstep, voffB); PG8_STAGE_A0(PG8_SA(1, 0), cA + kstep, false); PG8_STAGE(PG8_SB(1, 1), cB + hstepB + kstep, voffB);
        PG8_WAIT_V(6); PG8_BAR;
    }
    for (;;) {
        const bool has_next = S.next(ui + 1, nxt);
        const char* nA = has_next ? (const char*)g.A + (size_t)nxt.pm * tstepA : cA;
        const char* nB = has_next ? (const char*)g.Bt + (size_t)nxt.bz * g.bz_stride + (size_t)nxt.pn * tstepB : cB;
        if constexpr (GATHER) { if (has_next) PG8_GIDX(ui + 1, vn0, vn1); }
#pragma unroll 1
        for (int t = 0; t < nt; t += 2) {
            const bool last = (t == nt - 2);
            const char* a1 = cA + (size_t)(t + 1) * kstep;
            const char* a2 = last ? nA : cA + (size_t)(t + 2) * kstep; const char* b2 = last ? nB : cB + (size_t)(t + 2) * kstep;
            const char* a3 = a2 + kstep; const char* b3 = b2 + kstep;
            if (last && has_next) S.a_ready(nxt);
            if constexpr (SP2) {
            PG8_LDB(B0, 0, 0); PG8_LDB(B1, 0, 1); PG8_SCHED; PG8_LDA(At, 0, 0); PG8_STAGE_A1(PG8_SA(1, 1), a1, false);
            PG8_WAIT_V(8); PG8_WAIT_L(0); PG8_BAR; PG8_MMA(0, 0, At, B0); PG8_MMA(0, 1, At, B1); PG8_BAR; PG8_SCHED;
            PG8_LDA(At, 0, 1); PG8_STAGE(PG8_SB(0, 0), b2, voffB); PG8_STAGE(PG8_SB(0, 1), b2 + hstepB, voffB); PG8_STAGE_A0(PG8_SA(0, 0), a2, last);
            PG8_WAIT_V(8); PG8_WAIT_L(0); PG8_BAR; PG8_MMA(1, 0, At, B0); PG8_MMA(1, 1, At, B1); PG8_BAR; PG8_SCHED;
            PG8_LDB(B0, 1, 0); PG8_LDB(B1, 1, 1); PG8_SCHED; PG8_LDA(At, 1, 0); PG8_STAGE_A1(PG8_SA(0, 1), a2, last);
            PG8_WAIT_V(8); PG8_WAIT_L(0); PG8_BAR; PG8_MMA(0, 0, At, B0); PG8_MMA(0, 1, At, B1); PG8_BAR; PG8_SCHED;
            PG8_LDA(At, 1, 1); PG8_STAGE(PG8_SB(1, 0), b3, voffB); PG8_STAGE(PG8_SB(1, 1), b3 + hstepB, voffB); PG8_STAGE_A0(PG8_SA(1, 0), a3, last);
            PG8_WAIT_V(8); PG8_WAIT_L(0); PG8_BAR; PG8_MMA(1, 0, At, B0); PG8_MMA(1, 1, At, B1); PG8_BAR; PG8_SCHED;
            } else {
            PG8_LDB(B0, 0, 0); PG8_SCHED; PG8_LDA(At, 0, 0); PG8_STAGE_A1(PG8_SA(1, 1), a1, false);
            PG8_WAIT_L(8); PG8_BAR; PG8_WAIT_L(0); PG8_MMA(0, 0, At, B0); PG8_BAR; PG8_SCHED;
            PG8_LDB(B1, 0, 1); PG8_STAGE(PG8_SB(0, 0), b2, voffB);
            PG8_BAR; PG8_WAIT_L(0); PG8_MMA(0, 1, At, B1); PG8_BAR;
            PG8_LDA(At, 0, 1); PG8_STAGE_A0(PG8_SA(0, 0), a2, last);
            PG8_BAR; PG8_WAIT_L(0); PG8_MMA(1, 0, At, B0); PG8_BAR; PG8_SCHED;
            PG8_STAGE(PG8_SB(0, 1), b2 + hstepB, voffB);
            PG8_WAIT_V(6); PG8_BAR; PG8_MMA(1, 1, At, B1); PG8_BAR;
            PG8_LDB(B0, 1, 0); PG8_SCHED; PG8_LDA(At, 1, 0); PG8_STAGE_A1(PG8_SA(0, 1), a2, last);
            PG8_WAIT_L(8); PG8_BAR; PG8_WAIT_L(0); PG8_MMA(0, 0, At, B0); PG8_BAR; PG8_SCHED;
            PG8_LDB(B1, 1, 1); PG8_STAGE(PG8_SB(1, 0), b3, voffB);
            PG8_BAR; PG8_WAIT_L(0); PG8_MMA(0, 1, At, B1); PG8_BAR;
            PG8_LDA(At, 1, 1); PG8_STAGE_A0(PG8_SA(1, 0), a3, last);
            PG8_BAR; PG8_WAIT_L(0); PG8_MMA(1, 0, At, B0); PG8_BAR; PG8_SCHED;
            PG8_STAGE(PG8_SB(1, 1), b3 + hstepB, voffB);
            PG8_WAIT_V(6); PG8_BAR; PG8_MMA(1, 1, At, B1); PG8_BAR;
            }
        }
        if constexpr (ALIGN_EPI) { if (wr == 0) PG8_BAR; }
        E(acc, cur, wr, wc, fr, fq); S.done(cur);
        if (!has_next) break;
#pragma unroll
        for (int a = 0; a < 2; ++a)
#pragma unroll
            for (int b = 0; b < 2; ++b)
#pragma unroll
                for (int m = 0; m < 4; ++m)
#pragma unroll
                    for (int n = 0; n < 2; ++n) acc[a][b][m][n] = (f32x4){0.f, 0.f, 0.f, 0.f};
        cur = nxt; cA = nA; cB = nB; ++ui;
        if constexpr (GATHER) { vc0[0] = vn0[0]; vc0[1] = vn0[1]; vc1[0] = vn1[0]; vc1[1] = vn1[1]; }
        if constexpr (ALIGN_EPI) { if (wr == 1) PG8_BAR; }
    }
    PG8_WAIT_V(0);
    if constexpr (!ALIGN_EPI) { if (wr == 0) PG8_BAR; }
    PG8_BAR;
#undef PG8_SA
#undef PG8_SB
#undef PG8_STAGE
#undef PG8_STAGE_A0
#undef PG8_STAGE_A1
#undef PG8_GIDX
#undef PG8_LDA
#undef PG8_LDB
#undef PG8_MMA
#undef PG8_WAIT_V
#undef PG8_WAIT_L
#undef PG8_BAR
#undef PG8_SCHED
}
}
#define GP_ALIGN true
#define GP_SP2 true

constexpr int DM = 1024, NB = 8, SEQ = 4096, CTXL = 256, TC = SEQ + CTXL  ;
constexpr int M0 = NB * TC  , M1 = NB * SEQ  ;
constexpr int NEXP = 16;
constexpr float RMS_EPS = 1e-6f;
constexpr int NCHUNK = 256;
constexpr int MAXTILES = 288;
constexpr int LCH = 68;

enum { I_X = 0, I_C, I_CTX, I_CCTX, I_ADAW, I_ADAB, I_N1G, I_N2G, I_FING, I_EVWIN, I_QNG, I_KVNG, I_WUQ, I_WUKV, I_LCW, I_LCB, I_LWA, I_LBA, I_LWX, I_LBX, I_LLAM, I_EVWOUT,
       I_ODWIN, I_HCW, I_HCB, I_HW1, I_HB1, I_HF1, I_HW2, I_HB2, I_HF2, I_HW3, I_HDEC, I_HSKIP, I_ODWOUT, I_RW, I_RB, I_MW1, I_MW3, I_MW2, N_IN };

constexpr size_t MiB = 1u << 20;
constexpr size_t WS_CTL = 0, CTL_ZERO_BYTES = 1 * MiB;
constexpr size_t WS_MOD = 1 * MiB;
constexpr size_t WS_RQ = WS_MOD + 2 * 9 * 6144 * 4;
constexpr size_t WS_RKV = WS_RQ + (size_t)M0 * 4;
constexpr size_t WS_A2 = 2 * MiB;
constexpr size_t WS_ROUTE_E = 3 * MiB;
constexpr size_t WS_ROUTE_W = WS_ROUTE_E + (size_t)M0 * 4;
constexpr size_t WS_ROUTE_S = WS_ROUTE_W + (size_t)M0 * 8;
constexpr size_t WS_CNT = WS_ROUTE_S + (size_t)M0 * 8;
constexpr size_t WS_TILEE = WS_CNT + 256 * 16 * 4;
static_assert(WS_TILEE + (MAXTILES + 64) * 4 <= 4 * MiB, "route region");
constexpr size_t WS_CP = 4 * MiB;
constexpr size_t WS_CS = WS_CP + (size_t)2 * 8 * LCH * 512 * 4;
static_assert(WS_CS + (size_t)2 * 8 * LCH * 512 * 4 <= 10 * MiB, "lru carries");
constexpr size_t WS_WIN = 10 * MiB;
constexpr size_t WS_WUQ = 14 * MiB;
constexpr size_t WS_WUKV = 15 * MiB;
constexpr size_t WS_WOUT = 16 * MiB;
constexpr size_t WS_WHIN = 18 * MiB;
constexpr size_t WS_WHOUT = 24 * MiB;
constexpr size_t WS_WG = 26 * MiB;
constexpr size_t WS_W13 = 27 * MiB;
constexpr size_t WS_W2 = 91 * MiB;
constexpr size_t WS_RH = 124 * MiB;
constexpr size_t WS_XC = 192 * MiB;
constexpr size_t WS_R2 = 200 * MiB;
constexpr size_t WS_CQ = WS_R2;
constexpr size_t WS_CKV = WS_R2 + 26 * MiB;
constexpr size_t WS_UX = WS_R2 + 43 * MiB;
constexpr size_t WS_UG = WS_R2 + 77 * MiB;
constexpr size_t WS_Q = WS_R2 + 111 * MiB;
constexpr size_t WS_K = WS_R2 + 162 * MiB;
constexpr size_t WS_V = WS_R2 + 213 * MiB;
constexpr size_t WS_HPERM = WS_R2;
constexpr size_t WS_ACT = WS_R2 + 144 * MiB;
constexpr size_t WS_PT = WS_R2;
constexpr size_t WS_ZT = WS_R2 + 192 * MiB;
constexpr size_t WS_Z = WS_R2;
constexpr size_t WS_HSPEC = 456 * MiB;
constexpr size_t WS_HIN = 488 * MiB;
constexpr size_t WS_SLOTTOK = 491 * MiB;
constexpr size_t WS_END = 492 * MiB;
static_assert(WS_V + (size_t)M0 * 512 * 2 <= WS_HSPEC && WS_ZT + (size_t)1024 * 32768 * 2 <= WS_HSPEC && WS_ACT + (size_t)73728 * 512 * 2 <= WS_HSPEC, "ws map");

constexpr int CW_TMO = 0, CW_BAR = 4096;

constexpr int RING_BYTES = 131072, LDS_BYTES = 155648, LDSCTL_OFF = LDS_BYTES - 1024, MISC_OFF = LDSCTL_OFF + 320;

#define XB_TMO      128
#define XB_XCNT(j)  (256  + 64 * (j))
#define XB_XSUB(j)  (1280 + 64 * (j))
#define XB_XGEN(j)  (2304 + 64 * (j))
#define XB_TOP      3328
#define XB_TOPGEN   3392
#define XCD_BAR_WORDS 3456
#define XB_SPIN_CAP (1u << 18)
__device__ __forceinline__ unsigned xb_ld(unsigned* p)              { return __hip_atomic_load(p, __ATOMIC_RELAXED, __HIP_MEMORY_SCOPE_AGENT); }
__device__ __forceinline__ unsigned xb_add(unsigned* p, unsigned v) { return __hip_atomic_fetch_add(p, v, __ATOMIC_RELAXED, __HIP_MEMORY_SCOPE_AGENT); }
__device__ __forceinline__ unsigned xb_xcc_id() { return (unsigned)__builtin_amdgcn_s_getreg((3 << 11) | 20) & 0xFu; }
#define XB_SPIN(cond, bar) do { unsigned _sp = 0; while (cond) { __builtin_amdgcn_s_sleep(1); \
    if ((++_sp & 255u) == 0u) { if (xb_ld(&(bar)[XB_TMO])) break; if (_sp > XB_SPIN_CAP) { atomicAdd(&(bar)[XB_TMO], 1u); break; } } } } while (0)
struct XcdBarrier { unsigned* bar; unsigned x; volatile LAS unsigned* st; };
__device__ __forceinline__ XcdBarrier xcd_barrier_post(unsigned* bar, volatile LAS unsigned* st) {
    XcdBarrier b; b.bar = bar; b.x = xb_xcc_id(); b.st = st;
    if (threadIdx.x == 0) (void)xb_add(&bar[XB_XCNT(b.x)], 1u);
    return b;
}
__device__ __forceinline__ void xcd_barrier_complete(unsigned* bar, unsigned x, unsigned& nloc, unsigned& nx) {
    const unsigned G = gridDim.x * gridDim.y * gridDim.z;
    unsigned sum, cnt, mine, sp = 0u;
    for (;;) {
        sum = 0u; cnt = 0u; mine = 0u;
#pragma unroll
        for (unsigned j = 0; j < 16; ++j) { const unsigned c = xb_ld(&bar[XB_XCNT(j)]); sum += c; cnt += (c > 0u) ? 1u : 0u; mine = (j == x) ? c : mine; }
        if (sum == G) break;
        __builtin_amdgcn_s_sleep(1);
        if ((++sp & 255u) == 0u) { if (xb_ld(&bar[XB_TMO])) break; if (sp > XB_SPIN_CAP) { atomicAdd(&bar[XB_TMO], 1u); break; } }
    }
    nloc = mine > 0u ? mine : 1u; nx = cnt > 0u ? cnt : 1u;
}
__device__ __forceinline__ void xcd_barrier(const XcdBarrier& b) {
    asm volatile("s_waitcnt vmcnt(0)" ::: "memory");
    __syncthreads();
    if (threadIdx.x == 0) {
        unsigned* bar = b.bar;
        __builtin_amdgcn_s_waitcnt(0);
        unsigned nloc = b.st[0], nx = b.st[1];
        if (nloc == 0u) { xcd_barrier_complete(bar, b.x, nloc, nx); b.st[0] = nloc; b.st[1] = nx; }
        const unsigned old = xb_add(&bar[XB_XSUB(b.x)], 1u);
        const unsigned gen = old / nloc;
        if (old + 1u == (gen + 1u) * nloc) {
            __builtin_amdgcn_fence(__ATOMIC_RELEASE, "agent");
            asm volatile("s_waitcnt vmcnt(0)" ::: "memory");
            const unsigned og = xb_add(&bar[XB_TOP], 1u);
            const unsigned tg = og / nx;
            if (og + 1u == (tg + 1u) * nx) xb_add(&bar[XB_TOPGEN], 1u);
            else XB_SPIN(xb_ld(&bar[XB_TOPGEN]) == tg, bar);
            __builtin_amdgcn_fence(__ATOMIC_ACQUIRE, "agent");
            xb_add(&bar[XB_XGEN(b.x)], 1u);
            asm volatile("s_waitcnt vmcnt(0)" ::: "memory");
        } else {
            XB_SPIN(xb_ld(&bar[XB_XGEN(b.x)]) == gen, bar);
            __builtin_amdgcn_fence(__ATOMIC_ACQUIRE, "agent");
            asm volatile("s_waitcnt vmcnt(0)" ::: "memory");
        }
    }
    __syncthreads();
}

struct Params { const float* in[N_IN]; float* out; unsigned char* ws; int ph_lo, ph_hi; };
typedef const __attribute__((address_space(4))) Params* ParamsK;
__device__ __forceinline__ Params load_params() {
#if defined(__HIP_DEVICE_COMPILE__)
    unsigned long long v = (unsigned long long)__builtin_amdgcn_kernarg_segment_ptr(); asm volatile("" : "+s"(v)); return *(ParamsK)v;
#else
    return Params{};
#endif
}

__device__ __forceinline__ u32x4 pack8(const f32x4 a, const f32x4 b) {
    u32x4 w; w.x = pg8::cvt_pk_bf16(a[0], a[1]); w.y = pg8::cvt_pk_bf16(a[2], a[3]); w.z = pg8::cvt_pk_bf16(b[0], b[1]); w.w = pg8::cvt_pk_bf16(b[2], b[3]); return w;
}
__device__ __forceinline__ void rope8(f32x4& v0, f32x4& v1, int fq, int tt  , bool on) {
    const int axis = fq >> 1, half = fq & 1; const float pos = (float)(axis == 0 ? (tt >> 6) : (tt & 63)) * 0.15915494309189535f;
    constexpr float IF[8] = {1.0f, 0.316227766f, 0.1f, 0.0316227766f, 0.01f, 0.00316227766f, 0.001f, 0.000316227766f};
#pragma unroll
    for (int i = 0; i < 4; ++i) {
        { const float x = v0[i], other = __shfl_xor(x, 16); const float sn = __builtin_amdgcn_sinf(pos * IF[i]), cs = __builtin_amdgcn_cosf(pos * IF[i]);
          const float r = half == 0 ? x * cs - other * sn : other * sn + x * cs; v0[i] = on ? r : x; }
        { const float x = v1[i], other = __shfl_xor(x, 16); const float sn = __builtin_amdgcn_sinf(pos * IF[4 + i]), cs = __builtin_amdgcn_cosf(pos * IF[4 + i]);
          const float r = half == 0 ? x * cs - other * sn : other * sn + x * cs; v1[i] = on ? r : x; }
    }
}

struct EpiIn {
    static constexpr bool PERM = true;
    bf16 *CQ, *CKV, *UX, *UG, *KB;
    __device__ __forceinline__ void operator()(const f32x4 (&acc)[2][2][4][2], const pg8::Unit& u, int wr, int wc, int fr, int fq) const {
        const int row0 = u.pm * 256 + wr * 64 + fr;
        const bool is_ctx = (u.pm % 17) == 0; const int bb = u.pm / 17;
#pragma unroll
        for (int bj = 0; bj < 2; ++bj) {
            const int blk = u.pn * 2 + bj;
            if (blk < 13) {
                bf16* dst; int ld, cb;
                if (blk < 3) { dst = CQ; ld = 384; cb = blk * 128; }
                else if (blk < 5) { dst = CKV; ld = 256; cb = (blk - 3) * 128; }
                else if (blk < 9) { dst = UX; ld = 512; cb = (blk - 5) * 128; }
                else { dst = UG; ld = 512; cb = (blk - 9) * 128; }
                const int col = cb + wc * 32 + 8 * fq;
#pragma unroll
                for (int ai = 0; ai < 2; ++ai)
#pragma unroll
                    for (int m = 0; m < 4; ++m) { const int row = row0 + ai * 128 + m * 16;
                        *(u32x4*)(dst + (size_t)row * ld + col) = pack8(acc[ai][bj][m][0], acc[ai][bj][m][1]); }
            } else if (wc == 0) {
#pragma unroll
                for (int ai = 0; ai < 2; ++ai)
#pragma unroll
                    for (int m = 0; m < 4; ++m) { const int row = row0 + ai * 128 + m * 16; const int tt = row - bb * TC - CTXL;
                        f32x4 v0 = acc[ai][bj][m][0], v1 = acc[ai][bj][m][1];
                        rope8(v0, v1, fq, tt, !is_ctx);
                        const u32x4 w = pack8(v0, v1);
#pragma unroll
                        for (int h = 0; h < 8; ++h) *(u32x4*)(KB + (size_t)row * 768 + h * 96 + 64 + 8 * fq) = w; }
            }
        }
    }
};
struct EpiQ {
    static constexpr bool PERM = true;
    bf16* Q; const float* rq;
    __device__ __forceinline__ void operator()(const f32x4 (&acc)[2][2][4][2], const pg8::Unit& u, int wr, int wc, int fr, int fq) const {
        const int row0 = u.pm * 256 + wr * 64 + fr;
#pragma unroll
        for (int ai = 0; ai < 2; ++ai)
#pragma unroll
            for (int m = 0; m < 4; ++m) { const int row = row0 + ai * 128 + m * 16; const float s = rq[row];
#pragma unroll
                for (int bj = 0; bj < 2; ++bj) {
                    const u32x4 w = pack8(acc[ai][bj][m][0] * s, acc[ai][bj][m][1] * s);
                    int off;
                    if (u.pn < 2) { const int c = u.pn * 256 + bj * 128 + wc * 32 + 8 * fq; off = (c >> 6) * 96 + (c & 63); }
                    else off = (4 * bj + wc) * 96 + 64 + 8 * fq;
                    *(u32x4*)(Q + (size_t)row * 768 + off) = w;
                } }
    }
};
struct EpiKV {
    static constexpr bool PERM = true;
    bf16 *K, *V; const float* rkv;
    __device__ __forceinline__ void operator()(const f32x4 (&acc)[2][2][4][2], const pg8::Unit& u, int wr, int wc, int fr, int fq) const {
        const int row0 = u.pm * 256 + wr * 64 + fr;
#pragma unroll
        for (int ai = 0; ai < 2; ++ai)
#pragma unroll
            for (int m = 0; m < 4; ++m) { const int row = row0 + ai * 128 + m * 16; const float s = rkv[row];
#pragma unroll
                for (int bj = 0; bj < 2; ++bj) { const int h = u.pn * 2 + bj;
                    const u32x4 w = pack8(acc[ai][bj][m][0] * s, acc[ai][bj][m][1] * s);
                    if (wc < 2) *(u32x4*)(K + (size_t)row * 768 + h * 96 + wc * 32 + 8 * fq) = w;
                    else *(u32x4*)(V + (size_t)row * 512 + h * 64 + (wc - 2) * 32 + 8 * fq) = w; } }
    }
};
template <int LAYER> struct EpiRes {
    static constexpr bool PERM = false;
    const float *x, *ctx, *mod; float *out, *xc;
    __device__ __forceinline__ void operator()(const f32x4 (&acc)[2][2][4][2], const pg8::Unit& u, int wr, int wc, int fr, int fq) const {
        const int row0 = u.pm * 256 + wr * 64 + fr, col0 = u.pn * 256 + wc * 32 + 4 * fq;
        const bool is_ctx = LAYER == 0 && (u.pm % 17) == 0; const int bb = LAYER == 0 ? u.pm / 17 : u.pm / 16;
        const float* g = mod + (size_t)(LAYER * 9 + (is_ctx ? 8 : bb)) * 6144 + 2048;
        f32x4 gv[2][2];
#pragma unroll
        for (int bj = 0; bj < 2; ++bj)
#pragma unroll
            for (int n = 0; n < 2; ++n) gv[bj][n] = *(const f32x4*)(g + col0 + bj * 128 + n * 16);
#pragma unroll
        for (int ai = 0; ai < 2; ++ai)
#pragma unroll
            for (int m = 0; m < 4; ++m) { const int row = row0 + ai * 128 + m * 16;
                const float* res; float* dst;
                if (LAYER == 0) { const int t = row - bb * TC;
                    if (is_ctx) { res = ctx + (size_t)(bb * CTXL + t) * DM; dst = xc + (size_t)(bb * CTXL + t) * DM; }
                    else { res = x + (size_t)(bb * SEQ + t - CTXL) * DM; dst = out + (size_t)(bb * SEQ + t - CTXL) * DM; } }
                else { res = out + (size_t)row * DM; dst = out + (size_t)row * DM; }
#pragma unroll
                for (int bj = 0; bj < 2; ++bj)
#pragma unroll
                    for (int n = 0; n < 2; ++n) { const int c = col0 + bj * 128 + n * 16;
                        *(f32x4*)(dst + c) = *(const f32x4*)(res + c) + gv[bj][n] * acc[ai][bj][m][n]; } }
    }
};
struct EpiMoe1 {
    static constexpr bool PERM = true;
    bf16* ACT;
    __device__ __forceinline__ void operator()(const f32x4 (&acc)[2][2][4][2], const pg8::Unit& u, int wr, int wc, int fr, int fq) const {
        const int row0 = u.pm * 256 + wr * 64 + fr, col = u.pn * 128 + wc * 32 + 8 * fq;
#pragma unroll
        for (int ai = 0; ai < 2; ++ai)
#pragma unroll
            for (int m = 0; m < 4; ++m) { const int row = row0 + ai * 128 + m * 16;
                f32x4 r[2];
#pragma unroll
                for (int n = 0; n < 2; ++n)
#pragma unroll
                    for (int i = 0; i < 4; ++i) { const float a = acc[ai][0][m][n][i], b = acc[ai][1][m][n][i]; r[n][i] = a / (1.f + __expf(-a)) * b; }
                *(u32x4*)(ACT + (size_t)row * 512 + col) = pack8(r[0], r[1]); }
    }
};
struct EpiStore {
    static constexpr bool PERM = true;
    bf16* O; int ldc;
    __device__ __forceinline__ void operator()(const f32x4 (&acc)[2][2][4][2], const pg8::Unit& u, int wr, int wc, int fr, int fq) const {
        const int row0 = u.pm * 256 + wr * 64 + fr, col0 = u.pn * 256 + wc * 32 + 8 * fq;
#pragma unroll
        for (int ai = 0; ai < 2; ++ai)
#pragma unroll
            for (int m = 0; m < 4; ++m) { bf16* rowp = O + (size_t)(row0 + ai * 128 + m * 16) * ldc + col0;
#pragma unroll
                for (int bj = 0; bj < 2; ++bj) *(u32x4*)(rowp + bj * 128) = pack8(acc[ai][bj][m][0], acc[ai][bj][m][1]); }
    }
};

__device__ __forceinline__ void cvt_item(const float* W, int ldw, int col0, const float* gk, bf16* WTrow0, int ldk, int k0, float* scr, int lane) {
    if (col0 >= 0) {
#pragma unroll 8
        for (int i = 0; i < 32; ++i) { const int kk = 2 * i + (lane >> 5); float v = W[(size_t)(k0 + kk) * ldw + col0 + (lane & 31)]; if (gk) v *= gk[k0 + kk]; scr[kk * 33 + (lane & 31)] = v; }
    } else {
#pragma unroll 8
        for (int i = 0; i < 32; ++i) { const int kk = 2 * i + (lane >> 5); scr[kk * 33 + (lane & 31)] = 0.f; }
    }
    LDS_WAIT(); asm volatile("" ::: "memory");
    const int c = lane & 7;
#pragma unroll
    for (int j = 0; j < 4; ++j) { const int n = (lane >> 3) + 8 * j; const float* s = scr + (8 * c) * 33 + n;
        u32x4 o; o.x = pk2(s[0 * 33], s[1 * 33]); o.y = pk2(s[2 * 33], s[3 * 33]); o.z = pk2(s[4 * 33], s[5 * 33]); o.w = pk2(s[6 * 33], s[7 * 33]);
        *(u32x4*)(WTrow0 + (size_t)n * ldk + k0 + 8 * c) = o; }
    LDS_WAIT(); asm volatile("" ::: "memory");
}

__device__ __forceinline__ void phase_prologue(const Params& P, unsigned char* lds, int tid, int lane, int wave, int G) {
    unsigned char* ws = P.ws;
    __syncthreads();
    {
        float* sl = (float*)lds;
        float* red = (float*)(lds + 40960);
        float* mod = (float*)(ws + WS_MOD);
        bool loaded = false;
        for (int u = blockIdx.x; u < 192; u += G) {
            if (!loaded) { for (int i = tid; i < 9 * 1024; i += 512) { const float v = i < 8192 ? P.in[I_C][i] : P.in[I_CCTX][i - 8192]; sl[i] = v / (1.f + expf(-v)); } loaded = true; __syncthreads(); }
            const int l = u / 96, col = (u % 96) * 64 + lane;
            const float* W = P.in[I_ADAW] + (size_t)l * 1024 * 6144 + col;
            float a[9];
#pragma unroll
            for (int b = 0; b < 9; ++b) a[b] = 0.f;
            const int kb = wave * 128;
#pragma unroll 4
            for (int k = 0; k < 128; ++k) { const float w = W[(size_t)(kb + k) * 6144];
#pragma unroll
                for (int b = 0; b < 9; ++b) a[b] += sl[b * 1024 + kb + k] * w; }
#pragma unroll
            for (int b = 0; b < 9; ++b) red[(wave * 9 + b) * 64 + lane] = a[b];
            __syncthreads();
            for (int i = tid; i < 9 * 64; i += 512) { const int b = i >> 6, cc = i & 63; float s = 0.f;
#pragma unroll
                for (int w = 0; w < 8; ++w) s += red[(w * 9 + b) * 64 + cc];
                const int c2 = (u % 96) * 64 + cc;
                mod[(size_t)(l * 9 + b) * 6144 + c2] = s + P.in[I_ADAB][l * 6144 + c2]; }
            __syncthreads();
        }
        __syncthreads();
    }
    {
        float* scr = (float*)(lds + wave * 16384);
        const int gw = blockIdx.x * 8 + wave, NGW = G * 8;
        constexpr int I_WIN = 16 * 56, I_UQ = 6 * 24, I_UKV = 4 * 32, I_OUT = 16 * 32, I_HIN = 16 * 96, I_HOUT = 16 * 32, I_WG = 64, I_M13 = 32 * 512, I_M2 = 32 * 256;
        constexpr int NITEMS = I_WIN + I_UQ + I_UKV + I_OUT + I_HIN + I_HOUT + I_WG + I_M13 + I_M2;
        for (int it = gw; it < NITEMS; it += NGW) {
            int r = it;
            if (r < I_M13) { const int le = r >> 9, q = r & 511, kb = q >> 5, nb = q & 31, n0 = 32 * nb, pn = n0 >> 8, j = n0 & 255;
                const float* src = (j < 128 ? P.in[I_MW1] : P.in[I_MW3]) + (size_t)le * 1024 * 512;
                cvt_item(src, 512, 128 * pn + (j & 127), nullptr, (bf16*)(ws + WS_W13) + ((size_t)le * 1024 + n0) * 1024, 1024, 64 * kb, scr, lane); continue; } r -= I_M13;
            if (r < I_M2) { const int le = r >> 8, q = r & 255, kb = q >> 5, nb = q & 31, n0 = 32 * nb;
                cvt_item(P.in[I_MW2] + (size_t)le * 512 * 1024, 1024, n0, nullptr, (bf16*)(ws + WS_W2) + ((size_t)le * 1024 + n0) * 512, 512, 64 * kb, scr, lane); continue; } r -= I_M2;
            if (r < I_WIN) { const int kb = r / 56, nb = r % 56, n0 = 32 * nb; const int col0 = n0 < 640 ? n0 : (n0 < 1664 ? n0 + 32 : (n0 < 1696 ? n0 - 1024 : -1));
                cvt_item(P.in[I_EVWIN], 1696, col0, nullptr, (bf16*)(ws + WS_WIN) + (size_t)n0 * 1024, 1024, 64 * kb, scr, lane); continue; } r -= I_WIN;
            if (r < I_UQ) { const int kb = r / 24, nb = r % 24, n0 = 32 * nb; const int col0 = n0 < 512 ? (n0 >> 6) * 96 + (n0 & 63) : ((n0 - 512) >> 5) * 96 + 64;
                cvt_item(P.in[I_WUQ], 768, col0, P.in[I_QNG], (bf16*)(ws + WS_WUQ) + (size_t)n0 * 384, 384, 64 * kb, scr, lane); continue; } r -= I_UQ;
            if (r < I_UKV) { const int kb = r / 32, nb = r % 32, n0 = 32 * nb;
                cvt_item(P.in[I_WUKV], 1024, n0, P.in[I_KVNG], (bf16*)(ws + WS_WUKV) + (size_t)n0 * 256, 256, 64 * kb, scr, lane); continue; } r -= I_UKV;
            if (r < I_OUT) { const int kb = r / 32, nb = r % 32, n0 = 32 * nb;
                cvt_item(P.in[I_EVWOUT], 1024, n0, nullptr, (bf16*)(ws + WS_WOUT) + (size_t)n0 * 1024, 1024, 64 * kb, scr, lane); continue; } r -= I_OUT;
            if (r < I_HIN) { const int kb = r / 96, nb = r % 96, n0 = 32 * nb;
                cvt_item(P.in[I_ODWIN], 3072, n0, nullptr, (bf16*)(ws + WS_WHIN) + (size_t)n0 * 1024, 1024, 64 * kb, scr, lane); continue; } r -= I_HIN;
            if (r < I_HOUT) { const int kb = r / 32, nb = r % 32, n0 = 32 * nb;
                cvt_item(P.in[I_ODWOUT], 1024, n0, nullptr, (bf16*)(ws + WS_WHOUT) + (size_t)n0 * 1024, 1024, 64 * kb, scr, lane); continue; } r -= I_HOUT;
            { const int mat = r >> 1, nb = r & 1, d = mat >> 4, gsel = (mat >> 3) & 1, h = mat & 7;
                const float* src = (gsel ? P.in[I_LWX] : P.in[I_LWA]) + (size_t)(d * 8 + h) * 4096;
                cvt_item(src, 64, 32 * nb, nullptr, (bf16*)(ws + WS_WG) + (size_t)(h * 256 + d * 128 + gsel * 64 + 32 * nb) * 64, 64, 0, scr, lane); }
        }
    }
    {
        const int gw = blockIdx.x * 8 + wave, NGW = G * 8;
        float* a2 = (float*)(ws + WS_A2);
        const float *w1 = P.in[I_HW1], *b1 = P.in[I_HB1], *f1 = P.in[I_HF1], *w2 = P.in[I_HW2], *b2 = P.in[I_HB2], *f2 = P.in[I_HF2];
        for (int t = gw; t < 4096; t += NGW) {
            const float tl = (float)t / 4095.f, w = (6.283185307179586f / 4096.f) * (float)t;
            float zi = 0.f;
            if (lane == 0) zi = tl;
            else if (lane <= 16) { const float f = 1e-4f + (float)(lane - 1) * ((15.f - 1e-4f) / 15.f); zi = cosf(f * w); }
            else if (lane <= 32) { const float f = 1e-4f + (float)(lane - 17) * ((15.f - 1e-4f) / 15.f); zi = -sinf(f * w); }
            float acc = b1[lane];
            for (int i = 0; i < 33; ++i) acc += __shfl(zi, i) * w1[i * 64 + lane];
            const float a1 = sinf(f1[lane] * acc);
            float acc2 = b2[lane];
            for (int i = 0; i < 64; ++i) acc2 += __shfl(a1, i) * w2[i * 64 + lane];
            a2[(size_t)lane * 4096 + t] = sinf(f2[lane] * acc2);
        }
    }
}

__device__ __forceinline__ void store_row_bf16(bf16* orow, const f32x4 (&v)[4], int lane) {
    unsigned long long* o8 = (unsigned long long*)orow + lane;
#pragma unroll
    for (int j = 0; j < 4; ++j) o8[64 * j] = (unsigned long long)pk2(v[j][0], v[j][1]) | ((unsigned long long)pk2(v[j][2], v[j][3]) << 32);
}
__device__ __forceinline__ void norm_mod(f32x4 (&v)[4], const float* g, const float* sh, const float* sc, int lane) {
    float ss = 0.f;
#pragma unroll
    for (int j = 0; j < 4; ++j) ss += (v[j][0] * v[j][0] + v[j][1] * v[j][1]) + (v[j][2] * v[j][2] + v[j][3] * v[j][3]);
    const float rr = rsqrtf(wave_sum(ss) * (1.f / 1024.f) + RMS_EPS);
#pragma unroll
    for (int j = 0; j < 4; ++j) { const f32x4 gg = ((const f32x4*)g)[lane + 64 * j], s1 = ((const f32x4*)sc)[lane + 64 * j], s0 = ((const f32x4*)sh)[lane + 64 * j];
        v[j] = (v[j] * rr * gg) * (1.f + s1) + s0; }
}
__device__ __forceinline__ void moe_combine(f32x4 (&v)[4], const bf16* Y, const int* rs, const float* rw, int r, const float* g2, int lane) {
    const int s0 = rs[2 * r], s1 = rs[2 * r + 1]; const float w0 = rw[2 * r], w1 = rw[2 * r + 1];
    const u32x2* y0 = (const u32x2*)(Y + (size_t)s0 * 1024) + lane; const u32x2* y1 = (const u32x2*)(Y + (size_t)s1 * 1024) + lane;
#pragma unroll
    for (int j = 0; j < 4; ++j) { const u32x2 a = y0[64 * j], b = y1[64 * j]; const f32x4 gg = ((const f32x4*)g2)[lane + 64 * j];
        f32x4 m; m[0] = w0 * bflo(a.x) + w1 * bflo(b.x); m[1] = w0 * bfhi(a.x) + w1 * bfhi(b.x); m[2] = w0 * bflo(a.y) + w1 * bflo(b.y); m[3] = w0 * bfhi(a.y) + w1 * bfhi(b.y);
        v[j] = v[j] + gg * m; }
}
__device__ __forceinline__ float rdlane(float x, int l) { return __builtin_bit_cast(float, __builtin_amdgcn_readlane(__builtin_bit_cast(int, x), l)); }
__device__ __forceinline__ void route_row(const f32x4 (&v)[4], const float* rwT  , const float* rb, int lane, int& e0o, int& e1o, float& w0o, float& w1o) {
    float p[16];
#pragma unroll
    for (int e = 0; e < 16; ++e) { float a = 0.f;
#pragma unroll
        for (int j = 0; j < 4; ++j) { const f32x4 w = ((const f32x4*)(rwT + e * 1024))[lane + 64 * j]; a += (v[j][0] * w[0] + v[j][1] * w[1]) + (v[j][2] * w[2] + v[j][3] * w[3]); }
        p[e] = a; }
    const bool h32 = lane & 32, h16 = lane & 16, h8 = lane & 8, h4 = lane & 4;
    float q8[8], q4[4], q2[2], q1;
#pragma unroll
    for (int e = 0; e < 8; ++e) { const float send = h32 ? p[e] : p[e + 8], keep = h32 ? p[e + 8] : p[e]; q8[e] = keep + __shfl_xor(send, 32); }
#pragma unroll
    for (int e = 0; e < 4; ++e) { const float send = h16 ? q8[e] : q8[e + 4], keep = h16 ? q8[e + 4] : q8[e]; q4[e] = keep + __shfl_xor(send, 16); }
#pragma unroll
    for (int e = 0; e < 2; ++e) { const float send = h8 ? q4[e] : q4[e + 2], keep = h8 ? q4[e + 2] : q4[e]; q2[e] = keep + __shfl_xor(send, 8); }
    { const float send = h4 ? q2[0] : q2[1], keep = h4 ? q2[1] : q2[0]; q1 = keep + __shfl_xor(send, 4); }
    q1 += __shfl_xor(q1, 1); q1 += __shfl_xor(q1, 2);
    const float sl = __builtin_amdgcn_rcpf(1.f + __expf(-q1));
    float s[16], sel[16];
#pragma unroll
    for (int e = 0; e < 16; ++e) { s[e] = rdlane(sl, 32 * (e >> 3) + 16 * ((e >> 2) & 1) + 8 * ((e >> 1) & 1) + 4 * (e & 1)); sel[e] = s[e] + rb[e]; }
    float gbest = -1e30f; int gi = 0;
#pragma unroll
    for (int g = 0; g < 4; ++g) { float m1 = -1e30f, m2 = -1e30f;
#pragma unroll
        for (int i = 0; i < 4; ++i) { const float x = sel[4 * g + i]; if (x > m1) { m2 = m1; m1 = x; } else if (x > m2) m2 = x; }
        const float gs = m1 + m2; if (gs > gbest) { gbest = gs; gi = g; } }
    float b0 = -1e30f, b1 = -1e30f; int e0 = 0, e1 = 0; float s0 = 0.f, s1 = 0.f;
#pragma unroll
    for (int e = 0; e < 16; ++e) { const bool in = (e >> 2) == gi; const float x = sel[e];
        if (in && x > b0) { b1 = b0; e1 = e0; s1 = s0; b0 = x; e0 = e; s0 = s[e]; } else if (in && x > b1) { b1 = x; e1 = e; s1 = s[e]; } }
    e0o = e0; e1o = e1; const float den = s0 + s1; w0o = s0 / den; w1o = s1 / den;
}

__device__ __forceinline__ const float* l0_row_ptr(const Params& P, int row, const float* xc_or_ctx, bool from_out) {
    const int b = row / TC, t = row - b * TC;
    return t < CTXL ? xc_or_ctx + (size_t)(b * CTXL + t) * DM : (from_out ? (const float*)P.out : P.in[I_X]) + (size_t)(b * SEQ + t - CTXL) * DM;
}
__device__ __forceinline__ void phase_norm1_l0(const Params& P, int lane, int wave, int G) {
    const float* mod = (const float*)(P.ws + WS_MOD); bf16* H = (bf16*)(P.ws + WS_RH);
    int row = blockIdx.x * 8 + wave; if (row >= M0) return;
    f32x4 nx[4];
    { const float* xr = l0_row_ptr(P, row, P.in[I_CTX], false);
#pragma unroll
      for (int j = 0; j < 4; ++j) nx[j] = ((const f32x4*)xr)[lane + 64 * j]; }
    for (; row < M0; row += G * 8) {
        f32x4 v[4];
#pragma unroll
        for (int j = 0; j < 4; ++j) v[j] = nx[j];
        if (row + G * 8 < M0) { const float* xr = l0_row_ptr(P, row + G * 8, P.in[I_CTX], false);
#pragma unroll
            for (int j = 0; j < 4; ++j) nx[j] = ((const f32x4*)xr)[lane + 64 * j]; }
        const int b = row / TC, t = row - b * TC;
        const float* md = mod + (size_t)(t < CTXL ? 8 : b) * 6144;
        norm_mod(v, P.in[I_N1G], md, md + 1024, lane);
        store_row_bf16(H + (size_t)row * DM, v, lane);
    }
}
template <int LAYER> __device__ __forceinline__ void phase_norm2_route(const Params& P, unsigned char* lds, int tid, int lane, int wave, int G) {
    constexpr int ROWS = LAYER == 0 ? 136 : 128;
    float* rwT = (float*)lds;
    int* cntl = (int*)(lds + 65536);
    const float* mod = (const float*)(P.ws + WS_MOD) + (size_t)LAYER * 9 * 6144; bf16* H = (bf16*)(P.ws + WS_RH);
    int* route_e = (int*)(P.ws + WS_ROUTE_E); float* route_w = (float*)(P.ws + WS_ROUTE_W); int* cnt = (int*)(P.ws + WS_CNT);
    for (int i = tid; i < 16384; i += 512) { const int k = i >> 4, e = i & 15; rwT[e * 1024 + k] = P.in[I_RW][i]; }
    for (int ch = blockIdx.x; ch < NCHUNK; ch += G) {
        if (tid < 16) cntl[tid] = 0;
        __syncthreads();
        f32x4 nx[4];
        { const int row = ch * ROWS + wave; const float* xr = LAYER == 0 ? l0_row_ptr(P, row, (const float*)(P.ws + WS_XC), true) : P.out + (size_t)row * DM;
#pragma unroll
          for (int j = 0; j < 4; ++j) nx[j] = ((const f32x4*)xr)[lane + 64 * j]; }
        for (int rl = wave; rl < ROWS; rl += 8) {
            const int row = ch * ROWS + rl; const float* md;
            if (LAYER == 0) { const int b = row / TC, t = row - b * TC; md = mod + (size_t)(t < CTXL ? 8 : b) * 6144; }
            else md = mod + (size_t)(row >> 12) * 6144;
            f32x4 v[4];
#pragma unroll
            for (int j = 0; j < 4; ++j) v[j] = nx[j];
            if (rl + 8 < ROWS) { const float* xr = LAYER == 0 ? l0_row_ptr(P, row + 8, (const float*)(P.ws + WS_XC), true) : P.out + (size_t)(row + 8) * DM;
#pragma unroll
                for (int j = 0; j < 4; ++j) nx[j] = ((const f32x4*)xr)[lane + 64 * j]; }
            norm_mod(v, P.in[I_N2G] + LAYER * 1024, md + 3072, md + 4096, lane);
            store_row_bf16(H + (size_t)row * DM, v, lane);
            int e0, e1; float w0, w1; route_row(v, rwT, P.in[I_RB], lane, e0, e1, w0, w1);
            if (lane == 0) { route_e[row] = e0 | (e1 << 8); route_w[2 * row] = w0; route_w[2 * row + 1] = w1; atomicAdd(&cntl[e0], 1); atomicAdd(&cntl[e1], 1); }
        }
        __syncthreads();
        if (tid < 16) cnt[ch * 16 + tid] = cntl[tid];
        __syncthreads();
    }
}
template <int LAYER> __device__ __forceinline__ void phase_permute(const Params& P, unsigned char* lds, int tid, int lane, int wave, int G) {
    constexpr int ROWS = LAYER == 0 ? 136 : 128;
    int* part_tot = (int*)lds;
    int* part_base = part_tot + 512;
    int* slot0 = part_base + 512;
    int* loc = slot0 + 16;
    int* slots = loc + 16;
    int* tstart = slots + 2 * 136;
    int* rel = tstart + 32;
    int* etot = rel + 136;
    const int* cnt = (const int*)(P.ws + WS_CNT); const int* route_e = (const int*)(P.ws + WS_ROUTE_E); int* route_s = (int*)(P.ws + WS_ROUTE_S);
    int* tile_e = (int*)(P.ws + WS_TILEE); int* slot_tok = (int*)(P.ws + WS_SLOTTOK);
    for (int ch = blockIdx.x; ch < NCHUNK; ch += G) {
        { const int e = tid & 15, part = tid >> 4; int tot = 0, bs = 0;
#pragma unroll
          for (int i = 0; i < 8; ++i) { const int c = part * 8 + i; const int x = cnt[c * 16 + e]; tot += x; bs += (c < ch) ? x : 0; }
          part_tot[part * 16 + e] = tot; part_base[part * 16 + e] = bs; }
        if (tid < ROWS) rel[tid] = route_e[ch * ROWS + tid];
        __syncthreads();
        if (tid == 0) {
            int ts = 0;
            for (int e = 0; e < 16; ++e) { int tot = 0, bs = 0; for (int p = 0; p < 32; ++p) { tot += part_tot[p * 16 + e]; bs += part_base[p * 16 + e]; }
                tstart[e] = ts; slot0[e] = ts * 256 + bs; loc[e] = 0; etot[e] = tot; ts += (tot + 255) >> 8; }
            tstart[16] = ts;
            if (ch == 0) { for (int e = 0; e < 16; ++e) for (int i = tstart[e]; i < tstart[e + 1]; ++i) tile_e[i] = e; tile_e[MAXTILES] = ts; }
            for (int rl = 0; rl < ROWS; ++rl) { const int row = ch * ROWS + rl; const int ee = rel[rl]; const int e0 = ee & 255, e1 = ee >> 8;
                const int s0 = slot0[e0] + loc[e0]; loc[e0] = loc[e0] + 1; const int s1 = slot0[e1] + loc[e1]; loc[e1] = loc[e1] + 1;
                slots[2 * rl] = s0; slots[2 * rl + 1] = s1; route_s[2 * row] = s0; route_s[2 * row + 1] = s1; }
        }
        __syncthreads();
        if (tid < 2 * ROWS) slot_tok[slots[tid]] = ch * ROWS + (tid >> 1);
        if (ch == 0) {
            for (int e = 0; e < 16; ++e) { const int lo = tstart[e] * 256 + etot[e], hi = tstart[e + 1] * 256; for (int sidx = lo + tid; sidx < hi; sidx += 512) slot_tok[sidx] = 0; }
        }
        __syncthreads();
    }
}
__device__ __forceinline__ void phase_combine_norm1_l1(const Params& P, int lane, int wave, int G) {
    const float* mod = (const float*)(P.ws + WS_MOD); bf16* H = (bf16*)(P.ws + WS_RH); const bf16* Y = (const bf16*)(P.ws + WS_HPERM);
    const int* rs = (const int*)(P.ws + WS_ROUTE_S); const float* rw = (const float*)(P.ws + WS_ROUTE_W);
    for (int row = blockIdx.x * 8 + wave; row < M1; row += G * 8) {
        const int b = row >> 12, t = row & 4095, r0 = b * TC + CTXL + t;
        float* xr = P.out + (size_t)row * DM;
        f32x4 v[4];
#pragma unroll
        for (int j = 0; j < 4; ++j) v[j] = ((const f32x4*)xr)[lane + 64 * j];
        moe_combine(v, Y, rs, rw, r0, mod + (size_t)b * 6144 + 5120, lane);
#pragma unroll
        for (int j = 0; j < 4; ++j) ((f32x4*)xr)[lane + 64 * j] = v[j];
        const float* md = mod + (size_t)(9 + b) * 6144;
        norm_mod(v, P.in[I_N1G] + 1024, md, md + 1024, lane);
        store_row_bf16(H + (size_t)row * DM, v, lane);
    }
}
__device__ __forceinline__ void phase_final(const Params& P, int lane, int wave, int G) {
    const float* mod = (const float*)(P.ws + WS_MOD); const bf16* Y = (const bf16*)(P.ws + WS_HPERM);
    const int* rs = (const int*)(P.ws + WS_ROUTE_S); const float* rw = (const float*)(P.ws + WS_ROUTE_W);
    for (int row = blockIdx.x * 8 + wave; row < M1; row += G * 8) {
        const int b = row >> 12;
        float* xr = P.out + (size_t)row * DM;
        f32x4 v[4];
#pragma unroll
        for (int j = 0; j < 4; ++j) v[j] = ((const f32x4*)xr)[lane + 64 * j];
        moe_combine(v, Y, rs, rw, row, mod + (size_t)(9 + b) * 6144 + 5120, lane);
        float ss = 0.f;
#pragma unroll
        for (int j = 0; j < 4; ++j) ss += (v[j][0] * v[j][0] + v[j][1] * v[j][1]) + (v[j][2] * v[j][2] + v[j][3] * v[j][3]);
        const float rr = rsqrtf(wave_sum(ss) * (1.f / 1024.f) + RMS_EPS);
#pragma unroll
        for (int j = 0; j < 4; ++j) ((f32x4*)xr)[lane + 64 * j] = v[j] * rr * ((const f32x4*)P.in[I_FING])[lane + 64 * j];
    }
}
__device__ __forceinline__ void phase_rowstat(const Params& P, int lane, int wave, int G) {
    const bf16* CQ = (const bf16*)(P.ws + WS_CQ); const bf16* CKV = (const bf16*)(P.ws + WS_CKV); float* rq = (float*)(P.ws + WS_RQ); float* rkv = (float*)(P.ws + WS_RKV);
    for (int row = blockIdx.x * 8 + wave; row < M0; row += G * 8) {
        float sq = 0.f, sk = 0.f;
        if (lane < 48) { const u32x4 a = ((const u32x4*)(CQ + (size_t)row * 384))[lane];
            sq = (bflo(a.x) * bflo(a.x) + bfhi(a.x) * bfhi(a.x)) + (bflo(a.y) * bflo(a.y) + bfhi(a.y) * bfhi(a.y)) + (bflo(a.z) * bflo(a.z) + bfhi(a.z) * bfhi(a.z)) + (bflo(a.w) * bflo(a.w) + bfhi(a.w) * bfhi(a.w)); }
        if (lane < 32) { const u32x4 a = ((const u32x4*)(CKV + (size_t)row * 256))[lane];
            sk = (bflo(a.x) * bflo(a.x) + bfhi(a.x) * bfhi(a.x)) + (bflo(a.y) * bflo(a.y) + bfhi(a.y) * bfhi(a.y)) + (bflo(a.z) * bflo(a.z) + bfhi(a.z) * bfhi(a.z)) + (bflo(a.w) * bflo(a.w) + bfhi(a.w) * bfhi(a.w)); }
        sq = wave_sum(sq); sk = wave_sum(sk);
        if (lane == 0) { rq[row] = rsqrtf(sq * (1.f / 384.f) + RMS_EPS); rkv[row] = rsqrtf(sk * (1.f / 256.f) + RMS_EPS); }
    }
}

constexpr int LRU_UXF = 0;
constexpr int LRU_UF = 17408;
constexpr int LRU_UB = LRU_UF + 16384;
constexpr int LRU_G = LRU_UB + 8192;
__device__ __forceinline__ int crow32(int r, int hi) { return (r & 3) + 8 * (r >> 2) + 4 * hi; }
struct LruK { float cw[4][8]; float cb[8]; float ba, bx, sp; bf16x8 bf[4]; int h; };
struct LruTile { u32x4 a, b; };
__device__ __forceinline__ void lru_load_consts(const Params& P, int h, int tid, int lane, int wave, LruK& K) {
    const int c0 = (tid & 7) * 8; const float* cw = P.in[I_LCW]; const float* cb = P.in[I_LCB];
#pragma unroll
    for (int i = 0; i < 8; ++i) { const int ch = h * 64 + c0 + i; K.cb[i] = cb[ch];
#pragma unroll
        for (int j = 0; j < 4; ++j) K.cw[j][i] = cw[j * 512 + ch]; }
    { const int c = tid & 63, d = (tid >> 6) & 1, ch = h * 64 + c; K.ba = P.in[I_LBA][d * 512 + ch]; K.bx = P.in[I_LBX][d * 512 + ch]; K.sp = log1pf(expf(-P.in[I_LLAM][d * 512 + ch])); }
    { const bf16* WgT = (const bf16*)(P.ws + WS_WG) + (size_t)h * 256 * 64; const int n = wave * 32 + (lane & 31), hi = lane >> 5;
#pragma unroll
      for (int ks = 0; ks < 4; ++ks) K.bf[ks] = *(const bf16x8*)(WgT + (size_t)n * 64 + 16 * ks + 8 * hi); }
    K.h = h;
}
__device__ __forceinline__ void lru_tile_load(const bf16* UX, int b, int ck, int h, int tid, LruTile& T) {
    const int seg_lo = ck < 4 ? 0 : CTXL, seg_hi = ck < 4 ? CTXL : TC, p0 = ck * 64 - 2, c8 = (tid & 7) * 8;
    T.a = (u32x4){0u, 0u, 0u, 0u}; T.b = (u32x4){0u, 0u, 0u, 0u};
    { const int pos = p0 + (tid >> 3); if (pos >= seg_lo && pos < seg_hi) T.a = *(const u32x4*)(UX + (size_t)(b * TC + pos) * 512 + h * 64 + c8); }
    if (tid < 24) { const int pos = p0 + 64 + (tid >> 3); if (pos >= seg_lo && pos < seg_hi) T.b = *(const u32x4*)(UX + (size_t)(b * TC + pos) * 512 + h * 64 + c8); }
}
__device__ __forceinline__ void st8f(float* d, const u32x4 a) { d[0] = bflo(a.x); d[1] = bfhi(a.x); d[2] = bflo(a.y); d[3] = bfhi(a.y); d[4] = bflo(a.z); d[5] = bfhi(a.z); d[6] = bflo(a.w); d[7] = bfhi(a.w); }
__device__ __forceinline__ void lru_coeffs(unsigned char* lds, const LruTile& T, const LruK& K, int tid, int lane, int wave) {
    float* uxf = (float*)(lds + LRU_UXF); float* uf = (float*)(lds + LRU_UF); bf16* ub = (bf16*)(lds + LRU_UB); float* Gm = (float*)(lds + LRU_G);
    __syncthreads();
    st8f(uxf + (tid >> 3) * 64 + (tid & 7) * 8, T.a);
    if (tid < 24) st8f(uxf + (64 + (tid >> 3)) * 64 + (tid & 7) * 8, T.b);
    __syncthreads();
    { const int t = tid >> 3, c0 = (tid & 7) * 8; float uo[8];
#pragma unroll
      for (int i = 0; i < 8; ++i) { float u = K.cb[i];
#pragma unroll
          for (int j = 0; j < 4; ++j) u += K.cw[j][i] * uxf[(t + j) * 64 + c0 + i];
          uo[i] = u; uf[t * 64 + c0 + i] = u; }
      u32x4 w; w.x = pk2(uo[0], uo[1]); w.y = pk2(uo[2], uo[3]); w.z = pk2(uo[4], uo[5]); w.w = pk2(uo[6], uo[7]);
      *(u32x4*)(ub + t * 64 + c0) = w; }
    __syncthreads();
    {
        const int r32 = lane & 31, hi = lane >> 5, n = wave * 32 + r32;
        f32x16 acc0 = {}, acc1 = {};
#pragma unroll
        for (int ks = 0; ks < 4; ++ks) {
            const bf16x8 a0 = *(const bf16x8*)(ub + (r32) * 64 + 16 * ks + 8 * hi), a1 = *(const bf16x8*)(ub + (32 + r32) * 64 + 16 * ks + 8 * hi);
            acc0 = __builtin_amdgcn_mfma_f32_32x32x16_bf16(a0, K.bf[ks], acc0, 0, 0, 0);
            acc1 = __builtin_amdgcn_mfma_f32_32x32x16_bf16(a1, K.bf[ks], acc1, 0, 0, 0);
        }
#pragma unroll
        for (int r = 0; r < 16; ++r) { Gm[crow32(r, hi) * 256 + n] = acc0[r]; Gm[(32 + crow32(r, hi)) * 256 + n] = acc1[r]; }
    }
    __syncthreads();
    { const int c = tid & 63, d = (tid >> 6) & 1, tg = tid >> 7;
#pragma unroll 4
      for (int i = 0; i < 16; ++i) { const int t = tg * 16 + i;
          const float ga = Gm[t * 256 + d * 128 + c] + K.ba, gx = Gm[t * 256 + d * 128 + 64 + c] + K.bx;
          const float r = __builtin_amdgcn_rcpf(1.f + __expf(-ga)), ii = __builtin_amdgcn_rcpf(1.f + __expf(-gx)), la = -8.f * r * K.sp;
          const float a = __expf(la), x2 = 2.f * la;
          const float em = -x2 * (1.f + x2 * (0.5f + x2 * (0.16666667f + x2 * (0.041666668f + x2 * 0.0083333333f))));
          const float bb = sqrtf(em) * (ii * uf[t * 64 + c]);
          Gm[t * 256 + d * 128 + c] = a; Gm[t * 256 + d * 128 + 64 + c] = bb; } }
    __syncthreads();
}
__device__ __forceinline__ void lru_unit(int u, int& b, int& ck, int& h) { h = u & 7; ck = (u >> 3) % LCH; b = u / (8 * LCH); }
__device__ __forceinline__ void phase_lru_f1(const Params& P, unsigned char* lds, int tid, int lane, int wave, int G) {
    float* Gm = (float*)(lds + LRU_G); float* CP = (float*)(P.ws + WS_CP); float* CS = (float*)(P.ws + WS_CS); const bf16* UX = (const bf16*)(P.ws + WS_UX);
    constexpr int NU = NB * LCH * 8;
    int u = blockIdx.x; if (u >= NU) return;
    int b, ck, h; lru_unit(u, b, ck, h);
    LruK K; lru_load_consts(P, h, tid, lane, wave, K);
    LruTile T; lru_tile_load(UX, b, ck, h, tid, T);
    for (;;) {
        if (h != K.h) lru_load_consts(P, h, tid, lane, wave, K);
        lru_coeffs(lds, T, K, tid, lane, wave);
        const int un = u + G; int bn = 0, ckn = 0, hn = h;
        if (un < NU) { lru_unit(un, bn, ckn, hn); lru_tile_load(UX, bn, ckn, hn, tid, T); }
        if (tid < 128) { const int d = tid >> 6, c = tid & 63; float hh = 0.f, pp = 1.f;
#pragma unroll 8
            for (int i = 0; i < 64; ++i) { const int t = d == 0 ? i : 63 - i; const float a = Gm[t * 256 + d * 128 + c], bb = Gm[t * 256 + d * 128 + 64 + c]; hh = a * hh + bb; pp *= a; }
            const size_t o = ((size_t)(d * 8 + b) * LCH + ck) * 512 + h * 64 + c; CP[o] = pp; CS[o] = hh; }
        if (un >= NU) break;
        u = un; b = bn; ck = ckn; h = hn;
    }
    __syncthreads();
}
__device__ __forceinline__ void phase_lru_carry(const Params& P, int lane, int wave, int G) {
    const float* CP = (const float*)(P.ws + WS_CP); const float* CS = (const float*)(P.ws + WS_CS); float* HIN = (float*)(P.ws + WS_HIN);
    if (wave != 0) return;
    for (int sb = blockIdx.x; sb < 128; sb += G) {
        const int s = sb * 64 + lane, d = s >> 12, b = (s >> 9) & 7, ch = s & 511; const size_t base = ((size_t)(d * 8 + b) * LCH) * 512 + ch;
        float hh = 0.f;
#pragma unroll 1
        for (int st = 0; st < LCH; st += 4) { float cp[4], cs[4]; int q[4];
#pragma unroll
            for (int i = 0; i < 4; ++i) { const int step = st + i; q[i] = d == 0 ? step : (step < 4 ? 3 - step : 71 - step); cp[i] = CP[base + (size_t)q[i] * 512]; cs[i] = CS[base + (size_t)q[i] * 512]; }
#pragma unroll
            for (int i = 0; i < 4; ++i) { HIN[base + (size_t)q[i] * 512] = hh; hh = cp[i] * hh + cs[i]; } }
    }
}
__device__ __forceinline__ float gelu_tanh(float x) { const float u = 0.7978845608028654f * (x + 0.044715f * x * x * x); return x * __builtin_amdgcn_rcpf(1.f + __expf(-2.f * u)); }
__device__ __forceinline__ void phase_lru_f3(const Params& P, unsigned char* lds, int tid, int lane, int wave, int G) {
    float* Gm = (float*)(lds + LRU_G); const bf16* UX = (const bf16*)(P.ws + WS_UX);
    const bf16* UG = (const bf16*)(P.ws + WS_UG); bf16* MIX = (bf16*)(P.ws + WS_RH); const float* HIN = (const float*)(P.ws + WS_HIN);
    constexpr int NU = NB * LCH * 8;
    int u = blockIdx.x; if (u >= NU) return;
    int b, ck, h; lru_unit(u, b, ck, h);
    LruK K; lru_load_consts(P, h, tid, lane, wave, K);
    LruTile T; lru_tile_load(UX, b, ck, h, tid, T);
    const int t = tid >> 3, c0 = (tid & 7) * 8;
    u32x4 gq = *(const u32x4*)(UG + ((size_t)b * TC + ck * 64 + t) * 512 + h * 64 + c0);
    float hin = 0.f; if (tid < 128) hin = HIN[((size_t)((tid >> 6) * 8 + b) * LCH + ck) * 512 + h * 64 + (tid & 63)];
    for (;;) {
        if (h != K.h) lru_load_consts(P, h, tid, lane, wave, K);
        lru_coeffs(lds, T, K, tid, lane, wave);
        const u32x4 g = gq; const float hh0 = hin;
        const int un = u + G; int bn = 0, ckn = 0, hn = h;
        if (un < NU) { lru_unit(un, bn, ckn, hn); lru_tile_load(UX, bn, ckn, hn, tid, T);
            gq = *(const u32x4*)(UG + ((size_t)bn * TC + ckn * 64 + t) * 512 + hn * 64 + c0);
            if (tid < 128) hin = HIN[((size_t)((tid >> 6) * 8 + bn) * LCH + ckn) * 512 + hn * 64 + (tid & 63)]; }
        if (tid < 128) { const int d = tid >> 6, c = tid & 63; float hh = hh0;
#pragma unroll 8
            for (int i = 0; i < 64; ++i) { const int tt = d == 0 ? i : 63 - i; const float a = Gm[tt * 256 + d * 128 + c], bb = Gm[tt * 256 + d * 128 + 64 + c]; hh = a * hh + bb; Gm[tt * 256 + d * 128 + c] = hh; } }
        __syncthreads();
        { const size_t row = (size_t)b * TC + ck * 64 + t;
          const float gv[8] = {bflo(g.x), bfhi(g.x), bflo(g.y), bfhi(g.y), bflo(g.z), bfhi(g.z), bflo(g.w), bfhi(g.w)};
          float o[8];
#pragma unroll
          for (int i = 0; i < 8; ++i) o[i] = (Gm[t * 256 + c0 + i] + Gm[t * 256 + 128 + c0 + i]) * gelu_tanh(gv[i]);
          u32x4 w; w.x = pk2(o[0], o[1]); w.y = pk2(o[2], o[3]); w.z = pk2(o[4], o[5]); w.w = pk2(o[6], o[7]);
          *(u32x4*)(MIX + row * 1024 + 512 + h * 64 + c0) = w; }
        if (un >= NU) break;
        u = un; b = bn; ck = ckn; h = hn;
    }
    __syncthreads();
}

namespace att {
constexpr int NW = 8, QBLK = 32, KVBLK = 64;
constexpr float SCALE = 0.10206207261596575f;
constexpr float THR = 8.f;
constexpr int LDQ = 768, LDK = 768, LDV = 512, LDO = 1024;
constexpr int SHM_V = 16384, SHM_K = 16384, SHM_ATTN = 2 * SHM_V + 2 * SHM_K + NW * 64 * 4;
#define KSWZ(row, colB) ((row) * 256 + ((colB) ^ (((row) & 7) << 4)))
#define SBAR() __builtin_amdgcn_sched_barrier(0)
__device__ __forceinline__ int crow(int r, int hi) { return (r & 3) + 8 * (r >> 2) + 4 * hi; }
__device__ __forceinline__ unsigned cvtpk(float lo, float hi) { unsigned r; asm volatile("v_cvt_pk_bf16_f32 %0, %1, %2" : "=v"(r) : "v"(lo), "v"(hi)); return r; }
__device__ __forceinline__ void partialSM(f32x16& p0, f32x16& p1, float& m_reg, float& mn, float& alpha) {
  constexpr float C = SCALE * 1.4426950408889634f;
  float pmax = p0[0];
#pragma unroll
  for (int r = 1; r < 16; ++r) pmax = fmaxf(pmax, p0[r]);
#pragma unroll
  for (int r = 0; r < 16; ++r) pmax = fmaxf(pmax, p1[r]);
  { auto rr = __builtin_amdgcn_permlane32_swap(__float_as_uint(pmax), __float_as_uint(pmax), false, false);
    pmax = fmaxf(__uint_as_float(rr[0]), __uint_as_float(rr[1])); }
  if (__builtin_expect(__all(pmax - m_reg <= THR / SCALE), 1)) { mn = m_reg; alpha = 1.f; }
  else { mn = fmaxf(m_reg, pmax); alpha = __builtin_amdgcn_exp2f((m_reg - mn) * C); m_reg = mn; }
  float mnC = -mn * C;
#pragma unroll
  for (int r = 0; r < 16; ++r) p0[r] = fmaf(p0[r], C, mnC);
#pragma unroll
  for (int r = 0; r < 16; ++r) p1[r] = fmaf(p1[r], C, mnC);
#pragma unroll
  for (int r = 0; r < 16; ++r) p0[r] = __builtin_amdgcn_exp2f(p0[r]);
}
__device__ __forceinline__ void finishSM(f32x16& p0, f32x16& p1, float alpha, float& l_reg, bf16x8& pa0, bf16x8& pa1, bf16x8& pa2, bf16x8& pa3) {
#pragma unroll
  for (int r = 0; r < 16; ++r) p1[r] = __builtin_amdgcn_exp2f(p1[r]);
  float ps = 0;
#pragma unroll
  for (int r = 0; r < 16; ++r) ps += p0[r];
#pragma unroll
  for (int r = 0; r < 16; ++r) ps += p1[r];
  { auto rr = __builtin_amdgcn_permlane32_swap(__float_as_uint(ps), __float_as_uint(ps), false, false);
    ps = __uint_as_float(rr[0]) + __uint_as_float(rr[1]); }
  l_reg = l_reg * alpha + ps;
#define PK4(P, BASE, OUT) do { unsigned a0 = cvtpk(P[BASE + 0], P[BASE + 1]), a1 = cvtpk(P[BASE + 2], P[BASE + 3]);   \
    unsigned b0 = cvtpk(P[BASE + 4], P[BASE + 5]), b1 = cvtpk(P[BASE + 6], P[BASE + 7]);                              \
    auto r0 = __builtin_amdgcn_permlane32_swap(a0, b0, false, false); auto r1 = __builtin_amdgcn_permlane32_swap(a1, b1, false, false); \
    u32x4 w = {r0[0], r1[0], r0[1], r1[1]}; OUT = *reinterpret_cast<bf16x8*>(&w); } while (0)
  PK4(p0, 0, pa0); PK4(p0, 8, pa1); PK4(p1, 0, pa2); PK4(p1, 8, pa3);
#undef PK4
}
__device__ __forceinline__ void qkt(f32x16& p0, f32x16& p1, const bf16* Ks, const bf16x8* qr, int r32, int hi) {
  p0 = f32x16{}; p1 = f32x16{};
#pragma unroll
  for (int d0 = 0; d0 < 6; ++d0) { int cb = (d0 * 16 + hi * 8) * 2;
    bf16x8 b0 = *reinterpret_cast<const bf16x8*>((const char*)Ks + KSWZ(r32, cb));
    bf16x8 b1 = *reinterpret_cast<const bf16x8*>((const char*)Ks + KSWZ(32 + r32, cb));
    p0 = __builtin_amdgcn_mfma_f32_32x32x16_bf16(b0, qr[d0], p0, 0, 0, 0);
    p1 = __builtin_amdgcn_mfma_f32_32x32x16_bf16(b1, qr[d0], p1, 0, 0, 0); }
}
__device__ __forceinline__ int v_st(int k, int c) { const int kk = (k & ~0xC) | ((k & 4) << 1) | ((k & 8) >> 1); return ((kk >> 3) * 4 + (c >> 5)) * 512 + ((kk & 7) * 32 + (c & 31)) * 2; }
__device__ __forceinline__ int v_rd_base(int lane) { return ((lane & 3) << 3) | (((lane >> 2) & 3) << 6) | (((lane >> 4) & 1) << 5) | (((lane >> 5) & 1) << 8); }
constexpr int v_rd_off(int d0, int ks, int half) { return d0 * 512 + ks * 4096 + half * 2048; }
template <int OFF> __device__ __forceinline__ s16x4 tr_read(int vb) {
  s16x4 r; asm volatile("ds_read_b64_tr_b16 %0, %1 offset:%2" : "=&v"(r) : "v"(vb), "i"(OFF) : "memory"); return r;
}
template <int D0> __device__ __forceinline__ void pv_one(f32x16& od, int vb, bf16x8 pa0, bf16x8 pa1, bf16x8 pa2, bf16x8 pa3) {
  const s16x4 l0 = tr_read<v_rd_off(D0, 0, 0)>(vb), h0 = tr_read<v_rd_off(D0, 0, 1)>(vb), l1 = tr_read<v_rd_off(D0, 1, 0)>(vb), h1 = tr_read<v_rd_off(D0, 1, 1)>(vb);
  const s16x4 l2 = tr_read<v_rd_off(D0, 2, 0)>(vb), h2 = tr_read<v_rd_off(D0, 2, 1)>(vb), l3 = tr_read<v_rd_off(D0, 3, 0)>(vb), h3 = tr_read<v_rd_off(D0, 3, 1)>(vb);
  asm volatile("s_waitcnt lgkmcnt(0)" ::: "memory"); SBAR();
#define PK(L, H) (bf16x8){L[0], L[1], L[2], L[3], H[0], H[1], H[2], H[3]}
  od = __builtin_amdgcn_mfma_f32_32x32x16_bf16(pa0, PK(l0, h0), od, 0, 0, 0);
  od = __builtin_amdgcn_mfma_f32_32x32x16_bf16(pa1, PK(l1, h1), od, 0, 0, 0);
  od = __builtin_amdgcn_mfma_f32_32x32x16_bf16(pa2, PK(l2, h2), od, 0, 0, 0);
  od = __builtin_amdgcn_mfma_f32_32x32x16_bf16(pa3, PK(l3, h3), od, 0, 0, 0);
#undef PK
}
__device__ __forceinline__ void pv_d0(f32x16* o, int vb, bf16x8 pa0, bf16x8 pa1, bf16x8 pa2, bf16x8 pa3) {
  pv_one<0>(o[0], vb, pa0, pa1, pa2, pa3); pv_one<1>(o[1], vb, pa0, pa1, pa2, pa3);
}
__device__ __forceinline__ void attn_dense_body(const bf16* __restrict__ Qb, const bf16* __restrict__ Kh, const bf16* __restrict__ Vh, bf16* __restrict__ Ob, int seq, int tq0  , char* lds) {
  const int tid = threadIdx.x, wid = tid >> 6, lane = tid & 63, r32 = lane & 31, hi = lane >> 5;
  bf16* V_lds = (bf16*)lds; bf16* K_lds = (bf16*)(lds + 2 * SHM_V);
  float* ws = (float*)(lds + 2 * SHM_V + 2 * SHM_K) + wid * 64; float* li_l = ws; float* al_l = ws + 32;
  float m_reg = -1e30f, l_reg = 0; f32x16 o[2] = {}; bf16x8 qr[6];
  const bf16* Qw = Qb + (long)(wid * QBLK + r32) * LDQ + hi * 8;
#pragma unroll
  for (int d0 = 0; d0 < 6; ++d0) qr[d0] = *reinterpret_cast<const bf16x8*>(Qw + d0 * 16);
  {
    const int tq = tq0 + wid * QBLK + r32; const bool on = tq0 >= 0;
    constexpr float IF[8] = {1.0f, 0.316227766f, 0.1f, 0.0316227766f, 0.01f, 0.00316227766f, 0.001f, 0.000316227766f};
#pragma unroll
    for (int ax = 0; ax < 2; ++ax) { const float pos = (float)(ax == 0 ? (tq >> 6) : (tq & 63)) * 0.15915494309189535f;
      bf16x8 qv = qr[4 + ax]; bf16x8 qo;
#pragma unroll
      for (int i = 0; i < 8; ++i) { const float x = __uint_as_float(((unsigned)(unsigned short)qv[i]) << 16); const float other = __shfl_xor(x, 32);
        const float sn = __builtin_amdgcn_sinf(pos * IF[i]), cs = __builtin_amdgcn_cosf(pos * IF[i]);
        const float r = hi == 0 ? x * cs - other * sn : other * sn + x * cs;
        unsigned u = __float_as_uint(on ? r : x); u = (u + 0x7fffu + ((u >> 16) & 1u)) >> 16; qo[i] = (short)u; }
      qr[4 + ax] = qo; }
  }
  const int sr = tid >> 3, sc = (tid & 7) * 8, vst = v_st(sr, sc), kr2 = (tid >> 2) & 63, kc2 = 64 + (tid & 3) * 8; const bool kb2 = tid < 256;
  const int vb0 = (int)(uintptr_t)V_lds + v_rd_base(lane);
  struct { bf16x8 vs, ka, kb; } sr_[2];
#define SLOAD(i, k0) do { sr_[i].vs = *reinterpret_cast<const bf16x8*>(&Vh[(long)((k0) + sr) * LDV + sc]); \
    sr_[i].ka = *reinterpret_cast<const bf16x8*>(&Kh[(long)((k0) + sr) * LDK + sc]); \
    if (kb2) sr_[i].kb = *reinterpret_cast<const bf16x8*>(&Kh[(long)((k0) + kr2) * LDK + kc2]); } while (0)
#define SWRITE(b, i) do { *(bf16x8*)((char*)V_lds + (b) * SHM_V + vst) = sr_[i].vs;          \
    *(bf16x8*)((char*)K_lds + (b) * SHM_K + KSWZ(sr, sc * 2)) = sr_[i].ka;                       \
    if (kb2) *(bf16x8*)((char*)K_lds + (b) * SHM_K + KSWZ(kr2, kc2 * 2)) = sr_[i].kb; } while (0)
#define SWAIT() asm volatile("s_waitcnt vmcnt(3)" ::: "memory")
#define RESC(a) do { if (__any((a) < 1.f)) { if (hi == 0) al_l[r32] = (a); asm volatile("s_waitcnt lgkmcnt(0)" ::: "memory"); \
    _Pragma("unroll") for (int d = 0; d < 2; ++d) _Pragma("unroll") for (int r = 0; r < 16; ++r) o[d][r] *= al_l[crow(r, hi)]; } } while (0)
  f32x16 pA0, pA1, pB0, pB1; float mnA, mnB, alA, alB; bf16x8 pa0, pa1, pa2, pa3; const int NT = seq / KVBLK;
  constexpr int SE = 0, SO = 1;
  SLOAD(SE, 0); asm volatile("s_waitcnt vmcnt(0)" ::: "memory"); SWRITE(0, SE); __syncthreads();
  qkt(pA0, pA1, K_lds, qr, r32, hi); partialSM(pA0, pA1, m_reg, mnA, alA);
  SLOAD(SO, KVBLK); if (2 < NT) SLOAD(SE, 2 * KVBLK);
  SWAIT(); SWRITE(1, SO); __syncthreads();
  for (int j = 1; j + 1 < NT; j += 2) {
    SBAR(); qkt(pB0, pB1, (bf16*)((char*)K_lds + SHM_K), qr, r32, hi);
    finishSM(pA0, pA1, alA, l_reg, pa0, pa1, pa2, pa3); SBAR();
    SLOAD(SO, (j + 2) * KVBLK); SBAR();
    pv_d0(o, vb0, pa0, pa1, pa2, pa3); partialSM(pB0, pB1, m_reg, mnB, alB);
    __syncthreads(); SWAIT(); SWRITE(0, SE);
    RESC(alB); __syncthreads();
    SBAR(); qkt(pA0, pA1, K_lds, qr, r32, hi);
    finishSM(pB0, pB1, alB, l_reg, pa0, pa1, pa2, pa3); SBAR();
    if (j + 3 < NT) SLOAD(SE, (j + 3) * KVBLK); SBAR();
    pv_d0(o, vb0 + (int)SHM_V, pa0, pa1, pa2, pa3); partialSM(pA0, pA1, m_reg, mnA, alA);
    __syncthreads(); SWAIT(); SWRITE(1, SO);
    RESC(alA); __syncthreads();
  }
  SBAR(); qkt(pB0, pB1, (bf16*)((char*)K_lds + SHM_K), qr, r32, hi);
  finishSM(pA0, pA1, alA, l_reg, pa0, pa1, pa2, pa3); SBAR();
  pv_d0(o, vb0, pa0, pa1, pa2, pa3); partialSM(pB0, pB1, m_reg, mnB, alB);
  __syncthreads(); RESC(alB);
  finishSM(pB0, pB1, alB, l_reg, pa0, pa1, pa2, pa3); SBAR();
  pv_d0(o, vb0 + (int)SHM_V, pa0, pa1, pa2, pa3);
  if (hi == 0) li_l[r32] = l_reg; asm volatile("s_waitcnt lgkmcnt(0)" ::: "memory");
  float rli[16];
#pragma unroll
  for (int r = 0; r < 16; ++r) rli[r] = __builtin_amdgcn_rcpf(li_l[crow(r, hi)]);
  bf16* Ow = Ob + (long)(wid * QBLK) * LDO;
#pragma unroll
  for (int r = 0; r < 16; ++r) { int orow = crow(r, hi);
#pragma unroll
    for (int d0 = 0; d0 < 2; ++d0) Ow[(long)orow * LDO + d0 * 32 + r32] = (bf16)f2bf(o[d0][r] * rli[r]); }
#undef SLOAD
#undef SWRITE
#undef SWAIT
#undef RESC
}
}

__device__ __forceinline__ void phase_attention(const Params& P, unsigned char* lds, int G) {
    const bf16* Q = (const bf16*)(P.ws + WS_Q); const bf16* K = (const bf16*)(P.ws + WS_K); const bf16* V = (const bf16*)(P.ws + WS_V); bf16* MIX = (bf16*)(P.ws + WS_RH);
    for (int idx = blockIdx.x; idx < 1024 + 64; idx += G) {
        int b, h, seq; size_t qrow;
        if (idx < 1024) { const int bh = idx >> 4, qb = idx & 15; b = bh >> 3; h = bh & 7; qrow = (size_t)b * TC + CTXL + qb * 256; seq = TC; }
        else { const int j = idx - 1024; b = j >> 3; h = j & 7; qrow = (size_t)b * TC; seq = CTXL; }
        att::attn_dense_body(Q + qrow * 768 + h * 96, K + (size_t)b * TC * 768 + h * 96, V + (size_t)b * TC * 512 + h * 64, MIX + qrow * 1024 + h * 64, seq, idx < 1024 ? (idx & 15) * 256 : -1, (char*)lds);
        __syncthreads();
    }
}

struct cf { float x, y; };
__device__ __forceinline__ cf cmul(cf a, cf b) { return cf{a.x * b.x - a.y * b.y, a.x * b.y + a.y * b.x}; }
__device__ __forceinline__ cf cis_rev(float rev) { return cf{__builtin_amdgcn_cosf(rev), __builtin_amdgcn_sinf(rev)}; }
template <int S> __device__ __forceinline__ void dft4(cf& a, cf& b, cf& c, cf& d) {
    const cf t0{a.x + c.x, a.y + c.y}, t1{a.x - c.x, a.y - c.y}, t2{b.x + d.x, b.y + d.y}, t3{b.x - d.x, b.y - d.y};
    const cf t3i{-(float)S * t3.y, (float)S * t3.x};
    a = cf{t0.x + t2.x, t0.y + t2.y}; c = cf{t0.x - t2.x, t0.y - t2.y}; b = cf{t1.x + t3i.x, t1.y + t3i.y}; d = cf{t1.x - t3i.x, t1.y - t3i.y};
}
template <int S> __device__ __forceinline__ void dft16(cf (&v)[16]) {
#pragma unroll
    for (int j0 = 0; j0 < 4; ++j0) dft4<S>(v[j0], v[j0 + 4], v[j0 + 8], v[j0 + 12]);
    constexpr float C1 = 0.9238795325112867f, S1 = 0.3826834323650898f, C2 = 0.7071067811865476f;
    v[5] = cmul(v[5], cf{C1, S * S1}); v[9] = cmul(v[9], cf{C2, S * C2}); v[13] = cmul(v[13], cf{S1, S * C1});
    v[6] = cmul(v[6], cf{C2, S * C2}); v[10] = cf{-(float)S * v[10].y, (float)S * v[10].x}; v[14] = cmul(v[14], cf{-C2, S * C2});
    v[7] = cmul(v[7], cf{S1, S * C1}); v[11] = cmul(v[11], cf{-C2, S * C2}); v[15] = cmul(v[15], cf{-C1, -S * S1});
#pragma unroll
    for (int k1 = 0; k1 < 4; ++k1) dft4<S>(v[4 * k1], v[4 * k1 + 1], v[4 * k1 + 2], v[4 * k1 + 3]);
}
#define REV4(k) ((((k) >> 2) | (((k) & 3) << 2)))
__device__ __forceinline__ int fphys(int L) { return L + (L >> 4); }
constexpr int FFT_BUF = 4352 * 8;
constexpr int FFT_ZB = 2 * FFT_BUF;
constexpr int FFT_HB1 = FFT_ZB + 32768;
constexpr int FFT_W3 = FFT_HB1 + 32768;
constexpr int FFT_RED = FFT_W3 + 1024;
static_assert(FFT_RED + 64 <= LDSCTL_OFF, "fft lds");
template <int PAT> __device__ __forceinline__ int fbase(int tp) {
    if (PAT == 0) return tp + (tp >> 4);
    if (PAT == 1) return (tp & 15) + 272 * (tp >> 4);
    return 17 * (tp & 15) + 272 * (tp >> 4);
}
template <int PAT> struct FStr { static constexpr int v = PAT == 0 ? 272 : (PAT == 1 ? 17 : 1); };
__device__ __forceinline__ int hide(int x) { asm volatile("" : "+v"(x)); return x; }
template <int PAT> __device__ __forceinline__ void fload(cf (&v)[16], const cf* buf, int tp) {
    const cf* p = buf + fbase<PAT>(tp);
#pragma unroll
    for (int j = 0; j < 16; ++j) v[j] = p[FStr<PAT>::v * j];
}
template <int PAT, int S, bool TW> __device__ __forceinline__ void fstore(cf (&v)[16], cf* buf, int tp, float base_rev) {
    cf* p = buf + fbase<PAT>(tp);
#pragma unroll
    for (int k = 0; k < 16; ++k) { cf x = v[REV4(k)]; if (TW && k > 0) x = cmul(x, cis_rev((float)S * base_rev * (float)k)); p[FStr<PAT>::v * k] = x; }
}
__device__ __forceinline__ void fft_fwd_pass2(cf* buf, int tp0) {
    const int tp = hide(tp0);
    cf v[16]; fload<1>(v, buf, tp); dft16<-1>(v);
    const int n0 = tp & 15, k2 = tp >> 4; const cf w0 = cis_rev(-(float)(n0 * k2) * (1.f / 4096.f));
    cf* p = buf + fbase<1>(tp);
#pragma unroll
    for (int k = 0; k < 16; ++k) { cf x = cmul(v[REV4(k)], w0); if (k > 0) x = cmul(x, cis_rev(-(float)(n0 * k) * (1.f / 256.f))); p[17 * k] = x; }
}
__device__ __forceinline__ void fft_inv_pass2(cf* buf, int tp0) {
    const int tp = hide(tp0);
    cf v[16]; fload<1>(v, buf, tp); dft16<1>(v);
    fstore<1, 1, true>(v, buf, tp, (float)(tp >> 4) * (1.f / 256.f));
}

__device__ __forceinline__ void load_row8(const bf16* rowp, int n0, float (&r)[10]) {
    const u32x4 a = *(const u32x4*)(rowp + n0);
    r[1] = bflo(a.x); r[2] = bfhi(a.x); r[3] = bflo(a.y); r[4] = bfhi(a.y); r[5] = bflo(a.z); r[6] = bfhi(a.z); r[7] = bflo(a.w); r[8] = bfhi(a.w);
    r[0] = n0 > 0 ? bf2f(rowp[n0 - 1]) : 0.f; r[9] = n0 + 8 < 4096 ? bf2f(rowp[n0 + 8]) : 0.f;
}

__device__ __forceinline__ void phase_hyena_fft(const Params& P, unsigned char* lds, int tid, int lane, int wave, int G) {
    cf* bufE = (cf*)lds; cf* bufO = (cf*)(lds + FFT_BUF); cf* zbuf = (cf*)(lds + FFT_ZB);
    float* w3c = (float*)(lds + FFT_W3); float* red = (float*)(lds + FFT_RED);
    const int str = tid >> 8, tp0 = tid & 255; cf* buf = str ? bufO : bufE;
    const bf16* Pt = (const bf16*)(P.ws + WS_PT); bf16* Zt = (bf16*)(P.ws + WS_ZT);
    cf* Hs = (cf*)(P.ws + WS_HSPEC) + (size_t)blockIdx.x * 4 * 4096;
    const float* a2T = (const float*)(P.ws + WS_A2);
#pragma unroll 1
    for (int c = blockIdx.x; c < 1024; c += G) {
        __syncthreads();
        if (tid < 256) w3c[tid] = P.in[I_HW3][(size_t)(tid & 63) * 4096 + (tid >> 6) * 1024 + c];
        __syncthreads();
        {
            float d[8][4];
#pragma unroll
            for (int j = 0; j < 8; ++j) { d[j][0] = 0.f; d[j][1] = 0.f; d[j][2] = 0.f; d[j][3] = 0.f; }
#pragma unroll 2
            for (int i = 0; i < 64; ++i) { const float w0 = w3c[i], w1 = w3c[64 + i], w2 = w3c[128 + i], w3 = w3c[192 + i]; const float* ar = a2T + (size_t)i * 4096 + tid;
#pragma unroll
                for (int j = 0; j < 8; ++j) { const float a = ar[512 * j]; d[j][0] += a * w0; d[j][1] += a * w1; d[j][2] += a * w2; d[j][3] += a * w3; } }
            float dec[4];
#pragma unroll
            for (int q = 0; q < 4; ++q) dec[q] = fabsf(P.in[I_HDEC][q * 1024 + c]);
            float as0 = 0.f, as1 = 0.f;
#pragma unroll
            for (int j = 0; j < 8; ++j) { const int t = tid + 512 * j; const float tl = (float)t / 4095.f;
                const float h0 = d[j][0] * expf(-tl * dec[0]), h1 = d[j][1] * expf(-tl * dec[1]), h2 = d[j][2] * expf(-tl * dec[2]), h3 = d[j][3] * expf(-tl * dec[3]);
                float* hb0 = (float*)(lds + FFT_ZB); float* hb1 = (float*)(lds + FFT_HB1);
                hb0[t] = h0; hb0[4096 + t] = h1; hb1[t] = h2; hb1[4096 + t] = h3; as0 += fabsf(h0) + fabsf(h1); as1 += fabsf(h2) + fabsf(h3); }
            as0 = wave_sum(as0); as1 = wave_sum(as1); if (lane == 0) { red[wave] = as0; red[8 + wave] = as1; }
        }
        __syncthreads();
#pragma unroll 1
        for (int o = 0; o < 2; ++o) {
            const float* hbuf = (const float*)(lds + (o == 0 ? FFT_ZB : FFT_HB1));
            float tot = 0.f;
#pragma unroll
            for (int w = 0; w < 8; ++w) tot += red[8 * o + w];
            const float inv = 1.f / ((tot + 1e-6f) * 8192.f);
            { const int tp = hide(tp0); cf v[16];
#pragma unroll
              for (int j = 0; j < 16; ++j) { const int n = tp + 256 * j; const float ta = (hbuf[n] + (n == 0 ? hbuf[4096] : 0.f)) * inv, tb = (n == 0 ? 0.f : hbuf[4096 + 4096 - n]) * inv;
                  if (str == 0) v[j] = cf{ta + tb, 0.f}; else { const cf w = cis_rev(-(float)n * (1.f / 8192.f)); v[j] = cf{(ta - tb) * w.x, (ta - tb) * w.y}; } }
              dft16<-1>(v); fstore<0, -1, true>(v, buf, tp, (float)(tp >> 4) * (1.f / 256.f)); }
            __syncthreads();
            fft_fwd_pass2(buf, tp0);
            __syncthreads();
            { const int tp = hide(tp0); cf v[16]; fload<2>(v, buf, tp); dft16<-1>(v);
              cf* hp = Hs + (size_t)(o * 2 + str) * 4096 + tp;
#pragma unroll
              for (int k = 0; k < 16; ++k) hp[k * 256] = v[REV4(k)]; }
            __syncthreads();
        }
#pragma unroll 1
        for (int pr = 0; pr < 4; ++pr) {
            { const int n0 = hide(tid) * 8; float ra[10], rb[10]; load_row8(Pt + (size_t)c * 32768 + (2 * pr) * 4096, n0, ra); load_row8(Pt + (size_t)c * 32768 + (2 * pr + 1) * 4096, n0, rb);
              const float w0 = P.in[I_HCW][c], w1 = P.in[I_HCW][3072 + c], w2 = P.in[I_HCW][6144 + c], bb = P.in[I_HCB][c];
#pragma unroll
              for (int i = 0; i < 8; ++i) zbuf[n0 + i] = cf{w0 * ra[i] + w1 * ra[i + 1] + w2 * ra[i + 2] + bb, w0 * rb[i] + w1 * rb[i + 1] + w2 * rb[i + 2] + bb}; }
            __syncthreads();
#pragma unroll 1
            for (int o = 0; o < 2; ++o) {
                { const int tp = hide(tp0); cf v[16];
#pragma unroll
                  for (int j = 0; j < 16; ++j) { const int n = tp + 256 * j; const cf z = zbuf[n]; v[j] = str == 0 ? z : cmul(z, cis_rev(-(float)n * (1.f / 8192.f))); }
                  dft16<-1>(v); fstore<0, -1, true>(v, buf, tp, (float)(tp >> 4) * (1.f / 256.f)); }
                __syncthreads();
                fft_fwd_pass2(buf, tp0);
                __syncthreads();
                { const int tp = hide(tp0); cf v[16]; fload<2>(v, buf, tp); dft16<-1>(v);
                  const cf* hp = Hs + (size_t)(o * 2 + str) * 4096 + tp;
                  cf y[16];
#pragma unroll
                  for (int k = 0; k < 16; ++k) y[k] = cmul(v[REV4(k)], hp[k * 256]);
                  dft16<1>(y);
                  fstore<2, 1, true>(y, buf, tp, (float)((tp >> 4) + 16 * (tp & 15)) * (1.f / 4096.f)); }
                __syncthreads();
                fft_inv_pass2(buf, tp0);
                __syncthreads();
                { const int tp = hide(tp0); cf v[16]; fload<0>(v, buf, tp); dft16<1>(v);
                  cf* p = buf + fbase<0>(tp);
#pragma unroll
                  for (int k = 0; k < 16; ++k) { cf x = v[REV4(k)]; if (str == 1) x = cmul(x, cis_rev((float)(tp + 256 * k) * (1.f / 8192.f))); p[272 * k] = x; } }
                __syncthreads();
                { const int n0 = hide(tid) * 8; float ga[10], gb[10]; const size_t grow = (size_t)((o + 1) * 1024 + c) * 32768;
                  load_row8(Pt + grow + (2 * pr) * 4096, n0, ga); load_row8(Pt + grow + (2 * pr + 1) * 4096, n0, gb);
                  const int gc = (o + 1) * 1024 + c;
                  const float w0 = P.in[I_HCW][gc], w1 = P.in[I_HCW][3072 + gc], w2 = P.in[I_HCW][6144 + gc], bb = P.in[I_HCB][gc];
                  const float sk = P.in[I_HSKIP][o * 1024 + c]; float oa[8], ob[8];
#pragma unroll
                  for (int i = 0; i < 8; ++i) { const int n = n0 + i; const cf e = bufE[fphys(n)], q = bufO[fphys(n)], z = zbuf[n];
                      const float g0 = w0 * ga[i] + w1 * ga[i + 1] + w2 * ga[i + 2] + bb;
                      const float g1 = w0 * gb[i] + w1 * gb[i + 1] + w2 * gb[i + 2] + bb;
                      oa[i] = (e.x + q.x + sk * z.x) * g0; ob[i] = (e.y + q.y + sk * z.y) * g1; }
                  if (o == 0) {
#pragma unroll
                      for (int i = 0; i < 8; ++i) zbuf[n0 + i] = cf{oa[i], ob[i]};
                  } else {
                      u32x4 wa, wb; wa.x = pk2(oa[0], oa[1]); wa.y = pk2(oa[2], oa[3]); wa.z = pk2(oa[4], oa[5]); wa.w = pk2(oa[6], oa[7]);
                      wb.x = pk2(ob[0], ob[1]); wb.y = pk2(ob[2], ob[3]); wb.z = pk2(ob[4], ob[5]); wb.w = pk2(ob[6], ob[7]);
                      *(u32x4*)(Zt + (size_t)c * 32768 + (2 * pr) * 4096 + n0) = wa; *(u32x4*)(Zt + (size_t)c * 32768 + (2 * pr + 1) * 4096 + n0) = wb;
                  } }
                __syncthreads();
            }
        }
    }
}
__device__ __forceinline__ void phase_transpose(const Params& P, unsigned char* lds, int lane, int wave, int G) {
    bf16* tile = (bf16*)(lds + wave * 16384);
    const bf16* Zt = (const bf16*)(P.ws + WS_ZT); bf16* Z = (bf16*)(P.ws + WS_Z);
    for (int it = blockIdx.x * 8 + wave; it < 16 * 512; it += G * 8) {
        const int cb = it & 15, tb = it >> 4, c0 = cb * 64, t0 = tb * 64;
#pragma unroll
        for (int i = 0; i < 8; ++i) { const int ch = i * 8 + (lane >> 3), tq = (lane & 7) * 8;
            const u32x4 a = *(const u32x4*)(Zt + (size_t)(c0 + ch) * 32768 + t0 + tq);
            unsigned* d = (unsigned*)(tile + ch * 66 + tq); d[0] = a.x; d[1] = a.y; d[2] = a.z; d[3] = a.w; }
        LDS_WAIT(); asm volatile("" ::: "memory");
#pragma unroll
        for (int i = 0; i < 8; ++i) { const int tk = i * 8 + (lane >> 3), cq = (lane & 7) * 8;
            unsigned short e[8];
#pragma unroll
            for (int j = 0; j < 8; ++j) e[j] = tile[(cq + j) * 66 + tk];
            u32x4 w; w.x = e[0] | ((unsigned)e[1] << 16); w.y = e[2] | ((unsigned)e[3] << 16); w.z = e[4] | ((unsigned)e[5] << 16); w.w = e[6] | ((unsigned)e[7] << 16);
            *(u32x4*)(Z + (size_t)(t0 + tk) * 1024 + c0 + cq) = w; }
        LDS_WAIT(); asm volatile("" ::: "memory");
    }
}

constexpr int N_PHASES = 21;
__global__ void __launch_bounds__(512, 2) fwd_kernel(Params P0) {
    extern __shared__ __attribute__((aligned(16))) unsigned char lds[];
    const int tid = threadIdx.x, lane = tid & 63, wave = __builtin_amdgcn_readfirstlane(tid >> 6), G = gridDim.x;
    PG8_LAS unsigned char* ldsl = (PG8_LAS unsigned char*)lds;
    for (int u = tid; u < (LDS_BYTES - LDSCTL_OFF) / 4; u += 512) ((unsigned*)(lds + LDSCTL_OFF))[u] = 0u;
    __syncthreads();
#if MK_ONE_LAUNCH
    XcdBarrier bar = xcd_barrier_post((unsigned*)(P0.ws + WS_CTL) + CW_BAR, (volatile LAS unsigned*)(ldsl + MISC_OFF) + 8);
#define GRID_BAR() xcd_barrier(bar)
#else
#define GRID_BAR() do { } while (0)
#endif
    const int lo = P0.ph_lo, hi = P0.ph_hi;
#ifndef PHASE_MASK
#define PHASE_MASK 0xFFFFFFFFu
#endif
#define IN(k) ((((PHASE_MASK) >> (k)) & 1u) && lo <= (k) && (k) < hi)
#define SEAM(k) do { if (IN(k) && IN((k) + 1)) GRID_BAR(); } while (0)
#ifndef REPEAT_MASK
#define REPEAT_MASK 0u
#endif
#ifndef REPEAT_SUB
#define REPEAT_SUB 0u
#endif
#define REPS(k) for (int reps_ = 0; reps_ < ((((REPEAT_SUB) >> (k)) & 1u) ? 2 : 1); ++reps_)
#define REP(k) for (int rep_ = 0; rep_ < ((((REPEAT_MASK) >> (k)) & 1u) ? 2 : 1); ++rep_)

    if (IN(0)) REP(0) { const Params P = load_params(); unsigned char* ws = P.ws; phase_prologue(P, lds, tid, lane, wave, G); } SEAM(0);
    if (IN(1)) REP(1) { const Params P = load_params(); unsigned char* ws = P.ws; phase_norm1_l0(P, lane, wave, G); } SEAM(1);
    if (IN(2)) REP(2) { const Params P = load_params(); unsigned char* ws = P.ws;
        pg8::Gemm g{(const bf16*)(ws + WS_RH), (const bf16*)(ws + WS_WIN), 1024, 1024, 1024, 0}; pg8::StaticOrder S; S.init(M0 / 256, 7, G, (int)blockIdx.x);
        EpiIn E{(bf16*)(ws + WS_CQ), (bf16*)(ws + WS_CKV), (bf16*)(ws + WS_UX), (bf16*)(ws + WS_UG), (bf16*)(ws + WS_K)};
        pg8::gemm_phase<EpiIn, pg8::StaticOrder, GP_ALIGN, GP_SP2>(ldsl, g, S, E);
    } SEAM(2);
    if (IN(3)) REP(3) { const Params P = load_params(); unsigned char* ws = P.ws; phase_rowstat(P, lane, wave, G); phase_lru_f1(P, lds, tid, lane, wave, G); } SEAM(3);
    if (IN(4)) REP(4) { const Params P = load_params(); unsigned char* ws = P.ws;
        phase_lru_carry(P, lane, wave, G);
        __syncthreads();
#ifndef NO_QUP
        REPS(0) { pg8::Gemm g{(const bf16*)(ws + WS_CQ), (const bf16*)(ws + WS_WUQ), 384, 384, 384, 0}; pg8::StaticOrder S; S.init(M0 / 256, 3, G, (int)blockIdx.x);
          EpiQ E{(bf16*)(ws + WS_Q), (const float*)(ws + WS_RQ)};
          pg8::gemm_phase<EpiQ, pg8::StaticOrder, GP_ALIGN, GP_SP2>(ldsl, g, S, E); }
#endif
        __syncthreads();
        REPS(1) { pg8::Gemm g{(const bf16*)(ws + WS_CKV), (const bf16*)(ws + WS_WUKV), 256, 256, 256, 0}; pg8::StaticOrder S; S.init(M0 / 256, 4, G, (int)blockIdx.x);
          EpiKV E{(bf16*)(ws + WS_K), (bf16*)(ws + WS_V), (const float*)(ws + WS_RKV)};
          pg8::gemm_phase<EpiKV, pg8::StaticOrder, GP_ALIGN, GP_SP2>(ldsl, g, S, E); }
        __syncthreads();
    } SEAM(4);
    if (IN(5)) REP(5) { const Params P = load_params(); unsigned char* ws = P.ws; REPS(2) phase_lru_f3(P, lds, tid, lane, wave, G); REPS(3) phase_attention(P, lds, G); } SEAM(5);
    if (IN(6)) REP(6) { const Params P = load_params(); unsigned char* ws = P.ws;
        pg8::Gemm g{(const bf16*)(ws + WS_RH), (const bf16*)(ws + WS_WOUT), 1024, 1024, 1024, 0}; pg8::StaticOrder S; S.init(M0 / 256, 4, G, (int)blockIdx.x);
        EpiRes<0> E{P.in[I_X], P.in[I_CTX], (const float*)(ws + WS_MOD), P.out, (float*)(ws + WS_XC)};
        pg8::gemm_phase<EpiRes<0>, pg8::StaticOrder, GP_ALIGN, GP_SP2>(ldsl, g, S, E);
    } SEAM(6);
    if (IN(7)) REP(7) { const Params P = load_params(); unsigned char* ws = P.ws; phase_norm2_route<0>(P, lds, tid, lane, wave, G); } SEAM(7);
    if (IN(8)) REP(8) { const Params P = load_params(); unsigned char* ws = P.ws; phase_permute<0>(P, lds, tid, lane, wave, G); } SEAM(8);
    if (IN(9)) REP(9) { const Params P = load_params(); unsigned char* ws = P.ws;
        const int* te = (const int*)(ws + WS_TILEE); const int nmt = te[MAXTILES];
        { int* gl = (int*)(lds + RING_BYTES); const int* st = (const int*)(ws + WS_SLOTTOK);
          for (int i = 0; ; ++i) { const long L = (long)i * G + blockIdx.x; if (L >= (long)nmt * 4 || i >= 20) break; if (tid < 256) gl[i * 256 + tid] = st[(int)(L >> 2) * 256 + tid]; }
          __syncthreads(); }
        pg8::Gemm g{(const bf16*)(ws + WS_RH), (const bf16*)(ws + WS_W13), 1024, 1024, 1024, (size_t)1024 * 1024 * 2, RING_BYTES}; pg8::MoeOrder S{nmt, G, (int)blockIdx.x, te};
        EpiMoe1 E{(bf16*)(ws + WS_ACT)};
        pg8::gemm_phase<EpiMoe1, pg8::MoeOrder, GP_ALIGN, GP_SP2, true>(ldsl, g, S, E);
    } SEAM(9);
    if (IN(10)) REP(10) { const Params P = load_params(); unsigned char* ws = P.ws;
        const int* te = (const int*)(ws + WS_TILEE);
        pg8::Gemm g{(const bf16*)(ws + WS_ACT), (const bf16*)(ws + WS_W2), 512, 512, 512, (size_t)1024 * 512 * 2}; pg8::MoeOrder S{te[MAXTILES], G, (int)blockIdx.x, te};
        EpiStore E{(bf16*)(ws + WS_HPERM), 1024};
        pg8::gemm_phase<EpiStore, pg8::MoeOrder, GP_ALIGN, GP_SP2>(ldsl, g, S, E);
    } SEAM(10);
    if (IN(11)) REP(11) { const Params P = load_params(); unsigned char* ws = P.ws; phase_combine_norm1_l1(P, lane, wave, G); } SEAM(11);
    if (IN(12)) REP(12) { const Params P = load_params(); unsigned char* ws = P.ws;
        pg8::Gemm g{(const bf16*)(ws + WS_WHIN), (const bf16*)(ws + WS_RH), 1024, 1024, 1024, 0}; pg8::StaticOrder S; S.init(3072 / 256, M1 / 256, G, (int)blockIdx.x);
        EpiStore E{(bf16*)(ws + WS_PT), 32768};
        pg8::gemm_phase<EpiStore, pg8::StaticOrder, GP_ALIGN, GP_SP2>(ldsl, g, S, E);
    } SEAM(12);
    if (IN(13)) REP(13) { const Params P = load_params(); unsigned char* ws = P.ws; phase_hyena_fft(P, lds, tid, lane, wave, G); } SEAM(13);
    if (IN(14)) REP(14) { const Params P = load_params(); unsigned char* ws = P.ws; phase_transpose(P, lds, lane, wave, G); } SEAM(14);
    if (IN(15)) REP(15) { const Params P = load_params(); unsigned char* ws = P.ws;
        pg8::Gemm g{(const bf16*)(ws + WS_Z), (const bf16*)(ws + WS_WHOUT), 1024, 1024, 1024, 0}; pg8::StaticOrder S; S.init(M1 / 256, 4, G, (int)blockIdx.x);
        EpiRes<1> E{nullptr, nullptr, (const float*)(ws + WS_MOD), P.out, nullptr};
        pg8::gemm_phase<EpiRes<1>, pg8::StaticOrder, GP_ALIGN, GP_SP2>(ldsl, g, S, E);
    } SEAM(15);
    if (IN(16)) REP(16) { const Params P = load_params(); unsigned char* ws = P.ws; phase_norm2_route<1>(P, lds, tid, lane, wave, G); } SEAM(16);
    if (IN(17)) REP(17) { const Params P = load_params(); unsigned char* ws = P.ws; phase_permute<1>(P, lds, tid, lane, wave, G); } SEAM(17);
    if (IN(18)) REP(18) { const Params P = load_params(); unsigned char* ws = P.ws;
        const int* te = (const int*)(ws + WS_TILEE); const int nmt = te[MAXTILES];
        { int* gl = (int*)(lds + RING_BYTES); const int* st = (const int*)(ws + WS_SLOTTOK);
          for (int i = 0; ; ++i) { const long L = (long)i * G + blockIdx.x; if (L >= (long)nmt * 4 || i >= 20) break; if (tid < 256) gl[i * 256 + tid] = st[(int)(L >> 2) * 256 + tid]; }
          __syncthreads(); }
        pg8::Gemm g{(const bf16*)(ws + WS_RH), (const bf16*)(ws + WS_W13) + (size_t)16 * 1024 * 1024, 1024, 1024, 1024, (size_t)1024 * 1024 * 2, RING_BYTES}; pg8::MoeOrder S{nmt, G, (int)blockIdx.x, te};
        EpiMoe1 E{(bf16*)(ws + WS_ACT)};
        pg8::gemm_phase<EpiMoe1, pg8::MoeOrder, GP_ALIGN, GP_SP2, true>(ldsl, g, S, E);
    } SEAM(18);
    if (IN(19)) REP(19) { const Params P = load_params(); unsigned char* ws = P.ws;
        const int* te = (const int*)(ws + WS_TILEE);
        pg8::Gemm g{(const bf16*)(ws + WS_ACT), (const bf16*)(ws + WS_W2) + (size_t)16 * 1024 * 512, 512, 512, 512, (size_t)1024 * 512 * 2}; pg8::MoeOrder S{te[MAXTILES], G, (int)blockIdx.x, te};
        EpiStore E{(bf16*)(ws + WS_HPERM), 1024};
        pg8::gemm_phase<EpiStore, pg8::MoeOrder, GP_ALIGN, GP_SP2>(ldsl, g, S, E);
    } SEAM(19);
    if (IN(20)) REP(20) { const Params P = load_params(); unsigned char* ws = P.ws; phase_final(P, lane, wave, G); }
#undef IN
#undef SEAM
}

extern "C" void kernel_launch(void* const* d_in, const int* in_sizes, int n_in, void* d_out, int out_size, void* d_ws, size_t ws_size, hipStream_t stream) {
    static int grid = 0;
    if (grid == 0) {
        if (n_in != N_IN || out_size != M1 * DM || ws_size < WS_END) { fprintf(stderr, "kernel_launch: unexpected shapes (n_in %d out %d ws %zu)\n", n_in, out_size, ws_size); grid = -1; return; }
        int dev = 0, cus = 0;
        if (hipGetDevice(&dev) != hipSuccess || hipDeviceGetAttribute(&cus, hipDeviceAttributeMultiprocessorCount, dev) != hipSuccess) { grid = -1; return; }
        if (hipFuncSetAttribute((const void*)fwd_kernel, hipFuncAttributeMaxDynamicSharedMemorySize, LDS_BYTES) != hipSuccess) { fprintf(stderr, "kernel_launch: hipFuncSetAttribute failed\n"); grid = -1; return; }
        int per_cu = 0;
        if (hipOccupancyMaxActiveBlocksPerMultiprocessor(&per_cu, (const void*)fwd_kernel, 512, LDS_BYTES) != hipSuccess || per_cu < 1) fprintf(stderr, "kernel_launch: occupancy query reports %d\n", per_cu);
        (void)hipGetLastError();
        grid = cus;
    }
    if (grid < 0) return;
    (void)hipMemsetAsync((char*)d_ws + WS_CTL, 0, CTL_ZERO_BYTES, stream);
    Params p{};
    for (int i = 0; i < N_IN; ++i) p.in[i] = (const float*)d_in[i];
    p.out = (float*)d_out; p.ws = (unsigned char*)d_ws;
#if MK_ONE_LAUNCH
    p.ph_lo = 0; p.ph_hi = N_PHASES;
    hipLaunchKernelGGL(fwd_kernel, dim3(grid), dim3(512), LDS_BYTES, stream, p);
#else
    for (int k = 0; k < N_PHASES; ++k) { p.ph_lo = k; p.ph_hi = k + 1; hipLaunchKernelGGL(fwd_kernel, dim3(grid), dim3(512), LDS_BYTES, stream, p); }
#endif
}
```

```cpp
#include <hip/hip_runtime.h>
#include <cstdio>
#include <cstdint>

#ifndef MK_ONE_LAUNCH
#define MK_ONE_LAUNCH 1
#endif

#define LAS __attribute__((address_space(3)))
#define GAS __attribute__((address_space(1)))
typedef unsigned short bf16;
typedef short bf16x8 __attribute__((ext_vector_type(8)));
typedef short s16x4 __attribute__((ext_vector_type(4)));
typedef float f32x2 __attribute__((ext_vector_type(2)));
typedef float f32x4 __attribute__((ext_vector_type(4)));
typedef float f32x16 __attribute__((ext_vector_type(16)));
typedef unsigned u32x2 __attribute__((ext_vector_type(2)));
typedef unsigned u32x4 __attribute__((ext_vector_type(4)));
#define LDS_WAIT() asm volatile("s_waitcnt lgkmcnt(0)" ::: "memory")
#define VM_WAIT() asm volatile("s_waitcnt vmcnt(0)" ::: "memory")

__device__ __forceinline__ unsigned f2bf(float f) { unsigned u = __builtin_bit_cast(unsigned, f); return (u + 0x7fffu + ((u >> 16) & 1u)) >> 16; }
__device__ __forceinline__ unsigned pk2(float lo, float hi) { return f2bf(lo) | (f2bf(hi) << 16); }
__device__ __forceinline__ float bf2f(unsigned b) { return __builtin_bit_cast(float, b << 16); }
__device__ __forceinline__ float bflo(unsigned w) { return __builtin_bit_cast(float, w << 16); }
__device__ __forceinline__ float bfhi(unsigned w) { return __builtin_bit_cast(float, w & 0xffff0000u); }
__device__ __forceinline__ float wave_sum(float v) {
#pragma unroll
    for (int o = 1; o < 64; o <<= 1) v += __shfl_xor(v, o);
    return v;
}
__device__ __forceinline__ float sigm(float x) { return 1.f / (1.f + expf(-x)); }

namespace pg8 {
#define PG8_LAS __attribute__((address_space(3)))
typedef unsigned short bf16_t;
constexpr int BM = 256, BK = 64, HALF = 128, HTB = HALF * BK * 2, STAGE_BYTES = 8 * HTB, NXCD = 8, WGM = 8;
__host__ __device__ __forceinline__ int lds_byte(int r, int c) { const int st = (r >> 4) * 2 + (c >> 5), rr = r & 15, cc = c & 31, ob = rr * 64 + cc * 2; return st * 1024 + (ob ^ (((ob >> 9) & 1) << 5)); }
__host__ __device__ __forceinline__ void stage_rc(int b, int& R, int& C) { const int st = b / 1024, sb = b % 1024, swz = sb ^ (((sb >> 9) & 1) << 5); R = (st >> 1) * 16 + swz / 64; C = (st & 1) * 32 + (swz % 64) / 2; }
__host__ __device__ __forceinline__ int perm32(int rho) { const int n = rho >> 4, i = rho & 15; return 8 * (i >> 2) + 4 * n + (i & 3); }

struct Unit { int pm, pn, bz; };
struct Gemm { const bf16_t* A; const bf16_t* Bt; int lda, ldb, K; size_t bz_stride; int gidx_off; };

struct StaticOrder {
    int nM, nN, nwg, G, c;
    __host__ __device__ void init(int nM_, int nN_, int G_, int c_) { nM = nM_; nN = nN_; nwg = nM * nN; G = G_; c = c_; }
    __host__ __device__ bool next(int i, Unit& u) const {
        const long L = (long)i * G + c; if (L >= nwg) return false;
        int wgid = (int)L; { const int q = nwg / NXCD, r = nwg % NXCD, xcd = wgid % NXCD, off = wgid / NXCD; wgid = (xcd < r ? xcd * (q + 1) : r * (q + 1) + (xcd - r) * q) + off; }
        const int nig = WGM * nN, gid = wgid / nig, fm = gid * WGM, gsz = (nM - fm) < WGM ? (nM - fm) : WGM;
        u.pm = fm + ((wgid % nig) % gsz); u.pn = (wgid % nig) / gsz; u.bz = 0; return true;
    }
    __device__ __forceinline__ void a_ready(const Unit&) const {}
    __device__ __forceinline__ void done(const Unit&) const {}
};
struct MoeOrder {
    int nM, G, c; const int* tile_e;
    __device__ bool next(int i, Unit& u) const {
        const long L = (long)i * G + c; if (L >= (long)nM * 4) return false;
        u.pm = (int)(L >> 2); u.pn = (int)(L & 3); u.bz = tile_e[u.pm]; return true;
    }
    __device__ __forceinline__ void a_ready(const Unit&) const {}
    __device__ __forceinline__ void done(const Unit&) const {}
};

__device__ __forceinline__ unsigned cvt_pk_bf16(float lo, float hi) { unsigned r; asm volatile("v_cvt_pk_bf16_f32 %0, %1, %2" : "=v"(r) : "v"(lo), "v"(hi)); return r; }

template <class Epi, class Sched, bool ALIGN_EPI = false, bool SP2 = false, bool GATHER = false>
__device__ __forceinline__ void gemm_phase(PG8_LAS unsigned char* lds, const Gemm g, const Sched& S, const Epi& E) {
    const int tid = threadIdx.x, wid = __builtin_amdgcn_readfirstlane(tid >> 6), lane = tid & 63, wr = wid >> 2, wc = wid & 3, fr = lane & 15, fq = lane >> 4;
    const int K = g.K, nt = K / BK;
    unsigned voffA[2], voffB[2];
#pragma unroll
    for (int i = 0; i < 2; ++i) { int R, C; stage_rc(tid * 16 + i * 8192, R, C); const int Rb = Epi::PERM ? ((R & ~31) + perm32(R & 31)) : R;
        voffA[i] = (unsigned)(R * g.lda + C) * 2u; voffB[i] = (unsigned)(Rb * g.ldb + C) * 2u; }
    unsigned vc0[2], vc1[2], vn0[2], vn1[2];
    const PG8_LAS int* gl = (const PG8_LAS int*)(lds + g.gidx_off);
#define PG8_GIDX(uix, v0, v1) do { _Pragma("unroll") for (int _i = 0; _i < 2; ++_i) { int _R, _C; stage_rc(tid * 16 + _i * 8192, _R, _C); \
        v0[_i] = (unsigned)(gl[(uix) * 256 + _R] * g.lda + _C) * 2u; v1[_i] = (unsigned)(gl[(uix) * 256 + 128 + _R] * g.lda + _C) * 2u; } } while (0)
    const size_t kstep = (size_t)(BK * 2);
    const size_t hstepA = (size_t)HALF * g.lda * 2, hstepB = (size_t)HALF * g.ldb * 2;
    const size_t tstepA = GATHER ? 0 : 2 * hstepA, tstepB = 2 * hstepB;
    const unsigned ldsw = (unsigned)wid * 1024u;
    const int aoff = lds_byte(wr * 64 + fr, fq * 8), boff = lds_byte(wc * 32 + fr, fq * 8);
#define PG8_SA(b, h) (((b) * 2 + (h)) * HTB)
#define PG8_SB(b, h) ((4 + (b) * 2 + (h)) * HTB)
#define PG8_STAGE(bufoff, gbase, voff) do { _Pragma("unroll") for (int _i = 0; _i < 2; ++_i) \
        __builtin_amdgcn_global_load_lds((const unsigned*)((const char*)(gbase) + (voff)[_i]), (PG8_LAS unsigned*)(lds + (bufoff) + ldsw + _i * 8192), 16, 0, 0); } while (0)
#define PG8_LDA(dst, b, h) do { _Pragma("unroll") for (int m = 0; m < 4; ++m) _Pragma("unroll") for (int k = 0; k < 2; ++k) dst[m][k] = *(const PG8_LAS bf16x8*)(lds + PG8_SA(b, h) + aoff + m * 2048 + k * 1024); } while (0)
#define PG8_LDB(dst, b, h) do { _Pragma("unroll") for (int n = 0; n < 2; ++n) _Pragma("unroll") for (int k = 0; k < 2; ++k) dst[n][k] = *(const PG8_LAS bf16x8*)(lds + PG8_SB(b, h) + boff + n * 2048 + k * 1024); } while (0)
#define PG8_MMA(ai, bj, At, Bt) do { __builtin_amdgcn_s_setprio(1); _Pragma("unroll") for (int m = 0; m < 4; ++m) _Pragma("unroll") for (int n = 0; n < 2; ++n) _Pragma("unroll") for (int k = 0; k < 2; ++k) \
        acc[ai][bj][m][n] = __builtin_amdgcn_mfma_f32_16x16x32_bf16(Bt[n][k], At[m][k], acc[ai][bj][m][n], 0, 0, 0); __builtin_amdgcn_s_setprio(0); } while (0)
#define PG8_WAIT_V(n) asm volatile("s_waitcnt vmcnt(" #n ")" ::: "memory")
#define PG8_WAIT_L(n) asm volatile("s_waitcnt lgkmcnt(" #n ")" ::: "memory")
#define PG8_BAR __builtin_amdgcn_s_barrier()
#define PG8_SCHED __builtin_amdgcn_sched_barrier(0)
    Unit cur, nxt; int ui = 0;
    if (!S.next(0, cur)) return;
    f32x4 acc[2][2][4][2];
#pragma unroll
    for (int a = 0; a < 2; ++a)
#pragma unroll
        for (int b = 0; b < 2; ++b)
#pragma unroll
            for (int m = 0; m < 4; ++m)
#pragma unroll
                for (int n = 0; n < 2; ++n) acc[a][b][m][n] = (f32x4){0.f, 0.f, 0.f, 0.f};
    bf16x8 At[4][2], B0[2][2], B1[2][2];
    const char* cA = (const char*)g.A + (size_t)cur.pm * tstepA; const char* cB = (const char*)g.Bt + (size_t)cur.bz * g.bz_stride + (size_t)cur.pn * tstepB;
    S.a_ready(cur);
    if constexpr (GATHER) { PG8_GIDX(0, vc0, vc1); vn0[0] = vc0[0]; vn0[1] = vc0[1]; vn1[0] = vc1[0]; vn1[1] = vc1[1]; }
#define PG8_STAGE_A0(bufoff, p, NX) do { if constexpr (GATHER) { unsigned _v[2] = {(NX) ? vn0[0] : vc0[0], (NX) ? vn0[1] : vc0[1]}; PG8_STAGE(bufoff, p, _v); } else PG8_STAGE(bufoff, p, voffA); } while (0)
#define PG8_STAGE_A1(bufoff, p, NX) do { if constexpr (GATHER) { unsigned _v[2] = {(NX) ? vn1[0] : vc1[0], (NX) ? vn1[1] : vc1[1]}; PG8_STAGE(bufoff, p, _v); } else PG8_STAGE(bufoff, (p) + hstepA, voffA); } while (0)
    if constexpr (SP2) {
        PG8_STAGE(PG8_SB(0, 0), cB, voffB); PG8_STAGE(PG8_SB(0, 1), cB + hstepB, voffB); PG8_STAGE_A0(PG8_SA(0, 0), cA, false); PG8_STAGE_A1(PG8_SA(0, 1), cA, false);
        if (wr == 1) PG8_BAR;
        PG8_WAIT_V(2); PG8_BAR;
        PG8_STAGE(PG8_SB(1, 0), cB + kstep, voffB); PG8_STAGE_A0(PG8_SA(1, 0), cA + kstep, false); PG8_STAGE(PG8_SB(1, 1), cB + hstepB + kstep, voffB);
        PG8_WAIT_V(6); PG8_BAR;
    } else {
        PG8_STAGE(PG8_SB(0, 0), cB, voffB); PG8_STAGE_A0(PG8_SA(0, 0), cA, false); PG8_STAGE(PG8_SB(0, 1), cB + hstepB, voffB); PG8_STAGE_A1(PG8_SA(0, 1), cA, false);
        if (wr == 1) PG8_BAR;
        PG8_WAIT_V(4); PG8_BAR;
        PG8_STAGE(PG8_SB(1, 0), cB + kstep, voffB); PG8_STAGE_A0(PG8_SA(1, 0), cA + kstep, false); PG8_STAGE(PG8_SB(1, 1), cB + hstepB + kstep, voffB);
        PG8_WAIT_V(6); PG8_BAR;
    }
    for (;;) {
        const bool has_next = S.next(ui + 1, nxt);
        const char* nA = has_next ? (const char*)g.A + (size_t)nxt.pm * tstepA : cA;
        const char* nB = has_next ? (const char*)g.Bt + (size_t)nxt.bz * g.bz_stride + (size_t)nxt.pn * tstepB : cB;
        if constexpr (GATHER) { if (has_next) PG8_GIDX(ui + 1, vn0, vn1); }
#pragma unroll 1
        for (int t = 0; t < nt; t += 2) {
            const bool last = (t == nt - 2);
            const char* a1 = cA + (size_t)(t + 1) * kstep;
            const char* a2 = last ? nA : cA + (size_t)(t + 2) * kstep; const char* b2 = last ? nB : cB + (size_t)(t + 2) * kstep;
            const char* a3 = a2 + kstep; const char* b3 = b2 + kstep;
            if (last && has_next) S.a_ready(nxt);
            if constexpr (SP2) {
            PG8_LDB(B0, 0, 0); PG8_LDB(B1, 0, 1); PG8_SCHED; PG8_LDA(At, 0, 0); PG8_STAGE_A1(PG8_SA(1, 1), a1, false);
            PG8_WAIT_V(8); PG8_WAIT_L(0); PG8_BAR; PG8_MMA(0, 0, At, B0); PG8_MMA(0, 1, At, B1); PG8_BAR; PG8_SCHED;
            PG8_LDA(At, 0, 1); PG8_STAGE(PG8_SB(0, 0), b2, voffB); PG8_STAGE(PG8_SB(0, 1), b2 + hstepB, voffB); PG8_STAGE_A0(PG8_SA(0, 0), a2, last);
            PG8_WAIT_V(8); PG8_WAIT_L(0); PG8_BAR; PG8_MMA(1, 0, At, B0); PG8_MMA(1, 1, At, B1); PG8_BAR; PG8_SCHED;
            PG8_LDB(B0, 1, 0); PG8_LDB(B1, 1, 1); PG8_SCHED; PG8_LDA(At, 1, 0); PG8_STAGE_A1(PG8_SA(0, 1), a2, last);
            PG8_WAIT_V(8); PG8_WAIT_L(0); PG8_BAR; PG8_MMA(0, 0, At, B0); PG8_MMA(0, 1, At, B1); PG8_BAR; PG8_SCHED;
            PG8_LDA(At, 1, 1); PG8_STAGE(PG8_SB(1, 0), b3, voffB); PG8_STAGE(PG8_SB(1, 1), b3 + hstepB, voffB); PG8_STAGE_A0(PG8_SA(1, 0), a3, last);
            PG8_WAIT_V(8); PG8_WAIT_L(0); PG8_BAR; PG8_MMA(1, 0, At, B0); PG8_MMA(1, 1, At, B1); PG8_BAR; PG8_SCHED;
            } else {
            PG8_LDB(B0, 0, 0); PG8_SCHED; PG8_LDA(At, 0, 0); PG8_STAGE_A1(PG8_SA(1, 1), a1, false);
            PG8_WAIT_L(8); PG8_BAR; PG8_WAIT_L(0); PG8_MMA(0, 0, At, B0); PG8_BAR; PG8_SCHED;
            PG8_LDB(B1, 0, 1); PG8_STAGE(PG8_SB(0, 0), b2, voffB);
            PG8_BAR; PG8_WAIT_L(0); PG8_MMA(0, 1, At, B1); PG8_BAR;
            PG8_LDA(At, 0, 1); PG8_STAGE_A0(PG8_SA(0, 0), a2, last);
            PG8_BAR; PG8_WAIT_L(0); PG8_MMA(1, 0, At, B0); PG8_BAR; PG8_SCHED;
            PG8_STAGE(PG8_SB(0, 1), b2 + hstepB, voffB);
            PG8_WAIT_V(6); PG8_BAR; PG8_MMA(1, 1, At, B1); PG8_BAR;
            PG8_LDB(B0, 1, 0); PG8_SCHED; PG8_LDA(At, 1, 0); PG8_STAGE_A1(PG8_SA(0, 1), a2, last);
            PG8_WAIT_L(8); PG8_BAR; PG8_WAIT_L(0); PG8_MMA(0, 0, At, B0); PG8_BAR; PG8_SCHED;
            PG8_LDB(B1, 1, 1); PG8_STAGE(PG8_SB(1, 0), b3, voffB);
            PG8_BAR; PG8_WAIT_L(0); PG8_MMA(0, 1, At, B1); PG8_BAR;
            PG8_LDA(At, 1, 1); PG8_STAGE_A0(PG8_SA(1, 0), a3, last);
            PG8_BAR; PG8_WAIT_L(0); PG8_MMA(1, 0, At, B0); PG8_BAR; PG8_SCHED;
            PG8_STAGE(PG8_SB(1, 1), b3 + hstepB, voffB);
            PG8_WAIT_V(6); PG8_BAR; PG8_MMA(1, 1, At, B1); PG8_BAR;
            }
        }
        if constexpr (ALIGN_EPI) { if (wr == 0) PG8_BAR; }
        E(acc, cur, wr, wc, fr, fq); S.done(cur);
        if (!has_next) break;
#pragma unroll
        for (int a = 0; a < 2; ++a)
#pragma unroll
            for (int b = 0; b < 2; ++b)
#pragma unroll
                for (int m = 0; m < 4; ++m)
#pragma unroll
                    for (int n = 0; n < 2; ++n) acc[a][b][m][n] = (f32x4){0.f, 0.f, 0.f, 0.f};
        cur = nxt; cA = nA; cB = nB; ++ui;
        if constexpr (GATHER) { vc0[0] = vn0[0]; vc0[1] = vn0[1]; vc1[0] = vn1[0]; vc1[1] = vn1[1]; }
        if constexpr (ALIGN_EPI) { if (wr == 1) PG8_BAR; }
    }
    PG8_WAIT_V(0);
    if constexpr (!ALIGN_EPI) { if (wr == 0) PG8_BAR; }
    PG8_BAR;
#undef PG8_SA
#undef PG8_SB
#undef PG8_STAGE
#undef PG8_STAGE_A0
#undef PG8_STAGE_A1
#undef PG8_GIDX
#undef PG8_LDA
#undef PG8_LDB
#undef PG8_MMA
#undef PG8_WAIT_V
#undef PG8_WAIT_L
#undef PG8_BAR
#undef PG8_SCHED
}
}
#define GP_ALIGN true
#define GP_SP2 true

constexpr int DM = 1024, NB = 8, SEQ = 4096, CTXL = 256, TC = SEQ + CTXL  ;
constexpr int M0 = NB * TC  , M1 = NB * SEQ  ;
constexpr int NEXP = 16;
constexpr float RMS_EPS = 1e-6f;
constexpr int NCHUNK = 256;
constexpr int MAXTILES = 288;
constexpr int LCH = 68;

enum { I_X = 0, I_C, I_CTX, I_CCTX, I_ADAW, I_ADAB, I_N1G, I_N2G, I_FING, I_EVWIN, I_QNG, I_KVNG, I_WUQ, I_WUKV, I_LCW, I_LCB, I_LWA, I_LBA, I_LWX, I_LBX, I_LLAM, I_EVWOUT,
       I_ODWIN, I_HCW, I_HCB, I_HW1, I_HB1, I_HF1, I_HW2, I_HB2, I_HF2, I_HW3, I_HDEC, I_HSKIP, I_ODWOUT, I_RW, I_RB, I_MW1, I_MW3, I_MW2, N_IN };

constexpr size_t MiB = 1u << 20;
constexpr size_t WS_CTL = 0, CTL_ZERO_BYTES = 1 * MiB;
constexpr size_t WS_MOD = 1 * MiB;
constexpr size_t WS_RQ = WS_MOD + 2 * 9 * 6144 * 4;
constexpr size_t WS_RKV = WS_RQ + (size_t)M0 * 4;
constexpr size_t WS_A2 = 2 * MiB;
constexpr size_t WS_ROUTE_E = 3 * MiB;
constexpr size_t WS_ROUTE_W = WS_ROUTE_E + (size_t)M0 * 4;
constexpr size_t WS_ROUTE_S = WS_ROUTE_W + (size_t)M0 * 8;
constexpr size_t WS_CNT = WS_ROUTE_S + (size_t)M0 * 8;
constexpr size_t WS_TILEE = WS_CNT + 256 * 16 * 4;
static_assert(WS_TILEE + (MAXTILES + 64) * 4 <= 4 * MiB, "route region");
constexpr size_t WS_CP = 4 * MiB;
constexpr size_t WS_CS = WS_CP + (size_t)2 * 8 * LCH * 512 * 4;
static_assert(WS_CS + (size_t)2 * 8 * LCH * 512 * 4 <= 10 * MiB, "lru carries");
constexpr size_t WS_WIN = 10 * MiB;
constexpr size_t WS_WUQ = 14 * MiB;
constexpr size_t WS_WUKV = 15 * MiB;
constexpr size_t WS_WOUT = 16 * MiB;
constexpr size_t WS_WHIN = 18 * MiB;
constexpr size_t WS_WHOUT = 24 * MiB;
constexpr size_t WS_WG = 26 * MiB;
constexpr size_t WS_W13 = 27 * MiB;
constexpr size_t WS_W2 = 91 * MiB;
constexpr size_t WS_RH = 124 * MiB;
constexpr size_t WS_XC = 192 * MiB;
constexpr size_t X2_OFF = 64 * MiB;
constexpr size_t WS_R2 = 200 * MiB;
constexpr size_t WS_CQ = WS_R2;
constexpr size_t WS_CKV = WS_R2 + 26 * MiB;
constexpr size_t WS_UX = WS_R2 + 43 * MiB;
constexpr size_t WS_UG = WS_R2 + 77 * MiB;
constexpr size_t WS_Q = WS_R2 + 111 * MiB;
constexpr size_t WS_K = WS_R2 + 162 * MiB;
constexpr size_t WS_V = WS_R2 + 213 * MiB;
constexpr size_t WS_HPERM = WS_R2;
constexpr size_t WS_ACT = WS_R2 + 144 * MiB;
constexpr size_t WS_PT = WS_R2;
constexpr size_t WS_ZT = WS_R2 + 192 * MiB;
constexpr size_t WS_Z = WS_R2;
constexpr size_t WS_HSPEC = 456 * MiB;
constexpr size_t WS_X3 = 416 * MiB;
constexpr size_t WS_HIN = 488 * MiB;
constexpr size_t WS_SLOTTOK = 491 * MiB;
constexpr size_t WS_END = 492 * MiB;
static_assert(WS_V + (size_t)M0 * 512 * 2 <= WS_HSPEC && WS_ZT + (size_t)1024 * 32768 * 2 <= WS_HSPEC && WS_ACT + (size_t)73728 * 512 * 2 <= WS_HSPEC, "ws map");

constexpr int CW_TMO = 0, CW_BAR = 4096;

constexpr int RING_BYTES = 131072, LDS_BYTES = 155648, LDSCTL_OFF = LDS_BYTES - 1024, MISC_OFF = LDSCTL_OFF + 320;

#define XB_TMO      128
#define XB_XCNT(j)  (256  + 64 * (j))
#define XB_XSUB(j)  (1280 + 64 * (j))
#define XB_XGEN(j)  (2304 + 64 * (j))
#define XB_TOP      3328
#define XB_TOPGEN   3392
#define XCD_BAR_WORDS 3456
#define XB_SPIN_CAP (1u << 18)
__device__ __forceinline__ unsigned xb_ld(unsigned* p)              { return __hip_atomic_load(p, __ATOMIC_RELAXED, __HIP_MEMORY_SCOPE_AGENT); }
__device__ __forceinline__ unsigned xb_add(unsigned* p, unsigned v) { return __hip_atomic_fetch_add(p, v, __ATOMIC_RELAXED, __HIP_MEMORY_SCOPE_AGENT); }
__device__ __forceinline__ unsigned xb_xcc_id() { return (unsigned)__builtin_amdgcn_s_getreg((3 << 11) | 20) & 0xFu; }
#define XB_SPIN(cond, bar) do { unsigned _sp = 0; while (cond) { __builtin_amdgcn_s_sleep(1); \
    if ((++_sp & 255u) == 0u) { if (xb_ld(&(bar)[XB_TMO])) break; if (_sp > XB_SPIN_CAP) { atomicAdd(&(bar)[XB_TMO], 1u); break; } } } } while (0)
struct XcdBarrier { unsigned* bar; unsigned x; volatile LAS unsigned* st; };
__device__ __forceinline__ XcdBarrier xcd_barrier_post(unsigned* bar, volatile LAS unsigned* st) {
    XcdBarrier b; b.bar = bar; b.x = xb_xcc_id(); b.st = st;
    if (threadIdx.x == 0) (void)xb_add(&bar[XB_XCNT(b.x)], 1u);
    return b;
}
__device__ __forceinline__ void xcd_barrier_complete(unsigned* bar, unsigned x, unsigned& nloc, unsigned& nx) {
    const unsigned G = gridDim.x * gridDim.y * gridDim.z;
    unsigned sum, cnt, mine, sp = 0u;
    for (;;) {
        sum = 0u; cnt = 0u; mine = 0u;
#pragma unroll
        for (unsigned j = 0; j < 16; ++j) { const unsigned c = xb_ld(&bar[XB_XCNT(j)]); sum += c; cnt += (c > 0u) ? 1u : 0u; mine = (j == x) ? c : mine; }
        if (sum == G) break;
        __builtin_amdgcn_s_sleep(1);
        if ((++sp & 255u) == 0u) { if (xb_ld(&bar[XB_TMO])) break; if (sp > XB_SPIN_CAP) { atomicAdd(&bar[XB_TMO], 1u); break; } }
    }
    nloc = mine > 0u ? mine : 1u; nx = cnt > 0u ? cnt : 1u;
}
__device__ __forceinline__ void xcd_barrier(const XcdBarrier& b) {
    asm volatile("s_waitcnt vmcnt(0)" ::: "memory");
    __syncthreads();
    if (threadIdx.x == 0) {
        unsigned* bar = b.bar;
        __builtin_amdgcn_s_waitcnt(0);
        unsigned nloc = b.st[0], nx = b.st[1];
        if (nloc == 0u) { xcd_barrier_complete(bar, b.x, nloc, nx); b.st[0] = nloc; b.st[1] = nx; }
        const unsigned old = xb_add(&bar[XB_XSUB(b.x)], 1u);
        const unsigned gen = old / nloc;
        if (old + 1u == (gen + 1u) * nloc) {
            __builtin_amdgcn_fence(__ATOMIC_RELEASE, "agent");
            asm volatile("s_waitcnt vmcnt(0)" ::: "memory");
            const unsigned og = xb_add(&bar[XB_TOP], 1u);
            const unsigned tg = og / nx;
            if (og + 1u == (tg + 1u) * nx) xb_add(&bar[XB_TOPGEN], 1u);
            else XB_SPIN(xb_ld(&bar[XB_TOPGEN]) == tg, bar);
            __builtin_amdgcn_fence(__ATOMIC_ACQUIRE, "agent");
            xb_add(&bar[XB_XGEN(b.x)], 1u);
            asm volatile("s_waitcnt vmcnt(0)" ::: "memory");
        } else {
            XB_SPIN(xb_ld(&bar[XB_XGEN(b.x)]) == gen, bar);
            __builtin_amdgcn_fence(__ATOMIC_ACQUIRE, "agent");
            asm volatile("s_waitcnt vmcnt(0)" ::: "memory");
        }
    }
    __syncthreads();
}

struct Params { const float* in[N_IN]; float* out; unsigned char* ws; int ph_lo, ph_hi; };
typedef const __attribute__((address_space(4))) Params* ParamsK;
__device__ __forceinline__ Params load_params() {
#if defined(__HIP_DEVICE_COMPILE__)
    unsigned long long v = (unsigned long long)__builtin_amdgcn_kernarg_segment_ptr(); asm volatile("" : "+s"(v)); return *(ParamsK)v;
#else
    return Params{};
#endif
}

__device__ __forceinline__ u32x4 pack8(const f32x4 a, const f32x4 b) {
    u32x4 w; w.x = pg8::cvt_pk_bf16(a[0], a[1]); w.y = pg8::cvt_pk_bf16(a[2], a[3]); w.z = pg8::cvt_pk_bf16(b[0], b[1]); w.w = pg8::cvt_pk_bf16(b[2], b[3]); return w;
}
__device__ __forceinline__ void rope8(f32x4& v0, f32x4& v1, int fq, int tt  , bool on) {
    const int axis = fq >> 1, half = fq & 1; const float pos = (float)(axis == 0 ? (tt >> 6) : (tt & 63)) * 0.15915494309189535f;
    constexpr float IF[8] = {1.0f, 0.316227766f, 0.1f, 0.0316227766f, 0.01f, 0.00316227766f, 0.001f, 0.000316227766f};
#pragma unroll
    for (int i = 0; i < 4; ++i) {
        { const float x = v0[i], other = __shfl_xor(x, 16); const float sn = __builtin_amdgcn_sinf(pos * IF[i]), cs = __builtin_amdgcn_cosf(pos * IF[i]);
          const float r = half == 0 ? x * cs - other * sn : other * sn + x * cs; v0[i] = on ? r : x; }
        { const float x = v1[i], other = __shfl_xor(x, 16); const float sn = __builtin_amdgcn_sinf(pos * IF[4 + i]), cs = __builtin_amdgcn_cosf(pos * IF[4 + i]);
          const float r = half == 0 ? x * cs - other * sn : other * sn + x * cs; v1[i] = on ? r : x; }
    }
}

struct EpiIn {
    static constexpr bool PERM = true;
    bf16 *CQ, *CKV, *UX, *UG, *KB;
    __device__ __forceinline__ void operator()(const f32x4 (&acc)[2][2][4][2], const pg8::Unit& u, int wr, int wc, int fr, int fq) const {
        const int row0 = u.pm * 256 + wr * 64 + fr;
        const bool is_ctx = (u.pm % 17) == 0; const int bb = u.pm / 17;
#pragma unroll
        for (int bj = 0; bj < 2; ++bj) {
            const int blk = u.pn * 2 + bj;
            if (blk < 13) {
                bf16* dst; int ld, cb;
                if (blk < 3) { dst = CQ; ld = 384; cb = blk * 128; }
                else if (blk < 5) { dst = CKV; ld = 256; cb = (blk - 3) * 128; }
                else if (blk < 9) { dst = UX; ld = 512; cb = (blk - 5) * 128; }
                else { dst = UG; ld = 512; cb = (blk - 9) * 128; }
                const int col = cb + wc * 32 + 8 * fq;
#pragma unroll
                for (int ai = 0; ai < 2; ++ai)
#pragma unroll
                    for (int m = 0; m < 4; ++m) { const int row = row0 + ai * 128 + m * 16;
                        *(u32x4*)(dst + (size_t)row * ld + col) = pack8(acc[ai][bj][m][0], acc[ai][bj][m][1]); }
            } else if (wc == 0) {
#pragma unroll
                for (int ai = 0; ai < 2; ++ai)
#pragma unroll
                    for (int m = 0; m < 4; ++m) { const int row = row0 + ai * 128 + m * 16; const int tt = row - bb * TC - CTXL;
                        f32x4 v0 = acc[ai][bj][m][0], v1 = acc[ai][bj][m][1];
                        rope8(v0, v1, fq, tt, !is_ctx);
                        const u32x4 w = pack8(v0, v1);
#pragma unroll
                        for (int h = 0; h < 8; ++h) *(u32x4*)(KB + (size_t)row * 768 + h * 96 + 64 + 8 * fq) = w; }
            }
        }
    }
};
struct EpiQ {
    static constexpr bool PERM = true;
    bf16* Q; const float* rq;
    __device__ __forceinline__ void operator()(const f32x4 (&acc)[2][2][4][2], const pg8::Unit& u, int wr, int wc, int fr, int fq) const {
        const int row0 = u.pm * 256 + wr * 64 + fr;
#pragma unroll
        for (int ai = 0; ai < 2; ++ai)
#pragma unroll
            for (int m = 0; m < 4; ++m) { const int row = row0 + ai * 128 + m * 16; const float s = rq[row];
#pragma unroll
                for (int bj = 0; bj < 2; ++bj) {
                    const u32x4 w = pack8(acc[ai][bj][m][0] * s, acc[ai][bj][m][1] * s);
                    int off;
                    if (u.pn < 2) { const int c = u.pn * 256 + bj * 128 + wc * 32 + 8 * fq; off = (c >> 6) * 96 + (c & 63); }
                    else off = (4 * bj + wc) * 96 + 64 + 8 * fq;
                    *(u32x4*)(Q + (size_t)row * 768 + off) = w;
                } }
    }
};
struct EpiKV {
    static constexpr bool PERM = true;
    bf16 *K, *V; const float* rkv;
    __device__ __forceinline__ void operator()(const f32x4 (&acc)[2][2][4][2], const pg8::Unit& u, int wr, int wc, int fr, int fq) const {
        const int row0 = u.pm * 256 + wr * 64 + fr;
#pragma unroll
        for (int ai = 0; ai < 2; ++ai)
#pragma unroll
            for (int m = 0; m < 4; ++m) { const int row = row0 + ai * 128 + m * 16; const float s = rkv[row];
#pragma unroll
                for (int bj = 0; bj < 2; ++bj) { const int h = u.pn * 2 + bj;
                    const u32x4 w = pack8(acc[ai][bj][m][0] * s, acc[ai][bj][m][1] * s);
                    if (wc < 2) *(u32x4*)(K + (size_t)row * 768 + h * 96 + wc * 32 + 8 * fq) = w;
                    else *(u32x4*)(V + (size_t)row * 512 + h * 64 + (wc - 2) * 32 + 8 * fq) = w; } }
    }
};
template <int LAYER> struct EpiRes {
    static constexpr bool PERM = true;
    const float *x, *ctx, *mod; const bf16* xin; bf16 *xout, *xc;
    __device__ __forceinline__ void operator()(const f32x4 (&acc)[2][2][4][2], const pg8::Unit& u, int wr, int wc, int fr, int fq) const {
        const int row0 = u.pm * 256 + wr * 64 + fr, col0 = u.pn * 256 + wc * 32 + 8 * fq;
        const bool is_ctx = LAYER == 0 && (u.pm % 17) == 0; const int bb = LAYER == 0 ? u.pm / 17 : u.pm / 16;
        const float* g = mod + (size_t)(LAYER * 9 + (is_ctx ? 8 : bb)) * 6144 + 2048;
        f32x4 gv[2][2];
#pragma unroll
        for (int bj = 0; bj < 2; ++bj)
#pragma unroll
            for (int n = 0; n < 2; ++n) gv[bj][n] = *(const f32x4*)(g + col0 + bj * 128 + n * 4);
#pragma unroll
        for (int ai = 0; ai < 2; ++ai)
#pragma unroll
            for (int m = 0; m < 4; ++m) { const int row = row0 + ai * 128 + m * 16;
                if (LAYER == 0) { const int t = row - bb * TC; const float* res; bf16* dst;
                    if (is_ctx) { res = ctx + (size_t)(bb * CTXL + t) * DM; dst = xc + (size_t)(bb * CTXL + t) * DM; }
                    else { res = x + (size_t)(bb * SEQ + t - CTXL) * DM; dst = xout + (size_t)(bb * SEQ + t - CTXL) * DM; }
#pragma unroll
                    for (int bj = 0; bj < 2; ++bj) { const int c = col0 + bj * 128;
                        const f32x4 r0 = *(const f32x4*)(res + c), r1 = *(const f32x4*)(res + c + 4);
                        *(u32x4*)(dst + c) = pack8(r0 + gv[bj][0] * acc[ai][bj][m][0], r1 + gv[bj][1] * acc[ai][bj][m][1]); } }
                else {
#pragma unroll
                    for (int bj = 0; bj < 2; ++bj) { const int c = col0 + bj * 128; const u32x4 q = *(const u32x4*)(xin + (size_t)row * DM + c);
                        const f32x4 r0 = {bflo(q.x), bfhi(q.x), bflo(q.y), bfhi(q.y)}, r1 = {bflo(q.z), bfhi(q.z), bflo(q.w), bfhi(q.w)};
                        *(u32x4*)(xout + (size_t)row * DM + c) = pack8(r0 + gv[bj][0] * acc[ai][bj][m][0], r1 + gv[bj][1] * acc[ai][bj][m][1]); } } }
    }
};
struct EpiMoe1 {
    static constexpr bool PERM = true;
    bf16* ACT;
    __device__ __forceinline__ void operator()(const f32x4 (&acc)[2][2][4][2], const pg8::Unit& u, int wr, int wc, int fr, int fq) const {
        const int row0 = u.pm * 256 + wr * 64 + fr, col = u.pn * 128 + wc * 32 + 8 * fq;
#pragma unroll
        for (int ai = 0; ai < 2; ++ai)
#pragma unroll
            for (int m = 0; m < 4; ++m) { const int row = row0 + ai * 128 + m * 16;
                f32x4 r[2];
#pragma unroll
                for (int n = 0; n < 2; ++n)
#pragma unroll
                    for (int i = 0; i < 4; ++i) { const float a = acc[ai][0][m][n][i], b = acc[ai][1][m][n][i]; r[n][i] = a / (1.f + __expf(-a)) * b; }
                *(u32x4*)(ACT + (size_t)row * 512 + col) = pack8(r[0], r[1]); }
    }
};
struct EpiStore {
    static constexpr bool PERM = true;
    bf16* O; int ldc;
    __device__ __forceinline__ void operator()(const f32x4 (&acc)[2][2][4][2], const pg8::Unit& u, int wr, int wc, int fr, int fq) const {
        const int row0 = u.pm * 256 + wr * 64 + fr, col0 = u.pn * 256 + wc * 32 + 8 * fq;
#pragma unroll
        for (int ai = 0; ai < 2; ++ai)
#pragma unroll
            for (int m = 0; m < 4; ++m) { bf16* rowp = O + (size_t)(row0 + ai * 128 + m * 16) * ldc + col0;
#pragma unroll
                for (int bj = 0; bj < 2; ++bj) *(u32x4*)(rowp + bj * 128) = pack8(acc[ai][bj][m][0], acc[ai][bj][m][1]); }
    }
};

__device__ __forceinline__ void cvt_item(const float* W, int ldw, int col0, const float* gk, bf16* WTrow0, int ldk, int k0, float* scr, int lane) {
    if (col0 >= 0) {
        float v[32];
#pragma unroll
        for (int i = 0; i < 32; ++i) v[i] = W[(size_t)(k0 + 2 * i + (lane >> 5)) * ldw + col0 + (lane & 31)];
        if (gk) {
#pragma unroll
            for (int i = 0; i < 32; ++i) v[i] *= gk[k0 + 2 * i + (lane >> 5)];
        }
#pragma unroll
        for (int i = 0; i < 32; ++i) scr[(2 * i + (lane >> 5)) * 33 + (lane & 31)] = v[i];
    } else {
#pragma unroll 8
        for (int i = 0; i < 32; ++i) { const int kk = 2 * i + (lane >> 5); scr[kk * 33 + (lane & 31)] = 0.f; }
    }
    LDS_WAIT(); asm volatile("" ::: "memory");
    const int c = lane & 7;
#pragma unroll
    for (int j = 0; j < 4; ++j) { const int n = (lane >> 3) + 8 * j; const float* s = scr + (8 * c) * 33 + n;
        u32x4 o; o.x = pk2(s[0 * 33], s[1 * 33]); o.y = pk2(s[2 * 33], s[3 * 33]); o.z = pk2(s[4 * 33], s[5 * 33]); o.w = pk2(s[6 * 33], s[7 * 33]);
        *(u32x4*)(WTrow0 + (size_t)n * ldk + k0 + 8 * c) = o; }
    LDS_WAIT(); asm volatile("" ::: "memory");
}

__device__ __forceinline__ void phase_prologue(const Params& P, unsigned char* lds, int tid, int lane, int wave, int G) {
    unsigned char* ws = P.ws;
    __syncthreads();
    {
        float* sl = (float*)lds;
        float* red = (float*)(lds + 40960);
        float* mod = (float*)(ws + WS_MOD);
        bool loaded = false;
        for (int u = blockIdx.x; u < 192; u += G) {
            if (!loaded) { for (int i = tid; i < 9 * 1024; i += 512) { const float v = i < 8192 ? P.in[I_C][i] : P.in[I_CCTX][i - 8192]; sl[i] = v / (1.f + expf(-v)); } loaded = true; __syncthreads(); }
            const int l = u / 96, col = (u % 96) * 64 + lane;
            const float* W = P.in[I_ADAW] + (size_t)l * 1024 * 6144 + col;
            float a[9];
#pragma unroll
            for (int b = 0; b < 9; ++b) a[b] = 0.f;
            const int kb = wave * 128;
#pragma unroll 16
            for (int k = 0; k < 128; ++k) { const float w = W[(size_t)(kb + k) * 6144];
#pragma unroll
                for (int b = 0; b < 9; ++b) a[b] += sl[b * 1024 + kb + k] * w; }
#pragma unroll
            for (int b = 0; b < 9; ++b) red[(wave * 9 + b) * 64 + lane] = a[b];
            __syncthreads();
            for (int i = tid; i < 9 * 64; i += 512) { const int b = i >> 6, cc = i & 63; float s = 0.f;
#pragma unroll
                for (int w = 0; w < 8; ++w) s += red[(w * 9 + b) * 64 + cc];
                const int c2 = (u % 96) * 64 + cc;
                mod[(size_t)(l * 9 + b) * 6144 + c2] = s + P.in[I_ADAB][l * 6144 + c2]; }
            __syncthreads();
        }
        __syncthreads();
    }
    {
        float* scr = (float*)(lds + wave * 16384);
        const int gw = blockIdx.x * 8 + wave, NGW = G * 8;
        constexpr int I_WIN = 16 * 56, I_UQ = 6 * 24, I_UKV = 4 * 32, I_OUT = 16 * 32, I_HIN = 16 * 96, I_HOUT = 16 * 32, I_WG = 64, I_M13 = 32 * 512, I_M2 = 32 * 256;
        constexpr int NITEMS = I_WIN + I_UQ + I_UKV + I_OUT + I_HIN + I_HOUT + I_WG + I_M13 + I_M2;
        for (int it = gw; it < NITEMS; it += NGW) {
            int r = it;
            if (r < I_M13) { const int le = r >> 9, q = r & 511, kb = q >> 5, nb = q & 31, n0 = 32 * nb, pn = n0 >> 8, j = n0 & 255;
                const float* src = (j < 128 ? P.in[I_MW1] : P.in[I_MW3]) + (size_t)le * 1024 * 512;
                cvt_item(src, 512, 128 * pn + (j & 127), nullptr, (bf16*)(ws + WS_W13) + ((size_t)le * 1024 + n0) * 1024, 1024, 64 * kb, scr, lane); continue; } r -= I_M13;
            if (r < I_M2) { const int le = r >> 8, q = r & 255, kb = q >> 5, nb = q & 31, n0 = 32 * nb;
                cvt_item(P.in[I_MW2] + (size_t)le * 512 * 1024, 1024, n0, nullptr, (bf16*)(ws + WS_W2) + ((size_t)le * 1024 + n0) * 512, 512, 64 * kb, scr, lane); continue; } r -= I_M2;
            if (r < I_WIN) { const int kb = r / 56, nb = r % 56, n0 = 32 * nb; const int col0 = n0 < 640 ? n0 : (n0 < 1664 ? n0 + 32 : (n0 < 1696 ? n0 - 1024 : -1));
                cvt_item(P.in[I_EVWIN], 1696, col0, nullptr, (bf16*)(ws + WS_WIN) + (size_t)n0 * 1024, 1024, 64 * kb, scr, lane); continue; } r -= I_WIN;
            if (r < I_UQ) { const int kb = r / 24, nb = r % 24, n0 = 32 * nb; const int col0 = n0 < 512 ? (n0 >> 6) * 96 + (n0 & 63) : ((n0 - 512) >> 5) * 96 + 64;
                cvt_item(P.in[I_WUQ], 768, col0, P.in[I_QNG], (bf16*)(ws + WS_WUQ) + (size_t)n0 * 384, 384, 64 * kb, scr, lane); continue; } r -= I_UQ;
            if (r < I_UKV) { const int kb = r / 32, nb = r % 32, n0 = 32 * nb;
                cvt_item(P.in[I_WUKV], 1024, n0, P.in[I_KVNG], (bf16*)(ws + WS_WUKV) + (size_t)n0 * 256, 256, 64 * kb, scr, lane); continue; } r -= I_UKV;
            if (r < I_OUT) { const int kb = r / 32, nb = r % 32, n0 = 32 * nb;
                cvt_item(P.in[I_EVWOUT], 1024, n0, nullptr, (bf16*)(ws + WS_WOUT) + (size_t)n0 * 1024, 1024, 64 * kb, scr, lane); continue; } r -= I_OUT;
            if (r < I_HIN) { const int kb = r / 96, nb = r % 96, n0 = 32 * nb;
                cvt_item(P.in[I_ODWIN], 3072, n0, nullptr, (bf16*)(ws + WS_WHIN) + (size_t)n0 * 1024, 1024, 64 * kb, scr, lane); continue; } r -= I_HIN;
            if (r < I_HOUT) { const int kb = r / 32, nb = r % 32, n0 = 32 * nb;
                cvt_item(P.in[I_ODWOUT], 1024, n0, nullptr, (bf16*)(ws + WS_WHOUT) + (size_t)n0 * 1024, 1024, 64 * kb, scr, lane); continue; } r -= I_HOUT;
            { const int mat = r >> 1, nb = r & 1, d = mat >> 4, gsel = (mat >> 3) & 1, h = mat & 7;
                const float* src = (gsel ? P.in[I_LWX] : P.in[I_LWA]) + (size_t)(d * 8 + h) * 4096;
                cvt_item(src, 64, 32 * nb, nullptr, (bf16*)(ws + WS_WG) + (size_t)(h * 256 + d * 128 + gsel * 64 + 32 * nb) * 64, 64, 0, scr, lane); }
        }
    }
    {
        const int gw = blockIdx.x * 8 + wave, NGW = G * 8;
        float* a2 = (float*)(ws + WS_A2);
        const float *w1 = P.in[I_HW1], *b1 = P.in[I_HB1], *f1 = P.in[I_HF1], *w2 = P.in[I_HW2], *b2 = P.in[I_HB2], *f2 = P.in[I_HF2];
        for (int t = gw; t < 4096; t += NGW) {
            const float tl = (float)t / 4095.f, w = (6.283185307179586f / 4096.f) * (float)t;
            float zi = 0.f;
            if (lane == 0) zi = tl;
            else if (lane <= 16) { const float f = 1e-4f + (float)(lane - 1) * ((15.f - 1e-4f) / 15.f); zi = cosf(f * w); }
            else if (lane <= 32) { const float f = 1e-4f + (float)(lane - 17) * ((15.f - 1e-4f) / 15.f); zi = -sinf(f * w); }
            float acc = b1[lane];
            for (int i = 0; i < 33; ++i) acc += __shfl(zi, i) * w1[i * 64 + lane];
            const float a1 = sinf(f1[lane] * acc);
            float acc2 = b2[lane];
            for (int i = 0; i < 64; ++i) acc2 += __shfl(a1, i) * w2[i * 64 + lane];
            a2[(size_t)lane * 4096 + t] = sinf(f2[lane] * acc2);
        }
    }
}

__device__ __forceinline__ void store_row_bf16(bf16* orow, const f32x4 (&v)[4], int lane) {
    unsigned long long* o8 = (unsigned long long*)orow + lane;
#pragma unroll
    for (int j = 0; j < 4; ++j) o8[64 * j] = (unsigned long long)pk2(v[j][0], v[j][1]) | ((unsigned long long)pk2(v[j][2], v[j][3]) << 32);
}
__device__ __forceinline__ void load_xrow(const bf16* row, int lane, u32x2 (&q)[4]) {
#pragma unroll
    for (int j = 0; j < 4; ++j) q[j] = ((const u32x2*)row)[lane + 64 * j];
}
__device__ __forceinline__ void cvt_xrow(const u32x2 (&q)[4], f32x4 (&v)[4]) {
#pragma unroll
    for (int j = 0; j < 4; ++j) v[j] = (f32x4){bflo(q[j].x), bfhi(q[j].x), bflo(q[j].y), bfhi(q[j].y)};
}
__device__ __forceinline__ void norm_mod(f32x4 (&v)[4], const float* g, const float* sh, const float* sc, int lane) {
    float ss = 0.f;
#pragma unroll
    for (int j = 0; j < 4; ++j) ss += (v[j][0] * v[j][0] + v[j][1] * v[j][1]) + (v[j][2] * v[j][2] + v[j][3] * v[j][3]);
    const float rr = rsqrtf(wave_sum(ss) * (1.f / 1024.f) + RMS_EPS);
#pragma unroll
    for (int j = 0; j < 4; ++j) { const f32x4 gg = ((const f32x4*)g)[lane + 64 * j], s1 = ((const f32x4*)sc)[lane + 64 * j], s0 = ((const f32x4*)sh)[lane + 64 * j];
        v[j] = (v[j] * rr * gg) * (1.f + s1) + s0; }
}
struct CombIdx { int s0, s1; float w0, w1; };
struct CombData { u32x2 x[4], y0[4], y1[4]; };
__device__ __forceinline__ void comb_load_idx(const int* rs, const float* rw, int r, CombIdx& I) { I.s0 = rs[2 * r]; I.s1 = rs[2 * r + 1]; I.w0 = rw[2 * r]; I.w1 = rw[2 * r + 1]; }
__device__ __forceinline__ void comb_load_data(const bf16* xrow, const bf16* Y, const CombIdx& I, int lane, CombData& D) {
    const u32x2* y0 = (const u32x2*)(Y + (size_t)I.s0 * 1024) + lane; const u32x2* y1 = (const u32x2*)(Y + (size_t)I.s1 * 1024) + lane;
#pragma unroll
    for (int j = 0; j < 4; ++j) { D.x[j] = ((const u32x2*)xrow)[lane + 64 * j]; D.y0[j] = y0[64 * j]; D.y1[j] = y1[64 * j]; }
}
__device__ __forceinline__ void comb_apply(f32x4 (&v)[4], const CombData& D, const CombIdx& I, const float* g2, int lane) {
#pragma unroll
    for (int j = 0; j < 4; ++j) { const u32x2 a = D.y0[j], b = D.y1[j]; const f32x4 gg = ((const f32x4*)g2)[lane + 64 * j];
        f32x4 m; m[0] = I.w0 * bflo(a.x) + I.w1 * bflo(b.x); m[1] = I.w0 * bfhi(a.x) + I.w1 * bfhi(b.x); m[2] = I.w0 * bflo(a.y) + I.w1 * bflo(b.y); m[3] = I.w0 * bfhi(a.y) + I.w1 * bfhi(b.y);
        v[j] = (f32x4){bflo(D.x[j].x), bfhi(D.x[j].x), bflo(D.x[j].y), bfhi(D.x[j].y)} + gg * m; }
}
__device__ __forceinline__ float route_scores(const f32x4 (&v)[4], const float* rwT  , int lane) {
    float p[16];
#pragma unroll
    for (int e = 0; e < 16; ++e) { f32x2 a2 = {0.f, 0.f};
#pragma unroll
        for (int j = 0; j < 4; ++j) { const f32x4 w = ((const f32x4*)(rwT + e * 1024))[lane + 64 * j];
            a2 = __builtin_elementwise_fma((f32x2){v[j][0], v[j][1]}, (f32x2){w[0], w[1]}, a2); a2 = __builtin_elementwise_fma((f32x2){v[j][2], v[j][3]}, (f32x2){w[2], w[3]}, a2); }
        p[e] = a2[0] + a2[1]; }
    const bool h32 = lane & 32, h16 = lane & 16, h8 = lane & 8, h4 = lane & 4;
    float q8[8], q4[4], q2[2], q1;
#pragma unroll
    for (int e = 0; e < 8; ++e) { const float send = h32 ? p[e] : p[e + 8], keep = h32 ? p[e + 8] : p[e]; q8[e] = keep + __shfl_xor(send, 32); }
#pragma unroll
    for (int e = 0; e < 4; ++e) { const float send = h16 ? q8[e] : q8[e + 4], keep = h16 ? q8[e + 4] : q8[e]; q4[e] = keep + __shfl_xor(send, 16); }
#pragma unroll
    for (int e = 0; e < 2; ++e) { const float send = h8 ? q4[e] : q4[e + 2], keep = h8 ? q4[e + 2] : q4[e]; q2[e] = keep + __shfl_xor(send, 8); }
    { const float send = h4 ? q2[0] : q2[1], keep = h4 ? q2[1] : q2[0]; q1 = keep + __shfl_xor(send, 4); }
    q1 += __shfl_xor(q1, 1); q1 += __shfl_xor(q1, 2);
    return __builtin_amdgcn_rcpf(1.f + __expf(-q1));
}
__device__ __forceinline__ void route_select(const float (&s)[16], const float* rb, int& e0o, int& e1o, float& w0o, float& w1o) {
    float sel[16];
#pragma unroll
    for (int e = 0; e < 16; ++e) sel[e] = s[e] + rb[e];
    float gbest = -1e30f; int gi = 0;
#pragma unroll
    for (int g = 0; g < 4; ++g) { float m1 = -1e30f, m2 = -1e30f;
#pragma unroll
        for (int i = 0; i < 4; ++i) { const float x = sel[4 * g + i]; if (x > m1) { m2 = m1; m1 = x; } else if (x > m2) m2 = x; }
        const float gs = m1 + m2; if (gs > gbest) { gbest = gs; gi = g; } }
    float b0 = -1e30f, b1 = -1e30f; int e0 = 0, e1 = 0; float s0 = 0.f, s1 = 0.f;
#pragma unroll
    for (int e = 0; e < 16; ++e) { const bool in = (e >> 2) == gi; const float x = sel[e];
        if (in && x > b0) { b1 = b0; e1 = e0; s1 = s0; b0 = x; e0 = e; s0 = s[e]; } else if (in && x > b1) { b1 = x; e1 = e; s1 = s[e]; } }
    e0o = e0; e1o = e1; const float den = s0 + s1; w0o = s0 / den; w1o = s1 / den;
}

__device__ __forceinline__ const float* l0_row_ptr(const Params& P, int row) {
    const int b = row / TC, t = row - b * TC;
    return t < CTXL ? P.in[I_CTX] + (size_t)(b * CTXL + t) * DM : P.in[I_X] + (size_t)(b * SEQ + t - CTXL) * DM;
}
__device__ __forceinline__ const bf16* l0_xrow_ptr(const Params& P, int row) {
    const int b = row / TC, t = row - b * TC;
    return t < CTXL ? (const bf16*)(P.ws + WS_XC) + (size_t)(b * CTXL + t) * DM : (const bf16*)P.out + (size_t)(b * SEQ + t - CTXL) * DM;
}
__device__ __forceinline__ void phase_norm1_l0(const Params& P, int lane, int wave, int G) {
    const float* mod = (const float*)(P.ws + WS_MOD); bf16* H = (bf16*)(P.ws + WS_RH);
    int row = blockIdx.x * 8 + wave; if (row >= M0) return;
    f32x4 nx[4];
    { const float* xr = l0_row_ptr(P, row);
#pragma unroll
      for (int j = 0; j < 4; ++j) nx[j] = ((const f32x4*)xr)[lane + 64 * j]; }
    for (; row < M0; row += G * 8) {
        f32x4 v[4];
#pragma unroll
        for (int j = 0; j < 4; ++j) v[j] = nx[j];
        if (row + G * 8 < M0) { const float* xr = l0_row_ptr(P, row + G * 8);
#pragma unroll
            for (int j = 0; j < 4; ++j) nx[j] = ((const f32x4*)xr)[lane + 64 * j]; }
        const int b = row / TC, t = row - b * TC;
        const float* md = mod + (size_t)(t < CTXL ? 8 : b) * 6144;
        norm_mod(v, P.in[I_N1G], md, md + 1024, lane);
        store_row_bf16(H + (size_t)row * DM, v, lane);
    }
}
template <int LAYER> __device__ __forceinline__ void phase_norm2_route(const Params& P, unsigned char* lds, int tid, int lane, int wave, int G) {
    constexpr int ROWS = LAYER == 0 ? 136 : 128;
    float* rwT = (float*)lds;
    int* cntl = (int*)(lds + 65536);
    float* slog = (float*)(lds + 65536 + 1024) + wave * (17 * 16);
    const float* mod = (const float*)(P.ws + WS_MOD) + (size_t)LAYER * 9 * 6144; bf16* H = (bf16*)(P.ws + WS_RH);
    int* route_e = (int*)(P.ws + WS_ROUTE_E); float* route_w = (float*)(P.ws + WS_ROUTE_W); int* cnt = (int*)(P.ws + WS_CNT);
    for (int i = tid; i < 16384; i += 512) { const int k = i >> 4, e = i & 15; rwT[e * 1024 + k] = P.in[I_RW][i]; }
    for (int ch = blockIdx.x; ch < NCHUNK; ch += G) {
        if (tid < 16) cntl[tid] = 0;
        __syncthreads();
        u32x2 nx[4];
        { const int row = ch * ROWS + wave; load_xrow(LAYER == 0 ? l0_xrow_ptr(P, row) : (const bf16*)(P.ws + WS_X3) + (size_t)row * DM, lane, nx); }
        for (int rl = wave; rl < ROWS; rl += 8) {
            const int row = ch * ROWS + rl; const float* md;
            if (LAYER == 0) { const int b = row / TC, t = row - b * TC; md = mod + (size_t)(t < CTXL ? 8 : b) * 6144; }
            else md = mod + (size_t)(row >> 12) * 6144;
            f32x4 v[4]; cvt_xrow(nx, v);
            if (rl + 8 < ROWS) load_xrow(LAYER == 0 ? l0_xrow_ptr(P, row + 8) : (const bf16*)(P.ws + WS_X3) + (size_t)(row + 8) * DM, lane, nx);
            norm_mod(v, P.in[I_N2G] + LAYER * 1024, md + 3072, md + 4096, lane);
            store_row_bf16(H + (size_t)row * DM, v, lane);
            const float sl = route_scores(v, rwT, lane);
            if ((lane & 3) == 0) slog[(rl >> 3) * 16 + 8 * ((lane >> 5) & 1) + 4 * ((lane >> 4) & 1) + 2 * ((lane >> 3) & 1) + ((lane >> 2) & 1)] = sl;
        }
        LDS_WAIT();
        if (lane < (ROWS - wave + 7) / 8) {
            const int rl = wave + 8 * lane, row = ch * ROWS + rl;
            float sc[16];
#pragma unroll
            for (int e = 0; e < 16; ++e) sc[e] = slog[lane * 16 + e];
            int e0, e1; float w0, w1; route_select(sc, P.in[I_RB], e0, e1, w0, w1);
            route_e[row] = e0 | (e1 << 8); route_w[2 * row] = w0; route_w[2 * row + 1] = w1; atomicAdd(&cntl[e0], 1); atomicAdd(&cntl[e1], 1);
        }
        __syncthreads();
        if (tid < 16) cnt[ch * 16 + tid] = cntl[tid];
        __syncthreads();
    }
}
template <int LAYER> __device__ __forceinline__ void phase_permute(const Params& P, unsigned char* lds, int tid, int lane, int wave, int G) {
    constexpr int ROWS = LAYER == 0 ? 136 : 128;
    int* part_tot = (int*)lds;
    int* part_base = part_tot + 512;
    int* slot0 = part_base + 512;
    int* loc = slot0 + 16;
    int* slots = loc + 16;
    int* tstart = slots + 2 * 136;
    int* rel = tstart + 32;
    int* etot = rel + 136;
    const int* cnt = (const int*)(P.ws + WS_CNT); const int* route_e = (const int*)(P.ws + WS_ROUTE_E); int* route_s = (int*)(P.ws + WS_ROUTE_S);
    int* tile_e = (int*)(P.ws + WS_TILEE); int* slot_tok = (int*)(P.ws + WS_SLOTTOK);
    for (int ch = blockIdx.x; ch < NCHUNK; ch += G) {
        { const int e = tid & 15, part = tid >> 4; int tot = 0, bs = 0;
#pragma unroll
          for (int i = 0; i < 8; ++i) { const int c = part * 8 + i; const int x = cnt[c * 16 + e]; tot += x; bs += (c < ch) ? x : 0; }
          part_tot[part * 16 + e] = tot; part_base[part * 16 + e] = bs; }
        if (tid < ROWS) rel[tid] = route_e[ch * ROWS + tid];
        __syncthreads();
        if (tid == 0) {
            int ts = 0;
            for (int e = 0; e < 16; ++e) { int tot = 0, bs = 0; for (int p = 0; p < 32; ++p) { tot += part_tot[p * 16 + e]; bs += part_base[p * 16 + e]; }
                tstart[e] = ts; slot0[e] = ts * 256 + bs; loc[e] = 0; etot[e] = tot; ts += (tot + 255) >> 8; }
            tstart[16] = ts;
            if (ch == 0) { for (int e = 0; e < 16; ++e) for (int i = tstart[e]; i < tstart[e + 1]; ++i) tile_e[i] = e; tile_e[MAXTILES] = ts; }
            for (int rl = 0; rl < ROWS; ++rl) { const int row = ch * ROWS + rl; const int ee = rel[rl]; const int e0 = ee & 255, e1 = ee >> 8;
                const int s0 = slot0[e0] + loc[e0]; loc[e0] = loc[e0] + 1; const int s1 = slot0[e1] + loc[e1]; loc[e1] = loc[e1] + 1;
                slots[2 * rl] = s0; slots[2 * rl + 1] = s1; route_s[2 * row] = s0; route_s[2 * row + 1] = s1; }
        }
        __syncthreads();
        if (tid < 2 * ROWS) slot_tok[slots[tid]] = ch * ROWS + (tid >> 1);
        if (ch == 0) {
            for (int e = 0; e < 16; ++e) { const int lo = tstart[e] * 256 + etot[e], hi = tstart[e + 1] * 256; for (int sidx = lo + tid; sidx < hi; sidx += 512) slot_tok[sidx] = 0; }
        }
        __syncthreads();
    }
}
__device__ __forceinline__ void phase_combine_norm1_l1(const Params& P, int lane, int wave, int G) {
    const float* mod = (const float*)(P.ws + WS_MOD); bf16* H = (bf16*)(P.ws + WS_RH); const bf16* Y = (const bf16*)(P.ws + WS_HPERM);
    const int* rs = (const int*)(P.ws + WS_ROUTE_S); const float* rw = (const float*)(P.ws + WS_ROUTE_W);
    const bf16* X1 = (const bf16*)P.out; bf16* X2 = (bf16*)((unsigned char*)P.out + X2_OFF);
    const int st = G * 8; int row = blockIdx.x * 8 + wave; if (row >= M1) return;
#define L0ROW(r) (((r) >> 12) * TC + CTXL + ((r) & 4095))
    CombIdx ic, in; CombData dc, dn;
    comb_load_idx(rs, rw, L0ROW(row), ic); comb_load_data(X1 + (size_t)row * DM, Y, ic, lane, dc);
    { const int r1 = row + st < M1 ? row + st : row; comb_load_idx(rs, rw, L0ROW(r1), in); }
    for (; row < M1; row += st) {
        const int r1 = row + st < M1 ? row + st : row, r2 = row + 2 * st < M1 ? row + 2 * st : r1;
        comb_load_data(X1 + (size_t)r1 * DM, Y, in, lane, dn);
        CombIdx i2; comb_load_idx(rs, rw, L0ROW(r2), i2);
        const int b = row >> 12;
        f32x4 v[4]; comb_apply(v, dc, ic, mod + (size_t)b * 6144 + 5120, lane);
        store_row_bf16(X2 + (size_t)row * DM, v, lane);
        const float* md = mod + (size_t)(9 + b) * 6144;
        norm_mod(v, P.in[I_N1G] + 1024, md, md + 1024, lane);
        store_row_bf16(H + (size_t)row * DM, v, lane);
        dc = dn; ic = in; in = i2;
    }
#undef L0ROW
}
__device__ __forceinline__ void phase_final(const Params& P, int lane, int wave, int G) {
    const float* mod = (const float*)(P.ws + WS_MOD); const bf16* Y = (const bf16*)(P.ws + WS_HPERM);
    const int* rs = (const int*)(P.ws + WS_ROUTE_S); const float* rw = (const float*)(P.ws + WS_ROUTE_W);
    const bf16* X3 = (const bf16*)(P.ws + WS_X3);
    const int st = G * 8; int row = blockIdx.x * 8 + wave; if (row >= M1) return;
    CombIdx ic, in; CombData dc, dn;
    comb_load_idx(rs, rw, row, ic); comb_load_data(X3 + (size_t)row * DM, Y, ic, lane, dc);
    { const int r1 = row + st < M1 ? row + st : row; comb_load_idx(rs, rw, r1, in); }
    for (; row < M1; row += st) {
        const int r1 = row + st < M1 ? row + st : row, r2 = row + 2 * st < M1 ? row + 2 * st : r1;
        comb_load_data(X3 + (size_t)r1 * DM, Y, in, lane, dn);
        CombIdx i2; comb_load_idx(rs, rw, r2, i2);
        const int b = row >> 12;
        float* xr = P.out + (size_t)row * DM;
        f32x4 v[4]; comb_apply(v, dc, ic, mod + (size_t)(9 + b) * 6144 + 5120, lane);
        float ss = 0.f;
#pragma unroll
        for (int j = 0; j < 4; ++j) ss += (v[j][0] * v[j][0] + v[j][1] * v[j][1]) + (v[j][2] * v[j][2] + v[j][3] * v[j][3]);
        const float rr = rsqrtf(wave_sum(ss) * (1.f / 1024.f) + RMS_EPS);
#pragma unroll
        for (int j = 0; j < 4; ++j) ((f32x4*)xr)[lane + 64 * j] = v[j] * rr * ((const f32x4*)P.in[I_FING])[lane + 64 * j];
        dc = dn; ic = in; in = i2;
    }
}
__device__ __forceinline__ void phase_rowstat(const Params& P, int lane, int wave, int G) {
    const bf16* CQ = (const bf16*)(P.ws + WS_CQ); const bf16* CKV = (const bf16*)(P.ws + WS_CKV); float* rq = (float*)(P.ws + WS_RQ); float* rkv = (float*)(P.ws + WS_RKV);
    for (int row = blockIdx.x * 8 + wave; row < M0; row += G * 8) {
        float sq = 0.f, sk = 0.f;
        if (lane < 48) { const u32x4 a = ((const u32x4*)(CQ + (size_t)row * 384))[lane];
            sq = (bflo(a.x) * bflo(a.x) + bfhi(a.x) * bfhi(a.x)) + (bflo(a.y) * bflo(a.y) + bfhi(a.y) * bfhi(a.y)) + (bflo(a.z) * bflo(a.z) + bfhi(a.z) * bfhi(a.z)) + (bflo(a.w) * bflo(a.w) + bfhi(a.w) * bfhi(a.w)); }
        if (lane < 32) { const u32x4 a = ((const u32x4*)(CKV + (size_t)row * 256))[lane];
            sk = (bflo(a.x) * bflo(a.x) + bfhi(a.x) * bfhi(a.x)) + (bflo(a.y) * bflo(a.y) + bfhi(a.y) * bfhi(a.y)) + (bflo(a.z) * bflo(a.z) + bfhi(a.z) * bfhi(a.z)) + (bflo(a.w) * bflo(a.w) + bfhi(a.w) * bfhi(a.w)); }
        sq = wave_sum(sq); sk = wave_sum(sk);
        if (lane == 0) { rq[row] = rsqrtf(sq * (1.f / 384.f) + RMS_EPS); rkv[row] = rsqrtf(sk * (1.f / 256.f) + RMS_EPS); }
    }
}

constexpr int LRU_UXF = 0;
constexpr int LRU_UF = 17408;
constexpr int LRU_UB = LRU_UF + 16384;
constexpr int LRU_G = LRU_UB + 8192;
__device__ __forceinline__ int crow32(int r, int hi) { return (r & 3) + 8 * (r >> 2) + 4 * hi; }
struct LruK { float cw[4][8]; float cb[8]; float ba, bx, sp; bf16x8 bf[4]; int h; };
struct LruTile { u32x4 a, b; };
__device__ __forceinline__ void lru_load_consts(const Params& P, int h, int tid, int lane, int wave, LruK& K) {
    const int c0 = (tid & 7) * 8; const float* cw = P.in[I_LCW]; const float* cb = P.in[I_LCB];
#pragma unroll
    for (int i = 0; i < 8; ++i) { const int ch = h * 64 + c0 + i; K.cb[i] = cb[ch];
#pragma unroll
        for (int j = 0; j < 4; ++j) K.cw[j][i] = cw[j * 512 + ch]; }
    { const int c = tid & 63, d = (tid >> 6) & 1, ch = h * 64 + c; K.ba = P.in[I_LBA][d * 512 + ch]; K.bx = P.in[I_LBX][d * 512 + ch]; K.sp = log1pf(expf(-P.in[I_LLAM][d * 512 + ch])); }
    { const bf16* WgT = (const bf16*)(P.ws + WS_WG) + (size_t)h * 256 * 64; const int n = wave * 32 + (lane & 31), hi = lane >> 5;
#pragma unroll
      for (int ks = 0; ks < 4; ++ks) K.bf[ks] = *(const bf16x8*)(WgT + (size_t)n * 64 + 16 * ks + 8 * hi); }
    K.h = h;
}
__device__ __forceinline__ void lru_tile_load(const bf16* UX, int b, int ck, int h, int tid, LruTile& T) {
    const int seg_lo = ck < 4 ? 0 : CTXL, seg_hi = ck < 4 ? CTXL : TC, p0 = ck * 64 - 2, c8 = (tid & 7) * 8;
    T.a = (u32x4){0u, 0u, 0u, 0u}; T.b = (u32x4){0u, 0u, 0u, 0u};
    { const int pos = p0 + (tid >> 3); if (pos >= seg_lo && pos < seg_hi) T.a = *(const u32x4*)(UX + (size_t)(b * TC + pos) * 512 + h * 64 + c8); }
    if (tid < 24) { const int pos = p0 + 64 + (tid >> 3); if (pos >= seg_lo && pos < seg_hi) T.b = *(const u32x4*)(UX + (size_t)(b * TC + pos) * 512 + h * 64 + c8); }
}
__device__ __forceinline__ void st8f(float* d, const u32x4 a) { d[0] = bflo(a.x); d[1] = bfhi(a.x); d[2] = bflo(a.y); d[3] = bfhi(a.y); d[4] = bflo(a.z); d[5] = bfhi(a.z); d[6] = bflo(a.w); d[7] = bfhi(a.w); }
constexpr int LRU_QP = LRU_G + 65536;
constexpr int LRU_QS = LRU_QP + 2048;
constexpr int LRU_HQ = LRU_QS + 2048;
template <int MODE> __device__ __forceinline__ void lru_coeffs(unsigned char* lds, const LruTile& T, const LruK& K, int tid, int lane, int wave) {
    float* uxf = (float*)(lds + LRU_UXF); float* uf = (float*)(lds + LRU_UF); bf16* ub = (bf16*)(lds + LRU_UB); float* Gm = (float*)(lds + LRU_G);
    __syncthreads();
    st8f(uxf + (tid >> 3) * 64 + (tid & 7) * 8, T.a);
    if (tid < 24) st8f(uxf + (64 + (tid >> 3)) * 64 + (tid & 7) * 8, T.b);
    __syncthreads();
    { const int t = tid >> 3, c0 = (tid & 7) * 8; float uo[8];
#pragma unroll
      for (int i = 0; i < 8; ++i) { float u = K.cb[i];
#pragma unroll
          for (int j = 0; j < 4; ++j) u += K.cw[j][i] * uxf[(t + j) * 64 + c0 + i];
          uo[i] = u; uf[t * 64 + c0 + i] = u; }
      u32x4 w; w.x = pk2(uo[0], uo[1]); w.y = pk2(uo[2], uo[3]); w.z = pk2(uo[4], uo[5]); w.w = pk2(uo[6], uo[7]);
      *(u32x4*)(ub + t * 64 + c0) = w; }
    __syncthreads();
    {
        const int r32 = lane & 31, hi = lane >> 5, n = wave * 32 + r32;
        f32x16 acc0 = {}, acc1 = {};
#pragma unroll
        for (int ks = 0; ks < 4; ++ks) {
            const bf16x8 a0 = *(const bf16x8*)(ub + (r32) * 64 + 16 * ks + 8 * hi), a1 = *(const bf16x8*)(ub + (32 + r32) * 64 + 16 * ks + 8 * hi);
            acc0 = __builtin_amdgcn_mfma_f32_32x32x16_bf16(a0, K.bf[ks], acc0, 0, 0, 0);
            acc1 = __builtin_amdgcn_mfma_f32_32x32x16_bf16(a1, K.bf[ks], acc1, 0, 0, 0);
        }
#pragma unroll
        for (int r = 0; r < 16; ++r) { Gm[crow32(r, hi) * 256 + n] = acc0[r]; Gm[(32 + crow32(r, hi)) * 256 + n] = acc1[r]; }
    }
    __syncthreads();
    { const int c = tid & 63, d = (tid >> 6) & 1, tg = tid >> 7;
      constexpr float L2E = 1.4426950408889634f; const float kba = K.ba, kbx = K.bx, ksp8 = -8.f * K.sp;
      float* g0 = Gm + (tg * 16) * 256 + d * 128 + c; const float* u0 = uf + (tg * 16) * 64 + c;
      float hh = 0.f, pp = 1.f;
#pragma unroll 2
      for (int k = 0; k < 8; ++k) { const int i = d ? 14 - 2 * k : 2 * k;
          const f32x2 ga = (f32x2){g0[i * 256] + kba, g0[(i + 1) * 256] + kba}, gx = (f32x2){g0[i * 256 + 64] + kbx, g0[(i + 1) * 256 + 64] + kbx};
          const f32x2 ta = ga * (-L2E), tx = gx * (-L2E);
          const f32x2 ea = (f32x2){__builtin_amdgcn_exp2f(ta[0]), __builtin_amdgcn_exp2f(ta[1])} + 1.f, ex = (f32x2){__builtin_amdgcn_exp2f(tx[0]), __builtin_amdgcn_exp2f(tx[1])} + 1.f;
          const f32x2 r = {__builtin_amdgcn_rcpf(ea[0]), __builtin_amdgcn_rcpf(ea[1])}, ii = {__builtin_amdgcn_rcpf(ex[0]), __builtin_amdgcn_rcpf(ex[1])};
          const f32x2 la = r * ksp8, tl = la * L2E;
          const f32x2 a = {__builtin_amdgcn_exp2f(tl[0]), __builtin_amdgcn_exp2f(tl[1])};
          const f32x2 x2 = la + la;
          const f32x2 emp = -x2 * (x2 * (x2 * (x2 * 0.041666668f + 0.16666667f) + 0.5f) + 1.f);
          const f32x2 ema = 1.f - a * a;
          const f32x2 em = {x2[0] > -0.25f ? emp[0] : ema[0], x2[1] > -0.25f ? emp[1] : ema[1]};
          const f32x2 sq = {__builtin_amdgcn_sqrtf(em[0]), __builtin_amdgcn_sqrtf(em[1])};
          const f32x2 bb = sq * (ii * (f32x2){u0[i * 64], u0[(i + 1) * 64]});
          const float a_f = d ? a[1] : a[0], a_s = d ? a[0] : a[1], b_f = d ? bb[1] : bb[0], b_s = d ? bb[0] : bb[1];
          hh = a_f * hh + b_f; pp *= a_f; const float h_f = hh, p_f = pp;
          hh = a_s * hh + b_s; pp *= a_s;
          if (MODE == 3) { const int of = d ? i + 1 : i, os = d ? i : i + 1;
              g0[of * 256] = h_f; g0[of * 256 + 64] = p_f; g0[os * 256] = hh; g0[os * 256 + 64] = pp; } }
      ((float*)(lds + LRU_QP))[(d * 4 + tg) * 64 + c] = pp; ((float*)(lds + LRU_QS))[(d * 4 + tg) * 64 + c] = hh; }
    __syncthreads();
}
__device__ __forceinline__ void lru_unit(int u, int& b, int& ck, int& h) { h = u & 7; ck = (u >> 3) % LCH; b = u / (8 * LCH); }
__device__ __forceinline__ void phase_lru_f1(const Params& P, unsigned char* lds, int tid, int lane, int wave, int G) {
    float* Gm = (float*)(lds + LRU_G); float* CP = (float*)(P.ws + WS_CP); float* CS = (float*)(P.ws + WS_CS); const bf16* UX = (const bf16*)(P.ws + WS_UX);
    constexpr int NU = NB * LCH * 8;
    int u = blockIdx.x; if (u >= NU) return;
    int b, ck, h; lru_unit(u, b, ck, h);
    LruK K; lru_load_consts(P, h, tid, lane, wave, K);
    LruTile T; lru_tile_load(UX, b, ck, h, tid, T);
    for (;;) {
        if (h != K.h) lru_load_consts(P, h, tid, lane, wave, K);
        lru_coeffs<1>(lds, T, K, tid, lane, wave);
        const int un = u + G; int bn = 0, ckn = 0, hn = h;
        if (un < NU) { lru_unit(un, bn, ckn, hn); lru_tile_load(UX, bn, ckn, hn, tid, T); }
        if (tid < 128) { const int d = tid >> 6, c = tid & 63; float hh = 0.f, pp = 1.f;
            const float* QP = (const float*)(lds + LRU_QP); const float* QS = (const float*)(lds + LRU_QS);
#pragma unroll
            for (int k = 0; k < 4; ++k) { const int q = d ? 3 - k : k; const float a = QP[(d * 4 + q) * 64 + c], bb = QS[(d * 4 + q) * 64 + c]; hh = a * hh + bb; pp *= a; }
            const size_t o = ((size_t)(d * 8 + b) * LCH + ck) * 512 + h * 64 + c; CP[o] = pp; CS[o] = hh; }
        if (un >= NU) break;
        u = un; b = bn; ck = ckn; h = hn;
    }
    __syncthreads();
}
__device__ __forceinline__ void phase_lru_carry(const Params& P, int lane, int wave, int G) {
    const float* CP = (const float*)(P.ws + WS_CP); const float* CS = (const float*)(P.ws + WS_CS); float* HIN = (float*)(P.ws + WS_HIN);
    if (wave != 0) return;
    for (int sb = blockIdx.x; sb < 128; sb += G) {
        const int s = sb * 64 + lane, d = s >> 12, b = (s >> 9) & 7, ch = s & 511; const size_t base = ((size_t)(d * 8 + b) * LCH) * 512 + ch;
        float hh = 0.f;
#pragma unroll 1
        for (int st = 0; st < LCH; st += 17) { float cp[17], cs[17]; int q[17];
#pragma unroll
            for (int i = 0; i < 17; ++i) { const int step = st + i; q[i] = d == 0 ? step : (step < 4 ? 3 - step : 71 - step); cp[i] = CP[base + (size_t)q[i] * 512]; cs[i] = CS[base + (size_t)q[i] * 512]; }
#pragma unroll
            for (int i = 0; i < 17; ++i) { HIN[base + (size_t)q[i] * 512] = hh; hh = cp[i] * hh + cs[i]; } }
    }
}
__device__ __forceinline__ float gelu_tanh(float x) { const float u = 0.7978845608028654f * (x + 0.044715f * x * x * x); return x * __builtin_amdgcn_rcpf(1.f + __expf(-2.f * u)); }
__device__ __forceinline__ void phase_lru_f3(const Params& P, unsigned char* lds, int tid, int lane, int wave, int G) {
    float* Gm = (float*)(lds + LRU_G); const bf16* UX = (const bf16*)(P.ws + WS_UX);
    const bf16* UG = (const bf16*)(P.ws + WS_UG); bf16* MIX = (bf16*)(P.ws + WS_RH); const float* HIN = (const float*)(P.ws + WS_HIN);
    constexpr int NU = NB * LCH * 8;
    int u = blockIdx.x; if (u >= NU) return;
    int b, ck, h; lru_unit(u, b, ck, h);
    LruK K; lru_load_consts(P, h, tid, lane, wave, K);
    LruTile T; lru_tile_load(UX, b, ck, h, tid, T);
    const int t = tid >> 3, c0 = (tid & 7) * 8;
    u32x4 gq = *(const u32x4*)(UG + ((size_t)b * TC + ck * 64 + t) * 512 + h * 64 + c0);
    float hin = 0.f; if (tid < 128) hin = HIN[((size_t)((tid >> 6) * 8 + b) * LCH + ck) * 512 + h * 64 + (tid & 63)];
    for (;;) {
        if (h != K.h) lru_load_consts(P, h, tid, lane, wave, K);
        lru_coeffs<3>(lds, T, K, tid, lane, wave);
        const u32x4 g = gq; const float hh0 = hin;
        const int un = u + G; int bn = 0, ckn = 0, hn = h;
        if (un < NU) { lru_unit(un, bn, ckn, hn); lru_tile_load(UX, bn, ckn, hn, tid, T);
            gq = *(const u32x4*)(UG + ((size_t)bn * TC + ckn * 64 + t) * 512 + hn * 64 + c0);
            if (tid < 128) hin = HIN[((size_t)((tid >> 6) * 8 + bn) * LCH + ckn) * 512 + hn * 64 + (tid & 63)]; }
        float* HQ = (float*)(lds + LRU_HQ);
        if (tid < 128) { const int d = tid >> 6, c = tid & 63; float hh = hh0;
            const float* QP = (const float*)(lds + LRU_QP); const float* QS = (const float*)(lds + LRU_QS);
#pragma unroll
            for (int k = 0; k < 4; ++k) { const int q = d ? 3 - k : k; HQ[(d * 4 + q) * 64 + c] = hh; hh = QP[(d * 4 + q) * 64 + c] * hh + QS[(d * 4 + q) * 64 + c]; } }
        __syncthreads();
        { const size_t row = (size_t)b * TC + ck * 64 + t; const int q = t >> 4;
          const float gv[8] = {bflo(g.x), bfhi(g.x), bflo(g.y), bfhi(g.y), bflo(g.z), bfhi(g.z), bflo(g.w), bfhi(g.w)};
          float o[8];
#pragma unroll
          for (int i = 0; i < 8; ++i) { const int cc = c0 + i;
              const float y = (Gm[t * 256 + cc] + Gm[t * 256 + 64 + cc] * HQ[q * 64 + cc]) + (Gm[t * 256 + 128 + cc] + Gm[t * 256 + 192 + cc] * HQ[(4 + q) * 64 + cc]);
              o[i] = y * gelu_tanh(gv[i]); }
          u32x4 w; w.x = pk2(o[0], o[1]); w.y = pk2(o[2], o[3]); w.z = pk2(o[4], o[5]); w.w = pk2(o[6], o[7]);
          *(u32x4*)(MIX + row * 1024 + 512 + h * 64 + c0) = w; }
        if (un >= NU) break;
        u = un; b = bn; ck = ckn; h = hn;
    }
    __syncthreads();
}

namespace att {
constexpr int NW = 8, QBLK = 32, KVBLK = 64;
constexpr float SCALE = 0.10206207261596575f;
constexpr float THR = 8.f;
constexpr int LDQ = 768, LDK = 768, LDV = 512, LDO = 1024;
constexpr int SHM_V = 16384, SHM_K = 16384, SHM_ATTN = 2 * SHM_V + 2 * SHM_K + NW * 64 * 4;
#define KSWZ(row, colB) ((row) * 256 + ((colB) ^ (((row) & 7) << 4)))
#define SBAR() __builtin_amdgcn_sched_barrier(0)
__device__ __forceinline__ int crow(int r, int hi) { return (r & 3) + 8 * (r >> 2) + 4 * hi; }
__device__ __forceinline__ unsigned cvtpk(float lo, float hi) { unsigned r; asm volatile("v_cvt_pk_bf16_f32 %0, %1, %2" : "=v"(r) : "v"(lo), "v"(hi)); return r; }
__device__ __forceinline__ void partialSM(f32x16& p0, f32x16& p1, float& m_reg, float& mn, float& alpha) {
  constexpr float C = SCALE * 1.4426950408889634f;
  float pmax = p0[0];
#pragma unroll
  for (int r = 1; r < 16; ++r) pmax = fmaxf(pmax, p0[r]);
#pragma unroll
  for (int r = 0; r < 16; ++r) pmax = fmaxf(pmax, p1[r]);
  { auto rr = __builtin_amdgcn_permlane32_swap(__float_as_uint(pmax), __float_as_uint(pmax), false, false);
    pmax = fmaxf(__uint_as_float(rr[0]), __uint_as_float(rr[1])); }
  if (__builtin_expect(__all(pmax - m_reg <= THR / SCALE), 1)) { mn = m_reg; alpha = 1.f; }
  else { mn = fmaxf(m_reg, pmax); alpha = __builtin_amdgcn_exp2f((m_reg - mn) * C); m_reg = mn; }
  float mnC = -mn * C;
#pragma unroll
  for (int r = 0; r < 16; ++r) p0[r] = fmaf(p0[r], C, mnC);
#pragma unroll
  for (int r = 0; r < 16; ++r) p1[r] = fmaf(p1[r], C, mnC);
#pragma unroll
  for (int r = 0; r < 16; ++r) p0[r] = __builtin_amdgcn_exp2f(p0[r]);
}
__device__ __forceinline__ void finishSM(f32x16& p0, f32x16& p1, float alpha, float& l_reg, bf16x8& pa0, bf16x8& pa1, bf16x8& pa2, bf16x8& pa3) {
#pragma unroll
  for (int r = 0; r < 16; ++r) p1[r] = __builtin_amdgcn_exp2f(p1[r]);
  float ps = 0;
#pragma unroll
  for (int r = 0; r < 16; ++r) ps += p0[r];
#pragma unroll
  for (int r = 0; r < 16; ++r) ps += p1[r];
  { auto rr = __builtin_amdgcn_permlane32_swap(__float_as_uint(ps), __float_as_uint(ps), false, false);
    ps = __uint_as_float(rr[0]) + __uint_as_float(rr[1]); }
  l_reg = l_reg * alpha + ps;
#define PK4(P, BASE, OUT) do { unsigned a0 = cvtpk(P[BASE + 0], P[BASE + 1]), a1 = cvtpk(P[BASE + 2], P[BASE + 3]);   \
    unsigned b0 = cvtpk(P[BASE + 4], P[BASE + 5]), b1 = cvtpk(P[BASE + 6], P[BASE + 7]);                              \
    auto r0 = __builtin_amdgcn_permlane32_swap(a0, b0, false, false); auto r1 = __builtin_amdgcn_permlane32_swap(a1, b1, false, false); \
    u32x4 w = {r0[0], r1[0], r0[1], r1[1]}; OUT = *reinterpret_cast<bf16x8*>(&w); } while (0)
  PK4(p0, 0, pa0); PK4(p0, 8, pa1); PK4(p1, 0, pa2); PK4(p1, 8, pa3);
#undef PK4
}
__device__ __forceinline__ void qkt(f32x16& p0, f32x16& p1, const bf16* Ks, const bf16x8* qr, int r32, int hi) {
  p0 = f32x16{}; p1 = f32x16{};
#pragma unroll
  for (int d0 = 0; d0 < 6; ++d0) { int cb = (d0 * 16 + hi * 8) * 2;
    bf16x8 b0 = *reinterpret_cast<const bf16x8*>((const char*)Ks + KSWZ(r32, cb));
    bf16x8 b1 = *reinterpret_cast<const bf16x8*>((const char*)Ks + KSWZ(32 + r32, cb));
    p0 = __builtin_amdgcn_mfma_f32_32x32x16_bf16(b0, qr[d0], p0, 0, 0, 0);
    p1 = __builtin_amdgcn_mfma_f32_32x32x16_bf16(b1, qr[d0], p1, 0, 0, 0); }
}
__device__ __forceinline__ int v_st(int k, int c) { const int kk = (k & ~0xC) | ((k & 4) << 1) | ((k & 8) >> 1); return ((kk >> 3) * 4 + (c >> 5)) * 512 + ((kk & 7) * 32 + (c & 31)) * 2; }
__device__ __forceinline__ int v_rd_base(int lane) { return ((lane & 3) << 3) | (((lane >> 2) & 3) << 6) | (((lane >> 4) & 1) << 5) | (((lane >> 5) & 1) << 8); }
constexpr int v_rd_off(int d0, int ks, int half) { return d0 * 512 + ks * 4096 + half * 2048; }
template <int OFF> __device__ __forceinline__ s16x4 tr_read(int vb) {
  s16x4 r; asm volatile("ds_read_b64_tr_b16 %0, %1 offset:%2" : "=&v"(r) : "v"(vb), "i"(OFF) : "memory"); return r;
}
template <int D0> __device__ __forceinline__ void pv_one(f32x16& od, int vb, bf16x8 pa0, bf16x8 pa1, bf16x8 pa2, bf16x8 pa3) {
  const s16x4 l0 = tr_read<v_rd_off(D0, 0, 0)>(vb), h0 = tr_read<v_rd_off(D0, 0, 1)>(vb), l1 = tr_read<v_rd_off(D0, 1, 0)>(vb), h1 = tr_read<v_rd_off(D0, 1, 1)>(vb);
  const s16x4 l2 = tr_read<v_rd_off(D0, 2, 0)>(vb), h2 = tr_read<v_rd_off(D0, 2, 1)>(vb), l3 = tr_read<v_rd_off(D0, 3, 0)>(vb), h3 = tr_read<v_rd_off(D0, 3, 1)>(vb);
  asm volatile("s_waitcnt lgkmcnt(0)" ::: "memory"); SBAR();
#define PK(L, H) (bf16x8){L[0], L[1], L[2], L[3], H[0], H[1], H[2], H[3]}
  od = __builtin_amdgcn_mfma_f32_32x32x16_bf16(pa0, PK(l0, h0), od, 0, 0, 0);
  od = __builtin_amdgcn_mfma_f32_32x32x16_bf16(pa1, PK(l1, h1), od, 0, 0, 0);
  od = __builtin_amdgcn_mfma_f32_32x32x16_bf16(pa2, PK(l2, h2), od, 0, 0, 0);
  od = __builtin_amdgcn_mfma_f32_32x32x16_bf16(pa3, PK(l3, h3), od, 0, 0, 0);
#undef PK
}
__device__ __forceinline__ void pv_d0(f32x16* o, int vb, bf16x8 pa0, bf16x8 pa1, bf16x8 pa2, bf16x8 pa3) {
  pv_one<0>(o[0], vb, pa0, pa1, pa2, pa3); pv_one<1>(o[1], vb, pa0, pa1, pa2, pa3);
}
__device__ __forceinline__ void attn_dense_body(const bf16* __restrict__ Qb, const bf16* __restrict__ Kh, const bf16* __restrict__ Vh, bf16* __restrict__ Ob, int seq, int tq0  , char* lds) {
  const int tid = threadIdx.x, wid = tid >> 6, lane = tid & 63, r32 = lane & 31, hi = lane >> 5;
  bf16* V_lds = (bf16*)lds; bf16* K_lds = (bf16*)(lds + 2 * SHM_V);
  float* ws = (float*)(lds + 2 * SHM_V + 2 * SHM_K) + wid * 64; float* li_l = ws; float* al_l = ws + 32;
  float m_reg = -1e30f, l_reg = 0; f32x16 o[2] = {}; bf16x8 qr[6];
  const bf16* Qw = Qb + (long)(wid * QBLK + r32) * LDQ + hi * 8;
#pragma unroll
  for (int d0 = 0; d0 < 6; ++d0) qr[d0] = *reinterpret_cast<const bf16x8*>(Qw + d0 * 16);
  {
    const int tq = tq0 + wid * QBLK + r32; const bool on = tq0 >= 0;
    constexpr float IF[8] = {1.0f, 0.316227766f, 0.1f, 0.0316227766f, 0.01f, 0.00316227766f, 0.001f, 0.000316227766f};
#pragma unroll
    for (int ax = 0; ax < 2; ++ax) { const float pos = (float)(ax == 0 ? (tq >> 6) : (tq & 63)) * 0.15915494309189535f;
      bf16x8 qv = qr[4 + ax]; bf16x8 qo;
#pragma unroll
      for (int i = 0; i < 8; ++i) { const float x = __uint_as_float(((unsigned)(unsigned short)qv[i]) << 16); const float other = __shfl_xor(x, 32);
        const float sn = __builtin_amdgcn_sinf(pos * IF[i]), cs = __builtin_amdgcn_cosf(pos * IF[i]);
        const float r = hi == 0 ? x * cs - other * sn : other * sn + x * cs;
        unsigned u = __float_as_uint(on ? r : x); u = (u + 0x7fffu + ((u >> 16) & 1u)) >> 16; qo[i] = (short)u; }
      qr[4 + ax] = qo; }
  }
  const int sr = tid >> 3, sc = (tid & 7) * 8, vst = v_st(sr, sc), kr2 = (tid >> 2) & 63, kc2 = 64 + (tid & 3) * 8; const bool kb2 = tid < 256;
  const int vb0 = (int)(uintptr_t)V_lds + v_rd_base(lane);
  struct { bf16x8 vs, ka, kb; } sr_[2];
#define SLOAD(i, k0) do { sr_[i].vs = *reinterpret_cast<const bf16x8*>(&Vh[(long)((k0) + sr) * LDV + sc]); \
    sr_[i].ka = *reinterpret_cast<const bf16x8*>(&Kh[(long)((k0) + sr) * LDK + sc]); \
    if (kb2) sr_[i].kb = *reinterpret_cast<const bf16x8*>(&Kh[(long)((k0) + kr2) * LDK + kc2]); } while (0)
#define SWRITE(b, i) do { *(bf16x8*)((char*)V_lds + (b) * SHM_V + vst) = sr_[i].vs;          \
    *(bf16x8*)((char*)K_lds + (b) * SHM_K + KSWZ(sr, sc * 2)) = sr_[i].ka;                       \
    if (kb2) *(bf16x8*)((char*)K_lds + (b) * SHM_K + KSWZ(kr2, kc2 * 2)) = sr_[i].kb; } while (0)
#define SWAIT() asm volatile("s_waitcnt vmcnt(3)" ::: "memory")
#define RESC(a) do { if (__any((a) < 1.f)) { if (hi == 0) al_l[r32] = (a); asm volatile("s_waitcnt lgkmcnt(0)" ::: "memory"); \
    _Pragma("unroll") for (int d = 0; d < 2; ++d) _Pragma("unroll") for (int r = 0; r < 16; ++r) o[d][r] *= al_l[crow(r, hi)]; } } while (0)
  f32x16 pA0, pA1, pB0, pB1; float mnA, mnB, alA, alB; bf16x8 pa0, pa1, pa2, pa3; const int NT = seq / KVBLK;
  constexpr int SE = 0, SO = 1;
  SLOAD(SE, 0); asm volatile("s_waitcnt vmcnt(0)" ::: "memory"); SWRITE(0, SE); __syncthreads();
  qkt(pA0, pA1, K_lds, qr, r32, hi); partialSM(pA0, pA1, m_reg, mnA, alA);
  SLOAD(SO, KVBLK); if (2 < NT) SLOAD(SE, 2 * KVBLK);
  SWAIT(); SWRITE(1, SO); __syncthreads();
#ifndef ATT_SKEW
#define ATT_SKEW 0
#endif
  const bool swp = ATT_SKEW > 0 && (__builtin_amdgcn_readfirstlane(wid) >= 4);
  for (int j = 1; j + 1 < NT; j += 2) {
    if (swp) __builtin_amdgcn_s_sleep(ATT_SKEW);
    SBAR(); qkt(pB0, pB1, (bf16*)((char*)K_lds + SHM_K), qr, r32, hi);
    finishSM(pA0, pA1, alA, l_reg, pa0, pa1, pa2, pa3); SBAR();
    SLOAD(SO, (j + 2) * KVBLK); SBAR();
    pv_d0(o, vb0, pa0, pa1, pa2, pa3); partialSM(pB0, pB1, m_reg, mnB, alB);
    __syncthreads(); SWAIT(); SWRITE(0, SE);
    RESC(alB); __syncthreads();
    if (swp) __builtin_amdgcn_s_sleep(ATT_SKEW);
    SBAR(); qkt(pA0, pA1, K_lds, qr, r32, hi);
    finishSM(pB0, pB1, alB, l_reg, pa0, pa1, pa2, pa3); SBAR();
    if (j + 3 < NT) SLOAD(SE, (j + 3) * KVBLK); SBAR();
    pv_d0(o, vb0 + (int)SHM_V, pa0, pa1, pa2, pa3); partialSM(pA0, pA1, m_reg, mnA, alA);
    __syncthreads(); SWAIT(); SWRITE(1, SO);
    RESC(alA); __syncthreads();
  }
  SBAR(); qkt(pB0, pB1, (bf16*)((char*)K_lds + SHM_K), qr, r32, hi);
  finishSM(pA0, pA1, alA, l_reg, pa0, pa1, pa2, pa3); SBAR();
  pv_d0(o, vb0, pa0, pa1, pa2, pa3); partialSM(pB0, pB1, m_reg, mnB, alB);
  __syncthreads(); RESC(alB);
  finishSM(pB0, pB1, alB, l_reg, pa0, pa1, pa2, pa3); SBAR();
  pv_d0(o, vb0 + (int)SHM_V, pa0, pa1, pa2, pa3);
  if (hi == 0) li_l[r32] = l_reg; asm volatile("s_waitcnt lgkmcnt(0)" ::: "memory");
  float rli[16];
#pragma unroll
  for (int r = 0; r < 16; ++r) rli[r] = __builtin_amdgcn_rcpf(li_l[crow(r, hi)]);
  bf16* Ow = Ob + (long)(wid * QBLK) * LDO;
#pragma unroll
  for (int r = 0; r < 16; ++r) { int orow = crow(r, hi);
#pragma unroll
    for (int d0 = 0; d0 < 2; ++d0) Ow[(long)orow * LDO + d0 * 32 + r32] = (bf16)f2bf(o[d0][r] * rli[r]); }
#undef SLOAD
#undef SWRITE
#undef SWAIT
#undef RESC
}

}

__device__ __forceinline__ void phase_attention(const Params& P, unsigned char* lds, int G) {
    const bf16* Q = (const bf16*)(P.ws + WS_Q); const bf16* K = (const bf16*)(P.ws + WS_K); const bf16* V = (const bf16*)(P.ws + WS_V); bf16* MIX = (bf16*)(P.ws + WS_RH);
    for (int idx = blockIdx.x; idx < 1024 + 64; idx += G) {
        int b, h, seq; size_t qrow;
        if (idx < 1024) { const int bh = idx >> 4, qb = idx & 15; b = bh >> 3; h = bh & 7; qrow = (size_t)b * TC + CTXL + qb * 256; seq = TC; }
        else { const int j = idx - 1024; b = j >> 3; h = j & 7; qrow = (size_t)b * TC; seq = CTXL; }
        att::attn_dense_body(Q + qrow * 768 + h * 96, K + (size_t)b * TC * 768 + h * 96, V + (size_t)b * TC * 512 + h * 64, MIX + qrow * 1024 + h * 64, seq, idx < 1024 ? (idx & 15) * 256 : -1, (char*)lds);
        __syncthreads();
    }
}

typedef float cf __attribute__((ext_vector_type(2)));
__device__ __forceinline__ cf cmul(cf a, cf b) { return a * (cf){b.x, b.x} + (cf){a.y, a.x} * (cf){-b.y, b.y}; }
__device__ __forceinline__ cf cis_rev(float rev) { return cf{__builtin_amdgcn_cosf(rev), __builtin_amdgcn_sinf(rev)}; }
template <int S> __device__ __forceinline__ void dft4(cf& a, cf& b, cf& c, cf& d) {
    const cf t0 = a + c, t1 = a - c, t2 = b + d, t3 = b - d;
    const cf t3i = (cf){-(float)S * t3.y, (float)S * t3.x};
    a = t0 + t2; c = t0 - t2; b = t1 + t3i; d = t1 - t3i;
}
template <int S> __device__ __forceinline__ void dft16(cf (&v)[16]) {
#pragma unroll
    for (int j0 = 0; j0 < 4; ++j0) dft4<S>(v[j0], v[j0 + 4], v[j0 + 8], v[j0 + 12]);
    constexpr float C1 = 0.9238795325112867f, S1 = 0.3826834323650898f, C2 = 0.7071067811865476f;
    v[5] = cmul(v[5], cf{C1, S * S1}); v[9] = cmul(v[9], cf{C2, S * C2}); v[13] = cmul(v[13], cf{S1, S * C1});
    v[6] = cmul(v[6], cf{C2, S * C2}); v[10] = (cf){-(float)S * v[10].y, (float)S * v[10].x}; v[14] = cmul(v[14], cf{-C2, S * C2});
    v[7] = cmul(v[7], cf{S1, S * C1}); v[11] = cmul(v[11], cf{-C2, S * C2}); v[15] = cmul(v[15], cf{-C1, -S * S1});
#pragma unroll
    for (int k1 = 0; k1 < 4; ++k1) dft4<S>(v[4 * k1], v[4 * k1 + 1], v[4 * k1 + 2], v[4 * k1 + 3]);
}
#define REV4(k) ((((k) >> 2) | (((k) & 3) << 2)))
__device__ __forceinline__ int fphys(int L) { return L + (L >> 4); }
constexpr int FFT_BUF = 4352 * 8;
constexpr int FFT_ZB = 2 * FFT_BUF;
constexpr int FFT_HB1 = FFT_ZB + 32768;
constexpr int FFT_W3 = FFT_HB1 + 32768;
constexpr int FFT_RED = FFT_W3 + 1024;
static_assert(FFT_RED + 64 <= LDSCTL_OFF, "fft lds");
template <int PAT> __device__ __forceinline__ int fbase(int tp) {
    if (PAT == 0) return tp + (tp >> 4);
    if (PAT == 1) return (tp & 15) + 272 * (tp >> 4);
    return 17 * (tp & 15) + 272 * (tp >> 4);
}
template <int PAT> struct FStr { static constexpr int v = PAT == 0 ? 272 : (PAT == 1 ? 17 : 1); };
__device__ __forceinline__ int hide(int x) { asm volatile("" : "+v"(x)); return x; }
#if defined(__HIP_DEVICE_COMPILE__)
template <int OFF> __device__ __forceinline__ cf lds_rd64(unsigned addr) { f32x2 r; asm volatile("ds_read_b64 %0, %1 offset:%2" : "=v"(r) : "v"(addr), "i"(OFF) : "memory"); return cf{r[0], r[1]}; }
template <int OFF> __device__ __forceinline__ void lds_wr64(unsigned addr, cf x) { f32x2 r = {x.x, x.y}; asm volatile("ds_write_b64 %0, %1 offset:%2" :: "v"(addr), "v"(r), "i"(OFF) : "memory"); }
#define FFT_LGKM0() asm volatile("s_waitcnt lgkmcnt(0)" ::: "memory")
#else
template <int OFF> __device__ __forceinline__ cf lds_rd64(const cf* p) { return *(const cf*)((const char*)p + OFF); }
template <int OFF> __device__ __forceinline__ void lds_wr64(cf* p, cf x) { *(cf*)((char*)p + OFF) = x; }
#define FFT_LGKM0()
#endif
template <int PAT> __device__ __forceinline__ void fload(cf (&v)[16], const cf* buf, int tp) {
    constexpr int ST = FStr<PAT>::v * 8;
#if defined(__HIP_DEVICE_COMPILE__)
    const unsigned p = (unsigned)(uintptr_t)(buf + fbase<PAT>(tp));
    f32x2 r0, r1, r2, r3, r4, r5, r6, r7, r8, r9, r10, r11, r12, r13, r14, r15;
#define FRD(R, J) asm volatile("ds_read_b64 %0, %1 offset:%2" : "=v"(R) : "v"(p), "i"((J) * ST) : "memory")
    FRD(r0, 0); FRD(r1, 1); FRD(r2, 2); FRD(r3, 3); FRD(r4, 4); FRD(r5, 5); FRD(r6, 6); FRD(r7, 7); FRD(r8, 8); FRD(r9, 9); FRD(r10, 10); FRD(r11, 11); FRD(r12, 12); FRD(r13, 13); FRD(r14, 14); FRD(r15, 15);
#undef FRD
    asm volatile("s_waitcnt lgkmcnt(0)" : "+v"(r0), "+v"(r1), "+v"(r2), "+v"(r3), "+v"(r4), "+v"(r5), "+v"(r6), "+v"(r7), "+v"(r8), "+v"(r9), "+v"(r10), "+v"(r11), "+v"(r12), "+v"(r13), "+v"(r14), "+v"(r15) :: "memory");
    v[0] = cf{r0[0], r0[1]}; v[1] = cf{r1[0], r1[1]}; v[2] = cf{r2[0], r2[1]}; v[3] = cf{r3[0], r3[1]}; v[4] = cf{r4[0], r4[1]}; v[5] = cf{r5[0], r5[1]}; v[6] = cf{r6[0], r6[1]}; v[7] = cf{r7[0], r7[1]};
    v[8] = cf{r8[0], r8[1]}; v[9] = cf{r9[0], r9[1]}; v[10] = cf{r10[0], r10[1]}; v[11] = cf{r11[0], r11[1]}; v[12] = cf{r12[0], r12[1]}; v[13] = cf{r13[0], r13[1]}; v[14] = cf{r14[0], r14[1]}; v[15] = cf{r15[0], r15[1]};
#else
    const cf* p = buf + fbase<PAT>(tp);
#pragma unroll
    for (int j = 0; j < 16; ++j) v[j] = *(const cf*)((const char*)p + j * ST);
#endif
}
template <int PAT> __device__ __forceinline__ void fstore_raw(const cf (&x)[16], cf* buf, int tp) {
#if defined(__HIP_DEVICE_COMPILE__)
    const unsigned p = (unsigned)(uintptr_t)(buf + fbase<PAT>(tp));
#else
    cf* p = buf + fbase<PAT>(tp);
#endif
    constexpr int ST = FStr<PAT>::v * 8;
    lds_wr64<0>(p, x[0]); lds_wr64<ST>(p, x[1]); lds_wr64<2 * ST>(p, x[2]); lds_wr64<3 * ST>(p, x[3]); lds_wr64<4 * ST>(p, x[4]); lds_wr64<5 * ST>(p, x[5]); lds_wr64<6 * ST>(p, x[6]); lds_wr64<7 * ST>(p, x[7]);
    lds_wr64<8 * ST>(p, x[8]); lds_wr64<9 * ST>(p, x[9]); lds_wr64<10 * ST>(p, x[10]); lds_wr64<11 * ST>(p, x[11]); lds_wr64<12 * ST>(p, x[12]); lds_wr64<13 * ST>(p, x[13]); lds_wr64<14 * ST>(p, x[14]); lds_wr64<15 * ST>(p, x[15]);
    FFT_LGKM0();
}
template <int PAT> __device__ __forceinline__ void fstore_geo(cf (&v)[16], cf* buf, int tp, cf t0, cf r) {
    const cf r2 = cmul(r, r); cf te = t0, to = cmul(t0, r); cf x[16];
#pragma unroll
    for (int k = 0; k < 16; k += 2) { x[k] = cmul(v[REV4(k)], te); x[k + 1] = cmul(v[REV4(k + 1)], to); te = cmul(te, r2); to = cmul(to, r2); }
    fstore_raw<PAT>(x, buf, tp);
}
#ifndef FFT_GEO
#define FFT_GEO 1
#endif
template <int PAT> __device__ __forceinline__ void fstore_ang(cf (&v)[16], cf* buf, int tp, float a0, float ar) {
#if FFT_GEO
    fstore_geo<PAT>(v, buf, tp, cis_rev(a0), cis_rev(ar));
#else
    cf x[16];
#pragma unroll
    for (int k = 0; k < 16; ++k) x[k] = cmul(v[REV4(k)], cis_rev(a0 + (float)k * ar));
    fstore_raw<PAT>(x, buf, tp);
#endif
}
__device__ __forceinline__ void ftw_build(cf (&tw)[16], cf t0, cf r) {
    const cf r2 = cmul(r, r); cf te = t0, to = cmul(t0, r);
#pragma unroll
    for (int k = 0; k < 16; k += 2) { tw[k] = te; tw[k + 1] = to; te = cmul(te, r2); to = cmul(to, r2); }
}
template <int PAT> __device__ __forceinline__ void fstore_tw(cf (&v)[16], cf* buf, int tp, const cf (&tw)[16]) {
    cf x[16];
#pragma unroll
    for (int k = 0; k < 16; ++k) x[k] = cmul(v[REV4(k)], tw[k]);
    fstore_raw<PAT>(x, buf, tp);
}
#define W32C(j) ((j) == 0 ? 1.f : (j) == 1 ? 0.98078528f : (j) == 2 ? 0.92387953f : (j) == 3 ? 0.83146961f : (j) == 4 ? 0.70710678f : (j) == 5 ? 0.55557023f : (j) == 6 ? 0.38268343f : (j) == 7 ? 0.19509032f : (j) == 8 ? 0.f : \
                 (j) == 9 ? -0.19509032f : (j) == 10 ? -0.38268343f : (j) == 11 ? -0.55557023f : (j) == 12 ? -0.70710678f : (j) == 13 ? -0.83146961f : (j) == 14 ? -0.92387953f : -0.98078528f)
#define W32S(j) ((j) == 0 ? 0.f : (j) == 1 ? 0.19509032f : (j) == 2 ? 0.38268343f : (j) == 3 ? 0.55557023f : (j) == 4 ? 0.70710678f : (j) == 5 ? 0.83146961f : (j) == 6 ? 0.92387953f : (j) == 7 ? 0.98078528f : (j) == 8 ? 1.f : \
                 (j) == 9 ? 0.98078528f : (j) == 10 ? 0.92387953f : (j) == 11 ? 0.83146961f : (j) == 12 ? 0.70710678f : (j) == 13 ? 0.55557023f : (j) == 14 ? 0.38268343f : 0.19509032f)
__device__ __forceinline__ void fft_fwd_pass1(cf (&v)[16], cf* buf, int tp, int str) {
    if (str) {
#pragma unroll
        for (int j = 1; j < 16; ++j) v[j] = cmul(v[j], cf{W32C(j), -W32S(j)});
    }
    dft16<-1>(v);
    fstore_ang<0>(v, buf, tp, str ? -(float)tp * (1.f / 8192.f) : 0.f, -(float)(tp >> 4) * (1.f / 256.f));
}
__device__ __forceinline__ void fft_fwd_pass2(cf* buf, int tp0, const cf (&tw)[16]) {
    const int tp = hide(tp0);
    cf v[16]; fload<1>(v, buf, tp); dft16<-1>(v);
    fstore_tw<1>(v, buf, tp, tw);
}
__device__ __forceinline__ void fft_inv_pass2(cf* buf, int tp0, int str) {
    const int tp = hide(tp0);
    cf v[16]; fload<1>(v, buf, tp); dft16<1>(v);
    const int n0 = tp & 15, k2 = tp >> 4;
    fstore_ang<1>(v, buf, tp, str ? (float)n0 * (1.f / 8192.f) : 0.f, (float)k2 * (1.f / 256.f) + (str ? (1.f / 512.f) : 0.f));
}
__device__ __forceinline__ void fft_inv_pass3(cf* buf, int tp0, int str) {
    const int tp = hide(tp0);
    cf v[16]; fload<0>(v, buf, tp); dft16<1>(v);
    cf x[16];
#pragma unroll
    for (int k = 0; k < 16; ++k) { x[k] = v[REV4(k)]; if (str && k > 0) x[k] = cmul(x[k], cf{W32C(k), W32S(k)}); }
    fstore_raw<0>(x, buf, tp);
}

struct Row8 { u32x4 a; unsigned short l, r; };
__device__ __forceinline__ void load_row8(const bf16* rowp, int n0, Row8& q) {
    q.a = *(const u32x4*)(rowp + n0); const unsigned short l = rowp[n0 > 0 ? n0 - 1 : 0], r = rowp[n0 + 8 < 4096 ? n0 + 8 : 4095]; q.l = n0 > 0 ? l : (unsigned short)0; q.r = n0 + 8 < 4096 ? r : (unsigned short)0;
}
__device__ __forceinline__ void conv3_row8(const Row8& q, float w0, float w1, float w2, float bb, float (&o)[8]) {
    const float r[10] = {bf2f(q.l), bflo(q.a.x), bfhi(q.a.x), bflo(q.a.y), bfhi(q.a.y), bflo(q.a.z), bfhi(q.a.z), bflo(q.a.w), bfhi(q.a.w), bf2f(q.r)};
#pragma unroll
    for (int i = 0; i < 8; ++i) o[i] = w0 * r[i] + w1 * r[i + 1] + w2 * r[i + 2] + bb;
}

__device__ __forceinline__ void phase_hyena_fft(const Params& P, unsigned char* lds, int tid, int lane, int wave, int G) {
    cf* bufE = (cf*)lds; cf* bufO = (cf*)(lds + FFT_BUF); cf* zbuf = (cf*)(lds + FFT_ZB);
    float* w3c = (float*)(lds + FFT_W3); float* red = (float*)(lds + FFT_RED);
    const int str = __builtin_amdgcn_readfirstlane(tid >> 8), tp0 = tid & 255; cf* buf = str ? bufO : bufE;
    const bf16* Pt = (const bf16*)(P.ws + WS_PT); bf16* Zt = (bf16*)(P.ws + WS_ZT);
    cf* Hs = (cf*)(P.ws + WS_HSPEC) + (size_t)blockIdx.x * 4 * 4096;
    const float* a2T = (const float*)(P.ws + WS_A2);
#ifndef FFT_SBAR
#define FFT_SBAR 1
#endif
    unsigned* sb = (unsigned*)(lds + FFT_RED + 64) + str; unsigned sgen = 0u;
    if (tid < 2) ((unsigned*)(lds + FFT_RED + 64))[tid] = 0u;
#if FFT_SBAR
#define STREAM_BAR() do { asm volatile("s_waitcnt vmcnt(0) lgkmcnt(0)" ::: "memory"); sgen += 4u; \
        if (lane == 0) __hip_atomic_fetch_add(sb, 1u, __ATOMIC_RELAXED, __HIP_MEMORY_SCOPE_WORKGROUP); \
        while ((unsigned)__builtin_amdgcn_readfirstlane((int)__hip_atomic_load(sb, __ATOMIC_RELAXED, __HIP_MEMORY_SCOPE_WORKGROUP)) < sgen) __builtin_amdgcn_s_sleep(0); \
        asm volatile("" ::: "memory"); } while (0)
#else
#define STREAM_BAR() __syncthreads()
#endif
    cf tw2[16];
    { const int n0 = tp0 & 15, k2 = tp0 >> 4;
      ftw_build(tw2, cis_rev(-(float)(n0 * k2) * (1.f / 4096.f)), cis_rev(-(float)n0 * (1.f / 256.f))); }
#pragma unroll 1
    for (int c = blockIdx.x; c < 1024; c += G) {
        __syncthreads();
        if (tid < 256) w3c[tid] = P.in[I_HW3][(size_t)(tid & 63) * 4096 + (tid >> 6) * 1024 + c];
#ifndef FFT_ROWPF
#define FFT_ROWPF 0
#endif
        Row8 va, vb;
#if FFT_ROWPF
        load_row8(Pt + (size_t)c * 32768, hide(tid) * 8, va); load_row8(Pt + (size_t)c * 32768 + 4096, hide(tid) * 8, vb);
#endif
        __syncthreads();
        {
            float d[8][4];
#pragma unroll
            for (int j = 0; j < 8; ++j) { d[j][0] = 0.f; d[j][1] = 0.f; d[j][2] = 0.f; d[j][3] = 0.f; }
#pragma unroll 2
            for (int i = 0; i < 64; ++i) { const float w0 = w3c[i], w1 = w3c[64 + i], w2 = w3c[128 + i], w3 = w3c[192 + i]; const float* ar = a2T + (size_t)i * 4096 + tid;
#pragma unroll
                for (int j = 0; j < 8; ++j) { const float a = ar[512 * j]; d[j][0] += a * w0; d[j][1] += a * w1; d[j][2] += a * w2; d[j][3] += a * w3; } }
            float dec[4];
#pragma unroll
            for (int q = 0; q < 4; ++q) dec[q] = fabsf(P.in[I_HDEC][q * 1024 + c]) * (1.4426950408889634f / 4095.f);
            float as0 = 0.f, as1 = 0.f;
#pragma unroll
            for (int j = 0; j < 8; ++j) { const int t = tid + 512 * j; const float tf = (float)t;
                const float h0 = d[j][0] * __builtin_amdgcn_exp2f(-tf * dec[0]), h1 = d[j][1] * __builtin_amdgcn_exp2f(-tf * dec[1]), h2 = d[j][2] * __builtin_amdgcn_exp2f(-tf * dec[2]), h3 = d[j][3] * __builtin_amdgcn_exp2f(-tf * dec[3]);
                float* hb0 = (float*)(lds + FFT_ZB); float* hb1 = (float*)(lds + FFT_HB1);
                hb0[t] = h0; hb0[4096 + t] = h1; hb1[t] = h2; hb1[4096 + t] = h3; as0 += fabsf(h0) + fabsf(h1); as1 += fabsf(h2) + fabsf(h3); }
            as0 = wave_sum(as0); as1 = wave_sum(as1); if (lane == 0) { red[wave] = as0; red[8 + wave] = as1; }
        }
        __syncthreads();
#pragma unroll 1
        for (int o = 0; o < 2; ++o) {
            const float* hbuf = (const float*)(lds + (o == 0 ? FFT_ZB : FFT_HB1));
            float tot = 0.f;
#pragma unroll
            for (int w = 0; w < 8; ++w) tot += red[8 * o + w];
            const float inv = 1.f / ((tot + 1e-6f) * 8192.f);
            { const int tp = hide(tp0); cf v[16];
#pragma unroll
              for (int j = 0; j < 16; ++j) { const int n = tp + 256 * j; const float ta = (hbuf[n] + (n == 0 ? hbuf[4096] : 0.f)) * inv, tb = (n == 0 ? 0.f : hbuf[4096 + 4096 - n]) * inv;
                  v[j] = cf{str ? ta - tb : ta + tb, 0.f}; }
              fft_fwd_pass1(v, buf, tp, str); }
            STREAM_BAR();
            fft_fwd_pass2(buf, tp0, tw2);
            STREAM_BAR();
            { const int tp = hide(tp0); cf v[16]; fload<2>(v, buf, tp); dft16<-1>(v);
              cf* hp = Hs + (size_t)(o * 2 + str) * 4096 + tp;
#pragma unroll
              for (int k = 0; k < 16; ++k) hp[k * 256] = v[REV4(k)]; }
            __syncthreads();
        }
#pragma unroll 1
        for (int pr = 0; pr < 4; ++pr) {
            { const int n0 = hide(tid) * 8; float oa[8], ob[8];
#if !FFT_ROWPF
              load_row8(Pt + (size_t)c * 32768 + (2 * pr) * 4096, n0, va); load_row8(Pt + (size_t)c * 32768 + (2 * pr + 1) * 4096, n0, vb);
#endif
              const float w0 = P.in[I_HCW][c], w1 = P.in[I_HCW][3072 + c], w2 = P.in[I_HCW][6144 + c], bb = P.in[I_HCB][c];
              conv3_row8(va, w0, w1, w2, bb, oa); conv3_row8(vb, w0, w1, w2, bb, ob);
#pragma unroll
              for (int i = 0; i < 8; ++i) zbuf[n0 + i] = cf{oa[i], ob[i]}; }
            __syncthreads();
#pragma unroll 1
            for (int o = 0; o < 2; ++o) {
                Row8 ga, gb;
#if FFT_ROWPF
                { const int n0 = hide(tid) * 8; const size_t grow = (size_t)((o + 1) * 1024 + c) * 32768;
                    load_row8(Pt + grow + (2 * pr) * 4096, n0, ga); load_row8(Pt + grow + (2 * pr + 1) * 4096, n0, gb);
                    const int prn = pr < 3 ? pr + 1 : 3;
                    load_row8(Pt + (size_t)c * 32768 + (2 * prn) * 4096, n0, va); load_row8(Pt + (size_t)c * 32768 + (2 * prn + 1) * 4096, n0, vb); }
#endif
                { const int tp = hide(tp0); cf v[16];
#pragma unroll
                  for (int j = 0; j < 16; ++j) v[j] = zbuf[tp + 256 * j];
                  fft_fwd_pass1(v, buf, tp, str); }
                STREAM_BAR();
#ifndef FFT_PF
#define FFT_PF 1
#endif
                cf hq[16];
#if FFT_PF
                { const cf* hp = Hs + (size_t)(o * 2 + str) * 4096 + hide(tp0);
#pragma unroll
                  for (int k = 0; k < 16; ++k) hq[k] = hp[k * 256]; }
#endif
                fft_fwd_pass2(buf, tp0, tw2);
                STREAM_BAR();
                { const int tp = hide(tp0); cf v[16]; fload<2>(v, buf, tp); dft16<-1>(v);
#if !FFT_PF
                  { const cf* hp = Hs + (size_t)(o * 2 + str) * 4096 + tp;
#pragma unroll
                  for (int k = 0; k < 16; ++k) hq[k] = hp[k * 256]; }
#endif
                  cf y[16];
#pragma unroll
                  for (int k = 0; k < 16; ++k) y[k] = cmul(v[REV4(k)], hq[k]);
                  dft16<1>(y);
                  fstore_ang<2>(y, buf, tp, 0.f, (float)((tp >> 4) + 16 * (tp & 15)) * (1.f / 4096.f)); }
                STREAM_BAR();
                fft_inv_pass2(buf, tp0, str);
                STREAM_BAR();
                fft_inv_pass3(buf, tp0, str);
                __syncthreads();
                { const int n0 = hide(tid) * 8;
#if !FFT_ROWPF
                  { const size_t grow = (size_t)((o + 1) * 1024 + c) * 32768; load_row8(Pt + grow + (2 * pr) * 4096, n0, ga); load_row8(Pt + grow + (2 * pr + 1) * 4096, n0, gb); }
#endif
                  const int gc = (o + 1) * 1024 + c;
                  const float w0 = P.in[I_HCW][gc], w1 = P.in[I_HCW][3072 + gc], w2 = P.in[I_HCW][6144 + gc], bb = P.in[I_HCB][gc];
                  const float sk = P.in[I_HSKIP][o * 1024 + c]; float g0[8], g1[8], oa[8], ob[8];
                  conv3_row8(ga, w0, w1, w2, bb, g0); conv3_row8(gb, w0, w1, w2, bb, g1);
#pragma unroll
                  for (int i = 0; i < 8; ++i) { const int n = n0 + i; const cf e = bufE[fphys(n)], q = bufO[fphys(n)], z = zbuf[n];
                      oa[i] = (e.x + q.x + sk * z.x) * g0[i]; ob[i] = (e.y + q.y + sk * z.y) * g1[i]; }
                  if (o == 0) {
#pragma unroll
                      for (int i = 0; i < 8; ++i) zbuf[n0 + i] = cf{oa[i], ob[i]};
                  } else {
                      u32x4 wa, wb; wa.x = pk2(oa[0], oa[1]); wa.y = pk2(oa[2], oa[3]); wa.z = pk2(oa[4], oa[5]); wa.w = pk2(oa[6], oa[7]);
                      wb.x = pk2(ob[0], ob[1]); wb.y = pk2(ob[2], ob[3]); wb.z = pk2(ob[4], ob[5]); wb.w = pk2(ob[6], ob[7]);
                      *(u32x4*)(Zt + (size_t)c * 32768 + (2 * pr) * 4096 + n0) = wa; *(u32x4*)(Zt + (size_t)c * 32768 + (2 * pr + 1) * 4096 + n0) = wb;
                  } }
                __syncthreads();
            }
        }
    }
}
__device__ __forceinline__ void phase_transpose(const Params& P, unsigned char* lds, int lane, int wave, int G) {
    bf16* tile = (bf16*)(lds + wave * 16384);
    const bf16* Zt = (const bf16*)(P.ws + WS_ZT); bf16* Z = (bf16*)(P.ws + WS_Z);
    for (int it = blockIdx.x * 8 + wave; it < 16 * 512; it += G * 8) {
        const int cb = it & 15, tb = it >> 4, c0 = cb * 64, t0 = tb * 64;
#pragma unroll
        for (int i = 0; i < 8; ++i) { const int ch = i * 8 + (lane >> 3), tq = (lane & 7) * 8;
            const u32x4 a = *(const u32x4*)(Zt + (size_t)(c0 + ch) * 32768 + t0 + tq);
            unsigned* d = (unsigned*)(tile + ch * 66 + tq); d[0] = a.x; d[1] = a.y; d[2] = a.z; d[3] = a.w; }
        LDS_WAIT(); asm volatile("" ::: "memory");
#pragma unroll
        for (int i = 0; i < 8; ++i) { const int tk = i * 8 + (lane >> 3), cq = (lane & 7) * 8;
            unsigned short e[8];
#pragma unroll
            for (int j = 0; j < 8; ++j) e[j] = tile[(cq + j) * 66 + tk];
            u32x4 w; w.x = e[0] | ((unsigned)e[1] << 16); w.y = e[2] | ((unsigned)e[3] << 16); w.z = e[4] | ((unsigned)e[5] << 16); w.w = e[6] | ((unsigned)e[7] << 16);
            *(u32x4*)(Z + (size_t)(t0 + tk) * 1024 + c0 + cq) = w; }
        LDS_WAIT(); asm volatile("" ::: "memory");
    }
}

constexpr int N_PHASES = 21;
__global__ void __launch_bounds__(512, 2) fwd_kernel(Params P0) {
    extern __shared__ __attribute__((aligned(16))) unsigned char lds[];
    const int tid = threadIdx.x, lane = tid & 63, wave = __builtin_amdgcn_readfirstlane(tid >> 6), G = gridDim.x;
    PG8_LAS unsigned char* ldsl = (PG8_LAS unsigned char*)lds;
    for (int u = tid; u < (LDS_BYTES - LDSCTL_OFF) / 4; u += 512) ((unsigned*)(lds + LDSCTL_OFF))[u] = 0u;
    __syncthreads();
#if MK_ONE_LAUNCH
    XcdBarrier bar = xcd_barrier_post((unsigned*)(P0.ws + WS_CTL) + CW_BAR, (volatile LAS unsigned*)(ldsl + MISC_OFF) + 8);
#define GRID_BAR() xcd_barrier(bar)
#else
#define GRID_BAR() do { } while (0)
#endif
    const int lo = P0.ph_lo, hi = P0.ph_hi;
#ifndef PHASE_MASK
#define PHASE_MASK 0xFFFFFFFFu
#endif
#define IN(k) ((((PHASE_MASK) >> (k)) & 1u) && lo <= (k) && (k) < hi)
#ifndef DELAY_MASK
#define DELAY_MASK 0u
#endif
#ifndef CLKP
#define CLKP -1
#endif
    unsigned long long clk_c0 = 0, clk_r0 = 0;
    unsigned long long t_ph = 0;
#define SEAM(k) do { if (IN(k) && IN((k) + 1)) GRID_BAR(); \
    if (((DELAY_MASK) >> (k)) & 1u) { const unsigned long long t1 = __builtin_amdgcn_s_memrealtime(); const unsigned long long dt = t1 - t_ph; while (__builtin_amdgcn_s_memrealtime() - t1 < dt) __builtin_amdgcn_s_sleep(8); __syncthreads(); } \
    if ((k) == CLKP) { const unsigned long long c1 = __builtin_readcyclecounter(), r1 = __builtin_amdgcn_s_memrealtime(); \
        const unsigned long long ticks = (c1 - clk_c0) * 1000ull / (r1 - clk_r0 + 1ull);   \
        while (__builtin_amdgcn_s_memrealtime() - r1 < ticks) __builtin_amdgcn_s_sleep(8); __syncthreads(); } \
    if ((k) + 1 == CLKP) { clk_c0 = __builtin_readcyclecounter(); clk_r0 = __builtin_amdgcn_s_memrealtime(); } \
    if (((DELAY_MASK) >> ((k) + 1)) & 1u) t_ph = __builtin_amdgcn_s_memrealtime(); } while (0)
#ifndef REPEAT_MASK
#define REPEAT_MASK 0u
#endif
#ifndef REPEAT_SUB
#define REPEAT_SUB 0u
#endif
#define REPS(k) for (int reps_ = 0; reps_ < ((((REPEAT_SUB) >> (k)) & 1u) ? 2 : 1); ++reps_)
#define REP(k) for (int rep_ = 0; rep_ < ((((REPEAT_MASK) >> (k)) & 1u) ? 2 : 1); ++rep_)

    if (DELAY_MASK & 1u) t_ph = __builtin_amdgcn_s_memrealtime();
    if (IN(0)) REP(0) { const Params P = load_params(); unsigned char* ws = P.ws; phase_prologue(P, lds, tid, lane, wave, G); } SEAM(0);
    if (IN(1)) REP(1) { const Params P = load_params(); unsigned char* ws = P.ws; phase_norm1_l0(P, lane, wave, G); } SEAM(1);
    if (IN(2)) REP(2) { const Params P = load_params(); unsigned char* ws = P.ws;
        pg8::Gemm g{(const bf16*)(ws + WS_RH), (const bf16*)(ws + WS_WIN), 1024, 1024, 1024, 0}; pg8::StaticOrder S; S.init(M0 / 256, 7, G, (int)blockIdx.x);
        EpiIn E{(bf16*)(ws + WS_CQ), (bf16*)(ws + WS_CKV), (bf16*)(ws + WS_UX), (bf16*)(ws + WS_UG), (bf16*)(ws + WS_K)};
        pg8::gemm_phase<EpiIn, pg8::StaticOrder, GP_ALIGN, GP_SP2>(ldsl, g, S, E);
    } SEAM(2);
    if (IN(3)) REP(3) { const Params P = load_params(); unsigned char* ws = P.ws; phase_rowstat(P, lane, wave, G); phase_lru_f1(P, lds, tid, lane, wave, G); } SEAM(3);
    if (IN(4)) REP(4) { const Params P = load_params(); unsigned char* ws = P.ws;
        phase_lru_carry(P, lane, wave, G);
        __syncthreads();
#ifndef NO_QUP
        REPS(0) { pg8::Gemm g{(const bf16*)(ws + WS_CQ), (const bf16*)(ws + WS_WUQ), 384, 384, 384, 0}; pg8::StaticOrder S; S.init(M0 / 256, 3, G, (int)blockIdx.x);
          EpiQ E{(bf16*)(ws + WS_Q), (const float*)(ws + WS_RQ)};
          pg8::gemm_phase<EpiQ, pg8::StaticOrder, GP_ALIGN, GP_SP2>(ldsl, g, S, E); }
#endif
        __syncthreads();
        REPS(1) { pg8::Gemm g{(const bf16*)(ws + WS_CKV), (const bf16*)(ws + WS_WUKV), 256, 256, 256, 0}; pg8::StaticOrder S; S.init(M0 / 256, 4, G, (int)blockIdx.x);
          EpiKV E{(bf16*)(ws + WS_K), (bf16*)(ws + WS_V), (const float*)(ws + WS_RKV)};
          pg8::gemm_phase<EpiKV, pg8::StaticOrder, GP_ALIGN, GP_SP2>(ldsl, g, S, E); }
        __syncthreads();
    } SEAM(4);
    if (IN(5)) REP(5) { const Params P = load_params(); unsigned char* ws = P.ws; REPS(2) phase_lru_f3(P, lds, tid, lane, wave, G); REPS(3) phase_attention(P, lds, G); } SEAM(5);
    if (IN(6)) REP(6) { const Params P = load_params(); unsigned char* ws = P.ws;
        pg8::Gemm g{(const bf16*)(ws + WS_RH), (const bf16*)(ws + WS_WOUT), 1024, 1024, 1024, 0}; pg8::StaticOrder S; S.init(M0 / 256, 4, G, (int)blockIdx.x);
        EpiRes<0> E{P.in[I_X], P.in[I_CTX], (const float*)(ws + WS_MOD), nullptr, (bf16*)P.out, (bf16*)(ws + WS_XC)};
        pg8::gemm_phase<EpiRes<0>, pg8::StaticOrder, GP_ALIGN, GP_SP2>(ldsl, g, S, E);
    } SEAM(6);
    if (IN(7)) REP(7) { const Params P = load_params(); unsigned char* ws = P.ws; phase_norm2_route<0>(P, lds, tid, lane, wave, G); } SEAM(7);
    if (IN(8)) REP(8) { const Params P = load_params(); unsigned char* ws = P.ws; phase_permute<0>(P, lds, tid, lane, wave, G); } SEAM(8);
    if (IN(9)) REP(9) { const Params P = load_params(); unsigned char* ws = P.ws;
        const int* te = (const int*)(ws + WS_TILEE); const int nmt = te[MAXTILES];
        { int* gl = (int*)(lds + RING_BYTES); const int* st = (const int*)(ws + WS_SLOTTOK);
          for (int i = 0; ; ++i) { const long L = (long)i * G + blockIdx.x; if (L >= (long)nmt * 4 || i >= 20) break; if (tid < 256) gl[i * 256 + tid] = st[(int)(L >> 2) * 256 + tid]; }
          __syncthreads(); }
        pg8::Gemm g{(const bf16*)(ws + WS_RH), (const bf16*)(ws + WS_W13), 1024, 1024, 1024, (size_t)1024 * 1024 * 2, RING_BYTES}; pg8::MoeOrder S{nmt, G, (int)blockIdx.x, te};
        EpiMoe1 E{(bf16*)(ws + WS_ACT)};
        pg8::gemm_phase<EpiMoe1, pg8::MoeOrder, GP_ALIGN, GP_SP2, true>(ldsl, g, S, E);
    } SEAM(9);
    if (IN(10)) REP(10) { const Params P = load_params(); unsigned char* ws = P.ws;
        const int* te = (const int*)(ws + WS_TILEE);
        pg8::Gemm g{(const bf16*)(ws + WS_ACT), (const bf16*)(ws + WS_W2), 512, 512, 512, (size_t)1024 * 512 * 2}; pg8::MoeOrder S{te[MAXTILES], G, (int)blockIdx.x, te};
        EpiStore E{(bf16*)(ws + WS_HPERM), 1024};
        pg8::gemm_phase<EpiStore, pg8::MoeOrder, GP_ALIGN, GP_SP2>(ldsl, g, S, E);
    } SEAM(10);
    if (IN(11)) REP(11) { const Params P = load_params(); unsigned char* ws = P.ws; phase_combine_norm1_l1(P, lane, wave, G); } SEAM(11);
    if (IN(12)) REP(12) { const Params P = load_params(); unsigned char* ws = P.ws;
        pg8::Gemm g{(const bf16*)(ws + WS_WHIN), (const bf16*)(ws + WS_RH), 1024, 1024, 1024, 0}; pg8::StaticOrder S; S.init(3072 / 256, M1 / 256, G, (int)blockIdx.x);
        EpiStore E{(bf16*)(ws + WS_PT), 32768};
        pg8::gemm_phase<EpiStore, pg8::StaticOrder, GP_ALIGN, GP_SP2>(ldsl, g, S, E);
    } SEAM(12);
    if (IN(13)) REP(13) { const Params P = load_params(); unsigned char* ws = P.ws; phase_hyena_fft(P, lds, tid, lane, wave, G); } SEAM(13);
    if (IN(14)) REP(14) { const Params P = load_params(); unsigned char* ws = P.ws; phase_transpose(P, lds, lane, wave, G); } SEAM(14);
    if (IN(15)) REP(15) { const Params P = load_params(); unsigned char* ws = P.ws;
        pg8::Gemm g{(const bf16*)(ws + WS_Z), (const bf16*)(ws + WS_WHOUT), 1024, 1024, 1024, 0}; pg8::StaticOrder S; S.init(M1 / 256, 4, G, (int)blockIdx.x);
        EpiRes<1> E{nullptr, nullptr, (const float*)(ws + WS_MOD), (const bf16*)((unsigned char*)P.out + X2_OFF), (bf16*)(ws + WS_X3), nullptr};
        pg8::gemm_phase<EpiRes<1>, pg8::StaticOrder, GP_ALIGN, GP_SP2>(ldsl, g, S, E);
    } SEAM(15);
    if (IN(16)) REP(16) { const Params P = load_params(); unsigned char* ws = P.ws; phase_norm2_route<1>(P, lds, tid, lane, wave, G); } SEAM(16);
    if (IN(17)) REP(17) { const Params P = load_params(); unsigned char* ws = P.ws; phase_permute<1>(P, lds, tid, lane, wave, G); } SEAM(17);
    if (IN(18)) REP(18) { const Params P = load_params(); unsigned char* ws = P.ws;
        const int* te = (const int*)(ws + WS_TILEE); const int nmt = te[MAXTILES];
        { int* gl = (int*)(lds + RING_BYTES); const int* st = (const int*)(ws + WS_SLOTTOK);
          for (int i = 0; ; ++i) { const long L = (long)i * G + blockIdx.x; if (L >= (long)nmt * 4 || i >= 20) break; if (tid < 256) gl[i * 256 + tid] = st[(int)(L >> 2) * 256 + tid]; }
          __syncthreads(); }
        pg8::Gemm g{(const bf16*)(ws + WS_RH), (const bf16*)(ws + WS_W13) + (size_t)16 * 1024 * 1024, 1024, 1024, 1024, (size_t)1024 * 1024 * 2, RING_BYTES}; pg8::MoeOrder S{nmt, G, (int)blockIdx.x, te};
        EpiMoe1 E{(bf16*)(ws + WS_ACT)};
        pg8::gemm_phase<EpiMoe1, pg8::MoeOrder, GP_ALIGN, GP_SP2, true>(ldsl, g, S, E);
    } SEAM(18);
    if (IN(19)) REP(19) { const Params P = load_params(); unsigned char* ws = P.ws;
        const int* te = (const int*)(ws + WS_TILEE);
        pg8::Gemm g{(const bf16*)(ws + WS_ACT), (const bf16*)(ws + WS_W2) + (size_t)16 * 1024 * 512, 512, 512, 512, (size_t)1024 * 512 * 2}; pg8::MoeOrder S{te[MAXTILES], G, (int)blockIdx.x, te};
        EpiStore E{(bf16*)(ws + WS_HPERM), 1024};
        pg8::gemm_phase<EpiStore, pg8::MoeOrder, GP_ALIGN, GP_SP2>(ldsl, g, S, E);
    } SEAM(19);
    if (IN(20)) REP(20) { const Params P = load_params(); unsigned char* ws = P.ws; phase_final(P, lane, wave, G); } SEAM(20);
#undef IN
#undef SEAM
}

extern "C" void kernel_launch(void* const* d_in, const int* in_sizes, int n_in, void* d_out, int out_size, void* d_ws, size_t ws_size, hipStream_t stream) {
    static int grid = 0;
    if (grid == 0) {
        if (n_in != N_IN || out_size != M1 * DM || ws_size < WS_END) { fprintf(stderr, "kernel_launch: unexpected shapes (n_in %d out %d ws %zu)\n", n_in, out_size, ws_size); grid = -1; return; }
        int dev = 0, cus = 0;
        if (hipGetDevice(&dev) != hipSuccess || hipDeviceGetAttribute(&cus, hipDeviceAttributeMultiprocessorCount, dev) != hipSuccess) { grid = -1; return; }
        if (hipFuncSetAttribute((const void*)fwd_kernel, hipFuncAttributeMaxDynamicSharedMemorySize, LDS_BYTES) != hipSuccess) { fprintf(stderr, "kernel_launch: hipFuncSetAttribute failed\n"); grid = -1; return; }
        int per_cu = 0;
        if (hipOccupancyMaxActiveBlocksPerMultiprocessor(&per_cu, (const void*)fwd_kernel, 512, LDS_BYTES) != hipSuccess || per_cu < 1) fprintf(stderr, "kernel_launch: occupancy query reports %d\n", per_cu);
        (void)hipGetLastError();
        grid = cus;
    }
    if (grid < 0) return;
    (void)hipMemsetAsync((char*)d_ws + WS_CTL, 0, CTL_ZERO_BYTES, stream);
    Params p{};
    for (int i = 0; i < N_IN; ++i) p.in[i] = (const float*)d_in[i];
    p.out = (float*)d_out; p.ws = (unsigned char*)d_ws;
#if MK_ONE_LAUNCH
    p.ph_lo = 0; p.ph_hi = N_PHASES;
    hipLaunchKernelGGL(fwd_kernel, dim3(grid), dim3(512), LDS_BYTES, stream, p);
#else
    for (int k = 0; k < N_PHASES; ++k) { p.ph_lo = k; p.ph_hi = k + 1; hipLaunchKernelGGL(fwd_kernel, dim3(grid), dim3(512), LDS_BYTES, stream, p); }
#endif
}
```

```cpp
#include <hip/hip_runtime.h>
#include <cstdio>
#include <cstdint>

#ifndef MK_ONE_LAUNCH
#define MK_ONE_LAUNCH 1
#endif

#define LAS __attribute__((address_space(3)))
#define GAS __attribute__((address_space(1)))
typedef unsigned short bf16;
typedef short bf16x8 __attribute__((ext_vector_type(8)));
typedef short s16x4 __attribute__((ext_vector_type(4)));
typedef float f32x2 __attribute__((ext_vector_type(2)));
typedef float f32x4 __attribute__((ext_vector_type(4)));
typedef float f32x16 __attribute__((ext_vector_type(16)));
typedef unsigned u32x2 __attribute__((ext_vector_type(2)));
typedef unsigned u32x4 __attribute__((ext_vector_type(4)));
#define LDS_WAIT() asm volatile("s_waitcnt lgkmcnt(0)" ::: "memory")
#define VM_WAIT() asm volatile("s_waitcnt vmcnt(0)" ::: "memory")

__device__ __forceinline__ unsigned f2bf(float f) { unsigned u = __builtin_bit_cast(unsigned, f); return (u + 0x7fffu + ((u >> 16) & 1u)) >> 16; }
__device__ __forceinline__ unsigned pk2(float lo, float hi) { return f2bf(lo) | (f2bf(hi) << 16); }
__device__ __forceinline__ float bf2f(unsigned b) { return __builtin_bit_cast(float, b << 16); }
__device__ __forceinline__ float bflo(unsigned w) { return __builtin_bit_cast(float, w << 16); }
__device__ __forceinline__ float bfhi(unsigned w) { return __builtin_bit_cast(float, w & 0xffff0000u); }
__device__ __forceinline__ float wave_sum(float v) {
#pragma unroll
    for (int o = 1; o < 64; o <<= 1) v += __shfl_xor(v, o);
    return v;
}
__device__ __forceinline__ float sigm(float x) { return 1.f / (1.f + expf(-x)); }

namespace pg8 {
#define PG8_LAS __attribute__((address_space(3)))
typedef unsigned short bf16_t;
constexpr int BM = 256, BK = 64, HALF = 128, HTB = HALF * BK * 2, STAGE_BYTES = 8 * HTB, NXCD = 8, WGM = 8;
__host__ __device__ __forceinline__ int lds_byte(int r, int c) { const int st = (r >> 4) * 2 + (c >> 5), rr = r & 15, cc = c & 31, ob = rr * 64 + cc * 2; return st * 1024 + (ob ^ (((ob >> 9) & 1) << 5)); }
__host__ __device__ __forceinline__ void stage_rc(int b, int& R, int& C) { const int st = b / 1024, sb = b % 1024, swz = sb ^ (((sb >> 9) & 1) << 5); R = (st >> 1) * 16 + swz / 64; C = (st & 1) * 32 + (swz % 64) / 2; }
__host__ __device__ __forceinline__ int perm32(int rho) { const int n = rho >> 4, i = rho & 15; return 8 * (i >> 2) + 4 * n + (i & 3); }

struct Unit { int pm, pn, bz; };
struct Gemm { const bf16_t* A; const bf16_t* Bt; int lda, ldb, K; size_t bz_stride; int gidx_off; };

struct StaticOrder {
    int nM, nN, nwg, G, c;
    __host__ __device__ void init(int nM_, int nN_, int G_, int c_) { nM = nM_; nN = nN_; nwg = nM * nN; G = G_; c = c_; }
    __host__ __device__ bool next(int i, Unit& u) const {
        const long L = (long)i * G + c; if (L >= nwg) return false;
        int wgid = (int)L; { const int q = nwg / NXCD, r = nwg % NXCD, xcd = wgid % NXCD, off = wgid / NXCD; wgid = (xcd < r ? xcd * (q + 1) : r * (q + 1) + (xcd - r) * q) + off; }
        const int nig = WGM * nN, gid = wgid / nig, fm = gid * WGM, gsz = (nM - fm) < WGM ? (nM - fm) : WGM;
        u.pm = fm + ((wgid % nig) % gsz); u.pn = (wgid % nig) / gsz; u.bz = 0; return true;
    }
    __device__ __forceinline__ void a_ready(const Unit&) const {}
    __device__ __forceinline__ void done(const Unit&) const {}
};
struct MoeOrder {
    int nM, G, c; const int* tile_e;
    __device__ bool next(int i, Unit& u) const {
        const long L = (long)i * G + c; if (L >= (long)nM * 4) return false;
        u.pm = (int)(L >> 2); u.pn = (int)(L & 3); u.bz = tile_e[u.pm]; return true;
    }
    __device__ __forceinline__ void a_ready(const Unit&) const {}
    __device__ __forceinline__ void done(const Unit&) const {}
};

__device__ __forceinline__ unsigned cvt_pk_bf16(float lo, float hi) { unsigned r; asm volatile("v_cvt_pk_bf16_f32 %0, %1, %2" : "=v"(r) : "v"(lo), "v"(hi)); return r; }

template <class Epi, class Sched, bool ALIGN_EPI = false, bool SP2 = false, bool GATHER = false>
__device__ __forceinline__ void gemm_phase(PG8_LAS unsigned char* lds, const Gemm g, const Sched& S, const Epi& E) {
    const int tid = threadIdx.x, wid = __builtin_amdgcn_readfirstlane(tid >> 6), lane = tid & 63, wr = wid >> 2, wc = wid & 3, fr = lane & 15, fq = lane >> 4;
    const int K = g.K, nt = K / BK;
    unsigned voffA[2], voffB[2];
#pragma unroll
    for (int i = 0; i < 2; ++i) { int R, C; stage_rc(tid * 16 + i * 8192, R, C); const int Rb = Epi::PERM ? ((R & ~31) + perm32(R & 31)) : R;
        voffA[i] = (unsigned)(R * g.lda + C) * 2u; voffB[i] = (unsigned)(Rb * g.ldb + C) * 2u; }
    unsigned vc0[2], vc1[2], vn0[2], vn1[2];
    const PG8_LAS int* gl = (const PG8_LAS int*)(lds + g.gidx_off);
#define PG8_GIDX(uix, v0, v1) do { _Pragma("unroll") for (int _i = 0; _i < 2; ++_i) { int _R, _C; stage_rc(tid * 16 + _i * 8192, _R, _C); \
        v0[_i] = (unsigned)(gl[(uix) * 256 + _R] * g.lda + _C) * 2u; v1[_i] = (unsigned)(gl[(uix) * 256 + 128 + _R] * g.lda + _C) * 2u; } } while (0)
    const size_t kstep = (size_t)(BK * 2);
    const size_t hstepA = (size_t)HALF * g.lda * 2, hstepB = (size_t)HALF * g.ldb * 2;
    const size_t tstepA = GATHER ? 0 : 2 * hstepA, tstepB = 2 * hstepB;
    const unsigned ldsw = (unsigned)wid * 1024u;
    const int aoff = lds_byte(wr * 64 + fr, fq * 8), boff = lds_byte(wc * 32 + fr, fq * 8);
#define PG8_SA(b, h) (((b) * 2 + (h)) * HTB)
#define PG8_SB(b, h) ((4 + (b) * 2 + (h)) * HTB)
#define PG8_STAGE(bufoff, gbase, voff) do { _Pragma("unroll") for (int _i = 0; _i < 2; ++_i) \
        __builtin_amdgcn_global_load_lds((const unsigned*)((const char*)(gbase) + (voff)[_i]), (PG8_LAS unsigned*)(lds + (bufoff) + ldsw + _i * 8192), 16, 0, 0); } while (0)
#define PG8_LDA(dst, b, h) do { _Pragma("unroll") for (int m = 0; m < 4; ++m) _Pragma("unroll") for (int k = 0; k < 2; ++k) dst[m][k] = *(const PG8_LAS bf16x8*)(lds + PG8_SA(b, h) + aoff + m * 2048 + k * 1024); } while (0)
#define PG8_LDB(dst, b, h) do { _Pragma("unroll") for (int n = 0; n < 2; ++n) _Pragma("unroll") for (int k = 0; k < 2; ++k) dst[n][k] = *(const PG8_LAS bf16x8*)(lds + PG8_SB(b, h) + boff + n * 2048 + k * 1024); } while (0)
#define PG8_MMA(ai, bj, At, Bt) do { __builtin_amdgcn_s_setprio(1); _Pragma("unroll") for (int m = 0; m < 4; ++m) _Pragma("unroll") for (int n = 0; n < 2; ++n) _Pragma("unroll") for (int k = 0; k < 2; ++k) \
        acc[ai][bj][m][n] = __builtin_amdgcn_mfma_f32_16x16x32_bf16(Bt[n][k], At[m][k], acc[ai][bj][m][n], 0, 0, 0); __builtin_amdgcn_s_setprio(0); } while (0)
#define PG8_WAIT_V(n) asm volatile("s_waitcnt vmcnt(" #n ")" ::: "memory")
#define PG8_WAIT_L(n) asm volatile("s_waitcnt lgkmcnt(" #n ")" ::: "memory")
#define PG8_BAR __builtin_amdgcn_s_barrier()
#define PG8_SCHED __builtin_amdgcn_sched_barrier(0)
    Unit cur, nxt; int ui = 0;
    if (!S.next(0, cur)) return;
    f32x4 acc[2][2][4][2];
#pragma unroll
    for (int a = 0; a < 2; ++a)
#pragma unroll
        for (int b = 0; b < 2; ++b)
#pragma unroll
            for (int m = 0; m < 4; ++m)
#pragma unroll
                for (int n = 0; n < 2; ++n) acc[a][b][m][n] = (f32x4){0.f, 0.f, 0.f, 0.f};
    bf16x8 At[4][2], B0[2][2], B1[2][2];
    const char* cA = (const char*)g.A + (size_t)cur.pm * tstepA; const char* cB = (const char*)g.Bt + (size_t)cur.bz * g.bz_stride + (size_t)cur.pn * tstepB;
    S.a_ready(cur);
    if constexpr (GATHER) { PG8_GIDX(0, vc0, vc1); vn0[0] = vc0[0]; vn0[1] = vc0[1]; vn1[0] = vc1[0]; vn1[1] = vc1[1]; }
#define PG8_STAGE_A0(bufoff, p, NX) do { if constexpr (GATHER) { unsigned _v[2] = {(NX) ? vn0[0] : vc0[0], (NX) ? vn0[1] : vc0[1]}; PG8_STAGE(bufoff, p, _v); } else PG8_STAGE(bufoff, p, voffA); } while (0)
#define PG8_STAGE_A1(bufoff, p, NX) do { if constexpr (GATHER) { unsigned _v[2] = {(NX) ? vn1[0] : vc1[0], (NX) ? vn1[1] : vc1[1]}; PG8_STAGE(bufoff, p, _v); } else PG8_STAGE(bufoff, (p) + hstepA, voffA); } while (0)
    if constexpr (SP2) {
        PG8_STAGE(PG8_SB(0, 0), cB, voffB); PG8_STAGE(PG8_SB(0, 1), cB + hstepB, voffB); PG8_STAGE_A0(PG8_SA(0, 0), cA, false); PG8_STAGE_A1(PG8_SA(0, 1), cA, false);
        if (wr == 1) PG8_BAR;
        PG8_WAIT_V(2); PG8_BAR;
        PG8_STAGE(PG8_SB(1, 0), cB + kstep, voffB); PG8_STAGE_A0(PG8_SA(1, 0), cA + kstep, false); PG8_STAGE(PG8_SB(1, 1), cB + hstepB + kstep, voffB);
        PG8_WAIT_V(6); PG8_BAR;
    } else {
        PG8_STAGE(PG8_SB(0, 0), cB, voffB); PG8_STAGE_A0(PG8_SA(0, 0), cA, false); PG8_STAGE(PG8_SB(0, 1), cB + hstepB, voffB); PG8_STAGE_A1(PG8_SA(0, 1), cA, false);
        if (wr == 1) PG8_BAR;
        PG8_WAIT_V(4); PG8_BAR;
        PG8_STAGE(PG8_SB(1, 0), cB + kstep, voffB); PG8_STAGE_A0(PG8_SA(1, 0), cA + kstep, false); PG8_STAGE(PG8_SB(1, 1), cB + hstepB + kstep, voffB);
        PG8_WAIT_V(6); PG8_BAR;
    }
    for (;;) {
        const bool has_next = S.next(ui + 1, nxt);
        const char* nA = has_next ? (const char*)g.A + (size_t)nxt.pm * tstepA : cA;
        const char* nB = has_next ? (const char*)g.Bt + (size_t)nxt.bz * g.bz_stride + (size_t)nxt.pn * tstepB : cB;
        if constexpr (GATHER) { if (has_next) PG8_GIDX(ui + 1, vn0, vn1); }
#pragma unroll 1
        for (int t = 0; t < nt; t += 2) {
            const bool last = (t == nt - 2);
            const char* a1 = cA + (size_t)(t + 1) * kstep;
            const char* a2 = last ? nA : cA + (size_t)(t + 2) * kstep; const char* b2 = last ? nB : cB + (size_t)(t + 2) * kstep;
            const char* a3 = a2 + kstep; const char* b3 = b2 + kstep;
            if (last && has_next) S.a_ready(nxt);
            if constexpr (SP2) {
            PG8_LDB(B0, 0, 0); PG8_LDB(B1, 0, 1); PG8_SCHED; PG8_LDA(At, 0, 0); PG8_STAGE_A1(PG8_SA(1, 1), a1, false);
            PG8_WAIT_V(8); PG8_WAIT_L(0); PG8_BAR; PG8_MMA(0, 0, At, B0); PG8_MMA(0, 1, At, B1); PG8_BAR; PG8_SCHED;
            PG8_LDA(At, 0, 1); PG8_STAGE(PG8_SB(0, 0), b2, voffB); PG8_STAGE(PG8_SB(0, 1), b2 + hstepB, voffB); PG8_STAGE_A0(PG8_SA(0, 0), a2, last);
            PG8_WAIT_V(8); PG8_WAIT_L(0); PG8_BAR; PG8_MMA(1, 0, At, B0); PG8_MMA(1, 1, At, B1); PG8_BAR; PG8_SCHED;
            PG8_LDB(B0, 1, 0); PG8_LDB(B1, 1, 1); PG8_SCHED; PG8_LDA(At, 1, 0); PG8_STAGE_A1(PG8_SA(0, 1), a2, last);
            PG8_WAIT_V(8); PG8_WAIT_L(0); PG8_BAR; PG8_MMA(0, 0, At, B0); PG8_MMA(0, 1, At, B1); PG8_BAR; PG8_SCHED;
            PG8_LDA(At, 1, 1); PG8_STAGE(PG8_SB(1, 0), b3, voffB); PG8_STAGE(PG8_SB(1, 1), b3 + hstepB, voffB); PG8_STAGE_A0(PG8_SA(1, 0), a3, last);
            PG8_WAIT_V(8); PG8_WAIT_L(0); PG8_BAR; PG8_MMA(1, 0, At, B0); PG8_MMA(1, 1, At, B1); PG8_BAR; PG8_SCHED;
            } else {
            PG8_LDB(B0, 0, 0); PG8_SCHED; PG8_LDA(At, 0, 0); PG8_STAGE_A1(PG8_SA(1, 1), a1, false);
            PG8_WAIT_L(8); PG8_BAR; PG8_WAIT_L(0); PG8_MMA(0, 0, At, B0); PG8_BAR; PG8_SCHED;
            PG8_LDB(B1, 0, 1); PG8_STAGE(PG8_SB(0, 0), b2, voffB);
            PG8_BAR; PG8_WAIT_L(0); PG8_MMA(0, 1, At, B1); PG8_BAR;
            PG8_LDA(At, 0, 1); PG8_STAGE_A0(PG8_SA(0, 0), a2, last);
            PG8_BAR; PG8_WAIT_L(0); PG8_MMA(1, 0, At, B0); PG8_BAR; PG8_SCHED;
            PG8_STAGE(PG8_SB(0, 1), b2 + hstepB, voffB);
            PG8_WAIT_V(6); PG8_BAR; PG8_MMA(1, 1, At, B1); PG8_BAR;
            PG8_LDB(B0, 1, 0); PG8_SCHED; PG8_LDA(At, 1, 0); PG8_STAGE_A1(PG8_SA(0, 1), a2, last);
            PG8_WAIT_L(8); PG8_BAR; PG8_WAIT_L(0); PG8_MMA(0, 0, At, B0); PG8_BAR; PG8_SCHED;
            PG8_LDB(B1, 1, 1); PG8_STAGE(PG8_SB(1, 0), b3, voffB);
            PG8_BAR; PG8_WAIT_L(0); PG8_MMA(0, 1, At, B1); PG8_BAR;
            PG8_LDA(At, 1, 1); PG8_STAGE_A0(PG8_SA(1, 0), a3, last);
            PG8_BAR; PG8_WAIT_L(0); PG8_MMA(1, 0, At, B0); PG8_BAR; PG8_SCHED;
            PG8_STAGE(PG8_SB(1, 1), b3 + hstepB, voffB);
            PG8_WAIT_V(6); PG8_BAR; PG8_MMA(1, 1, At, B1); PG8_BAR;
            }
        }
        if constexpr (ALIGN_EPI) { if (wr == 0) PG8_BAR; }
        E(acc, cur, wr, wc, fr, fq); S.done(cur);
        if (!has_next) break;
#pragma unroll
        for (int a = 0; a < 2; ++a)
#pragma unroll
            for (int b = 0; b < 2; ++b)
#pragma unroll
                for (int m = 0; m < 4; ++m)
#pragma unroll
                    for (int n = 0; n < 2; ++n) acc[a][b][m][n] = (f32x4){0.f, 0.f, 0.f, 0.f};
        cur = nxt; cA = nA; cB = nB; ++ui;
        if constexpr (GATHER) { vc0[0] = vn0[0]; vc0[1] = vn0[1]; vc1[0] = vn1[0]; vc1[1] = vn1[1]; }
        if constexpr (ALIGN_EPI) { if (wr == 1) PG8_BAR; }
    }
    PG8_WAIT_V(0);
    if constexpr (!ALIGN_EPI) { if (wr == 0) PG8_BAR; }
    PG8_BAR;
#undef PG8_SA
#undef PG8_SB
#undef PG8_STAGE
#undef PG8_STAGE_A0
#undef PG8_STAGE_A1
#undef PG8_GIDX
#undef PG8_LDA
#undef PG8_LDB
#undef PG8_MMA
#undef PG8_WAIT_V
#undef PG8_WAIT_L
#undef PG8_BAR
#undef PG8_SCHED
}
}
#define GP_ALIGN true
#define GP_SP2 true

constexpr int DM = 1024, NB = 8, SEQ = 4096, CTXL = 256, TC = SEQ + CTXL  ;
constexpr int M0 = NB * TC  , M1 = NB * SEQ  ;
constexpr int NEXP = 16;
constexpr float RMS_EPS = 1e-6f;
constexpr int NCHUNK = 256;
constexpr int MAXTILES = 288;
constexpr int LCH = 68;

enum { I_X = 0, I_C, I_CTX, I_CCTX, I_ADAW, I_ADAB, I_N1G, I_N2G, I_FING, I_EVWIN, I_QNG, I_KVNG, I_WUQ, I_WUKV, I_LCW, I_LCB, I_LWA, I_LBA, I_LWX, I_LBX, I_LLAM, I_EVWOUT,
       I_ODWIN, I_HCW, I_HCB, I_HW1, I_HB1, I_HF1, I_HW2, I_HB2, I_HF2, I_HW3, I_HDEC, I_HSKIP, I_ODWOUT, I_RW, I_RB, I_MW1, I_MW3, I_MW2, N_IN };

constexpr size_t MiB = 1u << 20;
constexpr size_t WS_CTL = 0, CTL_ZERO_BYTES = 1 * MiB;
constexpr size_t WS_MOD = 1 * MiB;
constexpr size_t WS_RQ = WS_MOD + 2 * 9 * 6144 * 4;
constexpr size_t WS_RKV = WS_RQ + (size_t)M0 * 4;
constexpr size_t WS_A2 = 2 * MiB;
constexpr size_t WS_ROUTE_E = 3 * MiB;
constexpr size_t WS_ROUTE_W = WS_ROUTE_E + (size_t)M0 * 4;
constexpr size_t WS_ROUTE_S = WS_ROUTE_W + (size_t)M0 * 8;
constexpr size_t WS_CNT = WS_ROUTE_S + (size_t)M0 * 8;
constexpr size_t WS_TILEE = WS_CNT + 256 * 16 * 4;
static_assert(WS_TILEE + (MAXTILES + 64) * 4 <= 4 * MiB, "route region");
constexpr size_t WS_CP = 4 * MiB;
constexpr size_t WS_CS = WS_CP + (size_t)2 * 8 * LCH * 512 * 4;
static_assert(WS_CS + (size_t)2 * 8 * LCH * 512 * 4 <= 10 * MiB, "lru carries");
constexpr size_t WS_WIN = 10 * MiB;
constexpr size_t WS_WUQ = 14 * MiB;
constexpr size_t WS_WUKV = 15 * MiB;
constexpr size_t WS_WOUT = 16 * MiB;
constexpr size_t WS_WHIN = 18 * MiB;
constexpr size_t WS_WHOUT = 24 * MiB;
constexpr size_t WS_WG = 26 * MiB;
constexpr size_t WS_W13 = 27 * MiB;
constexpr size_t WS_W2 = 91 * MiB;
constexpr size_t WS_RH = 124 * MiB;
constexpr size_t WS_XC = 192 * MiB;
constexpr size_t X2_OFF = 64 * MiB;
constexpr size_t WS_R2 = 200 * MiB;
constexpr size_t WS_CQ = WS_R2;
constexpr size_t WS_CKV = WS_R2 + 26 * MiB;
constexpr size_t WS_UX = WS_R2 + 43 * MiB;
constexpr size_t WS_UG = WS_R2 + 77 * MiB;
constexpr size_t WS_Q = WS_R2 + 111 * MiB;
constexpr size_t WS_K = WS_R2 + 162 * MiB;
constexpr size_t WS_V = WS_R2 + 213 * MiB;
constexpr size_t WS_HPERM = WS_R2;
constexpr size_t WS_ACT = WS_R2 + 144 * MiB;
constexpr size_t WS_PT = WS_R2;
constexpr size_t WS_ZT = WS_R2 + 192 * MiB;
constexpr size_t WS_Z = WS_R2;
constexpr size_t WS_HSPEC = 456 * MiB;
constexpr size_t WS_X3 = 416 * MiB;
constexpr size_t WS_HIN = 488 * MiB;
constexpr size_t WS_SLOTTOK = 491 * MiB;
constexpr size_t WS_END = 492 * MiB;
static_assert(WS_V + (size_t)M0 * 512 * 2 <= WS_HSPEC && WS_ZT + (size_t)1024 * 32768 * 2 <= WS_HSPEC && WS_ACT + (size_t)73728 * 512 * 2 <= WS_HSPEC, "ws map");

constexpr int CW_TMO = 0, CW_BAR = 4096;

constexpr int RING_BYTES = 131072, LDS_BYTES = 155648, LDSCTL_OFF = LDS_BYTES - 1024, MISC_OFF = LDSCTL_OFF + 320;

#define XB_TMO      128
#define XB_XCNT(j)  (256  + 64 * (j))
#define XB_XSUB(j)  (1280 + 64 * (j))
#define XB_XGEN(j)  (2304 + 64 * (j))
#define XB_TOP      3328
#define XB_TOPGEN   3392
#define XCD_BAR_WORDS 3456
#define XB_SPIN_CAP (1u << 18)
__device__ __forceinline__ unsigned xb_ld(unsigned* p)              { return __hip_atomic_load(p, __ATOMIC_RELAXED, __HIP_MEMORY_SCOPE_AGENT); }
__device__ __forceinline__ unsigned xb_add(unsigned* p, unsigned v) { return __hip_atomic_fetch_add(p, v, __ATOMIC_RELAXED, __HIP_MEMORY_SCOPE_AGENT); }
__device__ __forceinline__ unsigned xb_xcc_id() { return (unsigned)__builtin_amdgcn_s_getreg((3 << 11) | 20) & 0xFu; }
#define XB_SPIN(cond, bar) do { unsigned _sp = 0; while (cond) { __builtin_amdgcn_s_sleep(1); \
    if ((++_sp & 255u) == 0u) { if (xb_ld(&(bar)[XB_TMO])) break; if (_sp > XB_SPIN_CAP) { atomicAdd(&(bar)[XB_TMO], 1u); break; } } } } while (0)
struct XcdBarrier { unsigned* bar; unsigned x; volatile LAS unsigned* st; };
__device__ __forceinline__ XcdBarrier xcd_barrier_post(unsigned* bar, volatile LAS unsigned* st) {
    XcdBarrier b; b.bar = bar; b.x = xb_xcc_id(); b.st = st;
    if (threadIdx.x == 0) (void)xb_add(&bar[XB_XCNT(b.x)], 1u);
    return b;
}
__device__ __forceinline__ void xcd_barrier_complete(unsigned* bar, unsigned x, unsigned& nloc, unsigned& nx) {
    const unsigned G = gridDim.x * gridDim.y * gridDim.z;
    unsigned sum, cnt, mine, sp = 0u;
    for (;;) {
        sum = 0u; cnt = 0u; mine = 0u;
#pragma unroll
        for (unsigned j = 0; j < 16; ++j) { const unsigned c = xb_ld(&bar[XB_XCNT(j)]); sum += c; cnt += (c > 0u) ? 1u : 0u; mine = (j == x) ? c : mine; }
        if (sum == G) break;
        __builtin_amdgcn_s_sleep(1);
        if ((++sp & 255u) == 0u) { if (xb_ld(&bar[XB_TMO])) break; if (sp > XB_SPIN_CAP) { atomicAdd(&bar[XB_TMO], 1u); break; } }
    }
    nloc = mine > 0u ? mine : 1u; nx = cnt > 0u ? cnt : 1u;
}
__device__ __forceinline__ void xcd_barrier(const XcdBarrier& b) {
    asm volatile("s_waitcnt vmcnt(0)" ::: "memory");
    __syncthreads();
    if (threadIdx.x == 0) {
        unsigned* bar = b.bar;
        __builtin_amdgcn_s_waitcnt(0);
        unsigned nloc = b.st[0], nx = b.st[1];
        if (nloc == 0u) { xcd_barrier_complete(bar, b.x, nloc, nx); b.st[0] = nloc; b.st[1] = nx; }
        const unsigned old = xb_add(&bar[XB_XSUB(b.x)], 1u);
        const unsigned gen = old / nloc;
        if (old + 1u == (gen + 1u) * nloc) {
            __builtin_amdgcn_fence(__ATOMIC_RELEASE, "agent");
            asm volatile("s_waitcnt vmcnt(0)" ::: "memory");
            const unsigned og = xb_add(&bar[XB_TOP], 1u);
            const unsigned tg = og / nx;
            if (og + 1u == (tg + 1u) * nx) xb_add(&bar[XB_TOPGEN], 1u);
            else XB_SPIN(xb_ld(&bar[XB_TOPGEN]) == tg, bar);
            __builtin_amdgcn_fence(__ATOMIC_ACQUIRE, "agent");
            xb_add(&bar[XB_XGEN(b.x)], 1u);
            asm volatile("s_waitcnt vmcnt(0)" ::: "memory");
        } else {
            XB_SPIN(xb_ld(&bar[XB_XGEN(b.x)]) == gen, bar);
            __builtin_amdgcn_fence(__ATOMIC_ACQUIRE, "agent");
            asm volatile("s_waitcnt vmcnt(0)" ::: "memory");
        }
    }
    __syncthreads();
}

struct Params { const float* in[N_IN]; float* out; unsigned char* ws; int ph_lo, ph_hi; };
typedef const __attribute__((address_space(4))) Params* ParamsK;
__device__ __forceinline__ Params load_params() {
#if defined(__HIP_DEVICE_COMPILE__)
    unsigned long long v = (unsigned long long)__builtin_amdgcn_kernarg_segment_ptr(); asm volatile("" : "+s"(v)); return *(ParamsK)v;
#else
    return Params{};
#endif
}

__device__ __forceinline__ u32x4 pack8(const f32x4 a, const f32x4 b) {
    u32x4 w; w.x = pg8::cvt_pk_bf16(a[0], a[1]); w.y = pg8::cvt_pk_bf16(a[2], a[3]); w.z = pg8::cvt_pk_bf16(b[0], b[1]); w.w = pg8::cvt_pk_bf16(b[2], b[3]); return w;
}
__device__ __forceinline__ void rope8(f32x4& v0, f32x4& v1, int fq, int tt  , bool on) {
    const int axis = fq >> 1, half = fq & 1; const float pos = (float)(axis == 0 ? (tt >> 6) : (tt & 63)) * 0.15915494309189535f;
    constexpr float IF[8] = {1.0f, 0.316227766f, 0.1f, 0.0316227766f, 0.01f, 0.00316227766f, 0.001f, 0.000316227766f};
#pragma unroll
    for (int i = 0; i < 4; ++i) {
        { const float x = v0[i], other = __shfl_xor(x, 16); const float sn = __builtin_amdgcn_sinf(pos * IF[i]), cs = __builtin_amdgcn_cosf(pos * IF[i]);
          const float r = half == 0 ? x * cs - other * sn : other * sn + x * cs; v0[i] = on ? r : x; }
        { const float x = v1[i], other = __shfl_xor(x, 16); const float sn = __builtin_amdgcn_sinf(pos * IF[4 + i]), cs = __builtin_amdgcn_cosf(pos * IF[4 + i]);
          const float r = half == 0 ? x * cs - other * sn : other * sn + x * cs; v1[i] = on ? r : x; }
    }
}

struct EpiIn {
    static constexpr bool PERM = true;
    bf16 *CQ, *CKV, *UX, *UG, *KB;
    __device__ __forceinline__ void operator()(const f32x4 (&acc)[2][2][4][2], const pg8::Unit& u, int wr, int wc, int fr, int fq) const {
        const int row0 = u.pm * 256 + wr * 64 + fr;
        const bool is_ctx = (u.pm % 17) == 0; const int bb = u.pm / 17;
#pragma unroll
        for (int bj = 0; bj < 2; ++bj) {
            const int blk = u.pn * 2 + bj;
            if (blk < 13) {
                bf16* dst; int ld, cb;
                if (blk < 3) { dst = CQ; ld = 384; cb = blk * 128; }
                else if (blk < 5) { dst = CKV; ld = 256; cb = (blk - 3) * 128; }
                else if (blk < 9) { dst = UX; ld = 512; cb = (blk - 5) * 128; }
                else { dst = UG; ld = 512; cb = (blk - 9) * 128; }
                const int col = cb + wc * 32 + 8 * fq;
#pragma unroll
                for (int ai = 0; ai < 2; ++ai)
#pragma unroll
                    for (int m = 0; m < 4; ++m) { const int row = row0 + ai * 128 + m * 16;
                        *(u32x4*)(dst + (size_t)row * ld + col) = pack8(acc[ai][bj][m][0], acc[ai][bj][m][1]); }
            } else if (wc == 0) {
#pragma unroll
                for (int ai = 0; ai < 2; ++ai)
#pragma unroll
                    for (int m = 0; m < 4; ++m) { const int row = row0 + ai * 128 + m * 16; const int tt = row - bb * TC - CTXL;
                        f32x4 v0 = acc[ai][bj][m][0], v1 = acc[ai][bj][m][1];
                        rope8(v0, v1, fq, tt, !is_ctx);
                        const u32x4 w = pack8(v0, v1);
#pragma unroll
                        for (int h = 0; h < 8; ++h) *(u32x4*)(KB + (size_t)row * 768 + h * 96 + 64 + 8 * fq) = w; }
            }
        }
    }
};
struct EpiQ {
    static constexpr bool PERM = true;
    bf16* Q; const float* rq;
    __device__ __forceinline__ void operator()(const f32x4 (&acc)[2][2][4][2], const pg8::Unit& u, int wr, int wc, int fr, int fq) const {
        const int row0 = u.pm * 256 + wr * 64 + fr;
#pragma unroll
        for (int ai = 0; ai < 2; ++ai)
#pragma unroll
            for (int m = 0; m < 4; ++m) { const int row = row0 + ai * 128 + m * 16; const float s = rq[row];
#pragma unroll
                for (int bj = 0; bj < 2; ++bj) {
                    const u32x4 w = pack8(acc[ai][bj][m][0] * s, acc[ai][bj][m][1] * s);
                    int off;
                    if (u.pn < 2) { const int c = u.pn * 256 + bj * 128 + wc * 32 + 8 * fq; off = (c >> 6) * 96 + (c & 63); }
                    else off = (4 * bj + wc) * 96 + 64 + 8 * fq;
                    *(u32x4*)(Q + (size_t)row * 768 + off) = w;
                } }
    }
};
struct EpiKV {
    static constexpr bool PERM = true;
    bf16 *K, *V; const float* rkv;
    __device__ __forceinline__ void operator()(const f32x4 (&acc)[2][2][4][2], const pg8::Unit& u, int wr, int wc, int fr, int fq) const {
        const int row0 = u.pm * 256 + wr * 64 + fr;
#pragma unroll
        for (int ai = 0; ai < 2; ++ai)
#pragma unroll
            for (int m = 0; m < 4; ++m) { const int row = row0 + ai * 128 + m * 16; const float s = rkv[row];
#pragma unroll
                for (int bj = 0; bj < 2; ++bj) { const int h = u.pn * 2 + bj;
                    const u32x4 w = pack8(acc[ai][bj][m][0] * s, acc[ai][bj][m][1] * s);
                    if (wc < 2) *(u32x4*)(K + (size_t)row * 768 + h * 96 + wc * 32 + 8 * fq) = w;
                    else *(u32x4*)(V + (size_t)row * 512 + h * 64 + (wc - 2) * 32 + 8 * fq) = w; } }
    }
};
template <int LAYER> struct EpiRes {
    static constexpr bool PERM = true;
    const float *x, *ctx, *mod; const bf16* xin; bf16 *xout, *xc;
    __device__ __forceinline__ void operator()(const f32x4 (&acc)[2][2][4][2], const pg8::Unit& u, int wr, int wc, int fr, int fq) const {
        const int row0 = u.pm * 256 + wr * 64 + fr, col0 = u.pn * 256 + wc * 32 + 8 * fq;
        const bool is_ctx = LAYER == 0 && (u.pm % 17) == 0; const int bb = LAYER == 0 ? u.pm / 17 : u.pm / 16;
        const float* g = mod + (size_t)(LAYER * 9 + (is_ctx ? 8 : bb)) * 6144 + 2048;
        f32x4 gv[2][2];
#pragma unroll
        for (int bj = 0; bj < 2; ++bj)
#pragma unroll
            for (int n = 0; n < 2; ++n) gv[bj][n] = *(const f32x4*)(g + col0 + bj * 128 + n * 4);
#pragma unroll
        for (int ai = 0; ai < 2; ++ai)
#pragma unroll
            for (int m = 0; m < 4; ++m) { const int row = row0 + ai * 128 + m * 16;
                if (LAYER == 0) { const int t = row - bb * TC; const float* res; bf16* dst;
                    if (is_ctx) { res = ctx + (size_t)(bb * CTXL + t) * DM; dst = xc + (size_t)(bb * CTXL + t) * DM; }
                    else { res = x + (size_t)(bb * SEQ + t - CTXL) * DM; dst = xout + (size_t)(bb * SEQ + t - CTXL) * DM; }
#pragma unroll
                    for (int bj = 0; bj < 2; ++bj) { const int c = col0 + bj * 128;
                        const f32x4 r0 = *(const f32x4*)(res + c), r1 = *(const f32x4*)(res + c + 4);
                        *(u32x4*)(dst + c) = pack8(r0 + gv[bj][0] * acc[ai][bj][m][0], r1 + gv[bj][1] * acc[ai][bj][m][1]); } }
                else {
#pragma unroll
                    for (int bj = 0; bj < 2; ++bj) { const int c = col0 + bj * 128; const u32x4 q = *(const u32x4*)(xin + (size_t)row * DM + c);
                        const f32x4 r0 = {bflo(q.x), bfhi(q.x), bflo(q.y), bfhi(q.y)}, r1 = {bflo(q.z), bfhi(q.z), bflo(q.w), bfhi(q.w)};
                        *(u32x4*)(xout + (size_t)row * DM + c) = pack8(r0 + gv[bj][0] * acc[ai][bj][m][0], r1 + gv[bj][1] * acc[ai][bj][m][1]); } } }
    }
};
struct EpiMoe1 {
    static constexpr bool PERM = true;
    bf16* ACT;
    __device__ __forceinline__ void operator()(const f32x4 (&acc)[2][2][4][2], const pg8::Unit& u, int wr, int wc, int fr, int fq) const {
        const int row0 = u.pm * 256 + wr * 64 + fr, col = u.pn * 128 + wc * 32 + 8 * fq;
#pragma unroll
        for (int ai = 0; ai < 2; ++ai)
#pragma unroll
            for (int m = 0; m < 4; ++m) { const int row = row0 + ai * 128 + m * 16;
                f32x4 r[2];
#pragma unroll
                for (int n = 0; n < 2; ++n)
#pragma unroll
                    for (int i = 0; i < 4; ++i) { const float a = acc[ai][0][m][n][i], b = acc[ai][1][m][n][i]; r[n][i] = a / (1.f + __expf(-a)) * b; }
                *(u32x4*)(ACT + (size_t)row * 512 + col) = pack8(r[0], r[1]); }
    }
};
struct EpiStore {
    static constexpr bool PERM = true;
    bf16* O; int ldc;
    __device__ __forceinline__ void operator()(const f32x4 (&acc)[2][2][4][2], const pg8::Unit& u, int wr, int wc, int fr, int fq) const {
        const int row0 = u.pm * 256 + wr * 64 + fr, col0 = u.pn * 256 + wc * 32 + 8 * fq;
#pragma unroll
        for (int ai = 0; ai < 2; ++ai)
#pragma unroll
            for (int m = 0; m < 4; ++m) { bf16* rowp = O + (size_t)(row0 + ai * 128 + m * 16) * ldc + col0;
#pragma unroll
                for (int bj = 0; bj < 2; ++bj) *(u32x4*)(rowp + bj * 128) = pack8(acc[ai][bj][m][0], acc[ai][bj][m][1]); }
    }
};

__device__ __forceinline__ void cvt_item(const float* W, int ldw, int col0, const float* gk, bf16* WTrow0, int ldk, int k0, float* scr, int lane) {
    if (col0 >= 0) {
        float v[32];
#pragma unroll
        for (int i = 0; i < 32; ++i) v[i] = W[(size_t)(k0 + 2 * i + (lane >> 5)) * ldw + col0 + (lane & 31)];
        if (gk) {
#pragma unroll
            for (int i = 0; i < 32; ++i) v[i] *= gk[k0 + 2 * i + (lane >> 5)];
        }
#pragma unroll
        for (int i = 0; i < 32; ++i) scr[(2 * i + (lane >> 5)) * 33 + (lane & 31)] = v[i];
    } else {
#pragma unroll 8
        for (int i = 0; i < 32; ++i) { const int kk = 2 * i + (lane >> 5); scr[kk * 33 + (lane & 31)] = 0.f; }
    }
    LDS_WAIT(); asm volatile("" ::: "memory");
    const int c = lane & 7;
#pragma unroll
    for (int j = 0; j < 4; ++j) { const int n = (lane >> 3) + 8 * j; const float* s = scr + (8 * c) * 33 + n;
        u32x4 o; o.x = pk2(s[0 * 33], s[1 * 33]); o.y = pk2(s[2 * 33], s[3 * 33]); o.z = pk2(s[4 * 33], s[5 * 33]); o.w = pk2(s[6 * 33], s[7 * 33]);
        *(u32x4*)(WTrow0 + (size_t)n * ldk + k0 + 8 * c) = o; }
    LDS_WAIT(); asm volatile("" ::: "memory");
}

__device__ __forceinline__ void phase_prologue(const Params& P, unsigned char* lds, int tid, int lane, int wave, int G) {
    unsigned char* ws = P.ws;
    __syncthreads();
    {
        float* sl = (float*)lds;
        float* red = (float*)(lds + 40960);
        float* mod = (float*)(ws + WS_MOD);
        bool loaded = false;
        for (int u = blockIdx.x; u < 192; u += G) {
            if (!loaded) { for (int i = tid; i < 9 * 1024; i += 512) { const float v = i < 8192 ? P.in[I_C][i] : P.in[I_CCTX][i - 8192]; sl[i] = v / (1.f + expf(-v)); } loaded = true; __syncthreads(); }
            const int l = u / 96, col = (u % 96) * 64 + lane;
            const float* W = P.in[I_ADAW] + (size_t)l * 1024 * 6144 + col;
            float a[9];
#pragma unroll
            for (int b = 0; b < 9; ++b) a[b] = 0.f;
            const int kb = wave * 128;
#pragma unroll 16
            for (int k = 0; k < 128; ++k) { const float w = W[(size_t)(kb + k) * 6144];
#pragma unroll
                for (int b = 0; b < 9; ++b) a[b] += sl[b * 1024 + kb + k] * w; }
#pragma unroll
            for (int b = 0; b < 9; ++b) red[(wave * 9 + b) * 64 + lane] = a[b];
            __syncthreads();
            for (int i = tid; i < 9 * 64; i += 512) { const int b = i >> 6, cc = i & 63; float s = 0.f;
#pragma unroll
                for (int w = 0; w < 8; ++w) s += red[(w * 9 + b) * 64 + cc];
                const int c2 = (u % 96) * 64 + cc;
                mod[(size_t)(l * 9 + b) * 6144 + c2] = s + P.in[I_ADAB][l * 6144 + c2]; }
            __syncthreads();
        }
        __syncthreads();
    }
    {
        float* scr = (float*)(lds + wave * 16384);
        const int gw = blockIdx.x * 8 + wave, NGW = G * 8;
        constexpr int I_WIN = 16 * 56, I_UQ = 6 * 24, I_UKV = 4 * 32, I_OUT = 16 * 32, I_HIN = 16 * 96, I_HOUT = 16 * 32, I_WG = 64, I_M13 = 32 * 512, I_M2 = 32 * 256;
        constexpr int NITEMS = I_WIN + I_UQ + I_UKV + I_OUT + I_HIN + I_HOUT + I_WG + I_M13 + I_M2;
        for (int it = gw; it < NITEMS; it += NGW) {
            int r = it;
            if (r < I_M13) { const int le = r >> 9, q = r & 511, kb = q >> 5, nb = q & 31, n0 = 32 * nb, pn = n0 >> 8, j = n0 & 255;
                const float* src = (j < 128 ? P.in[I_MW1] : P.in[I_MW3]) + (size_t)le * 1024 * 512;
                cvt_item(src, 512, 128 * pn + (j & 127), nullptr, (bf16*)(ws + WS_W13) + ((size_t)le * 1024 + n0) * 1024, 1024, 64 * kb, scr, lane); continue; } r -= I_M13;
            if (r < I_M2) { const int le = r >> 8, q = r & 255, kb = q >> 5, nb = q & 31, n0 = 32 * nb;
                cvt_item(P.in[I_MW2] + (size_t)le * 512 * 1024, 1024, n0, nullptr, (bf16*)(ws + WS_W2) + ((size_t)le * 1024 + n0) * 512, 512, 64 * kb, scr, lane); continue; } r -= I_M2;
            if (r < I_WIN) { const int kb = r / 56, nb = r % 56, n0 = 32 * nb; const int col0 = n0 < 640 ? n0 : (n0 < 1664 ? n0 + 32 : (n0 < 1696 ? n0 - 1024 : -1));
                cvt_item(P.in[I_EVWIN], 1696, col0, nullptr, (bf16*)(ws + WS_WIN) + (size_t)n0 * 1024, 1024, 64 * kb, scr, lane); continue; } r -= I_WIN;
            if (r < I_UQ) { const int kb = r / 24, nb = r % 24, n0 = 32 * nb; const int col0 = n0 < 512 ? (n0 >> 6) * 96 + (n0 & 63) : ((n0 - 512) >> 5) * 96 + 64;
                cvt_item(P.in[I_WUQ], 768, col0, P.in[I_QNG], (bf16*)(ws + WS_WUQ) + (size_t)n0 * 384, 384, 64 * kb, scr, lane); continue; } r -= I_UQ;
            if (r < I_UKV) { const int kb = r / 32, nb = r % 32, n0 = 32 * nb;
                cvt_item(P.in[I_WUKV], 1024, n0, P.in[I_KVNG], (bf16*)(ws + WS_WUKV) + (size_t)n0 * 256, 256, 64 * kb, scr, lane); continue; } r -= I_UKV;
            if (r < I_OUT) { const int kb = r / 32, nb = r % 32, n0 = 32 * nb;
                cvt_item(P.in[I_EVWOUT], 1024, n0, nullptr, (bf16*)(ws + WS_WOUT) + (size_t)n0 * 1024, 1024, 64 * kb, scr, lane); continue; } r -= I_OUT;
            if (r < I_HIN) { const int kb = r / 96, nb = r % 96, n0 = 32 * nb;
                cvt_item(P.in[I_ODWIN], 3072, n0, nullptr, (bf16*)(ws + WS_WHIN) + (size_t)n0 * 1024, 1024, 64 * kb, scr, lane); continue; } r -= I_HIN;
            if (r < I_HOUT) { const int kb = r / 32, nb = r % 32, n0 = 32 * nb;
                cvt_item(P.in[I_ODWOUT], 1024, n0, nullptr, (bf16*)(ws + WS_WHOUT) + (size_t)n0 * 1024, 1024, 64 * kb, scr, lane); continue; } r -= I_HOUT;
            { const int mat = r >> 1, nb = r & 1, d = mat >> 4, gsel = (mat >> 3) & 1, h = mat & 7;
                const float* src = (gsel ? P.in[I_LWX] : P.in[I_LWA]) + (size_t)(d * 8 + h) * 4096;
                cvt_item(src, 64, 32 * nb, nullptr, (bf16*)(ws + WS_WG) + (size_t)(h * 256 + d * 128 + gsel * 64 + 32 * nb) * 64, 64, 0, scr, lane); }
        }
    }
    {
        const int gw = blockIdx.x * 8 + wave, NGW = G * 8;
        float* a2 = (float*)(ws + WS_A2);
        const float *w1 = P.in[I_HW1], *b1 = P.in[I_HB1], *f1 = P.in[I_HF1], *w2 = P.in[I_HW2], *b2 = P.in[I_HB2], *f2 = P.in[I_HF2];
        for (int t = gw; t < 4096; t += NGW) {
            const float tl = (float)t / 4095.f, w = (6.283185307179586f / 4096.f) * (float)t;
            float zi = 0.f;
            if (lane == 0) zi = tl;
            else if (lane <= 16) { const float f = 1e-4f + (float)(lane - 1) * ((15.f - 1e-4f) / 15.f); zi = cosf(f * w); }
            else if (lane <= 32) { const float f = 1e-4f + (float)(lane - 17) * ((15.f - 1e-4f) / 15.f); zi = -sinf(f * w); }
            float acc = b1[lane];
            for (int i = 0; i < 33; ++i) acc += __shfl(zi, i) * w1[i * 64 + lane];
            const float a1 = sinf(f1[lane] * acc);
            float acc2 = b2[lane];
            for (int i = 0; i < 64; ++i) acc2 += __shfl(a1, i) * w2[i * 64 + lane];
            a2[(size_t)lane * 4096 + t] = sinf(f2[lane] * acc2);
        }
    }
}

__device__ __forceinline__ void store_row_bf16(bf16* orow, const f32x4 (&v)[4], int lane) {
    unsigned long long* o8 = (unsigned long long*)orow + lane;
#pragma unroll
    for (int j = 0; j < 4; ++j) o8[64 * j] = (unsigned long long)pk2(v[j][0], v[j][1]) | ((unsigned long long)pk2(v[j][2], v[j][3]) << 32);
}
__device__ __forceinline__ void load_xrow(const bf16* row, int lane, u32x2 (&q)[4]) {
#pragma unroll
    for (int j = 0; j < 4; ++j) q[j] = ((const u32x2*)row)[lane + 64 * j];
}
__device__ __forceinline__ void cvt_xrow(const u32x2 (&q)[4], f32x4 (&v)[4]) {
#pragma unroll
    for (int j = 0; j < 4; ++j) v[j] = (f32x4){bflo(q[j].x), bfhi(q[j].x), bflo(q[j].y), bfhi(q[j].y)};
}
__device__ __forceinline__ void norm_mod(f32x4 (&v)[4], const float* g, const float* sh, const float* sc, int lane) {
    float ss = 0.f;
#pragma unroll
    for (int j = 0; j < 4; ++j) ss += (v[j][0] * v[j][0] + v[j][1] * v[j][1]) + (v[j][2] * v[j][2] + v[j][3] * v[j][3]);
    const float rr = rsqrtf(wave_sum(ss) * (1.f / 1024.f) + RMS_EPS);
#pragma unroll
    for (int j = 0; j < 4; ++j) { const f32x4 gg = ((const f32x4*)g)[lane + 64 * j], s1 = ((const f32x4*)sc)[lane + 64 * j], s0 = ((const f32x4*)sh)[lane + 64 * j];
        v[j] = (v[j] * rr * gg) * (1.f + s1) + s0; }
}
struct CombIdx { int s0, s1; float w0, w1; };
struct CombData { u32x2 x[4], y0[4], y1[4]; };
__device__ __forceinline__ void comb_load_idx(const int* rs, const float* rw, int r, CombIdx& I) { I.s0 = rs[2 * r]; I.s1 = rs[2 * r + 1]; I.w0 = rw[2 * r]; I.w1 = rw[2 * r + 1]; }
__device__ __forceinline__ void comb_load_data(const bf16* xrow, const bf16* Y, const CombIdx& I, int lane, CombData& D) {
    const u32x2* y0 = (const u32x2*)(Y + (size_t)I.s0 * 1024) + lane; const u32x2* y1 = (const u32x2*)(Y + (size_t)I.s1 * 1024) + lane;
#pragma unroll
    for (int j = 0; j < 4; ++j) { D.x[j] = ((const u32x2*)xrow)[lane + 64 * j]; D.y0[j] = y0[64 * j]; D.y1[j] = y1[64 * j]; }
}
__device__ __forceinline__ void comb_apply(f32x4 (&v)[4], const CombData& D, const CombIdx& I, const float* g2, int lane) {
#pragma unroll
    for (int j = 0; j < 4; ++j) { const u32x2 a = D.y0[j], b = D.y1[j]; const f32x4 gg = ((const f32x4*)g2)[lane + 64 * j];
        f32x4 m; m[0] = I.w0 * bflo(a.x) + I.w1 * bflo(b.x); m[1] = I.w0 * bfhi(a.x) + I.w1 * bfhi(b.x); m[2] = I.w0 * bflo(a.y) + I.w1 * bflo(b.y); m[3] = I.w0 * bfhi(a.y) + I.w1 * bfhi(b.y);
        v[j] = (f32x4){bflo(D.x[j].x), bfhi(D.x[j].x), bflo(D.x[j].y), bfhi(D.x[j].y)} + gg * m; }
}
__device__ __forceinline__ float route_scores(const f32x4 (&v)[4], const float* rwT  , int lane) {
    float p[16];
#pragma unroll
    for (int e = 0; e < 16; ++e) { f32x2 a2 = {0.f, 0.f};
#pragma unroll
        for (int j = 0; j < 4; ++j) { const f32x4 w = ((const f32x4*)(rwT + e * 1024))[lane + 64 * j];
            a2 = __builtin_elementwise_fma((f32x2){v[j][0], v[j][1]}, (f32x2){w[0], w[1]}, a2); a2 = __builtin_elementwise_fma((f32x2){v[j][2], v[j][3]}, (f32x2){w[2], w[3]}, a2); }
        p[e] = a2[0] + a2[1]; }
    const bool h32 = lane & 32, h16 = lane & 16, h8 = lane & 8, h4 = lane & 4;
    float q8[8], q4[4], q2[2], q1;
#pragma unroll
    for (int e = 0; e < 8; ++e) { const float send = h32 ? p[e] : p[e + 8], keep = h32 ? p[e + 8] : p[e]; q8[e] = keep + __shfl_xor(send, 32); }
#pragma unroll
    for (int e = 0; e < 4; ++e) { const float send = h16 ? q8[e] : q8[e + 4], keep = h16 ? q8[e + 4] : q8[e]; q4[e] = keep + __shfl_xor(send, 16); }
#pragma unroll
    for (int e = 0; e < 2; ++e) { const float send = h8 ? q4[e] : q4[e + 2], keep = h8 ? q4[e + 2] : q4[e]; q2[e] = keep + __shfl_xor(send, 8); }
    { const float send = h4 ? q2[0] : q2[1], keep = h4 ? q2[1] : q2[0]; q1 = keep + __shfl_xor(send, 4); }
    q1 += __shfl_xor(q1, 1); q1 += __shfl_xor(q1, 2);
    return __builtin_amdgcn_rcpf(1.f + __expf(-q1));
}
__device__ __forceinline__ void route_select(const float (&s)[16], const float* rb, int& e0o, int& e1o, float& w0o, float& w1o) {
    float sel[16];
#pragma unroll
    for (int e = 0; e < 16; ++e) sel[e] = s[e] + rb[e];
    float gbest = -1e30f; int gi = 0;
#pragma unroll
    for (int g = 0; g < 4; ++g) { float m1 = -1e30f, m2 = -1e30f;
#pragma unroll
        for (int i = 0; i < 4; ++i) { const float x = sel[4 * g + i]; if (x > m1) { m2 = m1; m1 = x; } else if (x > m2) m2 = x; }
        const float gs = m1 + m2; if (gs > gbest) { gbest = gs; gi = g; } }
    float b0 = -1e30f, b1 = -1e30f; int e0 = 0, e1 = 0; float s0 = 0.f, s1 = 0.f;
#pragma unroll
    for (int e = 0; e < 16; ++e) { const bool in = (e >> 2) == gi; const float x = sel[e];
        if (in && x > b0) { b1 = b0; e1 = e0; s1 = s0; b0 = x; e0 = e; s0 = s[e]; } else if (in && x > b1) { b1 = x; e1 = e; s1 = s[e]; } }
    e0o = e0; e1o = e1; const float den = s0 + s1; w0o = s0 / den; w1o = s1 / den;
}

__device__ __forceinline__ const float* l0_row_ptr(const Params& P, int row) {
    const int b = row / TC, t = row - b * TC;
    return t < CTXL ? P.in[I_CTX] + (size_t)(b * CTXL + t) * DM : P.in[I_X] + (size_t)(b * SEQ + t - CTXL) * DM;
}
__device__ __forceinline__ const bf16* l0_xrow_ptr(const Params& P, int row) {
    const int b = row / TC, t = row - b * TC;
    return t < CTXL ? (const bf16*)(P.ws + WS_XC) + (size_t)(b * CTXL + t) * DM : (const bf16*)P.out + (size_t)(b * SEQ + t - CTXL) * DM;
}
__device__ __forceinline__ void phase_norm1_l0(const Params& P, int lane, int wave, int G) {
    const float* mod = (const float*)(P.ws + WS_MOD); bf16* H = (bf16*)(P.ws + WS_RH);
    int row = blockIdx.x * 8 + wave; if (row >= M0) return;
    f32x4 nx[4];
    { const float* xr = l0_row_ptr(P, row);
#pragma unroll
      for (int j = 0; j < 4; ++j) nx[j] = ((const f32x4*)xr)[lane + 64 * j]; }
    for (; row < M0; row += G * 8) {
        f32x4 v[4];
#pragma unroll
        for (int j = 0; j < 4; ++j) v[j] = nx[j];
        if (row + G * 8 < M0) { const float* xr = l0_row_ptr(P, row + G * 8);
#pragma unroll
            for (int j = 0; j < 4; ++j) nx[j] = ((const f32x4*)xr)[lane + 64 * j]; }
        const int b = row / TC, t = row - b * TC;
        const float* md = mod + (size_t)(t < CTXL ? 8 : b) * 6144;
        norm_mod(v, P.in[I_N1G], md, md + 1024, lane);
        store_row_bf16(H + (size_t)row * DM, v, lane);
    }
}
template <int LAYER> __device__ __forceinline__ void phase_norm2_route(const Params& P, unsigned char* lds, int tid, int lane, int wave, int G) {
    constexpr int ROWS = LAYER == 0 ? 136 : 128;
    float* rwT = (float*)lds;
    int* cntl = (int*)(lds + 65536);
    float* slog = (float*)(lds + 65536 + 1024) + wave * (17 * 16);
    const float* mod = (const float*)(P.ws + WS_MOD) + (size_t)LAYER * 9 * 6144; bf16* H = (bf16*)(P.ws + WS_RH);
    int* route_e = (int*)(P.ws + WS_ROUTE_E); float* route_w = (float*)(P.ws + WS_ROUTE_W); int* cnt = (int*)(P.ws + WS_CNT);
    for (int i = tid; i < 16384; i += 512) { const int k = i >> 4, e = i & 15; rwT[e * 1024 + k] = P.in[I_RW][i]; }
    for (int ch = blockIdx.x; ch < NCHUNK; ch += G) {
        if (tid < 16) cntl[tid] = 0;
        __syncthreads();
        u32x2 nx[4];
        { const int row = ch * ROWS + wave; load_xrow(LAYER == 0 ? l0_xrow_ptr(P, row) : (const bf16*)(P.ws + WS_X3) + (size_t)row * DM, lane, nx); }
        for (int rl = wave; rl < ROWS; rl += 8) {
            const int row = ch * ROWS + rl; const float* md;
            if (LAYER == 0) { const int b = row / TC, t = row - b * TC; md = mod + (size_t)(t < CTXL ? 8 : b) * 6144; }
            else md = mod + (size_t)(row >> 12) * 6144;
            f32x4 v[4]; cvt_xrow(nx, v);
            if (rl + 8 < ROWS) load_xrow(LAYER == 0 ? l0_xrow_ptr(P, row + 8) : (const bf16*)(P.ws + WS_X3) + (size_t)(row + 8) * DM, lane, nx);
            norm_mod(v, P.in[I_N2G] + LAYER * 1024, md + 3072, md + 4096, lane);
            store_row_bf16(H + (size_t)row * DM, v, lane);
            const float sl = route_scores(v, rwT, lane);
            if ((lane & 3) == 0) slog[(rl >> 3) * 16 + 8 * ((lane >> 5) & 1) + 4 * ((lane >> 4) & 1) + 2 * ((lane >> 3) & 1) + ((lane >> 2) & 1)] = sl;
        }
        LDS_WAIT();
        if (lane < (ROWS - wave + 7) / 8) {
            const int rl = wave + 8 * lane, row = ch * ROWS + rl;
            float sc[16];
#pragma unroll
            for (int e = 0; e < 16; ++e) sc[e] = slog[lane * 16 + e];
            int e0, e1; float w0, w1; route_select(sc, P.in[I_RB], e0, e1, w0, w1);
            route_e[row] = e0 | (e1 << 8); route_w[2 * row] = w0; route_w[2 * row + 1] = w1; atomicAdd(&cntl[e0], 1); atomicAdd(&cntl[e1], 1);
        }
        __syncthreads();
        if (tid < 16) cnt[ch * 16 + tid] = cntl[tid];
        __syncthreads();
    }
}
template <int LAYER> __device__ __forceinline__ void phase_permute(const Params& P, unsigned char* lds, int tid, int lane, int wave, int G) {
    constexpr int ROWS = LAYER == 0 ? 136 : 128;
    int* part_tot = (int*)lds;
    int* part_base = part_tot + 512;
    int* slot0 = part_base + 512;
    int* loc = slot0 + 16;
    int* slots = loc + 16;
    int* tstart = slots + 2 * 136;
    int* rel = tstart + 32;
    int* etot = rel + 136;
    const int* cnt = (const int*)(P.ws + WS_CNT); const int* route_e = (const int*)(P.ws + WS_ROUTE_E); int* route_s = (int*)(P.ws + WS_ROUTE_S);
    int* tile_e = (int*)(P.ws + WS_TILEE); int* slot_tok = (int*)(P.ws + WS_SLOTTOK);
    for (int ch = blockIdx.x; ch < NCHUNK; ch += G) {
        { const int e = tid & 15, part = tid >> 4; int tot = 0, bs = 0;
#pragma unroll
          for (int i = 0; i < 8; ++i) { const int c = part * 8 + i; const int x = cnt[c * 16 + e]; tot += x; bs += (c < ch) ? x : 0; }
          part_tot[part * 16 + e] = tot; part_base[part * 16 + e] = bs; }
        if (tid < ROWS) rel[tid] = route_e[ch * ROWS + tid];
        __syncthreads();
        if (tid == 0) {
            int ts = 0;
            for (int e = 0; e < 16; ++e) { int tot = 0, bs = 0; for (int p = 0; p < 32; ++p) { tot += part_tot[p * 16 + e]; bs += part_base[p * 16 + e]; }
                tstart[e] = ts; slot0[e] = ts * 256 + bs; loc[e] = 0; etot[e] = tot; ts += (tot + 255) >> 8; }
            tstart[16] = ts;
            if (ch == 0) { for (int e = 0; e < 16; ++e) for (int i = tstart[e]; i < tstart[e + 1]; ++i) tile_e[i] = e; tile_e[MAXTILES] = ts; }
            for (int rl = 0; rl < ROWS; ++rl) { const int row = ch * ROWS + rl; const int ee = rel[rl]; const int e0 = ee & 255, e1 = ee >> 8;
                const int s0 = slot0[e0] + loc[e0]; loc[e0] = loc[e0] + 1; const int s1 = slot0[e1] + loc[e1]; loc[e1] = loc[e1] + 1;
                slots[2 * rl] = s0; slots[2 * rl + 1] = s1; route_s[2 * row] = s0; route_s[2 * row + 1] = s1; }
        }
        __syncthreads();
        if (tid < 2 * ROWS) slot_tok[slots[tid]] = ch * ROWS + (tid >> 1);
        if (ch == 0) {
            for (int e = 0; e < 16; ++e) { const int lo = tstart[e] * 256 + etot[e], hi = tstart[e + 1] * 256; for (int sidx = lo + tid; sidx < hi; sidx += 512) slot_tok[sidx] = 0; }
        }
        __syncthreads();
    }
}
__device__ __forceinline__ void phase_combine_norm1_l1(const Params& P, int lane, int wave, int G) {
    const float* mod = (const float*)(P.ws + WS_MOD); bf16* H = (bf16*)(P.ws + WS_RH); const bf16* Y = (const bf16*)(P.ws + WS_HPERM);
    const int* rs = (const int*)(P.ws + WS_ROUTE_S); const float* rw = (const float*)(P.ws + WS_ROUTE_W);
    const bf16* X1 = (const bf16*)P.out; bf16* X2 = (bf16*)((unsigned char*)P.out + X2_OFF);
    const int st = G * 8; int row = blockIdx.x * 8 + wave; if (row >= M1) return;
#define L0ROW(r) (((r) >> 12) * TC + CTXL + ((r) & 4095))
    CombIdx ic, in; CombData dc, dn;
    comb_load_idx(rs, rw, L0ROW(row), ic); comb_load_data(X1 + (size_t)row * DM, Y, ic, lane, dc);
    { const int r1 = row + st < M1 ? row + st : row; comb_load_idx(rs, rw, L0ROW(r1), in); }
    for (; row < M1; row += st) {
        const int r1 = row + st < M1 ? row + st : row, r2 = row + 2 * st < M1 ? row + 2 * st : r1;
        comb_load_data(X1 + (size_t)r1 * DM, Y, in, lane, dn);
        CombIdx i2; comb_load_idx(rs, rw, L0ROW(r2), i2);
        const int b = row >> 12;
        f32x4 v[4]; comb_apply(v, dc, ic, mod + (size_t)b * 6144 + 5120, lane);
        store_row_bf16(X2 + (size_t)row * DM, v, lane);
        const float* md = mod + (size_t)(9 + b) * 6144;
        norm_mod(v, P.in[I_N1G] + 1024, md, md + 1024, lane);
        store_row_bf16(H + (size_t)row * DM, v, lane);
        dc = dn; ic = in; in = i2;
    }
#undef L0ROW
}
__device__ __forceinline__ void phase_final(const Params& P, int lane, int wave, int G) {
    const float* mod = (const float*)(P.ws + WS_MOD); const bf16* Y = (const bf16*)(P.ws + WS_HPERM);
    const int* rs = (const int*)(P.ws + WS_ROUTE_S); const float* rw = (const float*)(P.ws + WS_ROUTE_W);
    const bf16* X3 = (const bf16*)(P.ws + WS_X3);
    const int st = G * 8; int row = blockIdx.x * 8 + wave; if (row >= M1) return;
    CombIdx ic, in; CombData dc, dn;
    comb_load_idx(rs, rw, row, ic); comb_load_data(X3 + (size_t)row * DM, Y, ic, lane, dc);
    { const int r1 = row + st < M1 ? row + st : row; comb_load_idx(rs, rw, r1, in); }
    for (; row < M1; row += st) {
        const int r1 = row + st < M1 ? row + st : row, r2 = row + 2 * st < M1 ? row + 2 * st : r1;
        comb_load_data(X3 + (size_t)r1 * DM, Y, in, lane, dn);
        CombIdx i2; comb_load_idx(rs, rw, r2, i2);
        const int b = row >> 12;
        float* xr = P.out + (size_t)row * DM;
        f32x4 v[4]; comb_apply(v, dc, ic, mod + (size_t)(9 + b) * 6144 + 5120, lane);
        float ss = 0.f;
#pragma unroll
        for (int j = 0; j < 4; ++j) ss += (v[j][0] * v[j][0] + v[j][1] * v[j][1]) + (v[j][2] * v[j][2] + v[j][3] * v[j][3]);
        const float rr = rsqrtf(wave_sum(ss) * (1.f / 1024.f) + RMS_EPS);
#pragma unroll
        for (int j = 0; j < 4; ++j) ((f32x4*)xr)[lane + 64 * j] = v[j] * rr * ((const f32x4*)P.in[I_FING])[lane + 64 * j];
        dc = dn; ic = in; in = i2;
    }
}
__device__ __forceinline__ void phase_rowstat(const Params& P, int lane, int wave, int G) {
    const bf16* CQ = (const bf16*)(P.ws + WS_CQ); const bf16* CKV = (const bf16*)(P.ws + WS_CKV); float* rq = (float*)(P.ws + WS_RQ); float* rkv = (float*)(P.ws + WS_RKV);
    for (int row = blockIdx.x * 8 + wave; row < M0; row += G * 8) {
        float sq = 0.f, sk = 0.f;
        if (lane < 48) { const u32x4 a = ((const u32x4*)(CQ + (size_t)row * 384))[lane];
            sq = (bflo(a.x) * bflo(a.x) + bfhi(a.x) * bfhi(a.x)) + (bflo(a.y) * bflo(a.y) + bfhi(a.y) * bfhi(a.y)) + (bflo(a.z) * bflo(a.z) + bfhi(a.z) * bfhi(a.z)) + (bflo(a.w) * bflo(a.w) + bfhi(a.w) * bfhi(a.w)); }
        if (lane < 32) { const u32x4 a = ((const u32x4*)(CKV + (size_t)row * 256))[lane];
            sk = (bflo(a.x) * bflo(a.x) + bfhi(a.x) * bfhi(a.x)) + (bflo(a.y) * bflo(a.y) + bfhi(a.y) * bfhi(a.y)) + (bflo(a.z) * bflo(a.z) + bfhi(a.z) * bfhi(a.z)) + (bflo(a.w) * bflo(a.w) + bfhi(a.w) * bfhi(a.w)); }
        sq = wave_sum(sq); sk = wave_sum(sk);
        if (lane == 0) { rq[row] = rsqrtf(sq * (1.f / 384.f) + RMS_EPS); rkv[row] = rsqrtf(sk * (1.f / 256.f) + RMS_EPS); }
    }
}

constexpr int LRU_UXF = 0;
constexpr int LRU_UF = 17408;
constexpr int LRU_UB = LRU_UF + 16384;
constexpr int LRU_G = LRU_UB + 8192;
__device__ __forceinline__ int crow32(int r, int hi) { return (r & 3) + 8 * (r >> 2) + 4 * hi; }
struct LruK { float cw[4][8]; float cb[8]; float ba, bx, sp; bf16x8 bf[4]; int h; };
struct LruTile { u32x4 a, b; };
__device__ __forceinline__ void lru_load_consts(const Params& P, int h, int tid, int lane, int wave, LruK& K) {
    const int c0 = (tid & 7) * 8; const float* cw = P.in[I_LCW]; const float* cb = P.in[I_LCB];
#pragma unroll
    for (int i = 0; i < 8; ++i) { const int ch = h * 64 + c0 + i; K.cb[i] = cb[ch];
#pragma unroll
        for (int j = 0; j < 4; ++j) K.cw[j][i] = cw[j * 512 + ch]; }
    { const int c = tid & 63, d = (tid >> 6) & 1, ch = h * 64 + c; K.ba = P.in[I_LBA][d * 512 + ch]; K.bx = P.in[I_LBX][d * 512 + ch]; K.sp = log1pf(expf(-P.in[I_LLAM][d * 512 + ch])); }
    { const bf16* WgT = (const bf16*)(P.ws + WS_WG) + (size_t)h * 256 * 64; const int n = wave * 32 + (lane & 31), hi = lane >> 5;
#pragma unroll
      for (int ks = 0; ks < 4; ++ks) K.bf[ks] = *(const bf16x8*)(WgT + (size_t)n * 64 + 16 * ks + 8 * hi); }
    K.h = h;
}
__device__ __forceinline__ void lru_tile_load(const bf16* UX, int b, int ck, int h, int tid, LruTile& T) {
    const int seg_lo = ck < 4 ? 0 : CTXL, seg_hi = ck < 4 ? CTXL : TC, p0 = ck * 64 - 2, c8 = (tid & 7) * 8;
    T.a = (u32x4){0u, 0u, 0u, 0u}; T.b = (u32x4){0u, 0u, 0u, 0u};
    { const int pos = p0 + (tid >> 3); if (pos >= seg_lo && pos < seg_hi) T.a = *(const u32x4*)(UX + (size_t)(b * TC + pos) * 512 + h * 64 + c8); }
    if (tid < 24) { const int pos = p0 + 64 + (tid >> 3); if (pos >= seg_lo && pos < seg_hi) T.b = *(const u32x4*)(UX + (size_t)(b * TC + pos) * 512 + h * 64 + c8); }
}
__device__ __forceinline__ void st8f(float* d, const u32x4 a) { d[0] = bflo(a.x); d[1] = bfhi(a.x); d[2] = bflo(a.y); d[3] = bfhi(a.y); d[4] = bflo(a.z); d[5] = bfhi(a.z); d[6] = bflo(a.w); d[7] = bfhi(a.w); }
constexpr int LRU_QP = LRU_G + 65536;
constexpr int LRU_QS = LRU_QP + 2048;
constexpr int LRU_HQ = LRU_QS + 2048;
template <int MODE> __device__ __forceinline__ void lru_coeffs(unsigned char* lds, const LruTile& T, const LruK& K, int tid, int lane, int wave) {
    float* uxf = (float*)(lds + LRU_UXF); float* uf = (float*)(lds + LRU_UF); bf16* ub = (bf16*)(lds + LRU_UB); float* Gm = (float*)(lds + LRU_G);
    __syncthreads();
    st8f(uxf + (tid >> 3) * 64 + (tid & 7) * 8, T.a);
    if (tid < 24) st8f(uxf + (64 + (tid >> 3)) * 64 + (tid & 7) * 8, T.b);
    __syncthreads();
    { const int t = tid >> 3, c0 = (tid & 7) * 8; float uo[8];
#pragma unroll
      for (int i = 0; i < 8; ++i) { float u = K.cb[i];
#pragma unroll
          for (int j = 0; j < 4; ++j) u += K.cw[j][i] * uxf[(t + j) * 64 + c0 + i];
          uo[i] = u; uf[t * 64 + c0 + i] = u; }
      u32x4 w; w.x = pk2(uo[0], uo[1]); w.y = pk2(uo[2], uo[3]); w.z = pk2(uo[4], uo[5]); w.w = pk2(uo[6], uo[7]);
      *(u32x4*)(ub + t * 64 + c0) = w; }
    __syncthreads();
    {
        const int r32 = lane & 31, hi = lane >> 5, n = wave * 32 + r32;
        f32x16 acc0 = {}, acc1 = {};
#pragma unroll
        for (int ks = 0; ks < 4; ++ks) {
            const bf16x8 a0 = *(const bf16x8*)(ub + (r32) * 64 + 16 * ks + 8 * hi), a1 = *(const bf16x8*)(ub + (32 + r32) * 64 + 16 * ks + 8 * hi);
            acc0 = __builtin_amdgcn_mfma_f32_32x32x16_bf16(a0, K.bf[ks], acc0, 0, 0, 0);
            acc1 = __builtin_amdgcn_mfma_f32_32x32x16_bf16(a1, K.bf[ks], acc1, 0, 0, 0);
        }
#pragma unroll
        for (int r = 0; r < 16; ++r) { Gm[crow32(r, hi) * 256 + n] = acc0[r]; Gm[(32 + crow32(r, hi)) * 256 + n] = acc1[r]; }
    }
    __syncthreads();
    { const int c = tid & 63, d = (tid >> 6) & 1, tg = tid >> 7;
      constexpr float L2E = 1.4426950408889634f; const float kba = K.ba, kbx = K.bx, ksp8 = -8.f * K.sp;
      float* g0 = Gm + (tg * 16) * 256 + d * 128 + c; const float* u0 = uf + (tg * 16) * 64 + c;
      float hh = 0.f, pp = 1.f;
#pragma unroll 2
      for (int k = 0; k < 8; ++k) { const int i = d ? 14 - 2 * k : 2 * k;
          const f32x2 ga = (f32x2){g0[i * 256] + kba, g0[(i + 1) * 256] + kba}, gx = (f32x2){g0[i * 256 + 64] + kbx, g0[(i + 1) * 256 + 64] + kbx};
          const f32x2 ta = ga * (-L2E), tx = gx * (-L2E);
          const f32x2 ea = (f32x2){__builtin_amdgcn_exp2f(ta[0]), __builtin_amdgcn_exp2f(ta[1])} + 1.f, ex = (f32x2){__builtin_amdgcn_exp2f(tx[0]), __builtin_amdgcn_exp2f(tx[1])} + 1.f;
          const f32x2 r = {__builtin_amdgcn_rcpf(ea[0]), __builtin_amdgcn_rcpf(ea[1])}, ii = {__builtin_amdgcn_rcpf(ex[0]), __builtin_amdgcn_rcpf(ex[1])};
          const f32x2 la = r * ksp8, tl = la * L2E;
          const f32x2 a = {__builtin_amdgcn_exp2f(tl[0]), __builtin_amdgcn_exp2f(tl[1])};
          const f32x2 x2 = la + la;
          const f32x2 emp = -x2 * (x2 * (x2 * (x2 * 0.041666668f + 0.16666667f) + 0.5f) + 1.f);
          const f32x2 ema = 1.f - a * a;
          const f32x2 em = {x2[0] > -0.25f ? emp[0] : ema[0], x2[1] > -0.25f ? emp[1] : ema[1]};
          const f32x2 sq = {__builtin_amdgcn_sqrtf(em[0]), __builtin_amdgcn_sqrtf(em[1])};
          const f32x2 bb = sq * (ii * (f32x2){u0[i * 64], u0[(i + 1) * 64]});
          const float a_f = d ? a[1] : a[0], a_s = d ? a[0] : a[1], b_f = d ? bb[1] : bb[0], b_s = d ? bb[0] : bb[1];
          hh = a_f * hh + b_f; pp *= a_f; const float h_f = hh, p_f = pp;
          hh = a_s * hh + b_s; pp *= a_s;
          if (MODE == 3) { const int of = d ? i + 1 : i, os = d ? i : i + 1;
              g0[of * 256] = h_f; g0[of * 256 + 64] = p_f; g0[os * 256] = hh; g0[os * 256 + 64] = pp; } }
      ((float*)(lds + LRU_QP))[(d * 4 + tg) * 64 + c] = pp; ((float*)(lds + LRU_QS))[(d * 4 + tg) * 64 + c] = hh; }
    __syncthreads();
}
__device__ __forceinline__ void lru_unit(int u, int& b, int& ck, int& h) { h = u & 7; ck = (u >> 3) % LCH; b = u / (8 * LCH); }
__device__ __forceinline__ void phase_lru_f1(const Params& P, unsigned char* lds, int tid, int lane, int wave, int G) {
    float* Gm = (float*)(lds + LRU_G); float* CP = (float*)(P.ws + WS_CP); float* CS = (float*)(P.ws + WS_CS); const bf16* UX = (const bf16*)(P.ws + WS_UX);
    constexpr int NU = NB * LCH * 8;
    int u = blockIdx.x; if (u >= NU) return;
    int b, ck, h; lru_unit(u, b, ck, h);
    LruK K; lru_load_consts(P, h, tid, lane, wave, K);
    LruTile T; lru_tile_load(UX, b, ck, h, tid, T);
    for (;;) {
        if (h != K.h) lru_load_consts(P, h, tid, lane, wave, K);
        lru_coeffs<1>(lds, T, K, tid, lane, wave);
        const int un = u + G; int bn = 0, ckn = 0, hn = h;
        if (un < NU) { lru_unit(un, bn, ckn, hn); lru_tile_load(UX, bn, ckn, hn, tid, T); }
        if (tid < 128) { const int d = tid >> 6, c = tid & 63; float hh = 0.f, pp = 1.f;
            const float* QP = (const float*)(lds + LRU_QP); const float* QS = (const float*)(lds + LRU_QS);
#pragma unroll
            for (int k = 0; k < 4; ++k) { const int q = d ? 3 - k : k; const float a = QP[(d * 4 + q) * 64 + c], bb = QS[(d * 4 + q) * 64 + c]; hh = a * hh + bb; pp *= a; }
            const size_t o = ((size_t)(d * 8 + b) * LCH + ck) * 512 + h * 64 + c; CP[o] = pp; CS[o] = hh; }
        if (un >= NU) break;
        u = un; b = bn; ck = ckn; h = hn;
    }
    __syncthreads();
}
__device__ __forceinline__ void phase_lru_carry(const Params& P, int lane, int wave, int G) {
    const float* CP = (const float*)(P.ws + WS_CP); const float* CS = (const float*)(P.ws + WS_CS); float* HIN = (float*)(P.ws + WS_HIN);
    if (wave != 0) return;
    for (int sb = blockIdx.x; sb < 128; sb += G) {
        const int s = sb * 64 + lane, d = s >> 12, b = (s >> 9) & 7, ch = s & 511; const size_t base = ((size_t)(d * 8 + b) * LCH) * 512 + ch;
        float hh = 0.f;
#pragma unroll 1
        for (int st = 0; st < LCH; st += 17) { float cp[17], cs[17]; int q[17];
#pragma unroll
            for (int i = 0; i < 17; ++i) { const int step = st + i; q[i] = d == 0 ? step : (step < 4 ? 3 - step : 71 - step); cp[i] = CP[base + (size_t)q[i] * 512]; cs[i] = CS[base + (size_t)q[i] * 512]; }
#pragma unroll
            for (int i = 0; i < 17; ++i) { HIN[base + (size_t)q[i] * 512] = hh; hh = cp[i] * hh + cs[i]; } }
    }
}
__device__ __forceinline__ float gelu_tanh(float x) { const float u = 0.7978845608028654f * (x + 0.044715f * x * x * x); return x * __builtin_amdgcn_rcpf(1.f + __expf(-2.f * u)); }
__device__ __forceinline__ void phase_lru_f3(const Params& P, unsigned char* lds, int tid, int lane, int wave, int G) {
    float* Gm = (float*)(lds + LRU_G); const bf16* UX = (const bf16*)(P.ws + WS_UX);
    const bf16* UG = (const bf16*)(P.ws + WS_UG); bf16* MIX = (bf16*)(P.ws + WS_RH); const float* HIN = (const float*)(P.ws + WS_HIN);
    constexpr int NU = NB * LCH * 8;
    int u = blockIdx.x; if (u >= NU) return;
    int b, ck, h; lru_unit(u, b, ck, h);
    LruK K; lru_load_consts(P, h, tid, lane, wave, K);
    LruTile T; lru_tile_load(UX, b, ck, h, tid, T);
    const int t = tid >> 3, c0 = (tid & 7) * 8;
    u32x4 gq = *(const u32x4*)(UG + ((size_t)b * TC + ck * 64 + t) * 512 + h * 64 + c0);
    float hin = 0.f; if (tid < 128) hin = HIN[((size_t)((tid >> 6) * 8 + b) * LCH + ck) * 512 + h * 64 + (tid & 63)];
    for (;;) {
        if (h != K.h) lru_load_consts(P, h, tid, lane, wave, K);
        lru_coeffs<3>(lds, T, K, tid, lane, wave);
        const u32x4 g = gq; const float hh0 = hin;
        const int un = u + G; int bn = 0, ckn = 0, hn = h;
        if (un < NU) { lru_unit(un, bn, ckn, hn); lru_tile_load(UX, bn, ckn, hn, tid, T);
            gq = *(const u32x4*)(UG + ((size_t)bn * TC + ckn * 64 + t) * 512 + hn * 64 + c0);
            if (tid < 128) hin = HIN[((size_t)((tid >> 6) * 8 + bn) * LCH + ckn) * 512 + hn * 64 + (tid & 63)]; }
        float* HQ = (float*)(lds + LRU_HQ);
        if (tid < 128) { const int d = tid >> 6, c = tid & 63; float hh = hh0;
            const float* QP = (const float*)(lds + LRU_QP); const float* QS = (const float*)(lds + LRU_QS);
#pragma unroll
            for (int k = 0; k < 4; ++k) { const int q = d ? 3 - k : k; HQ[(d * 4 + q) * 64 + c] = hh; hh = QP[(d * 4 + q) * 64 + c] * hh + QS[(d * 4 + q) * 64 + c]; } }
        __syncthreads();
        { const size_t row = (size_t)b * TC + ck * 64 + t; const int q = t >> 4;
          const float gv[8] = {bflo(g.x), bfhi(g.x), bflo(g.y), bfhi(g.y), bflo(g.z), bfhi(g.z), bflo(g.w), bfhi(g.w)};
          float o[8];
#pragma unroll
          for (int i = 0; i < 8; ++i) { const int cc = c0 + i;
              const float y = (Gm[t * 256 + cc] + Gm[t * 256 + 64 + cc] * HQ[q * 64 + cc]) + (Gm[t * 256 + 128 + cc] + Gm[t * 256 + 192 + cc] * HQ[(4 + q) * 64 + cc]);
              o[i] = y * gelu_tanh(gv[i]); }
          u32x4 w; w.x = pk2(o[0], o[1]); w.y = pk2(o[2], o[3]); w.z = pk2(o[4], o[5]); w.w = pk2(o[6], o[7]);
          *(u32x4*)(MIX + row * 1024 + 512 + h * 64 + c0) = w; }
        if (un >= NU) break;
        u = un; b = bn; ck = ckn; h = hn;
    }
    __syncthreads();
}

namespace att {
constexpr int NW = 8, QBLK = 32, KVBLK = 64;
constexpr float SCALE = 0.10206207261596575f;
constexpr float THR = 8.f;
constexpr int LDQ = 768, LDK = 768, LDV = 512, LDO = 1024;
constexpr int SHM_V = 16384, SHM_K = 16384, SHM_ATTN = 2 * SHM_V + 2 * SHM_K + NW * 64 * 4;
#define KSWZ(row, colB) ((row) * 256 + ((colB) ^ (((row) & 7) << 4)))
#define SBAR() __builtin_amdgcn_sched_barrier(0)
__device__ __forceinline__ int crow(int r, int hi) { return (r & 3) + 8 * (r >> 2) + 4 * hi; }
__device__ __forceinline__ unsigned cvtpk(float lo, float hi) { unsigned r; asm volatile("v_cvt_pk_bf16_f32 %0, %1, %2" : "=v"(r) : "v"(lo), "v"(hi)); return r; }
__device__ __forceinline__ void partialSM(f32x16& p0, f32x16& p1, float& m_reg, float& mn, float& alpha) {
  constexpr float C = SCALE * 1.4426950408889634f;
  float pmax = p0[0];
#pragma unroll
  for (int r = 1; r < 16; ++r) pmax = fmaxf(pmax, p0[r]);
#pragma unroll
  for (int r = 0; r < 16; ++r) pmax = fmaxf(pmax, p1[r]);
  { auto rr = __builtin_amdgcn_permlane32_swap(__float_as_uint(pmax), __float_as_uint(pmax), false, false);
    pmax = fmaxf(__uint_as_float(rr[0]), __uint_as_float(rr[1])); }
  if (__builtin_expect(__all(pmax - m_reg <= THR / SCALE), 1)) { mn = m_reg; alpha = 1.f; }
  else { mn = fmaxf(m_reg, pmax); alpha = __builtin_amdgcn_exp2f((m_reg - mn) * C); m_reg = mn; }
  float mnC = -mn * C;
#pragma unroll
  for (int r = 0; r < 16; ++r) p0[r] = fmaf(p0[r], C, mnC);
#pragma unroll
  for (int r = 0; r < 16; ++r) p1[r] = fmaf(p1[r], C, mnC);
#pragma unroll
  for (int r = 0; r < 16; ++r) p0[r] = __builtin_amdgcn_exp2f(p0[r]);
}
__device__ __forceinline__ void finishSM(f32x16& p0, f32x16& p1, float alpha, float& l_reg, bf16x8& pa0, bf16x8& pa1, bf16x8& pa2, bf16x8& pa3) {
#pragma unroll
  for (int r = 0; r < 16; ++r) p1[r] = __builtin_amdgcn_exp2f(p1[r]);
  float ps = 0;
#pragma unroll
  for (int r = 0; r < 16; ++r) ps += p0[r];
#pragma unroll
  for (int r = 0; r < 16; ++r) ps += p1[r];
  { auto rr = __builtin_amdgcn_permlane32_swap(__float_as_uint(ps), __float_as_uint(ps), false, false);
    ps = __uint_as_float(rr[0]) + __uint_as_float(rr[1]); }
  l_reg = l_reg * alpha + ps;
#define PK4(P, BASE, OUT) do { unsigned a0 = cvtpk(P[BASE + 0], P[BASE + 1]), a1 = cvtpk(P[BASE + 2], P[BASE + 3]);   \
    unsigned b0 = cvtpk(P[BASE + 4], P[BASE + 5]), b1 = cvtpk(P[BASE + 6], P[BASE + 7]);                              \
    auto r0 = __builtin_amdgcn_permlane32_swap(a0, b0, false, false); auto r1 = __builtin_amdgcn_permlane32_swap(a1, b1, false, false); \
    u32x4 w = {r0[0], r1[0], r0[1], r1[1]}; OUT = *reinterpret_cast<bf16x8*>(&w); } while (0)
  PK4(p0, 0, pa0); PK4(p0, 8, pa1); PK4(p1, 0, pa2); PK4(p1, 8, pa3);
#undef PK4
}
__device__ __forceinline__ void qkt(f32x16& p0, f32x16& p1, const bf16* Ks, const bf16x8* qr, int r32, int hi) {
  p0 = f32x16{}; p1 = f32x16{};
#pragma unroll
  for (int d0 = 0; d0 < 6; ++d0) { int cb = (d0 * 16 + hi * 8) * 2;
    bf16x8 b0 = *reinterpret_cast<const bf16x8*>((const char*)Ks + KSWZ(r32, cb));
    bf16x8 b1 = *reinterpret_cast<const bf16x8*>((const char*)Ks + KSWZ(32 + r32, cb));
    p0 = __builtin_amdgcn_mfma_f32_32x32x16_bf16(b0, qr[d0], p0, 0, 0, 0);
    p1 = __builtin_amdgcn_mfma_f32_32x32x16_bf16(b1, qr[d0], p1, 0, 0, 0); }
}
__device__ __forceinline__ int v_st(int k, int c) { const int kk = (k & ~0xC) | ((k & 4) << 1) | ((k & 8) >> 1); return ((kk >> 3) * 4 + (c >> 5)) * 512 + ((kk & 7) * 32 + (c & 31)) * 2; }
__device__ __forceinline__ int v_rd_base(int lane) { return ((lane & 3) << 3) | (((lane >> 2) & 3) << 6) | (((lane >> 4) & 1) << 5) | (((lane >> 5) & 1) << 8); }
constexpr int v_rd_off(int d0, int ks, int half) { return d0 * 512 + ks * 4096 + half * 2048; }
template <int OFF> __device__ __forceinline__ s16x4 tr_read(int vb) {
  s16x4 r; asm volatile("ds_read_b64_tr_b16 %0, %1 offset:%2" : "=&v"(r) : "v"(vb), "i"(OFF) : "memory"); return r;
}
template <int D0> __device__ __forceinline__ void pv_one(f32x16& od, int vb, bf16x8 pa0, bf16x8 pa1, bf16x8 pa2, bf16x8 pa3) {
  const s16x4 l0 = tr_read<v_rd_off(D0, 0, 0)>(vb), h0 = tr_read<v_rd_off(D0, 0, 1)>(vb), l1 = tr_read<v_rd_off(D0, 1, 0)>(vb), h1 = tr_read<v_rd_off(D0, 1, 1)>(vb);
  const s16x4 l2 = tr_read<v_rd_off(D0, 2, 0)>(vb), h2 = tr_read<v_rd_off(D0, 2, 1)>(vb), l3 = tr_read<v_rd_off(D0, 3, 0)>(vb), h3 = tr_read<v_rd_off(D0, 3, 1)>(vb);
  asm volatile("s_waitcnt lgkmcnt(0)" ::: "memory"); SBAR();
#define PK(L, H) (bf16x8){L[0], L[1], L[2], L[3], H[0], H[1], H[2], H[3]}
  od = __builtin_amdgcn_mfma_f32_32x32x16_bf16(pa0, PK(l0, h0), od, 0, 0, 0);
  od = __builtin_amdgcn_mfma_f32_32x32x16_bf16(pa1, PK(l1, h1), od, 0, 0, 0);
  od = __builtin_amdgcn_mfma_f32_32x32x16_bf16(pa2, PK(l2, h2), od, 0, 0, 0);
  od = __builtin_amdgcn_mfma_f32_32x32x16_bf16(pa3, PK(l3, h3), od, 0, 0, 0);
#undef PK
}
__device__ __forceinline__ void pv_d0(f32x16* o, int vb, bf16x8 pa0, bf16x8 pa1, bf16x8 pa2, bf16x8 pa3) {
  pv_one<0>(o[0], vb, pa0, pa1, pa2, pa3); pv_one<1>(o[1], vb, pa0, pa1, pa2, pa3);
}
__device__ __forceinline__ void attn_dense_body(const bf16* __restrict__ Qb, const bf16* __restrict__ Kh, const bf16* __restrict__ Vh, bf16* __restrict__ Ob, int seq, int tq0  , char* lds) {
  const int tid = threadIdx.x, wid = tid >> 6, lane = tid & 63, r32 = lane & 31, hi = lane >> 5;
  bf16* V_lds = (bf16*)lds; bf16* K_lds = (bf16*)(lds + 2 * SHM_V);
  float* ws = (float*)(lds + 2 * SHM_V + 2 * SHM_K) + wid * 64; float* li_l = ws; float* al_l = ws + 32;
  float m_reg = -1e30f, l_reg = 0; f32x16 o[2] = {}; bf16x8 qr[6];
  const bf16* Qw = Qb + (long)(wid * QBLK + r32) * LDQ + hi * 8;
#pragma unroll
  for (int d0 = 0; d0 < 6; ++d0) qr[d0] = *reinterpret_cast<const bf16x8*>(Qw + d0 * 16);
  {
    const int tq = tq0 + wid * QBLK + r32; const bool on = tq0 >= 0;
    constexpr float IF[8] = {1.0f, 0.316227766f, 0.1f, 0.0316227766f, 0.01f, 0.00316227766f, 0.001f, 0.000316227766f};
#pragma unroll
    for (int ax = 0; ax < 2; ++ax) { const float pos = (float)(ax == 0 ? (tq >> 6) : (tq & 63)) * 0.15915494309189535f;
      bf16x8 qv = qr[4 + ax]; bf16x8 qo;
#pragma unroll
      for (int i = 0; i < 8; ++i) { const float x = __uint_as_float(((unsigned)(unsigned short)qv[i]) << 16); const float other = __shfl_xor(x, 32);
        const float sn = __builtin_amdgcn_sinf(pos * IF[i]), cs = __builtin_amdgcn_cosf(pos * IF[i]);
        const float r = hi == 0 ? x * cs - other * sn : other * sn + x * cs;
        unsigned u = __float_as_uint(on ? r : x); u = (u + 0x7fffu + ((u >> 16) & 1u)) >> 16; qo[i] = (short)u; }
      qr[4 + ax] = qo; }
  }
  const int sr = tid >> 3, sc = (tid & 7) * 8, vst = v_st(sr, sc), kr2 = (tid >> 2) & 63, kc2 = 64 + (tid & 3) * 8; const bool kb2 = tid < 256;
  const int vb0 = (int)(uintptr_t)V_lds + v_rd_base(lane);
  struct { bf16x8 vs, ka, kb; } sr_[2];
#define SLOAD(i, k0) do { sr_[i].vs = *reinterpret_cast<const bf16x8*>(&Vh[(long)((k0) + sr) * LDV + sc]); \
    sr_[i].ka = *reinterpret_cast<const bf16x8*>(&Kh[(long)((k0) + sr) * LDK + sc]); \
    if (kb2) sr_[i].kb = *reinterpret_cast<const bf16x8*>(&Kh[(long)((k0) + kr2) * LDK + kc2]); } while (0)
#define SWRITE(b, i) do { *(bf16x8*)((char*)V_lds + (b) * SHM_V + vst) = sr_[i].vs;          \
    *(bf16x8*)((char*)K_lds + (b) * SHM_K + KSWZ(sr, sc * 2)) = sr_[i].ka;                       \
    if (kb2) *(bf16x8*)((char*)K_lds + (b) * SHM_K + KSWZ(kr2, kc2 * 2)) = sr_[i].kb; } while (0)
#define SWAIT() asm volatile("s_waitcnt vmcnt(3)" ::: "memory")
#define RESC(a) do { if (__any((a) < 1.f)) { if (hi == 0) al_l[r32] = (a); asm volatile("s_waitcnt lgkmcnt(0)" ::: "memory"); \
    _Pragma("unroll") for (int d = 0; d < 2; ++d) _Pragma("unroll") for (int r = 0; r < 16; ++r) o[d][r] *= al_l[crow(r, hi)]; } } while (0)
  f32x16 pA0, pA1, pB0, pB1; float mnA, mnB, alA, alB; bf16x8 pa0, pa1, pa2, pa3; const int NT = seq / KVBLK;
  constexpr int SE = 0, SO = 1;
  SLOAD(SE, 0); asm volatile("s_waitcnt vmcnt(0)" ::: "memory"); SWRITE(0, SE); __syncthreads();
  qkt(pA0, pA1, K_lds, qr, r32, hi); partialSM(pA0, pA1, m_reg, mnA, alA);
  SLOAD(SO, KVBLK); if (2 < NT) SLOAD(SE, 2 * KVBLK);
  SWAIT(); SWRITE(1, SO); __syncthreads();
#ifndef ATT_SKEW
#define ATT_SKEW 0
#endif
  const bool swp = ATT_SKEW > 0 && (__builtin_amdgcn_readfirstlane(wid) >= 4);
  for (int j = 1; j + 1 < NT; j += 2) {
    if (swp) __builtin_amdgcn_s_sleep(ATT_SKEW);
    SBAR(); qkt(pB0, pB1, (bf16*)((char*)K_lds + SHM_K), qr, r32, hi);
    finishSM(pA0, pA1, alA, l_reg, pa0, pa1, pa2, pa3); SBAR();
    SLOAD(SO, (j + 2) * KVBLK); SBAR();
    pv_d0(o, vb0, pa0, pa1, pa2, pa3); partialSM(pB0, pB1, m_reg, mnB, alB);
    __syncthreads(); SWAIT(); SWRITE(0, SE);
    RESC(alB); __syncthreads();
    if (swp) __builtin_amdgcn_s_sleep(ATT_SKEW);
    SBAR(); qkt(pA0, pA1, K_lds, qr, r32, hi);
    finishSM(pB0, pB1, alB, l_reg, pa0, pa1, pa2, pa3); SBAR();
    if (j + 3 < NT) SLOAD(SE, (j + 3) * KVBLK); SBAR();
    pv_d0(o, vb0 + (int)SHM_V, pa0, pa1, pa2, pa3); partialSM(pA0, pA1, m_reg, mnA, alA);
    __syncthreads(); SWAIT(); SWRITE(1, SO);
    RESC(alA); __syncthreads();
  }
  SBAR(); qkt(pB0, pB1, (bf16*)((char*)K_lds + SHM_K), qr, r32, hi);
  finishSM(pA0, pA1, alA, l_reg, pa0, pa1, pa2, pa3); SBAR();
  pv_d0(o, vb0, pa0, pa1, pa2, pa3); partialSM(pB0, pB1, m_reg, mnB, alB);
  __syncthreads(); RESC(alB);
  finishSM(pB0, pB1, alB, l_reg, pa0, pa1, pa2, pa3); SBAR();
  pv_d0(o, vb0 + (int)SHM_V, pa0, pa1, pa2, pa3);
  if (hi == 0) li_l[r32] = l_reg; asm volatile("s_waitcnt lgkmcnt(0)" ::: "memory");
  float rli[16];
#pragma unroll
  for (int r = 0; r < 16; ++r) rli[r] = __builtin_amdgcn_rcpf(li_l[crow(r, hi)]);
  bf16* Ow = Ob + (long)(wid * QBLK) * LDO;
#pragma unroll
  for (int r = 0; r < 16; ++r) { int orow = crow(r, hi);
#pragma unroll
    for (int d0 = 0; d0 < 2; ++d0) Ow[(long)orow * LDO + d0 * 32 + r32] = (bf16)f2bf(o[d0][r] * rli[r]); }
#undef SLOAD
#undef SWRITE
#undef SWAIT
#undef RESC
}

}

__device__ __forceinline__ void phase_attention(const Params& P, unsigned char* lds, int G) {
    const bf16* Q = (const bf16*)(P.ws + WS_Q); const bf16* K = (const bf16*)(P.ws + WS_K); const bf16* V = (const bf16*)(P.ws + WS_V); bf16* MIX = (bf16*)(P.ws + WS_RH);
    const int vcu = (G % 8 == 0) ? ((int)blockIdx.x % 8) * (G / 8) + (int)blockIdx.x / 8 : (int)blockIdx.x;
    for (int idx = vcu; idx < 1024 + 64; idx += G) {
        int b, h, seq; size_t qrow;
        if (idx < 1024) { const int bh = idx >> 4, qb = idx & 15; b = bh >> 3; h = bh & 7; qrow = (size_t)b * TC + CTXL + qb * 256; seq = TC; }
        else { const int j = idx - 1024; b = j >> 3; h = j & 7; qrow = (size_t)b * TC; seq = CTXL; }
        att::attn_dense_body(Q + qrow * 768 + h * 96, K + (size_t)b * TC * 768 + h * 96, V + (size_t)b * TC * 512 + h * 64, MIX + qrow * 1024 + h * 64, seq, idx < 1024 ? (idx & 15) * 256 : -1, (char*)lds);
        __syncthreads();
    }
}

typedef float cf __attribute__((ext_vector_type(2)));
__device__ __forceinline__ cf cmul(cf a, cf b) { return a * (cf){b.x, b.x} + (cf){a.y, a.x} * (cf){-b.y, b.y}; }
__device__ __forceinline__ cf cis_rev(float rev) { return cf{__builtin_amdgcn_cosf(rev), __builtin_amdgcn_sinf(rev)}; }
template <int S> __device__ __forceinline__ void dft4(cf& a, cf& b, cf& c, cf& d) {
    const cf t0 = a + c, t1 = a - c, t2 = b + d, t3 = b - d;
    const cf t3i = (cf){-(float)S * t3.y, (float)S * t3.x};
    a = t0 + t2; c = t0 - t2; b = t1 + t3i; d = t1 - t3i;
}
template <int S> __device__ __forceinline__ void dft16(cf (&v)[16]) {
#pragma unroll
    for (int j0 = 0; j0 < 4; ++j0) dft4<S>(v[j0], v[j0 + 4], v[j0 + 8], v[j0 + 12]);
    constexpr float C1 = 0.9238795325112867f, S1 = 0.3826834323650898f, C2 = 0.7071067811865476f;
    v[5] = cmul(v[5], cf{C1, S * S1}); v[9] = cmul(v[9], cf{C2, S * C2}); v[13] = cmul(v[13], cf{S1, S * C1});
    v[6] = cmul(v[6], cf{C2, S * C2}); v[10] = (cf){-(float)S * v[10].y, (float)S * v[10].x}; v[14] = cmul(v[14], cf{-C2, S * C2});
    v[7] = cmul(v[7], cf{S1, S * C1}); v[11] = cmul(v[11], cf{-C2, S * C2}); v[15] = cmul(v[15], cf{-C1, -S * S1});
#pragma unroll
    for (int k1 = 0; k1 < 4; ++k1) dft4<S>(v[4 * k1], v[4 * k1 + 1], v[4 * k1 + 2], v[4 * k1 + 3]);
}
#define REV4(k) ((((k) >> 2) | (((k) & 3) << 2)))
__device__ __forceinline__ int fphys(int L) { return L + (L >> 4); }
constexpr int FFT_BUF = 4352 * 8;
constexpr int FFT_ZB = 2 * FFT_BUF;
constexpr int FFT_HB1 = FFT_ZB + 32768;
constexpr int FFT_W3 = FFT_HB1 + 32768;
constexpr int FFT_RED = FFT_W3 + 1024;
static_assert(FFT_RED + 64 <= LDSCTL_OFF, "fft lds");
template <int PAT> __device__ __forceinline__ int fbase(int tp) {
    if (PAT == 0) return tp + (tp >> 4);
    if (PAT == 1) return (tp & 15) + 272 * (tp >> 4);
    return 17 * (tp & 15) + 272 * (tp >> 4);
}
template <int PAT> struct FStr { static constexpr int v = PAT == 0 ? 272 : (PAT == 1 ? 17 : 1); };
__device__ __forceinline__ int hide(int x) { asm volatile("" : "+v"(x)); return x; }
#if defined(__HIP_DEVICE_COMPILE__)
template <int OFF> __device__ __forceinline__ cf lds_rd64(unsigned addr) { f32x2 r; asm volatile("ds_read_b64 %0, %1 offset:%2" : "=v"(r) : "v"(addr), "i"(OFF) : "memory"); return cf{r[0], r[1]}; }
template <int OFF> __device__ __forceinline__ void lds_wr64(unsigned addr, cf x) { f32x2 r = {x.x, x.y}; asm volatile("ds_write_b64 %0, %1 offset:%2" :: "v"(addr), "v"(r), "i"(OFF) : "memory"); }
#define FFT_LGKM0() asm volatile("s_waitcnt lgkmcnt(0)" ::: "memory")
#else
template <int OFF> __device__ __forceinline__ cf lds_rd64(const cf* p) { return *(const cf*)((const char*)p + OFF); }
template <int OFF> __device__ __forceinline__ void lds_wr64(cf* p, cf x) { *(cf*)((char*)p + OFF) = x; }
#define FFT_LGKM0()
#endif
template <int PAT> __device__ __forceinline__ void fload(cf (&v)[16], const cf* buf, int tp) {
    constexpr int ST = FStr<PAT>::v * 8;
#if defined(__HIP_DEVICE_COMPILE__)
    const unsigned p = (unsigned)(uintptr_t)(buf + fbase<PAT>(tp));
    f32x2 r0, r1, r2, r3, r4, r5, r6, r7, r8, r9, r10, r11, r12, r13, r14, r15;
#define FRD(R, J) asm volatile("ds_read_b64 %0, %1 offset:%2" : "=v"(R) : "v"(p), "i"((J) * ST) : "memory")
    FRD(r0, 0); FRD(r1, 1); FRD(r2, 2); FRD(r3, 3); FRD(r4, 4); FRD(r5, 5); FRD(r6, 6); FRD(r7, 7); FRD(r8, 8); FRD(r9, 9); FRD(r10, 10); FRD(r11, 11); FRD(r12, 12); FRD(r13, 13); FRD(r14, 14); FRD(r15, 15);
#undef FRD
    asm volatile("s_waitcnt lgkmcnt(0)" : "+v"(r0), "+v"(r1), "+v"(r2), "+v"(r3), "+v"(r4), "+v"(r5), "+v"(r6), "+v"(r7), "+v"(r8), "+v"(r9), "+v"(r10), "+v"(r11), "+v"(r12), "+v"(r13), "+v"(r14), "+v"(r15) :: "memory");
    v[0] = cf{r0[0], r0[1]}; v[1] = cf{r1[0], r1[1]}; v[2] = cf{r2[0], r2[1]}; v[3] = cf{r3[0], r3[1]}; v[4] = cf{r4[0], r4[1]}; v[5] = cf{r5[0], r5[1]}; v[6] = cf{r6[0], r6[1]}; v[7] = cf{r7[0], r7[1]};
    v[8] = cf{r8[0], r8[1]}; v[9] = cf{r9[0], r9[1]}; v[10] = cf{r10[0], r10[1]}; v[11] = cf{r11[0], r11[1]}; v[12] = cf{r12[0], r12[1]}; v[13] = cf{r13[0], r13[1]}; v[14] = cf{r14[0], r14[1]}; v[15] = cf{r15[0], r15[1]};
#else
    const cf* p = buf + fbase<PAT>(tp);
#pragma unroll
    for (int j = 0; j < 16; ++j) v[j] = *(const cf*)((const char*)p + j * ST);
#endif
}
template <int PAT> __device__ __forceinline__ void fstore_raw(const cf (&x)[16], cf* buf, int tp) {
#if defined(__HIP_DEVICE_COMPILE__)
    const unsigned p = (unsigned)(uintptr_t)(buf + fbase<PAT>(tp));
#else
    cf* p = buf + fbase<PAT>(tp);
#endif
    constexpr int ST = FStr<PAT>::v * 8;
    lds_wr64<0>(p, x[0]); lds_wr64<ST>(p, x[1]); lds_wr64<2 * ST>(p, x[2]); lds_wr64<3 * ST>(p, x[3]); lds_wr64<4 * ST>(p, x[4]); lds_wr64<5 * ST>(p, x[5]); lds_wr64<6 * ST>(p, x[6]); lds_wr64<7 * ST>(p, x[7]);
    lds_wr64<8 * ST>(p, x[8]); lds_wr64<9 * ST>(p, x[9]); lds_wr64<10 * ST>(p, x[10]); lds_wr64<11 * ST>(p, x[11]); lds_wr64<12 * ST>(p, x[12]); lds_wr64<13 * ST>(p, x[13]); lds_wr64<14 * ST>(p, x[14]); lds_wr64<15 * ST>(p, x[15]);
    FFT_LGKM0();
}
template <int PAT> __device__ __forceinline__ void fstore_geo(cf (&v)[16], cf* buf, int tp, cf t0, cf r) {
    const cf r2 = cmul(r, r); cf te = t0, to = cmul(t0, r); cf x[16];
#pragma unroll
    for (int k = 0; k < 16; k += 2) { x[k] = cmul(v[REV4(k)], te); x[k + 1] = cmul(v[REV4(k + 1)], to); te = cmul(te, r2); to = cmul(to, r2); }
    fstore_raw<PAT>(x, buf, tp);
}
#ifndef FFT_GEO
#define FFT_GEO 1
#endif
template <int PAT> __device__ __forceinline__ void fstore_ang(cf (&v)[16], cf* buf, int tp, float a0, float ar) {
#if FFT_GEO
    fstore_geo<PAT>(v, buf, tp, cis_rev(a0), cis_rev(ar));
#else
    cf x[16];
#pragma unroll
    for (int k = 0; k < 16; ++k) x[k] = cmul(v[REV4(k)], cis_rev(a0 + (float)k * ar));
    fstore_raw<PAT>(x, buf, tp);
#endif
}
__device__ __forceinline__ void ftw_build(cf (&tw)[16], cf t0, cf r) {
    const cf r2 = cmul(r, r); cf te = t0, to = cmul(t0, r);
#pragma unroll
    for (int k = 0; k < 16; k += 2) { tw[k] = te; tw[k + 1] = to; te = cmul(te, r2); to = cmul(to, r2); }
}
template <int PAT> __device__ __forceinline__ void fstore_tw(cf (&v)[16], cf* buf, int tp, const cf (&tw)[16]) {
    cf x[16];
#pragma unroll
    for (int k = 0; k < 16; ++k) x[k] = cmul(v[REV4(k)], tw[k]);
    fstore_raw<PAT>(x, buf, tp);
}
#define W32C(j) ((j) == 0 ? 1.f : (j) == 1 ? 0.98078528f : (j) == 2 ? 0.92387953f : (j) == 3 ? 0.83146961f : (j) == 4 ? 0.70710678f : (j) == 5 ? 0.55557023f : (j) == 6 ? 0.38268343f : (j) == 7 ? 0.19509032f : (j) == 8 ? 0.f : \
                 (j) == 9 ? -0.19509032f : (j) == 10 ? -0.38268343f : (j) == 11 ? -0.55557023f : (j) == 12 ? -0.70710678f : (j) == 13 ? -0.83146961f : (j) == 14 ? -0.92387953f : -0.98078528f)
#define W32S(j) ((j) == 0 ? 0.f : (j) == 1 ? 0.19509032f : (j) == 2 ? 0.38268343f : (j) == 3 ? 0.55557023f : (j) == 4 ? 0.70710678f : (j) == 5 ? 0.83146961f : (j) == 6 ? 0.92387953f : (j) == 7 ? 0.98078528f : (j) == 8 ? 1.f : \
                 (j) == 9 ? 0.98078528f : (j) == 10 ? 0.92387953f : (j) == 11 ? 0.83146961f : (j) == 12 ? 0.70710678f : (j) == 13 ? 0.55557023f : (j) == 14 ? 0.38268343f : 0.19509032f)
__device__ __forceinline__ void fft_fwd_pass1(cf (&v)[16], cf* buf, int tp, int str) {
    if (str) {
#pragma unroll
        for (int j = 1; j < 16; ++j) v[j] = cmul(v[j], cf{W32C(j), -W32S(j)});
    }
    dft16<-1>(v);
    fstore_ang<0>(v, buf, tp, str ? -(float)tp * (1.f / 8192.f) : 0.f, -(float)(tp >> 4) * (1.f / 256.f));
}
__device__ __forceinline__ void fft_fwd_pass2(cf* buf, int tp0, const cf (&tw)[16]) {
    const int tp = hide(tp0);
    cf v[16]; fload<1>(v, buf, tp); dft16<-1>(v);
    fstore_tw<1>(v, buf, tp, tw);
}
__device__ __forceinline__ void fft_inv_pass2(cf* buf, int tp0, int str) {
    const int tp = hide(tp0);
    cf v[16]; fload<1>(v, buf, tp); dft16<1>(v);
    const int n0 = tp & 15, k2 = tp >> 4;
    fstore_ang<1>(v, buf, tp, str ? (float)n0 * (1.f / 8192.f) : 0.f, (float)k2 * (1.f / 256.f) + (str ? (1.f / 512.f) : 0.f));
}
__device__ __forceinline__ void fft_inv_pass3(cf* buf, int tp0, int str) {
    const int tp = hide(tp0);
    cf v[16]; fload<0>(v, buf, tp); dft16<1>(v);
    cf x[16];
#pragma unroll
    for (int k = 0; k < 16; ++k) { x[k] = v[REV4(k)]; if (str && k > 0) x[k] = cmul(x[k], cf{W32C(k), W32S(k)}); }
    fstore_raw<0>(x, buf, tp);
}

struct Row8 { u32x4 a; unsigned short l, r; };
__device__ __forceinline__ void load_row8(const bf16* rowp, int n0, Row8& q) {
    q.a = *(const u32x4*)(rowp + n0); const unsigned short l = rowp[n0 > 0 ? n0 - 1 : 0], r = rowp[n0 + 8 < 4096 ? n0 + 8 : 4095]; q.l = n0 > 0 ? l : (unsigned short)0; q.r = n0 + 8 < 4096 ? r : (unsigned short)0;
}
__device__ __forceinline__ void conv3_row8(const Row8& q, float w0, float w1, float w2, float bb, float (&o)[8]) {
    const float r[10] = {bf2f(q.l), bflo(q.a.x), bfhi(q.a.x), bflo(q.a.y), bfhi(q.a.y), bflo(q.a.z), bfhi(q.a.z), bflo(q.a.w), bfhi(q.a.w), bf2f(q.r)};
#pragma unroll
    for (int i = 0; i < 8; ++i) o[i] = w0 * r[i] + w1 * r[i + 1] + w2 * r[i + 2] + bb;
}

__device__ __forceinline__ void phase_hyena_fft(const Params& P, unsigned char* lds, int tid, int lane, int wave, int G) {
    cf* bufE = (cf*)lds; cf* bufO = (cf*)(lds + FFT_BUF); cf* zbuf = (cf*)(lds + FFT_ZB);
    float* w3c = (float*)(lds + FFT_W3); float* red = (float*)(lds + FFT_RED);
    const int str = __builtin_amdgcn_readfirstlane(tid >> 8), tp0 = tid & 255; cf* buf = str ? bufO : bufE;
    const bf16* Pt = (const bf16*)(P.ws + WS_PT); bf16* Zt = (bf16*)(P.ws + WS_ZT);
    cf* Hs = (cf*)(P.ws + WS_HSPEC) + (size_t)blockIdx.x * 4 * 4096;
    const float* a2T = (const float*)(P.ws + WS_A2);
#ifndef FFT_SBAR
#define FFT_SBAR 1
#endif
    unsigned* sb = (unsigned*)(lds + FFT_RED + 64) + str; unsigned sgen = 0u;
    if (tid < 2) ((unsigned*)(lds + FFT_RED + 64))[tid] = 0u;
#if FFT_SBAR
#define STREAM_BAR() do { asm volatile("s_waitcnt vmcnt(0) lgkmcnt(0)" ::: "memory"); sgen += 4u; \
        if (lane == 0) __hip_atomic_fetch_add(sb, 1u, __ATOMIC_RELAXED, __HIP_MEMORY_SCOPE_WORKGROUP); \
        while ((unsigned)__builtin_amdgcn_readfirstlane((int)__hip_atomic_load(sb, __ATOMIC_RELAXED, __HIP_MEMORY_SCOPE_WORKGROUP)) < sgen) __builtin_amdgcn_s_sleep(0); \
        asm volatile("" ::: "memory"); } while (0)
#else
#define STREAM_BAR() __syncthreads()
#endif
    cf tw2[16];
    { const int n0 = tp0 & 15, k2 = tp0 >> 4;
      ftw_build(tw2, cis_rev(-(float)(n0 * k2) * (1.f / 4096.f)), cis_rev(-(float)n0 * (1.f / 256.f))); }
#pragma unroll 1
    for (int c = blockIdx.x; c < 1024; c += G) {
        __syncthreads();
        if (tid < 256) w3c[tid] = P.in[I_HW3][(size_t)(tid & 63) * 4096 + (tid >> 6) * 1024 + c];
#ifndef FFT_ROWPF
#define FFT_ROWPF 0
#endif
        Row8 va, vb;
#if FFT_ROWPF
        load_row8(Pt + (size_t)c * 32768, hide(tid) * 8, va); load_row8(Pt + (size_t)c * 32768 + 4096, hide(tid) * 8, vb);
#endif
        __syncthreads();
        {
            float d[8][4];
#pragma unroll
            for (int j = 0; j < 8; ++j) { d[j][0] = 0.f; d[j][1] = 0.f; d[j][2] = 0.f; d[j][3] = 0.f; }
#pragma unroll 2
            for (int i = 0; i < 64; ++i) { const float w0 = w3c[i], w1 = w3c[64 + i], w2 = w3c[128 + i], w3 = w3c[192 + i]; const float* ar = a2T + (size_t)i * 4096 + tid;
#pragma unroll
                for (int j = 0; j < 8; ++j) { const float a = ar[512 * j]; d[j][0] += a * w0; d[j][1] += a * w1; d[j][2] += a * w2; d[j][3] += a * w3; } }
            float dec[4];
#pragma unroll
            for (int q = 0; q < 4; ++q) dec[q] = fabsf(P.in[I_HDEC][q * 1024 + c]) * (1.4426950408889634f / 4095.f);
            float as0 = 0.f, as1 = 0.f;
#pragma unroll
            for (int j = 0; j < 8; ++j) { const int t = tid + 512 * j; const float tf = (float)t;
                const float h0 = d[j][0] * __builtin_amdgcn_exp2f(-tf * dec[0]), h1 = d[j][1] * __builtin_amdgcn_exp2f(-tf * dec[1]), h2 = d[j][2] * __builtin_amdgcn_exp2f(-tf * dec[2]), h3 = d[j][3] * __builtin_amdgcn_exp2f(-tf * dec[3]);
                float* hb0 = (float*)(lds + FFT_ZB); float* hb1 = (float*)(lds + FFT_HB1);
                hb0[t] = h0; hb0[4096 + t] = h1; hb1[t] = h2; hb1[4096 + t] = h3; as0 += fabsf(h0) + fabsf(h1); as1 += fabsf(h2) + fabsf(h3); }
            as0 = wave_sum(as0); as1 = wave_sum(as1); if (lane == 0) { red[wave] = as0; red[8 + wave] = as1; }
        }
        __syncthreads();
#pragma unroll 1
        for (int o = 0; o < 2; ++o) {
            const float* hbuf = (const float*)(lds + (o == 0 ? FFT_ZB : FFT_HB1));
            float tot = 0.f;
#pragma unroll
            for (int w = 0; w < 8; ++w) tot += red[8 * o + w];
            const float inv = 1.f / ((tot + 1e-6f) * 8192.f);
            { const int tp = hide(tp0); cf v[16];
#pragma unroll
              for (int j = 0; j < 16; ++j) { const int n = tp + 256 * j; const float ta = (hbuf[n] + (n == 0 ? hbuf[4096] : 0.f)) * inv, tb = (n == 0 ? 0.f : hbuf[4096 + 4096 - n]) * inv;
                  v[j] = cf{str ? ta - tb : ta + tb, 0.f}; }
              fft_fwd_pass1(v, buf, tp, str); }
            STREAM_BAR();
            fft_fwd_pass2(buf, tp0, tw2);
            STREAM_BAR();
            { const int tp = hide(tp0); cf v[16]; fload<2>(v, buf, tp); dft16<-1>(v);
              cf* hp = Hs + (size_t)(o * 2 + str) * 4096 + tp;
#pragma unroll
              for (int k = 0; k < 16; ++k) hp[k * 256] = v[REV4(k)]; }
            __syncthreads();
        }
#pragma unroll 1
        for (int pr = 0; pr < 4; ++pr) {
            { const int n0 = hide(tid) * 8; float oa[8], ob[8];
#if !FFT_ROWPF
              load_row8(Pt + (size_t)c * 32768 + (2 * pr) * 4096, n0, va); load_row8(Pt + (size_t)c * 32768 + (2 * pr + 1) * 4096, n0, vb);
#endif
              const float w0 = P.in[I_HCW][c], w1 = P.in[I_HCW][3072 + c], w2 = P.in[I_HCW][6144 + c], bb = P.in[I_HCB][c];
              conv3_row8(va, w0, w1, w2, bb, oa); conv3_row8(vb, w0, w1, w2, bb, ob);
#pragma unroll
              for (int i = 0; i < 8; ++i) zbuf[n0 + i] = cf{oa[i], ob[i]}; }
            __syncthreads();
#pragma unroll 1
            for (int o = 0; o < 2; ++o) {
                Row8 ga, gb;
#if FFT_ROWPF
                { const int n0 = hide(tid) * 8; const size_t grow = (size_t)((o + 1) * 1024 + c) * 32768;
                    load_row8(Pt + grow + (2 * pr) * 4096, n0, ga); load_row8(Pt + grow + (2 * pr + 1) * 4096, n0, gb);
                    const int prn = pr < 3 ? pr + 1 : 3;
                    load_row8(Pt + (size_t)c * 32768 + (2 * prn) * 4096, n0, va); load_row8(Pt + (size_t)c * 32768 + (2 * prn + 1) * 4096, n0, vb); }
#endif
                { const int tp = hide(tp0); cf v[16];
#pragma unroll
                  for (int j = 0; j < 16; ++j) v[j] = zbuf[tp + 256 * j];
                  fft_fwd_pass1(v, buf, tp, str); }
                STREAM_BAR();
#ifndef FFT_PF
#define FFT_PF 1
#endif
                cf hq[16];
#if FFT_PF
                { const cf* hp = Hs + (size_t)(o * 2 + str) * 4096 + hide(tp0);
#pragma unroll
                  for (int k = 0; k < 16; ++k) hq[k] = hp[k * 256]; }
#endif
                fft_fwd_pass2(buf, tp0, tw2);
                STREAM_BAR();
                { const int tp = hide(tp0); cf v[16]; fload<2>(v, buf, tp); dft16<-1>(v);
#if !FFT_PF
                  { const cf* hp = Hs + (size_t)(o * 2 + str) * 4096 + tp;
#pragma unroll
                  for (int k = 0; k < 16; ++k) hq[k] = hp[k * 256]; }
#endif
                  cf y[16];
#pragma unroll
                  for (int k = 0; k < 16; ++k) y[k] = cmul(v[REV4(k)], hq[k]);
                  dft16<1>(y);
                  fstore_ang<2>(y, buf, tp, 0.f, (float)((tp >> 4) + 16 * (tp & 15)) * (1.f / 4096.f)); }
                STREAM_BAR();
                fft_inv_pass2(buf, tp0, str);
                STREAM_BAR();
                fft_inv_pass3(buf, tp0, str);
                __syncthreads();
                { const int n0 = hide(tid) * 8;
#if !FFT_ROWPF
                  { const size_t grow = (size_t)((o + 1) * 1024 + c) * 32768; load_row8(Pt + grow + (2 * pr) * 4096, n0, ga); load_row8(Pt + grow + (2 * pr + 1) * 4096, n0, gb); }
#endif
                  const int gc = (o + 1) * 1024 + c;
                  const float w0 = P.in[I_HCW][gc], w1 = P.in[I_HCW][3072 + gc], w2 = P.in[I_HCW][6144 + gc], bb = P.in[I_HCB][gc];
                  const float sk = P.in[I_HSKIP][o * 1024 + c]; float g0[8], g1[8], oa[8], ob[8];
                  conv3_row8(ga, w0, w1, w2, bb, g0); conv3_row8(gb, w0, w1, w2, bb, g1);
#pragma unroll
                  for (int i = 0; i < 8; ++i) { const int n = n0 + i; const cf e = bufE[fphys(n)], q = bufO[fphys(n)], z = zbuf[n];
                      oa[i] = (e.x + q.x + sk * z.x) * g0[i]; ob[i] = (e.y + q.y + sk * z.y) * g1[i]; }
                  if (o == 0) {
#pragma unroll
                      for (int i = 0; i < 8; ++i) zbuf[n0 + i] = cf{oa[i], ob[i]};
                  } else {
                      u32x4 wa, wb; wa.x = pk2(oa[0], oa[1]); wa.y = pk2(oa[2], oa[3]); wa.z = pk2(oa[4], oa[5]); wa.w = pk2(oa[6], oa[7]);
                      wb.x = pk2(ob[0], ob[1]); wb.y = pk2(ob[2], ob[3]); wb.z = pk2(ob[4], ob[5]); wb.w = pk2(ob[6], ob[7]);
                      *(u32x4*)(Zt + (size_t)c * 32768 + (2 * pr) * 4096 + n0) = wa; *(u32x4*)(Zt + (size_t)c * 32768 + (2 * pr + 1) * 4096 + n0) = wb;
                  } }
                __syncthreads();
            }
        }
    }
}
__device__ __forceinline__ void phase_transpose(const Params& P, unsigned char* lds, int lane, int wave, int G) {
    bf16* tile = (bf16*)(lds + wave * 16384);
    const bf16* Zt = (const bf16*)(P.ws + WS_ZT); bf16* Z = (bf16*)(P.ws + WS_Z);
    for (int it = blockIdx.x * 8 + wave; it < 16 * 512; it += G * 8) {
        const int cb = it & 15, tb = it >> 4, c0 = cb * 64, t0 = tb * 64;
#pragma unroll
        for (int i = 0; i < 8; ++i) { const int ch = i * 8 + (lane >> 3), tq = (lane & 7) * 8;
            const u32x4 a = *(const u32x4*)(Zt + (size_t)(c0 + ch) * 32768 + t0 + tq);
            unsigned* d = (unsigned*)(tile + ch * 66 + tq); d[0] = a.x; d[1] = a.y; d[2] = a.z; d[3] = a.w; }
        LDS_WAIT(); asm volatile("" ::: "memory");
#pragma unroll
        for (int i = 0; i < 8; ++i) { const int tk = i * 8 + (lane >> 3), cq = (lane & 7) * 8;
            unsigned short e[8];
#pragma unroll
            for (int j = 0; j < 8; ++j) e[j] = tile[(cq + j) * 66 + tk];
            u32x4 w; w.x = e[0] | ((unsigned)e[1] << 16); w.y = e[2] | ((unsigned)e[3] << 16); w.z = e[4] | ((unsigned)e[5] << 16); w.w = e[6] | ((unsigned)e[7] << 16);
            *(u32x4*)(Z + (size_t)(t0 + tk) * 1024 + c0 + cq) = w; }
        LDS_WAIT(); asm volatile("" ::: "memory");
    }
}

constexpr int N_PHASES = 21;
__global__ void __launch_bounds__(512, 2) fwd_kernel(Params P0) {
    extern __shared__ __attribute__((aligned(16))) unsigned char lds[];
    const int tid = threadIdx.x, lane = tid & 63, wave = __builtin_amdgcn_readfirstlane(tid >> 6), G = gridDim.x;
    PG8_LAS unsigned char* ldsl = (PG8_LAS unsigned char*)lds;
    for (int u = tid; u < (LDS_BYTES - LDSCTL_OFF) / 4; u += 512) ((unsigned*)(lds + LDSCTL_OFF))[u] = 0u;
    __syncthreads();
#if MK_ONE_LAUNCH
    XcdBarrier bar = xcd_barrier_post((unsigned*)(P0.ws + WS_CTL) + CW_BAR, (volatile LAS unsigned*)(ldsl + MISC_OFF) + 8);
#define GRID_BAR() xcd_barrier(bar)
#else
#define GRID_BAR() do { } while (0)
#endif
    const int lo = P0.ph_lo, hi = P0.ph_hi;
#ifndef PHASE_MASK
#define PHASE_MASK 0xFFFFFFFFu
#endif
#define IN(k) ((((PHASE_MASK) >> (k)) & 1u) && lo <= (k) && (k) < hi)
#ifndef DELAY_MASK
#define DELAY_MASK 0u
#endif
#ifndef CLKP
#define CLKP -1
#endif
    unsigned long long clk_c0 = 0, clk_r0 = 0;
    unsigned long long t_ph = 0;
#define SEAM(k) do { if (IN(k) && IN((k) + 1)) GRID_BAR(); \
    if (((DELAY_MASK) >> (k)) & 1u) { const unsigned long long t1 = __builtin_amdgcn_s_memrealtime(); const unsigned long long dt = t1 - t_ph; while (__builtin_amdgcn_s_memrealtime() - t1 < dt) __builtin_amdgcn_s_sleep(8); __syncthreads(); } \
    if ((k) == CLKP) { const unsigned long long c1 = __builtin_readcyclecounter(), r1 = __builtin_amdgcn_s_memrealtime(); \
        const unsigned long long ticks = (c1 - clk_c0) * 1000ull / (r1 - clk_r0 + 1ull);   \
        while (__builtin_amdgcn_s_memrealtime() - r1 < ticks) __builtin_amdgcn_s_sleep(8); __syncthreads(); } \
    if ((k) + 1 == CLKP) { clk_c0 = __builtin_readcyclecounter(); clk_r0 = __builtin_amdgcn_s_memrealtime(); } \
    if (((DELAY_MASK) >> ((k) + 1)) & 1u) t_ph = __builtin_amdgcn_s_memrealtime(); } while (0)
#ifndef REPEAT_MASK
#define REPEAT_MASK 0u
#endif
#ifndef REPEAT_SUB
#define REPEAT_SUB 0u
#endif
#define REPS(k) for (int reps_ = 0; reps_ < ((((REPEAT_SUB) >> (k)) & 1u) ? 2 : 1); ++reps_)
#define REP(k) for (int rep_ = 0; rep_ < ((((REPEAT_MASK) >> (k)) & 1u) ? 2 : 1); ++rep_)

    if (DELAY_MASK & 1u) t_ph = __builtin_amdgcn_s_memrealtime();
    if (IN(0)) REP(0) { const Params P = load_params(); unsigned char* ws = P.ws; phase_prologue(P, lds, tid, lane, wave, G); } SEAM(0);
    if (IN(1)) REP(1) { const Params P = load_params(); unsigned char* ws = P.ws; phase_norm1_l0(P, lane, wave, G); } SEAM(1);
    if (IN(2)) REP(2) { const Params P = load_params(); unsigned char* ws = P.ws;
        pg8::Gemm g{(const bf16*)(ws + WS_RH), (const bf16*)(ws + WS_WIN), 1024, 1024, 1024, 0}; pg8::StaticOrder S; S.init(M0 / 256, 7, G, (int)blockIdx.x);
        EpiIn E{(bf16*)(ws + WS_CQ), (bf16*)(ws + WS_CKV), (bf16*)(ws + WS_UX), (bf16*)(ws + WS_UG), (bf16*)(ws + WS_K)};
        pg8::gemm_phase<EpiIn, pg8::StaticOrder, GP_ALIGN, GP_SP2>(ldsl, g, S, E);
    } SEAM(2);
    if (IN(3)) REP(3) { const Params P = load_params(); unsigned char* ws = P.ws; phase_rowstat(P, lane, wave, G); phase_lru_f1(P, lds, tid, lane, wave, G); } SEAM(3);
    if (IN(4)) REP(4) { const Params P = load_params(); unsigned char* ws = P.ws;
        phase_lru_carry(P, lane, wave, G);
        __syncthreads();
#ifndef NO_QUP
        REPS(0) { pg8::Gemm g{(const bf16*)(ws + WS_CQ), (const bf16*)(ws + WS_WUQ), 384, 384, 384, 0}; pg8::StaticOrder S; S.init(M0 / 256, 3, G, (int)blockIdx.x);
          EpiQ E{(bf16*)(ws + WS_Q), (const float*)(ws + WS_RQ)};
          pg8::gemm_phase<EpiQ, pg8::StaticOrder, GP_ALIGN, GP_SP2>(ldsl, g, S, E); }
#endif
        __syncthreads();
        REPS(1) { pg8::Gemm g{(const bf16*)(ws + WS_CKV), (const bf16*)(ws + WS_WUKV), 256, 256, 256, 0}; pg8::StaticOrder S; S.init(M0 / 256, 4, G, (int)blockIdx.x);
          EpiKV E{(bf16*)(ws + WS_K), (bf16*)(ws + WS_V), (const float*)(ws + WS_RKV)};
          pg8::gemm_phase<EpiKV, pg8::StaticOrder, GP_ALIGN, GP_SP2>(ldsl, g, S, E); }
        __syncthreads();
    } SEAM(4);
    if (IN(5)) REP(5) { const Params P = load_params(); unsigned char* ws = P.ws; REPS(2) phase_lru_f3(P, lds, tid, lane, wave, G); REPS(3) phase_attention(P, lds, G); } SEAM(5);
    if (IN(6)) REP(6) { const Params P = load_params(); unsigned char* ws = P.ws;
        pg8::Gemm g{(const bf16*)(ws + WS_RH), (const bf16*)(ws + WS_WOUT), 1024, 1024, 1024, 0}; pg8::StaticOrder S; S.init(M0 / 256, 4, G, (int)blockIdx.x);
        EpiRes<0> E{P.in[I_X], P.in[I_CTX], (const float*)(ws + WS_MOD), nullptr, (bf16*)P.out, (bf16*)(ws + WS_XC)};
        pg8::gemm_phase<EpiRes<0>, pg8::StaticOrder, GP_ALIGN, GP_SP2>(ldsl, g, S, E);
    } SEAM(6);
    if (IN(7)) REP(7) { const Params P = load_params(); unsigned char* ws = P.ws; phase_norm2_route<0>(P, lds, tid, lane, wave, G); } SEAM(7);
    if (IN(8)) REP(8) { const Params P = load_params(); unsigned char* ws = P.ws; phase_permute<0>(P, lds, tid, lane, wave, G); } SEAM(8);
    if (IN(9)) REP(9) { const Params P = load_params(); unsigned char* ws = P.ws;
        const int* te = (const int*)(ws + WS_TILEE); const int nmt = te[MAXTILES];
        { int* gl = (int*)(lds + RING_BYTES); const int* st = (const int*)(ws + WS_SLOTTOK);
          for (int i = 0; ; ++i) { const long L = (long)i * G + ((G % 8 == 0) ? ((int)blockIdx.x % 8) * (G / 8) + (int)blockIdx.x / 8 : (int)blockIdx.x); if (L >= (long)nmt * 4 || i >= 20) break; if (tid < 256) gl[i * 256 + tid] = st[(int)(L >> 2) * 256 + tid]; }
          __syncthreads(); }
        pg8::Gemm g{(const bf16*)(ws + WS_RH), (const bf16*)(ws + WS_W13), 1024, 1024, 1024, (size_t)1024 * 1024 * 2, RING_BYTES}; pg8::MoeOrder S{nmt, G, (G % 8 == 0) ? ((int)blockIdx.x % 8) * (G / 8) + (int)blockIdx.x / 8 : (int)blockIdx.x, te};
        EpiMoe1 E{(bf16*)(ws + WS_ACT)};
        pg8::gemm_phase<EpiMoe1, pg8::MoeOrder, GP_ALIGN, GP_SP2, true>(ldsl, g, S, E);
    } SEAM(9);
    if (IN(10)) REP(10) { const Params P = load_params(); unsigned char* ws = P.ws;
        const int* te = (const int*)(ws + WS_TILEE);
        pg8::Gemm g{(const bf16*)(ws + WS_ACT), (const bf16*)(ws + WS_W2), 512, 512, 512, (size_t)1024 * 512 * 2}; pg8::MoeOrder S{te[MAXTILES], G, (G % 8 == 0) ? ((int)blockIdx.x % 8) * (G / 8) + (int)blockIdx.x / 8 : (int)blockIdx.x, te};
        EpiStore E{(bf16*)(ws + WS_HPERM), 1024};
        pg8::gemm_phase<EpiStore, pg8::MoeOrder, GP_ALIGN, GP_SP2>(ldsl, g, S, E);
    } SEAM(10);
    if (IN(11)) REP(11) { const Params P = load_params(); unsigned char* ws = P.ws; phase_combine_norm1_l1(P, lane, wave, G); } SEAM(11);
    if (IN(12)) REP(12) { const Params P = load_params(); unsigned char* ws = P.ws;
        pg8::Gemm g{(const bf16*)(ws + WS_WHIN), (const bf16*)(ws + WS_RH), 1024, 1024, 1024, 0}; pg8::StaticOrder S; S.init(3072 / 256, M1 / 256, G, (int)blockIdx.x);
        EpiStore E{(bf16*)(ws + WS_PT), 32768};
        pg8::gemm_phase<EpiStore, pg8::StaticOrder, GP_ALIGN, GP_SP2>(ldsl, g, S, E);
    } SEAM(12);
    if (IN(13)) REP(13) { const Params P = load_params(); unsigned char* ws = P.ws; phase_hyena_fft(P, lds, tid, lane, wave, G); } SEAM(13);
    if (IN(14)) REP(14) { const Params P = load_params(); unsigned char* ws = P.ws; phase_transpose(P, lds, lane, wave, G); } SEAM(14);
    if (IN(15)) REP(15) { const Params P = load_params(); unsigned char* ws = P.ws;
        pg8::Gemm g{(const bf16*)(ws + WS_Z), (const bf16*)(ws + WS_WHOUT), 1024, 1024, 1024, 0}; pg8::StaticOrder S; S.init(M1 / 256, 4, G, (int)blockIdx.x);
        EpiRes<1> E{nullptr, nullptr, (const float*)(ws + WS_MOD), (const bf16*)((unsigned char*)P.out + X2_OFF), (bf16*)(ws + WS_X3), nullptr};
        pg8::gemm_phase<EpiRes<1>, pg8::StaticOrder, GP_ALIGN, GP_SP2>(ldsl, g, S, E);
    } SEAM(15);
    if (IN(16)) REP(16) { const Params P = load_params(); unsigned char* ws = P.ws; phase_norm2_route<1>(P, lds, tid, lane, wave, G); } SEAM(16);
    if (IN(17)) REP(17) { const Params P = load_params(); unsigned char* ws = P.ws; phase_permute<1>(P, lds, tid, lane, wave, G); } SEAM(17);
    if (IN(18)) REP(18) { const Params P = load_params(); unsigned char* ws = P.ws;
        const int* te = (const int*)(ws + WS_TILEE); const int nmt = te[MAXTILES];
        { int* gl = (int*)(lds + RING_BYTES); const int* st = (const int*)(ws + WS_SLOTTOK);
          for (int i = 0; ; ++i) { const long L = (long)i * G + ((G % 8 == 0) ? ((int)blockIdx.x % 8) * (G / 8) + (int)blockIdx.x / 8 : (int)blockIdx.x); if (L >= (long)nmt * 4 || i >= 20) break; if (tid < 256) gl[i * 256 + tid] = st[(int)(L >> 2) * 256 + tid]; }
          __syncthreads(); }
        pg8::Gemm g{(const bf16*)(ws + WS_RH), (const bf16*)(ws + WS_W13) + (size_t)16 * 1024 * 1024, 1024, 1024, 1024, (size_t)1024 * 1024 * 2, RING_BYTES}; pg8::MoeOrder S{nmt, G, (G % 8 == 0) ? ((int)blockIdx.x % 8) * (G / 8) + (int)blockIdx.x / 8 : (int)blockIdx.x, te};
        EpiMoe1 E{(bf16*)(ws + WS_ACT)};
        pg8::gemm_phase<EpiMoe1, pg8::MoeOrder, GP_ALIGN, GP_SP2, true>(ldsl, g, S, E);
    } SEAM(18);
    if (IN(19)) REP(19) { const Params P = load_params(); unsigned char* ws = P.ws;
        const int* te = (const int*)(ws + WS_TILEE);
        pg8::Gemm g{(const bf16*)(ws + WS_ACT), (const bf16*)(ws + WS_W2) + (size_t)16 * 1024 * 512, 512, 512, 512, (size_t)1024 * 512 * 2}; pg8::MoeOrder S{te[MAXTILES], G, (G % 8 == 0) ? ((int)blockIdx.x % 8) * (G / 8) + (int)blockIdx.x / 8 : (int)blockIdx.x, te};
        EpiStore E{(bf16*)(ws + WS_HPERM), 1024};
        pg8::gemm_phase<EpiStore, pg8::MoeOrder, GP_ALIGN, GP_SP2>(ldsl, g, S, E);
    } SEAM(19);
    if (IN(20)) REP(20) { const Params P = load_params(); unsigned char* ws = P.ws; phase_final(P, lane, wave, G); } SEAM(20);
#undef IN
#undef SEAM
}

extern "C" void kernel_launch(void* const* d_in, const int* in_sizes, int n_in, void* d_out, int out_size, void* d_ws, size_t ws_size, hipStream_t stream) {
    static int grid = 0;
    if (grid == 0) {
        if (n_in != N_IN || out_size != M1 * DM || ws_size < WS_END) { fprintf(stderr, "kernel_launch: unexpected shapes (n_in %d out %d ws %zu)\n", n_in, out_size, ws_size); grid = -1; return; }
        int dev = 0, cus = 0;
        if (hipGetDevice(&dev) != hipSuccess || hipDeviceGetAttribute(&cus, hipDeviceAttributeMultiprocessorCount, dev) != hipSuccess) { grid = -1; return; }
        if (hipFuncSetAttribute((const void*)fwd_kernel, hipFuncAttributeMaxDynamicSharedMemorySize, LDS_BYTES) != hipSuccess) { fprintf(stderr, "kernel_launch: hipFuncSetAttribute failed\n"); grid = -1; return; }
        int per_cu = 0;
        if (hipOccupancyMaxActiveBlocksPerMultiprocessor(&per_cu, (const void*)fwd_kernel, 512, LDS_BYTES) != hipSuccess || per_cu < 1) fprintf(stderr, "kernel_launch: occupancy query reports %d\n", per_cu);
        (void)hipGetLastError();
        grid = cus;
    }
    if (grid < 0) return;
    (void)hipMemsetAsync((char*)d_ws + WS_CTL, 0, CTL_ZERO_BYTES, stream);
    Params p{};
    for (int i = 0; i < N_IN; ++i) p.in[i] = (const float*)d_in[i];
    p.out = (float*)d_out; p.ws = (unsigned char*)d_ws;
#if MK_ONE_LAUNCH
    p.ph_lo = 0; p.ph_hi = N_PHASES;
    hipLaunchKernelGGL(fwd_kernel, dim3(grid), dim3(512), LDS_BYTES, stream, p);
#else
    for (int k = 0; k < N_PHASES; ++k) { p.ph_lo = k; p.ph_hi = k + 1; hipLaunchKernelGGL(fwd_kernel, dim3(grid), dim3(512), LDS_BYTES, stream, p); }
#endif
}
```

```cpp
#include <hip/hip_runtime.h>
#include <cstdio>
#include <cstdint>

#ifndef MK_ONE_LAUNCH
#define MK_ONE_LAUNCH 1
#endif

#define LAS __attribute__((address_space(3)))
#define GAS __attribute__((address_space(1)))
typedef unsigned short bf16;
typedef short bf16x8 __attribute__((ext_vector_type(8)));
typedef short s16x4 __attribute__((ext_vector_type(4)));
typedef float f32x2 __attribute__((ext_vector_type(2)));
typedef float f32x4 __attribute__((ext_vector_type(4)));
typedef float f32x16 __attribute__((ext_vector_type(16)));
typedef unsigned u32x2 __attribute__((ext_vector_type(2)));
typedef unsigned u32x4 __attribute__((ext_vector_type(4)));
#define LDS_WAIT() asm volatile("s_waitcnt lgkmcnt(0)" ::: "memory")
#define VM_WAIT() asm volatile("s_waitcnt vmcnt(0)" ::: "memory")

__device__ __forceinline__ unsigned f2bf(float f) { unsigned u = __builtin_bit_cast(unsigned, f); return (u + 0x7fffu + ((u >> 16) & 1u)) >> 16; }
__device__ __forceinline__ unsigned pk2(float lo, float hi) { return f2bf(lo) | (f2bf(hi) << 16); }
__device__ __forceinline__ float bf2f(unsigned b) { return __builtin_bit_cast(float, b << 16); }
__device__ __forceinline__ float bflo(unsigned w) { return __builtin_bit_cast(float, w << 16); }
__device__ __forceinline__ float bfhi(unsigned w) { return __builtin_bit_cast(float, w & 0xffff0000u); }
__device__ __forceinline__ float wave_sum(float v) {
#pragma unroll
    for (int o = 1; o < 64; o <<= 1) v += __shfl_xor(v, o);
    return v;
}
__device__ __forceinline__ float sigm(float x) { return 1.f / (1.f + expf(-x)); }

namespace pg8 {
#define PG8_LAS __attribute__((address_space(3)))
typedef unsigned short bf16_t;
constexpr int BM = 256, BK = 64, HALF = 128, HTB = HALF * BK * 2, STAGE_BYTES = 8 * HTB, NXCD = 8, WGM = 8;
__host__ __device__ __forceinline__ int lds_byte(int r, int c) { const int st = (r >> 4) * 2 + (c >> 5), rr = r & 15, cc = c & 31, ob = rr * 64 + cc * 2; return st * 1024 + (ob ^ (((ob >> 9) & 1) << 5)); }
__host__ __device__ __forceinline__ void stage_rc(int b, int& R, int& C) { const int st = b / 1024, sb = b % 1024, swz = sb ^ (((sb >> 9) & 1) << 5); R = (st >> 1) * 16 + swz / 64; C = (st & 1) * 32 + (swz % 64) / 2; }
__host__ __device__ __forceinline__ int perm32(int rho) { const int n = rho >> 4, i = rho & 15; return 8 * (i >> 2) + 4 * n + (i & 3); }

struct Unit { int pm, pn, bz; };
struct Gemm { const bf16_t* A; const bf16_t* Bt; int lda, ldb, K; size_t bz_stride; int gidx_off; };

struct StaticOrder {
    int nM, nN, nwg, G, c;
    __host__ __device__ void init(int nM_, int nN_, int G_, int c_) { nM = nM_; nN = nN_; nwg = nM * nN; G = G_; c = c_; }
    __host__ __device__ bool next(int i, Unit& u) const {
        const long L = (long)i * G + c; if (L >= nwg) return false;
        int wgid = (int)L; { const int q = nwg / NXCD, r = nwg % NXCD, xcd = wgid % NXCD, off = wgid / NXCD; wgid = (xcd < r ? xcd * (q + 1) : r * (q + 1) + (xcd - r) * q) + off; }
        const int nig = WGM * nN, gid = wgid / nig, fm = gid * WGM, gsz = (nM - fm) < WGM ? (nM - fm) : WGM;
        u.pm = fm + ((wgid % nig) % gsz); u.pn = (wgid % nig) / gsz; u.bz = 0; return true;
    }
    __device__ __forceinline__ void a_ready(const Unit&) const {}
    __device__ __forceinline__ void done(const Unit&) const {}
};
struct MoeOrder {
    int nM, G, c; const int* tile_e;
    __device__ bool next(int i, Unit& u) const {
        const long L = (long)i * G + c; if (L >= (long)nM * 4) return false;
        u.pm = (int)(L >> 2); u.pn = (int)(L & 3); u.bz = tile_e[u.pm]; return true;
    }
    __device__ __forceinline__ void a_ready(const Unit&) const {}
    __device__ __forceinline__ void done(const Unit&) const {}
};

__device__ __forceinline__ unsigned cvt_pk_bf16(float lo, float hi) { unsigned r; asm volatile("v_cvt_pk_bf16_f32 %0, %1, %2" : "=v"(r) : "v"(lo), "v"(hi)); return r; }

template <class Epi, class Sched, bool ALIGN_EPI = false, bool SP2 = false, bool GATHER = false>
__device__ __forceinline__ void gemm_phase(PG8_LAS unsigned char* lds, const Gemm g, const Sched& S, const Epi& E) {
    const int tid = threadIdx.x, wid = __builtin_amdgcn_readfirstlane(tid >> 6), lane = tid & 63, wr = wid >> 2, wc = wid & 3, fr = lane & 15, fq = lane >> 4;
    const int K = g.K, nt = K / BK;
    unsigned voffA[2], voffB[2];
#pragma unroll
    for (int i = 0; i < 2; ++i) { int R, C; stage_rc(tid * 16 + i * 8192, R, C); const int Rb = Epi::PERM ? ((R & ~31) + perm32(R & 31)) : R;
        voffA[i] = (unsigned)(R * g.lda + C) * 2u; voffB[i] = (unsigned)(Rb * g.ldb + C) * 2u; }
    unsigned vc0[2], vc1[2], vn0[2], vn1[2];
    const PG8_LAS int* gl = (const PG8_LAS int*)(lds + g.gidx_off);
#define PG8_GIDX(uix, v0, v1) do { _Pragma("unroll") for (int _i = 0; _i < 2; ++_i) { int _R, _C; stage_rc(tid * 16 + _i * 8192, _R, _C); \
        v0[_i] = (unsigned)(gl[(uix) * 256 + _R] * g.lda + _C) * 2u; v1[_i] = (unsigned)(gl[(uix) * 256 + 128 + _R] * g.lda + _C) * 2u; } } while (0)
    const size_t kstep = (size_t)(BK * 2);
    const size_t hstepA = (size_t)HALF * g.lda * 2, hstepB = (size_t)HALF * g.ldb * 2;
    const size_t tstepA = GATHER ? 0 : 2 * hstepA, tstepB = 2 * hstepB;
    const unsigned ldsw = (unsigned)wid * 1024u;
    const int aoff = lds_byte(wr * 64 + fr, fq * 8), boff = lds_byte(wc * 32 + fr, fq * 8);
#define PG8_SA(b, h) (((b) * 2 + (h)) * HTB)
#define PG8_SB(b, h) ((4 + (b) * 2 + (h)) * HTB)
#define PG8_STAGE(bufoff, gbase, voff) do { _Pragma("unroll") for (int _i = 0; _i < 2; ++_i) \
        __builtin_amdgcn_global_load_lds((const unsigned*)((const char*)(gbase) + (voff)[_i]), (PG8_LAS unsigned*)(lds + (bufoff) + ldsw + _i * 8192), 16, 0, 0); } while (0)
#define PG8_LDA(dst, b, h) do { _Pragma("unroll") for (int m = 0; m < 4; ++m) _Pragma("unroll") for (int k = 0; k < 2; ++k) dst[m][k] = *(const PG8_LAS bf16x8*)(lds + PG8_SA(b, h) + aoff + m * 2048 + k * 1024); } while (0)
#define PG8_LDB(dst, b, h) do { _Pragma("unroll") for (int n = 0; n < 2; ++n) _Pragma("unroll") for (int k = 0; k < 2; ++k) dst[n][k] = *(const PG8_LAS bf16x8*)(lds + PG8_SB(b, h) + boff + n * 2048 + k * 1024); } while (0)
#define PG8_MMA(ai, bj, At, Bt) do { __builtin_amdgcn_s_setprio(1); _Pragma("unroll") for (int m = 0; m < 4; ++m) _Pragma("unroll") for (int n = 0; n < 2; ++n) _Pragma("unroll") for (int k = 0; k < 2; ++k) \
        acc[ai][bj][m][n] = __builtin_amdgcn_mfma_f32_16x16x32_bf16(Bt[n][k], At[m][k], acc[ai][bj][m][n], 0, 0, 0); __builtin_amdgcn_s_setprio(0); } while (0)
#define PG8_WAIT_V(n) asm volatile("s_waitcnt vmcnt(" #n ")" ::: "memory")
#define PG8_WAIT_L(n) asm volatile("s_waitcnt lgkmcnt(" #n ")" ::: "memory")
#define PG8_BAR __builtin_amdgcn_s_barrier()
#define PG8_SCHED __builtin_amdgcn_sched_barrier(0)
    Unit cur, nxt; int ui = 0;
    if (!S.next(0, cur)) return;
    f32x4 acc[2][2][4][2];
#pragma unroll
    for (int a = 0; a < 2; ++a)
#pragma unroll
        for (int b = 0; b < 2; ++b)
#pragma unroll
            for (int m = 0; m < 4; ++m)
#pragma unroll
                for (int n = 0; n < 2; ++n) acc[a][b][m][n] = (f32x4){0.f, 0.f, 0.f, 0.f};
    bf16x8 At[4][2], B0[2][2], B1[2][2];
    const char* cA = (const char*)g.A + (size_t)cur.pm * tstepA; const char* cB = (const char*)g.Bt + (size_t)cur.bz * g.bz_stride + (size_t)cur.pn * tstepB;
    S.a_ready(cur);
    if constexpr (GATHER) { PG8_GIDX(0, vc0, vc1); vn0[0] = vc0[0]; vn0[1] = vc0[1]; vn1[0] = vc1[0]; vn1[1] = vc1[1]; }
#define PG8_STAGE_A0(bufoff, p, NX) do { if constexpr (GATHER) { unsigned _v[2] = {(NX) ? vn0[0] : vc0[0], (NX) ? vn0[1] : vc0[1]}; PG8_STAGE(bufoff, p, _v); } else PG8_STAGE(bufoff, p, voffA); } while (0)
#define PG8_STAGE_A1(bufoff, p, NX) do { if constexpr (GATHER) { unsigned _v[2] = {(NX) ? vn1[0] : vc1[0], (NX) ? vn1[1] : vc1[1]}; PG8_STAGE(bufoff, p, _v); } else PG8_STAGE(bufoff, (p) + hstepA, voffA); } while (0)
    if constexpr (SP2) {
        PG8_STAGE(PG8_SB(0, 0), cB, voffB); PG8_STAGE(PG8_SB(0, 1), cB + hstepB, voffB); PG8_STAGE_A0(PG8_SA(0, 0), cA, false); PG8_STAGE_A1(PG8_SA(0, 1), cA, false);
        if (wr == 1) PG8_BAR;
        PG8_WAIT_V(2); PG8_BAR;
        PG8_STAGE(PG8_SB(1, 0), cB + kstep, voffB); PG8_STAGE_A0(PG8_SA(1, 0), cA + kstep, false); PG8_STAGE(PG8_SB(1, 1), cB + hstepB + kstep, voffB);
        PG8_WAIT_V(6); PG8_BAR;
    } else {
        PG8_STAGE(PG8_SB(0, 0), cB, voffB); PG8_STAGE_A0(PG8_SA(0, 0), cA, false); PG8_STAGE(PG8_SB(0, 1), cB + hstepB, voffB); PG8_STAGE_A1(PG8_SA(0, 1), cA, false);
        if (wr == 1) PG8_BAR;
        PG8_WAIT_V(4); PG8_BAR;
        PG8_STAGE(PG8_SB(1, 0), cB + kstep, voffB); PG8_STAGE_A0(PG8_SA(1, 0), cA + kstep, false); PG8_STAGE(PG8_SB(1, 1), cB + hstepB + kstep, voffB);
        PG8_WAIT_V(6); PG8_BAR;
    }
    for (;;) {
        const bool has_next = S.next(ui + 1, nxt);
        const char* nA = has_next ? (const char*)g.A + (size_t)nxt.pm * tstepA : cA;
        const char* nB = has_next ? (const char*)g.Bt + (size_t)nxt.bz * g.bz_stride + (size_t)nxt.pn * tstepB : cB;
        if constexpr (GATHER) { if (has_next) PG8_GIDX(ui + 1, vn0, vn1); }
#pragma unroll 1
        for (int t = 0; t < nt; t += 2) {
            const bool last = (t == nt - 2);
            const char* a1 = cA + (size_t)(t + 1) * kstep;
            const char* a2 = last ? nA : cA + (size_t)(t + 2) * kstep; const char* b2 = last ? nB : cB + (size_t)(t + 2) * kstep;
            const char* a3 = a2 + kstep; const char* b3 = b2 + kstep;
            if (last && has_next) S.a_ready(nxt);
            if constexpr (SP2) {
            PG8_LDB(B0, 0, 0); PG8_LDB(B1, 0, 1); PG8_SCHED; PG8_LDA(At, 0, 0); PG8_STAGE_A1(PG8_SA(1, 1), a1, false);
            PG8_WAIT_V(8); PG8_WAIT_L(0); PG8_BAR; PG8_MMA(0, 0, At, B0); PG8_MMA(0, 1, At, B1); PG8_BAR; PG8_SCHED;
            PG8_LDA(At, 0, 1); PG8_STAGE(PG8_SB(0, 0), b2, voffB); PG8_STAGE(PG8_SB(0, 1), b2 + hstepB, voffB); PG8_STAGE_A0(PG8_SA(0, 0), a2, last);
            PG8_WAIT_V(8); PG8_WAIT_L(0); PG8_BAR; PG8_MMA(1, 0, At, B0); PG8_MMA(1, 1, At, B1); PG8_BAR; PG8_SCHED;
            PG8_LDB(B0, 1, 0); PG8_LDB(B1, 1, 1); PG8_SCHED; PG8_LDA(At, 1, 0); PG8_STAGE_A1(PG8_SA(0, 1), a2, last);
            PG8_WAIT_V(8); PG8_WAIT_L(0); PG8_BAR; PG8_MMA(0, 0, At, B0); PG8_MMA(0, 1, At, B1); PG8_BAR; PG8_SCHED;
            PG8_LDA(At, 1, 1); PG8_STAGE(PG8_SB(1, 0), b3, voffB); PG8_STAGE(PG8_SB(1, 1), b3 + hstepB, voffB); PG8_STAGE_A0(PG8_SA(1, 0), a3, last);
            PG8_WAIT_V(8); PG8_WAIT_L(0); PG8_BAR; PG8_MMA(1, 0, At, B0); PG8_MMA(1, 1, At, B1); PG8_BAR; PG8_SCHED;
            } else {
            PG8_LDB(B0, 0, 0); PG8_SCHED; PG8_LDA(At, 0, 0); PG8_STAGE_A1(PG8_SA(1, 1), a1, false);
            PG8_WAIT_L(8); PG8_BAR; PG8_WAIT_L(0); PG8_MMA(0, 0, At, B0); PG8_BAR; PG8_SCHED;
            PG8_LDB(B1, 0, 1); PG8_STAGE(PG8_SB(0, 0), b2, voffB);
            PG8_BAR; PG8_WAIT_L(0); PG8_MMA(0, 1, At, B1); PG8_BAR;
            PG8_LDA(At, 0, 1); PG8_STAGE_A0(PG8_SA(0, 0), a2, last);
            PG8_BAR; PG8_WAIT_L(0); PG8_MMA(1, 0, At, B0); PG8_BAR; PG8_SCHED;
            PG8_STAGE(PG8_SB(0, 1), b2 + hstepB, voffB);
            PG8_WAIT_V(6); PG8_BAR; PG8_MMA(1, 1, At, B1); PG8_BAR;
            PG8_LDB(B0, 1, 0); PG8_SCHED; PG8_LDA(At, 1, 0); PG8_STAGE_A1(PG8_SA(0, 1), a2, last);
            PG8_WAIT_L(8); PG8_BAR; PG8_WAIT_L(0); PG8_MMA(0, 0, At, B0); PG8_BAR; PG8_SCHED;
            PG8_LDB(B1, 1, 1); PG8_STAGE(PG8_SB(1, 0), b3, voffB);
            PG8_BAR; PG8_WAIT_L(0); PG8_MMA(0, 1, At, B1); PG8_BAR;
            PG8_LDA(At, 1, 1); PG8_STAGE_A0(PG8_SA(1, 0), a3, last);
            PG8_BAR; PG8_WAIT_L(0); PG8_MMA(1, 0, At, B0); PG8_BAR; PG8_SCHED;
            PG8_STAGE(PG8_SB(1, 1), b3 + hstepB, voffB);
            PG8_WAIT_V(6); PG8_BAR; PG8_MMA(1, 1, At, B1); PG8_BAR;
            }
        }
        if constexpr (ALIGN_EPI) { if (wr == 0) PG8_BAR; }
        E(acc, cur, wr, wc, fr, fq); S.done(cur);
        if (!has_next) break;
#pragma unroll
        for (int a = 0; a < 2; ++a)
#pragma unroll
            for (int b = 0; b < 2; ++b)
#pragma unroll
                for (int m = 0; m < 4; ++m)
#pragma unroll
                    for (int n = 0; n < 2; ++n) acc[a][b][m][n] = (f32x4){0.f, 0.f, 0.f, 0.f};
        cur = nxt; cA = nA; cB = nB; ++ui;
        if constexpr (GATHER) { vc0[0] = vn0[0]; vc0[1] = vn0[1]; vc1[0] = vn1[0]; vc1[1] = vn1[1]; }
        if constexpr (ALIGN_EPI) { if (wr == 1) PG8_BAR; }
    }
    PG8_WAIT_V(0);
    if constexpr (!ALIGN_EPI) { if (wr == 0) PG8_BAR; }
    PG8_BAR;
#undef PG8_SA
#undef PG8_SB
#undef PG8_STAGE
#undef PG8_STAGE_A0
#undef PG8_STAGE_A1
#undef PG8_GIDX
#undef PG8_LDA
#undef PG8_LDB
#undef PG8_MMA
#undef PG8_WAIT_V
#undef PG8_WAIT_L
#undef PG8_BAR
#undef PG8_SCHED
}
}
#define GP_ALIGN true
#define GP_SP2 true

constexpr int DM = 1024, NB = 8, SEQ = 4096, CTXL = 256, TC = SEQ + CTXL  ;
constexpr int M0 = NB * TC  , M1 = NB * SEQ  ;
constexpr int NEXP = 16;
constexpr float RMS_EPS = 1e-6f;
constexpr int NCHUNK = 256;
constexpr int MAXTILES = 288;
constexpr int LCH = 68;

enum { I_X = 0, I_C, I_CTX, I_CCTX, I_ADAW, I_ADAB, I_N1G, I_N2G, I_FING, I_EVWIN, I_QNG, I_KVNG, I_WUQ, I_WUKV, I_LCW, I_LCB, I_LWA, I_LBA, I_LWX, I_LBX, I_LLAM, I_EVWOUT,
       I_ODWIN, I_HCW, I_HCB, I_HW1, I_HB1, I_HF1, I_HW2, I_HB2, I_HF2, I_HW3, I_HDEC, I_HSKIP, I_ODWOUT, I_RW, I_RB, I_MW1, I_MW3, I_MW2, N_IN };

constexpr size_t MiB = 1u << 20;
constexpr size_t WS_CTL = 0, CTL_ZERO_BYTES = 1 * MiB;
constexpr size_t WS_MOD = 1 * MiB;
constexpr size_t WS_RQ = WS_MOD + 2 * 9 * 6144 * 4;
constexpr size_t WS_RKV = WS_RQ + (size_t)M0 * 4;
constexpr size_t WS_A2 = 2 * MiB;
constexpr size_t WS_ROUTE_E = 3 * MiB;
constexpr size_t WS_ROUTE_W = WS_ROUTE_E + (size_t)M0 * 4;
constexpr size_t WS_ROUTE_S = WS_ROUTE_W + (size_t)M0 * 8;
constexpr size_t WS_CNT = WS_ROUTE_S + (size_t)M0 * 8;
constexpr size_t WS_TILEE = WS_CNT + 256 * 16 * 4;
static_assert(WS_TILEE + (MAXTILES + 64) * 4 <= 4 * MiB, "route region");
constexpr size_t WS_CP = 4 * MiB;
constexpr size_t WS_CS = WS_CP + (size_t)2 * 8 * LCH * 512 * 4;
static_assert(WS_CS + (size_t)2 * 8 * LCH * 512 * 4 <= 10 * MiB, "lru carries");
constexpr size_t WS_WIN = 10 * MiB;
constexpr size_t WS_WUQ = 14 * MiB;
constexpr size_t WS_WUKV = 15 * MiB;
constexpr size_t WS_WOUT = 16 * MiB;
constexpr size_t WS_WHIN = 18 * MiB;
constexpr size_t WS_WHOUT = 24 * MiB;
constexpr size_t WS_WG = 26 * MiB;
constexpr size_t WS_W13 = 27 * MiB;
constexpr size_t WS_W2 = 91 * MiB;
constexpr size_t WS_RH = 124 * MiB;
constexpr size_t WS_XC = 192 * MiB;
constexpr size_t X2_OFF = 64 * MiB;
constexpr size_t WS_R2 = 200 * MiB;
constexpr size_t WS_CQ = WS_R2;
constexpr size_t WS_CKV = WS_R2 + 26 * MiB;
constexpr size_t WS_UX = WS_R2 + 43 * MiB;
constexpr size_t WS_UG = WS_R2 + 77 * MiB;
constexpr size_t WS_Q = WS_R2 + 111 * MiB;
constexpr size_t WS_K = WS_R2 + 162 * MiB;
constexpr size_t WS_V = WS_R2 + 213 * MiB;
constexpr size_t WS_HPERM = WS_R2;
constexpr size_t WS_ACT = WS_R2 + 144 * MiB;
constexpr size_t WS_PT = WS_R2;
constexpr size_t WS_ZT = WS_R2 + 192 * MiB;
constexpr size_t WS_Z = WS_R2;
constexpr size_t WS_HSPEC = 456 * MiB;
constexpr size_t WS_X3 = 416 * MiB;
constexpr size_t WS_HIN = 488 * MiB;
constexpr size_t WS_SLOTTOK = 491 * MiB;
constexpr size_t WS_END = 492 * MiB;
static_assert(WS_V + (size_t)M0 * 512 * 2 <= WS_HSPEC && WS_ZT + (size_t)1024 * 32768 * 2 <= WS_HSPEC && WS_ACT + (size_t)73728 * 512 * 2 <= WS_HSPEC, "ws map");

constexpr int CW_TMO = 0, CW_BAR = 4096;

constexpr int RING_BYTES = 131072, LDS_BYTES = 155648, LDSCTL_OFF = LDS_BYTES - 1024, MISC_OFF = LDSCTL_OFF + 320;

#define XB_TMO      128
#define XB_XCNT(j)  (256  + 64 * (j))
#define XB_XSUB(j)  (1280 + 64 * (j))
#define XB_XGEN(j)  (2304 + 64 * (j))
#define XB_TOP      3328
#define XB_TOPGEN   3392
#define XCD_BAR_WORDS 3456
#define XB_SPIN_CAP (1u << 18)
__device__ __forceinline__ unsigned xb_ld(unsigned* p)              { return __hip_atomic_load(p, __ATOMIC_RELAXED, __HIP_MEMORY_SCOPE_AGENT); }
__device__ __forceinline__ unsigned xb_add(unsigned* p, unsigned v) { return __hip_atomic_fetch_add(p, v, __ATOMIC_RELAXED, __HIP_MEMORY_SCOPE_AGENT); }
__device__ __forceinline__ unsigned xb_xcc_id() { return (unsigned)__builtin_amdgcn_s_getreg((3 << 11) | 20) & 0xFu; }
#define XB_SPIN(cond, bar) do { unsigned _sp = 0; while (cond) { __builtin_amdgcn_s_sleep(1); \
    if ((++_sp & 255u) == 0u) { if (xb_ld(&(bar)[XB_TMO])) break; if (_sp > XB_SPIN_CAP) { atomicAdd(&(bar)[XB_TMO], 1u); break; } } } } while (0)
struct XcdBarrier { unsigned* bar; unsigned x; volatile LAS unsigned* st; };
__device__ __forceinline__ XcdBarrier xcd_barrier_post(unsigned* bar, volatile LAS unsigned* st) {
    XcdBarrier b; b.bar = bar; b.x = xb_xcc_id(); b.st = st;
    if (threadIdx.x == 0) (void)xb_add(&bar[XB_XCNT(b.x)], 1u);
    return b;
}
__device__ __forceinline__ void xcd_barrier_complete(unsigned* bar, unsigned x, unsigned& nloc, unsigned& nx) {
    const unsigned G = gridDim.x * gridDim.y * gridDim.z;
    unsigned sum, cnt, mine, sp = 0u;
    for (;;) {
        sum = 0u; cnt = 0u; mine = 0u;
#pragma unroll
        for (unsigned j = 0; j < 16; ++j) { const unsigned c = xb_ld(&bar[XB_XCNT(j)]); sum += c; cnt += (c > 0u) ? 1u : 0u; mine = (j == x) ? c : mine; }
        if (sum == G) break;
        __builtin_amdgcn_s_sleep(1);
        if ((++sp & 255u) == 0u) { if (xb_ld(&bar[XB_TMO])) break; if (sp > XB_SPIN_CAP) { atomicAdd(&bar[XB_TMO], 1u); break; } }
    }
    nloc = mine > 0u ? mine : 1u; nx = cnt > 0u ? cnt : 1u;
}
__device__ __forceinline__ void xcd_barrier(const XcdBarrier& b) {
    asm volatile("s_waitcnt vmcnt(0)" ::: "memory");
    __syncthreads();
    if (threadIdx.x == 0) {
        unsigned* bar = b.bar;
        __builtin_amdgcn_s_waitcnt(0);
        unsigned nloc = b.st[0], nx = b.st[1];
        if (nloc == 0u) { xcd_barrier_complete(bar, b.x, nloc, nx); b.st[0] = nloc; b.st[1] = nx; }
        const unsigned old = xb_add(&bar[XB_XSUB(b.x)], 1u);
        const unsigned gen = old / nloc;
        if (old + 1u == (gen + 1u) * nloc) {
            __builtin_amdgcn_fence(__ATOMIC_RELEASE, "agent");
            asm volatile("s_waitcnt vmcnt(0)" ::: "memory");
            const unsigned og = xb_add(&bar[XB_TOP], 1u);
            const unsigned tg = og / nx;
            if (og + 1u == (tg + 1u) * nx) xb_add(&bar[XB_TOPGEN], 1u);
            else XB_SPIN(xb_ld(&bar[XB_TOPGEN]) == tg, bar);
            __builtin_amdgcn_fence(__ATOMIC_ACQUIRE, "agent");
            xb_add(&bar[XB_XGEN(b.x)], 1u);
            asm volatile("s_waitcnt vmcnt(0)" ::: "memory");
        } else {
            XB_SPIN(xb_ld(&bar[XB_XGEN(b.x)]) == gen, bar);
            __builtin_amdgcn_fence(__ATOMIC_ACQUIRE, "agent");
            asm volatile("s_waitcnt vmcnt(0)" ::: "memory");
        }
    }
    __syncthreads();
}

struct Params { const float* in[N_IN]; float* out; unsigned char* ws; int ph_lo, ph_hi; };
typedef const __attribute__((address_space(4))) Params* ParamsK;
__device__ __forceinline__ Params load_params() {
#if defined(__HIP_DEVICE_COMPILE__)
    unsigned long long v = (unsigned long long)__builtin_amdgcn_kernarg_segment_ptr(); asm volatile("" : "+s"(v)); return *(ParamsK)v;
#else
    return Params{};
#endif
}

__device__ __forceinline__ u32x4 pack8(const f32x4 a, const f32x4 b) {
    u32x4 w; w.x = pg8::cvt_pk_bf16(a[0], a[1]); w.y = pg8::cvt_pk_bf16(a[2], a[3]); w.z = pg8::cvt_pk_bf16(b[0], b[1]); w.w = pg8::cvt_pk_bf16(b[2], b[3]); return w;
}
__device__ __forceinline__ void rope8(f32x4& v0, f32x4& v1, int fq, int tt  , bool on) {
    const int axis = fq >> 1, half = fq & 1; const float pos = (float)(axis == 0 ? (tt >> 6) : (tt & 63)) * 0.15915494309189535f;
    constexpr float IF[8] = {1.0f, 0.316227766f, 0.1f, 0.0316227766f, 0.01f, 0.00316227766f, 0.001f, 0.000316227766f};
#pragma unroll
    for (int i = 0; i < 4; ++i) {
        { const float x = v0[i], other = __shfl_xor(x, 16); const float sn = __builtin_amdgcn_sinf(pos * IF[i]), cs = __builtin_amdgcn_cosf(pos * IF[i]);
          const float r = half == 0 ? x * cs - other * sn : other * sn + x * cs; v0[i] = on ? r : x; }
        { const float x = v1[i], other = __shfl_xor(x, 16); const float sn = __builtin_amdgcn_sinf(pos * IF[4 + i]), cs = __builtin_amdgcn_cosf(pos * IF[4 + i]);
          const float r = half == 0 ? x * cs - other * sn : other * sn + x * cs; v1[i] = on ? r : x; }
    }
}

struct EpiIn {
    static constexpr bool PERM = true;
    bf16 *CQ, *CKV, *UX, *UG, *KB;
    __device__ __forceinline__ void operator()(const f32x4 (&acc)[2][2][4][2], const pg8::Unit& u, int wr, int wc, int fr, int fq) const {
        const int row0 = u.pm * 256 + wr * 64 + fr;
        const bool is_ctx = (u.pm % 17) == 0; const int bb = u.pm / 17;
#pragma unroll
        for (int bj = 0; bj < 2; ++bj) {
            const int blk = u.pn * 2 + bj;
            if (blk < 13) {
                bf16* dst; int ld, cb;
                if (blk < 3) { dst = CQ; ld = 384; cb = blk * 128; }
                else if (blk < 5) { dst = CKV; ld = 256; cb = (blk - 3) * 128; }
                else if (blk < 9) { dst = UX; ld = 512; cb = (blk - 5) * 128; }
                else { dst = UG; ld = 512; cb = (blk - 9) * 128; }
                const int col = cb + wc * 32 + 8 * fq;
#pragma unroll
                for (int ai = 0; ai < 2; ++ai)
#pragma unroll
                    for (int m = 0; m < 4; ++m) { const int row = row0 + ai * 128 + m * 16;
                        *(u32x4*)(dst + (size_t)row * ld + col) = pack8(acc[ai][bj][m][0], acc[ai][bj][m][1]); }
            } else if (wc == 0) {
#pragma unroll
                for (int ai = 0; ai < 2; ++ai)
#pragma unroll
                    for (int m = 0; m < 4; ++m) { const int row = row0 + ai * 128 + m * 16; const int tt = row - bb * TC - CTXL;
                        f32x4 v0 = acc[ai][bj][m][0], v1 = acc[ai][bj][m][1];
                        rope8(v0, v1, fq, tt, !is_ctx);
                        const u32x4 w = pack8(v0, v1);
#pragma unroll
                        for (int h = 0; h < 8; ++h) *(u32x4*)(KB + (size_t)row * 768 + h * 96 + 64 + 8 * fq) = w; }
            }
        }
    }
};
struct EpiQ {
    static constexpr bool PERM = true;
    bf16* Q; const float* rq;
    __device__ __forceinline__ void operator()(const f32x4 (&acc)[2][2][4][2], const pg8::Unit& u, int wr, int wc, int fr, int fq) const {
        const int row0 = u.pm * 256 + wr * 64 + fr;
#pragma unroll
        for (int ai = 0; ai < 2; ++ai)
#pragma unroll
            for (int m = 0; m < 4; ++m) { const int row = row0 + ai * 128 + m * 16; const float s = rq[row];
#pragma unroll
                for (int bj = 0; bj < 2; ++bj) {
                    const u32x4 w = pack8(acc[ai][bj][m][0] * s, acc[ai][bj][m][1] * s);
                    int off;
                    if (u.pn < 2) { const int c = u.pn * 256 + bj * 128 + wc * 32 + 8 * fq; off = (c >> 6) * 96 + (c & 63); }
                    else off = (4 * bj + wc) * 96 + 64 + 8 * fq;
                    *(u32x4*)(Q + (size_t)row * 768 + off) = w;
                } }
    }
};
struct EpiKV {
    static constexpr bool PERM = true;
    bf16 *K, *V; const float* rkv;
    __device__ __forceinline__ void operator()(const f32x4 (&acc)[2][2][4][2], const pg8::Unit& u, int wr, int wc, int fr, int fq) const {
        const int row0 = u.pm * 256 + wr * 64 + fr;
#pragma unroll
        for (int ai = 0; ai < 2; ++ai)
#pragma unroll
            for (int m = 0; m < 4; ++m) { const int row = row0 + ai * 128 + m * 16; const float s = rkv[row];
#pragma unroll
                for (int bj = 0; bj < 2; ++bj) { const int h = u.pn * 2 + bj;
                    const u32x4 w = pack8(acc[ai][bj][m][0] * s, acc[ai][bj][m][1] * s);
                    if (wc < 2) *(u32x4*)(K + (size_t)row * 768 + h * 96 + wc * 32 + 8 * fq) = w;
                    else *(u32x4*)(V + (size_t)row * 512 + h * 64 + (wc - 2) * 32 + 8 * fq) = w; } }
    }
};
template <int LAYER> struct EpiRes {
    static constexpr bool PERM = true;
    const float *x, *ctx, *mod; const bf16* xin; bf16 *xout, *xc;
    __device__ __forceinline__ void operator()(const f32x4 (&acc)[2][2][4][2], const pg8::Unit& u, int wr, int wc, int fr, int fq) const {
        const int row0 = u.pm * 256 + wr * 64 + fr, col0 = u.pn * 256 + wc * 32 + 8 * fq;
        const bool is_ctx = LAYER == 0 && (u.pm % 17) == 0; const int bb = LAYER == 0 ? u.pm / 17 : u.pm / 16;
        const float* g = mod + (size_t)(LAYER * 9 + (is_ctx ? 8 : bb)) * 6144 + 2048;
        f32x4 gv[2][2];
#pragma unroll
        for (int bj = 0; bj < 2; ++bj)
#pragma unroll
            for (int n = 0; n < 2; ++n) gv[bj][n] = *(const f32x4*)(g + col0 + bj * 128 + n * 4);
#pragma unroll
        for (int ai = 0; ai < 2; ++ai)
#pragma unroll
            for (int m = 0; m < 4; ++m) { const int row = row0 + ai * 128 + m * 16;
                if (LAYER == 0) { const int t = row - bb * TC; const float* res; bf16* dst;
                    if (is_ctx) { res = ctx + (size_t)(bb * CTXL + t) * DM; dst = xc + (size_t)(bb * CTXL + t) * DM; }
                    else { res = x + (size_t)(bb * SEQ + t - CTXL) * DM; dst = xout + (size_t)(bb * SEQ + t - CTXL) * DM; }
#pragma unroll
                    for (int bj = 0; bj < 2; ++bj) { const int c = col0 + bj * 128;
                        const f32x4 r0 = *(const f32x4*)(res + c), r1 = *(const f32x4*)(res + c + 4);
                        *(u32x4*)(dst + c) = pack8(r0 + gv[bj][0] * acc[ai][bj][m][0], r1 + gv[bj][1] * acc[ai][bj][m][1]); } }
                else {
#pragma unroll
                    for (int bj = 0; bj < 2; ++bj) { const int c = col0 + bj * 128; const u32x4 q = *(const u32x4*)(xin + (size_t)row * DM + c);
                        const f32x4 r0 = {bflo(q.x), bfhi(q.x), bflo(q.y), bfhi(q.y)}, r1 = {bflo(q.z), bfhi(q.z), bflo(q.w), bfhi(q.w)};
                        *(u32x4*)(xout + (size_t)row * DM + c) = pack8(r0 + gv[bj][0] * acc[ai][bj][m][0], r1 + gv[bj][1] * acc[ai][bj][m][1]); } } }
    }
};
struct EpiMoe1 {
    static constexpr bool PERM = true;
    bf16* ACT;
    __device__ __forceinline__ void operator()(const f32x4 (&acc)[2][2][4][2], const pg8::Unit& u, int wr, int wc, int fr, int fq) const {
        const int row0 = u.pm * 256 + wr * 64 + fr, col = u.pn * 128 + wc * 32 + 8 * fq;
#pragma unroll
        for (int ai = 0; ai < 2; ++ai)
#pragma unroll
            for (int m = 0; m < 4; ++m) { const int row = row0 + ai * 128 + m * 16;
                f32x4 r[2];
#pragma unroll
                for (int n = 0; n < 2; ++n)
#pragma unroll
                    for (int i = 0; i < 4; ++i) { const float a = acc[ai][0][m][n][i], b = acc[ai][1][m][n][i]; r[n][i] = a / (1.f + __expf(-a)) * b; }
                *(u32x4*)(ACT + (size_t)row * 512 + col) = pack8(r[0], r[1]); }
    }
};
struct EpiStore {
    static constexpr bool PERM = true;
    bf16* O; int ldc;
    __device__ __forceinline__ void operator()(const f32x4 (&acc)[2][2][4][2], const pg8::Unit& u, int wr, int wc, int fr, int fq) const {
        const int row0 = u.pm * 256 + wr * 64 + fr, col0 = u.pn * 256 + wc * 32 + 8 * fq;
#pragma unroll
        for (int ai = 0; ai < 2; ++ai)
#pragma unroll
            for (int m = 0; m < 4; ++m) { bf16* rowp = O + (size_t)(row0 + ai * 128 + m * 16) * ldc + col0;
#pragma unroll
                for (int bj = 0; bj < 2; ++bj) *(u32x4*)(rowp + bj * 128) = pack8(acc[ai][bj][m][0], acc[ai][bj][m][1]); }
    }
};

__device__ __forceinline__ void cvt_item(const float* W, int ldw, int col0, const float* gk, bf16* WTrow0, int ldk, int k0, float* scr, int lane) {
    if (col0 >= 0) {
        float v[32];
#pragma unroll
        for (int i = 0; i < 32; ++i) v[i] = W[(size_t)(k0 + 2 * i + (lane >> 5)) * ldw + col0 + (lane & 31)];
        if (gk) {
#pragma unroll
            for (int i = 0; i < 32; ++i) v[i] *= gk[k0 + 2 * i + (lane >> 5)];
        }
#pragma unroll
        for (int i = 0; i < 32; ++i) scr[(2 * i + (lane >> 5)) * 33 + (lane & 31)] = v[i];
    } else {
#pragma unroll 8
        for (int i = 0; i < 32; ++i) { const int kk = 2 * i + (lane >> 5); scr[kk * 33 + (lane & 31)] = 0.f; }
    }
    LDS_WAIT(); asm volatile("" ::: "memory");
    const int c = lane & 7;
#pragma unroll
    for (int j = 0; j < 4; ++j) { const int n = (lane >> 3) + 8 * j; const float* s = scr + (8 * c) * 33 + n;
        u32x4 o; o.x = pk2(s[0 * 33], s[1 * 33]); o.y = pk2(s[2 * 33], s[3 * 33]); o.z = pk2(s[4 * 33], s[5 * 33]); o.w = pk2(s[6 * 33], s[7 * 33]);
        *(u32x4*)(WTrow0 + (size_t)n * ldk + k0 + 8 * c) = o; }
    LDS_WAIT(); asm volatile("" ::: "memory");
}

__device__ __forceinline__ void phase_prologue(const Params& P, unsigned char* lds, int tid, int lane, int wave, int G) {
    unsigned char* ws = P.ws;
    __syncthreads();
    {
        float* sl = (float*)lds;
        float* red = (float*)(lds + 40960);
        float* mod = (float*)(ws + WS_MOD);
        bool loaded = false;
        for (int u = blockIdx.x; u < 192; u += G) {
            if (!loaded) { for (int i = tid; i < 9 * 1024; i += 512) { const float v = i < 8192 ? P.in[I_C][i] : P.in[I_CCTX][i - 8192]; sl[i] = v / (1.f + expf(-v)); } loaded = true; __syncthreads(); }
            const int l = u / 96, col = (u % 96) * 64 + lane;
            const float* W = P.in[I_ADAW] + (size_t)l * 1024 * 6144 + col;
            float a[9];
#pragma unroll
            for (int b = 0; b < 9; ++b) a[b] = 0.f;
            const int kb = wave * 128;
#pragma unroll 16
            for (int k = 0; k < 128; ++k) { const float w = W[(size_t)(kb + k) * 6144];
#pragma unroll
                for (int b = 0; b < 9; ++b) a[b] += sl[b * 1024 + kb + k] * w; }
#pragma unroll
            for (int b = 0; b < 9; ++b) red[(wave * 9 + b) * 64 + lane] = a[b];
            __syncthreads();
            for (int i = tid; i < 9 * 64; i += 512) { const int b = i >> 6, cc = i & 63; float s = 0.f;
#pragma unroll
                for (int w = 0; w < 8; ++w) s += red[(w * 9 + b) * 64 + cc];
                const int c2 = (u % 96) * 64 + cc;
                mod[(size_t)(l * 9 + b) * 6144 + c2] = s + P.in[I_ADAB][l * 6144 + c2]; }
            __syncthreads();
        }
        __syncthreads();
    }
    {
        float* scr = (float*)(lds + wave * 16384);
        const int gw = blockIdx.x * 8 + wave, NGW = G * 8;
        constexpr int I_WIN = 16 * 56, I_UQ = 6 * 24, I_UKV = 4 * 32, I_OUT = 16 * 32, I_HIN = 16 * 96, I_HOUT = 16 * 32, I_WG = 64, I_M13 = 32 * 512, I_M2 = 32 * 256;
        constexpr int NITEMS = I_WIN + I_UQ + I_UKV + I_OUT + I_HIN + I_HOUT + I_WG + I_M13 + I_M2;
        for (int it = gw; it < NITEMS; it += NGW) {
            int r = it;
            if (r < I_M13) { const int le = r >> 9, q = r & 511, kb = q >> 5, nb = q & 31, n0 = 32 * nb, pn = n0 >> 8, j = n0 & 255;
                const float* src = (j < 128 ? P.in[I_MW1] : P.in[I_MW3]) + (size_t)le * 1024 * 512;
                cvt_item(src, 512, 128 * pn + (j & 127), nullptr, (bf16*)(ws + WS_W13) + ((size_t)le * 1024 + n0) * 1024, 1024, 64 * kb, scr, lane); continue; } r -= I_M13;
            if (r < I_M2) { const int le = r >> 8, q = r & 255, kb = q >> 5, nb = q & 31, n0 = 32 * nb;
                cvt_item(P.in[I_MW2] + (size_t)le * 512 * 1024, 1024, n0, nullptr, (bf16*)(ws + WS_W2) + ((size_t)le * 1024 + n0) * 512, 512, 64 * kb, scr, lane); continue; } r -= I_M2;
            if (r < I_WIN) { const int kb = r / 56, nb = r % 56, n0 = 32 * nb; const int col0 = n0 < 640 ? n0 : (n0 < 1664 ? n0 + 32 : (n0 < 1696 ? n0 - 1024 : -1));
                cvt_item(P.in[I_EVWIN], 1696, col0, nullptr, (bf16*)(ws + WS_WIN) + (size_t)n0 * 1024, 1024, 64 * kb, scr, lane); continue; } r -= I_WIN;
            if (r < I_UQ) { const int kb = r / 24, nb = r % 24, n0 = 32 * nb; const int col0 = n0 < 512 ? (n0 >> 6) * 96 + (n0 & 63) : ((n0 - 512) >> 5) * 96 + 64;
                cvt_item(P.in[I_WUQ], 768, col0, P.in[I_QNG], (bf16*)(ws + WS_WUQ) + (size_t)n0 * 384, 384, 64 * kb, scr, lane); continue; } r -= I_UQ;
            if (r < I_UKV) { const int kb = r / 32, nb = r % 32, n0 = 32 * nb;
                cvt_item(P.in[I_WUKV], 1024, n0, P.in[I_KVNG], (bf16*)(ws + WS_WUKV) + (size_t)n0 * 256, 256, 64 * kb, scr, lane); continue; } r -= I_UKV;
            if (r < I_OUT) { const int kb = r / 32, nb = r % 32, n0 = 32 * nb;
                cvt_item(P.in[I_EVWOUT], 1024, n0, nullptr, (bf16*)(ws + WS_WOUT) + (size_t)n0 * 1024, 1024, 64 * kb, scr, lane); continue; } r -= I_OUT;
            if (r < I_HIN) { const int kb = r / 96, nb = r % 96, n0 = 32 * nb;
                cvt_item(P.in[I_ODWIN], 3072, n0, nullptr, (bf16*)(ws + WS_WHIN) + (size_t)n0 * 1024, 1024, 64 * kb, scr, lane); continue; } r -= I_HIN;
            if (r < I_HOUT) { const int kb = r / 32, nb = r % 32, n0 = 32 * nb;
                cvt_item(P.in[I_ODWOUT], 1024, n0, nullptr, (bf16*)(ws + WS_WHOUT) + (size_t)n0 * 1024, 1024, 64 * kb, scr, lane); continue; } r -= I_HOUT;
            { const int mat = r >> 1, nb = r & 1, d = mat >> 4, gsel = (mat >> 3) & 1, h = mat & 7;
                const float* src = (gsel ? P.in[I_LWX] : P.in[I_LWA]) + (size_t)(d * 8 + h) * 4096;
                cvt_item(src, 64, 32 * nb, nullptr, (bf16*)(ws + WS_WG) + (size_t)(h * 256 + d * 128 + gsel * 64 + 32 * nb) * 64, 64, 0, scr, lane); }
        }
    }
    {
        const int gw = blockIdx.x * 8 + wave, NGW = G * 8;
        float* a2 = (float*)(ws + WS_A2);
        const float *w1 = P.in[I_HW1], *b1 = P.in[I_HB1], *f1 = P.in[I_HF1], *w2 = P.in[I_HW2], *b2 = P.in[I_HB2], *f2 = P.in[I_HF2];
        for (int t = gw; t < 4096; t += NGW) {
            const float tl = (float)t / 4095.f, w = (6.283185307179586f / 4096.f) * (float)t;
            float zi = 0.f;
            if (lane == 0) zi = tl;
            else if (lane <= 16) { const float f = 1e-4f + (float)(lane - 1) * ((15.f - 1e-4f) / 15.f); zi = cosf(f * w); }
            else if (lane <= 32) { const float f = 1e-4f + (float)(lane - 17) * ((15.f - 1e-4f) / 15.f); zi = -sinf(f * w); }
            float acc = b1[lane];
            for (int i = 0; i < 33; ++i) acc += __shfl(zi, i) * w1[i * 64 + lane];
            const float a1 = sinf(f1[lane] * acc);
            float acc2 = b2[lane];
            for (int i = 0; i < 64; ++i) acc2 += __shfl(a1, i) * w2[i * 64 + lane];
            a2[(size_t)lane * 4096 + t] = sinf(f2[lane] * acc2);
        }
    }
}

__device__ __forceinline__ void store_row_bf16(bf16* orow, const f32x4 (&v)[4], int lane) {
    unsigned long long* o8 = (unsigned long long*)orow + lane;
#pragma unroll
    for (int j = 0; j < 4; ++j) o8[64 * j] = (unsigned long long)pk2(v[j][0], v[j][1]) | ((unsigned long long)pk2(v[j][2], v[j][3]) << 32);
}
__device__ __forceinline__ void load_xrow(const bf16* row, int lane, u32x2 (&q)[4]) {
#pragma unroll
    for (int j = 0; j < 4; ++j) q[j] = ((const u32x2*)row)[lane + 64 * j];
}
__device__ __forceinline__ void cvt_xrow(const u32x2 (&q)[4], f32x4 (&v)[4]) {
#pragma unroll
    for (int j = 0; j < 4; ++j) v[j] = (f32x4){bflo(q[j].x), bfhi(q[j].x), bflo(q[j].y), bfhi(q[j].y)};
}
__device__ __forceinline__ void norm_mod(f32x4 (&v)[4], const float* g, const float* sh, const float* sc, int lane) {
    float ss = 0.f;
#pragma unroll
    for (int j = 0; j < 4; ++j) ss += (v[j][0] * v[j][0] + v[j][1] * v[j][1]) + (v[j][2] * v[j][2] + v[j][3] * v[j][3]);
    const float rr = rsqrtf(wave_sum(ss) * (1.f / 1024.f) + RMS_EPS);
#pragma unroll
    for (int j = 0; j < 4; ++j) { const f32x4 gg = ((const f32x4*)g)[lane + 64 * j], s1 = ((const f32x4*)sc)[lane + 64 * j], s0 = ((const f32x4*)sh)[lane + 64 * j];
        v[j] = (v[j] * rr * gg) * (1.f + s1) + s0; }
}
struct CombIdx { int s0, s1; float w0, w1; };
struct CombData { u32x2 x[4], y0[4], y1[4]; };
__device__ __forceinline__ void comb_load_idx(const int* rs, const float* rw, int r, CombIdx& I) { I.s0 = rs[2 * r]; I.s1 = rs[2 * r + 1]; I.w0 = rw[2 * r]; I.w1 = rw[2 * r + 1]; }
__device__ __forceinline__ void comb_load_data(const bf16* xrow, const bf16* Y, const CombIdx& I, int lane, CombData& D) {
    const u32x2* y0 = (const u32x2*)(Y + (size_t)I.s0 * 1024) + lane; const u32x2* y1 = (const u32x2*)(Y + (size_t)I.s1 * 1024) + lane;
#pragma unroll
    for (int j = 0; j < 4; ++j) { D.x[j] = ((const u32x2*)xrow)[lane + 64 * j]; D.y0[j] = y0[64 * j]; D.y1[j] = y1[64 * j]; }
}
__device__ __forceinline__ void comb_apply(f32x4 (&v)[4], const CombData& D, const CombIdx& I, const float* g2, int lane) {
#pragma unroll
    for (int j = 0; j < 4; ++j) { const u32x2 a = D.y0[j], b = D.y1[j]; const f32x4 gg = ((const f32x4*)g2)[lane + 64 * j];
        f32x4 m; m[0] = I.w0 * bflo(a.x) + I.w1 * bflo(b.x); m[1] = I.w0 * bfhi(a.x) + I.w1 * bfhi(b.x); m[2] = I.w0 * bflo(a.y) + I.w1 * bflo(b.y); m[3] = I.w0 * bfhi(a.y) + I.w1 * bfhi(b.y);
        v[j] = (f32x4){bflo(D.x[j].x), bfhi(D.x[j].x), bflo(D.x[j].y), bfhi(D.x[j].y)} + gg * m; }
}
__device__ __forceinline__ float route_scores(const f32x4 (&v)[4], const float* rwT  , int lane) {
    float p[16];
#pragma unroll
    for (int e = 0; e < 16; ++e) { f32x2 a2 = {0.f, 0.f};
#pragma unroll
        for (int j = 0; j < 4; ++j) { const f32x4 w = ((const f32x4*)(rwT + e * 1024))[lane + 64 * j];
            a2 = __builtin_elementwise_fma((f32x2){v[j][0], v[j][1]}, (f32x2){w[0], w[1]}, a2); a2 = __builtin_elementwise_fma((f32x2){v[j][2], v[j][3]}, (f32x2){w[2], w[3]}, a2); }
        p[e] = a2[0] + a2[1]; }
    const bool h32 = lane & 32, h16 = lane & 16, h8 = lane & 8, h4 = lane & 4;
    float q8[8], q4[4], q2[2], q1;
#pragma unroll
    for (int e = 0; e < 8; ++e) { const float send = h32 ? p[e] : p[e + 8], keep = h32 ? p[e + 8] : p[e]; q8[e] = keep + __shfl_xor(send, 32); }
#pragma unroll
    for (int e = 0; e < 4; ++e) { const float send = h16 ? q8[e] : q8[e + 4], keep = h16 ? q8[e + 4] : q8[e]; q4[e] = keep + __shfl_xor(send, 16); }
#pragma unroll
    for (int e = 0; e < 2; ++e) { const float send = h8 ? q4[e] : q4[e + 2], keep = h8 ? q4[e + 2] : q4[e]; q2[e] = keep + __shfl_xor(send, 8); }
    { const float send = h4 ? q2[0] : q2[1], keep = h4 ? q2[1] : q2[0]; q1 = keep + __shfl_xor(send, 4); }
    q1 += __shfl_xor(q1, 1); q1 += __shfl_xor(q1, 2);
    return __builtin_amdgcn_rcpf(1.f + __expf(-q1));
}
__device__ __forceinline__ void route_select(const float (&s)[16], const float* rb, int& e0o, int& e1o, float& w0o, float& w1o) {
    float sel[16];
#pragma unroll
    for (int e = 0; e < 16; ++e) sel[e] = s[e] + rb[e];
    float gbest = -1e30f; int gi = 0;
#pragma unroll
    for (int g = 0; g < 4; ++g) { float m1 = -1e30f, m2 = -1e30f;
#pragma unroll
        for (int i = 0; i < 4; ++i) { const float x = sel[4 * g + i]; if (x > m1) { m2 = m1; m1 = x; } else if (x > m2) m2 = x; }
        const float gs = m1 + m2; if (gs > gbest) { gbest = gs; gi = g; } }
    float b0 = -1e30f, b1 = -1e30f; int e0 = 0, e1 = 0; float s0 = 0.f, s1 = 0.f;
#pragma unroll
    for (int e = 0; e < 16; ++e) { const bool in = (e >> 2) == gi; const float x = sel[e];
        if (in && x > b0) { b1 = b0; e1 = e0; s1 = s0; b0 = x; e0 = e; s0 = s[e]; } else if (in && x > b1) { b1 = x; e1 = e; s1 = s[e]; } }
    e0o = e0; e1o = e1; const float den = s0 + s1; w0o = s0 / den; w1o = s1 / den;
}

__device__ __forceinline__ const float* l0_row_ptr(const Params& P, int row) {
    const int b = row / TC, t = row - b * TC;
    return t < CTXL ? P.in[I_CTX] + (size_t)(b * CTXL + t) * DM : P.in[I_X] + (size_t)(b * SEQ + t - CTXL) * DM;
}
__device__ __forceinline__ const bf16* l0_xrow_ptr(const Params& P, int row) {
    const int b = row / TC, t = row - b * TC;
    return t < CTXL ? (const bf16*)(P.ws + WS_XC) + (size_t)(b * CTXL + t) * DM : (const bf16*)P.out + (size_t)(b * SEQ + t - CTXL) * DM;
}
__device__ __forceinline__ void phase_norm1_l0(const Params& P, int lane, int wave, int G) {
    const float* mod = (const float*)(P.ws + WS_MOD); bf16* H = (bf16*)(P.ws + WS_RH);
    int row = blockIdx.x * 8 + wave; if (row >= M0) return;
    f32x4 nx[4];
    { const float* xr = l0_row_ptr(P, row);
#pragma unroll
      for (int j = 0; j < 4; ++j) nx[j] = ((const f32x4*)xr)[lane + 64 * j]; }
    for (; row < M0; row += G * 8) {
        f32x4 v[4];
#pragma unroll
        for (int j = 0; j < 4; ++j) v[j] = nx[j];
        if (row + G * 8 < M0) { const float* xr = l0_row_ptr(P, row + G * 8);
#pragma unroll
            for (int j = 0; j < 4; ++j) nx[j] = ((const f32x4*)xr)[lane + 64 * j]; }
        const int b = row / TC, t = row - b * TC;
        const float* md = mod + (size_t)(t < CTXL ? 8 : b) * 6144;
        norm_mod(v, P.in[I_N1G], md, md + 1024, lane);
        store_row_bf16(H + (size_t)row * DM, v, lane);
    }
}
template <int LAYER> __device__ __forceinline__ void phase_norm2_route(const Params& P, unsigned char* lds, int tid, int lane, int wave, int G) {
    constexpr int ROWS = LAYER == 0 ? 136 : 128;
    float* rwT = (float*)lds;
    int* cntl = (int*)(lds + 65536);
    float* slog = (float*)(lds + 65536 + 1024) + wave * (17 * 16);
    const float* mod = (const float*)(P.ws + WS_MOD) + (size_t)LAYER * 9 * 6144; bf16* H = (bf16*)(P.ws + WS_RH);
    int* route_e = (int*)(P.ws + WS_ROUTE_E); float* route_w = (float*)(P.ws + WS_ROUTE_W); int* cnt = (int*)(P.ws + WS_CNT);
    for (int i = tid; i < 16384; i += 512) { const int k = i >> 4, e = i & 15; rwT[e * 1024 + k] = P.in[I_RW][i]; }
    for (int ch = blockIdx.x; ch < NCHUNK; ch += G) {
        if (tid < 16) cntl[tid] = 0;
        __syncthreads();
        u32x2 nx[4];
        { const int row = ch * ROWS + wave; load_xrow(LAYER == 0 ? l0_xrow_ptr(P, row) : (const bf16*)(P.ws + WS_X3) + (size_t)row * DM, lane, nx); }
        for (int rl = wave; rl < ROWS; rl += 8) {
            const int row = ch * ROWS + rl; const float* md;
            if (LAYER == 0) { const int b = row / TC, t = row - b * TC; md = mod + (size_t)(t < CTXL ? 8 : b) * 6144; }
            else md = mod + (size_t)(row >> 12) * 6144;
            f32x4 v[4]; cvt_xrow(nx, v);
            if (rl + 8 < ROWS) load_xrow(LAYER == 0 ? l0_xrow_ptr(P, row + 8) : (const bf16*)(P.ws + WS_X3) + (size_t)(row + 8) * DM, lane, nx);
            norm_mod(v, P.in[I_N2G] + LAYER * 1024, md + 3072, md + 4096, lane);
            store_row_bf16(H + (size_t)row * DM, v, lane);
            const float sl = route_scores(v, rwT, lane);
            if ((lane & 3) == 0) slog[(rl >> 3) * 16 + 8 * ((lane >> 5) & 1) + 4 * ((lane >> 4) & 1) + 2 * ((lane >> 3) & 1) + ((lane >> 2) & 1)] = sl;
        }
        LDS_WAIT();
        if (lane < (ROWS - wave + 7) / 8) {
            const int rl = wave + 8 * lane, row = ch * ROWS + rl;
            float sc[16];
#pragma unroll
            for (int e = 0; e < 16; ++e) sc[e] = slog[lane * 16 + e];
            int e0, e1; float w0, w1; route_select(sc, P.in[I_RB], e0, e1, w0, w1);
            route_e[row] = e0 | (e1 << 8); route_w[2 * row] = w0; route_w[2 * row + 1] = w1; atomicAdd(&cntl[e0], 1); atomicAdd(&cntl[e1], 1);
        }
        __syncthreads();
        if (tid < 16) cnt[ch * 16 + tid] = cntl[tid];
        __syncthreads();
    }
}
template <int LAYER> __device__ __forceinline__ void phase_permute(const Params& P, unsigned char* lds, int tid, int lane, int wave, int G) {
    constexpr int ROWS = LAYER == 0 ? 136 : 128;
    int* part_tot = (int*)lds;
    int* part_base = part_tot + 512;
    int* slot0 = part_base + 512;
    int* loc = slot0 + 16;
    int* slots = loc + 16;
    int* tstart = slots + 2 * 136;
    int* rel = tstart + 32;
    int* etot = rel + 136;
    const int* cnt = (const int*)(P.ws + WS_CNT); const int* route_e = (const int*)(P.ws + WS_ROUTE_E); int* route_s = (int*)(P.ws + WS_ROUTE_S);
    int* tile_e = (int*)(P.ws + WS_TILEE); int* slot_tok = (int*)(P.ws + WS_SLOTTOK);
    for (int ch = blockIdx.x; ch < NCHUNK; ch += G) {
        { const int e = tid & 15, part = tid >> 4; int tot = 0, bs = 0;
#pragma unroll
          for (int i = 0; i < 8; ++i) { const int c = part * 8 + i; const int x = cnt[c * 16 + e]; tot += x; bs += (c < ch) ? x : 0; }
          part_tot[part * 16 + e] = tot; part_base[part * 16 + e] = bs; }
        if (tid < ROWS) rel[tid] = route_e[ch * ROWS + tid];
        __syncthreads();
        if (tid == 0) {
            int ts = 0;
            for (int e = 0; e < 16; ++e) { int tot = 0, bs = 0; for (int p = 0; p < 32; ++p) { tot += part_tot[p * 16 + e]; bs += part_base[p * 16 + e]; }
                tstart[e] = ts; slot0[e] = ts * 256 + bs; loc[e] = 0; etot[e] = tot; ts += (tot + 255) >> 8; }
            tstart[16] = ts;
            if (ch == 0) { for (int e = 0; e < 16; ++e) for (int i = tstart[e]; i < tstart[e + 1]; ++i) tile_e[i] = e; tile_e[MAXTILES] = ts; }
            for (int rl = 0; rl < ROWS; ++rl) { const int row = ch * ROWS + rl; const int ee = rel[rl]; const int e0 = ee & 255, e1 = ee >> 8;
                const int s0 = slot0[e0] + loc[e0]; loc[e0] = loc[e0] + 1; const int s1 = slot0[e1] + loc[e1]; loc[e1] = loc[e1] + 1;
                slots[2 * rl] = s0; slots[2 * rl + 1] = s1; route_s[2 * row] = s0; route_s[2 * row + 1] = s1; }
        }
        __syncthreads();
        if (tid < 2 * ROWS) slot_tok[slots[tid]] = ch * ROWS + (tid >> 1);
        if (ch == 0) {
            for (int e = 0; e < 16; ++e) { const int lo = tstart[e] * 256 + etot[e], hi = tstart[e + 1] * 256; for (int sidx = lo + tid; sidx < hi; sidx += 512) slot_tok[sidx] = 0; }
        }
        __syncthreads();
    }
}
__device__ __forceinline__ void phase_combine_norm1_l1(const Params& P, int lane, int wave, int G) {
    const float* mod = (const float*)(P.ws + WS_MOD); bf16* H = (bf16*)(P.ws + WS_RH); const bf16* Y = (const bf16*)(P.ws + WS_HPERM);
    const int* rs = (const int*)(P.ws + WS_ROUTE_S); const float* rw = (const float*)(P.ws + WS_ROUTE_W);
    const bf16* X1 = (const bf16*)P.out; bf16* X2 = (bf16*)((unsigned char*)P.out + X2_OFF);
    const int st = G * 8; int row = blockIdx.x * 8 + wave; if (row >= M1) return;
#define L0ROW(r) (((r) >> 12) * TC + CTXL + ((r) & 4095))
    CombIdx ic, in; CombData dc, dn;
    comb_load_idx(rs, rw, L0ROW(row), ic); comb_load_data(X1 + (size_t)row * DM, Y, ic, lane, dc);
    { const int r1 = row + st < M1 ? row + st : row; comb_load_idx(rs, rw, L0ROW(r1), in); }
    for (; row < M1; row += st) {
        const int r1 = row + st < M1 ? row + st : row, r2 = row + 2 * st < M1 ? row + 2 * st : r1;
        comb_load_data(X1 + (size_t)r1 * DM, Y, in, lane, dn);
        CombIdx i2; comb_load_idx(rs, rw, L0ROW(r2), i2);
        const int b = row >> 12;
        f32x4 v[4]; comb_apply(v, dc, ic, mod + (size_t)b * 6144 + 5120, lane);
        store_row_bf16(X2 + (size_t)row * DM, v, lane);
        const float* md = mod + (size_t)(9 + b) * 6144;
        norm_mod(v, P.in[I_N1G] + 1024, md, md + 1024, lane);
        store_row_bf16(H + (size_t)row * DM, v, lane);
        dc = dn; ic = in; in = i2;
    }
#undef L0ROW
}
__device__ __forceinline__ void phase_final(const Params& P, int lane, int wave, int G) {
    const float* mod = (const float*)(P.ws + WS_MOD); const bf16* Y = (const bf16*)(P.ws + WS_HPERM);
    const int* rs = (const int*)(P.ws + WS_ROUTE_S); const float* rw = (const float*)(P.ws + WS_ROUTE_W);
    const bf16* X3 = (const bf16*)(P.ws + WS_X3);
    const int st = G * 8; int row = blockIdx.x * 8 + wave; if (row >= M1) return;
    CombIdx ic, in; CombData dc, dn;
    comb_load_idx(rs, rw, row, ic); comb_load_data(X3 + (size_t)row * DM, Y, ic, lane, dc);
    { const int r1 = row + st < M1 ? row + st : row; comb_load_idx(rs, rw, r1, in); }
    for (; row < M1; row += st) {
        const int r1 = row + st < M1 ? row + st : row, r2 = row + 2 * st < M1 ? row + 2 * st : r1;
        comb_load_data(X3 + (size_t)r1 * DM, Y, in, lane, dn);
        CombIdx i2; comb_load_idx(rs, rw, r2, i2);
        const int b = row >> 12;
        float* xr = P.out + (size_t)row * DM;
        f32x4 v[4]; comb_apply(v, dc, ic, mod + (size_t)(9 + b) * 6144 + 5120, lane);
        float ss = 0.f;
#pragma unroll
        for (int j = 0; j < 4; ++j) ss += (v[j][0] * v[j][0] + v[j][1] * v[j][1]) + (v[j][2] * v[j][2] + v[j][3] * v[j][3]);
        const float rr = rsqrtf(wave_sum(ss) * (1.f / 1024.f) + RMS_EPS);
#pragma unroll
        for (int j = 0; j < 4; ++j) ((f32x4*)xr)[lane + 64 * j] = v[j] * rr * ((const f32x4*)P.in[I_FING])[lane + 64 * j];
        dc = dn; ic = in; in = i2;
    }
}
__device__ __forceinline__ void phase_rowstat(const Params& P, int lane, int wave, int G) {
    const bf16* CQ = (const bf16*)(P.ws + WS_CQ); const bf16* CKV = (const bf16*)(P.ws + WS_CKV); float* rq = (float*)(P.ws + WS_RQ); float* rkv = (float*)(P.ws + WS_RKV);
    for (int row = blockIdx.x * 8 + wave; row < M0; row += G * 8) {
        float sq = 0.f, sk = 0.f;
        if (lane < 48) { const u32x4 a = ((const u32x4*)(CQ + (size_t)row * 384))[lane];
            sq = (bflo(a.x) * bflo(a.x) + bfhi(a.x) * bfhi(a.x)) + (bflo(a.y) * bflo(a.y) + bfhi(a.y) * bfhi(a.y)) + (bflo(a.z) * bflo(a.z) + bfhi(a.z) * bfhi(a.z)) + (bflo(a.w) * bflo(a.w) + bfhi(a.w) * bfhi(a.w)); }
        if (lane < 32) { const u32x4 a = ((const u32x4*)(CKV + (size_t)row * 256))[lane];
            sk = (bflo(a.x) * bflo(a.x) + bfhi(a.x) * bfhi(a.x)) + (bflo(a.y) * bflo(a.y) + bfhi(a.y) * bfhi(a.y)) + (bflo(a.z) * bflo(a.z) + bfhi(a.z) * bfhi(a.z)) + (bflo(a.w) * bflo(a.w) + bfhi(a.w) * bfhi(a.w)); }
        sq = wave_sum(sq); sk = wave_sum(sk);
        if (lane == 0) { rq[row] = rsqrtf(sq * (1.f / 384.f) + RMS_EPS); rkv[row] = rsqrtf(sk * (1.f / 256.f) + RMS_EPS); }
    }
}

constexpr int LRU_UXF = 0;
constexpr int LRU_UF = 17408;
constexpr int LRU_UB = LRU_UF + 16384;
constexpr int LRU_G = LRU_UB + 8192;
__device__ __forceinline__ int crow32(int r, int hi) { return (r & 3) + 8 * (r >> 2) + 4 * hi; }
struct LruK { float cw[4][8]; float cb[8]; float ba, bx, sp; bf16x8 bf[4]; int h; };
struct LruTile { u32x4 a, b; };
__device__ __forceinline__ void lru_load_consts(const Params& P, int h, int tid, int lane, int wave, LruK& K) {
    const int c0 = (tid & 7) * 8; const float* cw = P.in[I_LCW]; const float* cb = P.in[I_LCB];
#pragma unroll
    for (int i = 0; i < 8; ++i) { const int ch = h * 64 + c0 + i; K.cb[i] = cb[ch];
#pragma unroll
        for (int j = 0; j < 4; ++j) K.cw[j][i] = cw[j * 512 + ch]; }
    { const int c = tid & 63, d = (tid >> 6) & 1, ch = h * 64 + c; K.ba = P.in[I_LBA][d * 512 + ch]; K.bx = P.in[I_LBX][d * 512 + ch]; K.sp = log1pf(expf(-P.in[I_LLAM][d * 512 + ch])); }
    { const bf16* WgT = (const bf16*)(P.ws + WS_WG) + (size_t)h * 256 * 64; const int n = wave * 32 + (lane & 31), hi = lane >> 5;
#pragma unroll
      for (int ks = 0; ks < 4; ++ks) K.bf[ks] = *(const bf16x8*)(WgT + (size_t)n * 64 + 16 * ks + 8 * hi); }
    K.h = h;
}
__device__ __forceinline__ void lru_tile_load(const bf16* UX, int b, int ck, int h, int tid, LruTile& T) {
    const int seg_lo = ck < 4 ? 0 : CTXL, seg_hi = ck < 4 ? CTXL : TC, p0 = ck * 64 - 2, c8 = (tid & 7) * 8;
    T.a = (u32x4){0u, 0u, 0u, 0u}; T.b = (u32x4){0u, 0u, 0u, 0u};
    { const int pos = p0 + (tid >> 3); if (pos >= seg_lo && pos < seg_hi) T.a = *(const u32x4*)(UX + (size_t)(b * TC + pos) * 512 + h * 64 + c8); }
    if (tid < 24) { const int pos = p0 + 64 + (tid >> 3); if (pos >= seg_lo && pos < seg_hi) T.b = *(const u32x4*)(UX + (size_t)(b * TC + pos) * 512 + h * 64 + c8); }
}
__device__ __forceinline__ void st8f(float* d, const u32x4 a) { d[0] = bflo(a.x); d[1] = bfhi(a.x); d[2] = bflo(a.y); d[3] = bfhi(a.y); d[4] = bflo(a.z); d[5] = bfhi(a.z); d[6] = bflo(a.w); d[7] = bfhi(a.w); }
constexpr int LRU_QP = LRU_G + 65536;
constexpr int LRU_QS = LRU_QP + 2048;
constexpr int LRU_HQ = LRU_QS + 2048;
template <int MODE> __device__ __forceinline__ void lru_coeffs(unsigned char* lds, const LruTile& T, const LruK& K, int tid, int lane, int wave) {
    float* uxf = (float*)(lds + LRU_UXF); float* uf = (float*)(lds + LRU_UF); bf16* ub = (bf16*)(lds + LRU_UB); float* Gm = (float*)(lds + LRU_G);
    __syncthreads();
    st8f(uxf + (tid >> 3) * 64 + (tid & 7) * 8, T.a);
    if (tid < 24) st8f(uxf + (64 + (tid >> 3)) * 64 + (tid & 7) * 8, T.b);
    __syncthreads();
    { const int t = tid >> 3, c0 = (tid & 7) * 8; float uo[8];
#pragma unroll
      for (int i = 0; i < 8; ++i) { float u = K.cb[i];
#pragma unroll
          for (int j = 0; j < 4; ++j) u += K.cw[j][i] * uxf[(t + j) * 64 + c0 + i];
          uo[i] = u; uf[t * 64 + c0 + i] = u; }
      u32x4 w; w.x = pk2(uo[0], uo[1]); w.y = pk2(uo[2], uo[3]); w.z = pk2(uo[4], uo[5]); w.w = pk2(uo[6], uo[7]);
      *(u32x4*)(ub + t * 64 + c0) = w; }
    __syncthreads();
    {
        const int r32 = lane & 31, hi = lane >> 5, n = wave * 32 + r32;
        f32x16 acc0 = {}, acc1 = {};
#pragma unroll
        for (int ks = 0; ks < 4; ++ks) {
            const bf16x8 a0 = *(const bf16x8*)(ub + (r32) * 64 + 16 * ks + 8 * hi), a1 = *(const bf16x8*)(ub + (32 + r32) * 64 + 16 * ks + 8 * hi);
            acc0 = __builtin_amdgcn_mfma_f32_32x32x16_bf16(a0, K.bf[ks], acc0, 0, 0, 0);
            acc1 = __builtin_amdgcn_mfma_f32_32x32x16_bf16(a1, K.bf[ks], acc1, 0, 0, 0);
        }
#pragma unroll
        for (int r = 0; r < 16; ++r) { Gm[crow32(r, hi) * 256 + n] = acc0[r]; Gm[(32 + crow32(r, hi)) * 256 + n] = acc1[r]; }
    }
    __syncthreads();
    { const int c = tid & 63, d = (tid >> 6) & 1, tg = tid >> 7;
      constexpr float L2E = 1.4426950408889634f; const float kba = K.ba, kbx = K.bx, ksp8 = -8.f * K.sp;
      float* g0 = Gm + (tg * 16) * 256 + d * 128 + c; const float* u0 = uf + (tg * 16) * 64 + c;
      float hh = 0.f, pp = 1.f;
#pragma unroll 2
      for (int k = 0; k < 8; ++k) { const int i = d ? 14 - 2 * k : 2 * k;
          const f32x2 ga = (f32x2){g0[i * 256] + kba, g0[(i + 1) * 256] + kba}, gx = (f32x2){g0[i * 256 + 64] + kbx, g0[(i + 1) * 256 + 64] + kbx};
          const f32x2 ta = ga * (-L2E), tx = gx * (-L2E);
          const f32x2 ea = (f32x2){__builtin_amdgcn_exp2f(ta[0]), __builtin_amdgcn_exp2f(ta[1])} + 1.f, ex = (f32x2){__builtin_amdgcn_exp2f(tx[0]), __builtin_amdgcn_exp2f(tx[1])} + 1.f;
          const f32x2 r = {__builtin_amdgcn_rcpf(ea[0]), __builtin_amdgcn_rcpf(ea[1])}, ii = {__builtin_amdgcn_rcpf(ex[0]), __builtin_amdgcn_rcpf(ex[1])};
          const f32x2 la = r * ksp8, tl = la * L2E;
          const f32x2 a = {__builtin_amdgcn_exp2f(tl[0]), __builtin_amdgcn_exp2f(tl[1])};
          const f32x2 x2 = la + la;
          const f32x2 emp = -x2 * (x2 * (x2 * (x2 * 0.041666668f + 0.16666667f) + 0.5f) + 1.f);
          const f32x2 ema = 1.f - a * a;
          const f32x2 em = {x2[0] > -0.25f ? emp[0] : ema[0], x2[1] > -0.25f ? emp[1] : ema[1]};
          const f32x2 sq = {__builtin_amdgcn_sqrtf(em[0]), __builtin_amdgcn_sqrtf(em[1])};
          const f32x2 bb = sq * (ii * (f32x2){u0[i * 64], u0[(i + 1) * 64]});
          const float a_f = d ? a[1] : a[0], a_s = d ? a[0] : a[1], b_f = d ? bb[1] : bb[0], b_s = d ? bb[0] : bb[1];
          hh = a_f * hh + b_f; pp *= a_f; const float h_f = hh, p_f = pp;
          hh = a_s * hh + b_s; pp *= a_s;
          if (MODE == 3) { const int of = d ? i + 1 : i, os = d ? i : i + 1;
              g0[of * 256] = h_f; g0[of * 256 + 64] = p_f; g0[os * 256] = hh; g0[os * 256 + 64] = pp; } }
      ((float*)(lds + LRU_QP))[(d * 4 + tg) * 64 + c] = pp; ((float*)(lds + LRU_QS))[(d * 4 + tg) * 64 + c] = hh; }
    __syncthreads();
}
__device__ __forceinline__ void lru_unit(int u, int& b, int& ck, int& h) { h = u & 7; ck = (u >> 3) % LCH; b = u / (8 * LCH); }
__device__ __forceinline__ void phase_lru_f1(const Params& P, unsigned char* lds, int tid, int lane, int wave, int G) {
    float* Gm = (float*)(lds + LRU_G); float* CP = (float*)(P.ws + WS_CP); float* CS = (float*)(P.ws + WS_CS); const bf16* UX = (const bf16*)(P.ws + WS_UX);
    constexpr int NU = NB * LCH * 8;
    int u = blockIdx.x; if (u >= NU) return;
    int b, ck, h; lru_unit(u, b, ck, h);
    LruK K; lru_load_consts(P, h, tid, lane, wave, K);
    LruTile T; lru_tile_load(UX, b, ck, h, tid, T);
    for (;;) {
        if (h != K.h) lru_load_consts(P, h, tid, lane, wave, K);
        lru_coeffs<1>(lds, T, K, tid, lane, wave);
        const int un = u + G; int bn = 0, ckn = 0, hn = h;
        if (un < NU) { lru_unit(un, bn, ckn, hn); lru_tile_load(UX, bn, ckn, hn, tid, T); }
        if (tid < 128) { const int d = tid >> 6, c = tid & 63; float hh = 0.f, pp = 1.f;
            const float* QP = (const float*)(lds + LRU_QP); const float* QS = (const float*)(lds + LRU_QS);
#pragma unroll
            for (int k = 0; k < 4; ++k) { const int q = d ? 3 - k : k; const float a = QP[(d * 4 + q) * 64 + c], bb = QS[(d * 4 + q) * 64 + c]; hh = a * hh + bb; pp *= a; }
            const size_t o = ((size_t)(d * 8 + b) * LCH + ck) * 512 + h * 64 + c; CP[o] = pp; CS[o] = hh; }
        if (un >= NU) break;
        u = un; b = bn; ck = ckn; h = hn;
    }
    __syncthreads();
}
__device__ __forceinline__ void phase_lru_carry(const Params& P, int lane, int wave, int G) {
    const float* CP = (const float*)(P.ws + WS_CP); const float* CS = (const float*)(P.ws + WS_CS); float* HIN = (float*)(P.ws + WS_HIN);
    if (wave != 0) return;
    for (int sb = blockIdx.x; sb < 128; sb += G) {
        const int s = sb * 64 + lane, d = s >> 12, b = (s >> 9) & 7, ch = s & 511; const size_t base = ((size_t)(d * 8 + b) * LCH) * 512 + ch;
        float hh = 0.f;
#pragma unroll 1
        for (int st = 0; st < LCH; st += 17) { float cp[17], cs[17]; int q[17];
#pragma unroll
            for (int i = 0; i < 17; ++i) { const int step = st + i; q[i] = d == 0 ? step : (step < 4 ? 3 - step : 71 - step); cp[i] = CP[base + (size_t)q[i] * 512]; cs[i] = CS[base + (size_t)q[i] * 512]; }
#pragma unroll
            for (int i = 0; i < 17; ++i) { HIN[base + (size_t)q[i] * 512] = hh; hh = cp[i] * hh + cs[i]; } }
    }
}
__device__ __forceinline__ float gelu_tanh(float x) { const float u = 0.7978845608028654f * (x + 0.044715f * x * x * x); return x * __builtin_amdgcn_rcpf(1.f + __expf(-2.f * u)); }
__device__ __forceinline__ void phase_lru_f3(const Params& P, unsigned char* lds, int tid, int lane, int wave, int G) {
    float* Gm = (float*)(lds + LRU_G); const bf16* UX = (const bf16*)(P.ws + WS_UX);
    const bf16* UG = (const bf16*)(P.ws + WS_UG); bf16* MIX = (bf16*)(P.ws + WS_RH); const float* HIN = (const float*)(P.ws + WS_HIN);
    constexpr int NU = NB * LCH * 8;
    int u = blockIdx.x; if (u >= NU) return;
    int b, ck, h; lru_unit(u, b, ck, h);
    LruK K; lru_load_consts(P, h, tid, lane, wave, K);
    LruTile T; lru_tile_load(UX, b, ck, h, tid, T);
    const int t = tid >> 3, c0 = (tid & 7) * 8;
    u32x4 gq = *(const u32x4*)(UG + ((size_t)b * TC + ck * 64 + t) * 512 + h * 64 + c0);
    float hin = 0.f; if (tid < 128) hin = HIN[((size_t)((tid >> 6) * 8 + b) * LCH + ck) * 512 + h * 64 + (tid & 63)];
    for (;;) {
        if (h != K.h) lru_load_consts(P, h, tid, lane, wave, K);
        lru_coeffs<3>(lds, T, K, tid, lane, wave);
        const u32x4 g = gq; const float hh0 = hin;
        const int un = u + G; int bn = 0, ckn = 0, hn = h;
        if (un < NU) { lru_unit(un, bn, ckn, hn); lru_tile_load(UX, bn, ckn, hn, tid, T);
            gq = *(const u32x4*)(UG + ((size_t)bn * TC + ckn * 64 + t) * 512 + hn * 64 + c0);
            if (tid < 128) hin = HIN[((size_t)((tid >> 6) * 8 + bn) * LCH + ckn) * 512 + hn * 64 + (tid & 63)]; }
        float* HQ = (float*)(lds + LRU_HQ);
        if (tid < 128) { const int d = tid >> 6, c = tid & 63; float hh = hh0;
            const float* QP = (const float*)(lds + LRU_QP); const float* QS = (const float*)(lds + LRU_QS);
#pragma unroll
            for (int k = 0; k < 4; ++k) { const int q = d ? 3 - k : k; HQ[(d * 4 + q) * 64 + c] = hh; hh = QP[(d * 4 + q) * 64 + c] * hh + QS[(d * 4 + q) * 64 + c]; } }
        __syncthreads();
        { const size_t row = (size_t)b * TC + ck * 64 + t; const int q = t >> 4;
          const float gv[8] = {bflo(g.x), bfhi(g.x), bflo(g.y), bfhi(g.y), bflo(g.z), bfhi(g.z), bflo(g.w), bfhi(g.w)};
          float o[8];
#pragma unroll
          for (int i = 0; i < 8; ++i) { const int cc = c0 + i;
              const float y = (Gm[t * 256 + cc] + Gm[t * 256 + 64 + cc] * HQ[q * 64 + cc]) + (Gm[t * 256 + 128 + cc] + Gm[t * 256 + 192 + cc] * HQ[(4 + q) * 64 + cc]);
              o[i] = y * gelu_tanh(gv[i]); }
          u32x4 w; w.x = pk2(o[0], o[1]); w.y = pk2(o[2], o[3]); w.z = pk2(o[4], o[5]); w.w = pk2(o[6], o[7]);
          *(u32x4*)(MIX + row * 1024 + 512 + h * 64 + c0) = w; }
        if (un >= NU) break;
        u = un; b = bn; ck = ckn; h = hn;
    }
    __syncthreads();
}

namespace att {
constexpr int NW = 8, QBLK = 32, KVBLK = 64;
constexpr float SCALE = 0.10206207261596575f;
constexpr float THR = 8.f;
constexpr int LDQ = 768, LDK = 768, LDV = 512, LDO = 1024;
constexpr int SHM_V = 16384, SHM_K = 16384, SHM_ATTN = 2 * SHM_V + 2 * SHM_K + NW * 64 * 4;
#define KSWZ(row, colB) ((row) * 256 + ((colB) ^ (((row) & 7) << 4)))
#define SBAR() __builtin_amdgcn_sched_barrier(0)
__device__ __forceinline__ int crow(int r, int hi) { return (r & 3) + 8 * (r >> 2) + 4 * hi; }
__device__ __forceinline__ unsigned cvtpk(float lo, float hi) { unsigned r; asm volatile("v_cvt_pk_bf16_f32 %0, %1, %2" : "=v"(r) : "v"(lo), "v"(hi)); return r; }
__device__ __forceinline__ void partialSM(f32x16& p0, f32x16& p1, float& m_reg, float& mn, float& alpha) {
  constexpr float C = SCALE * 1.4426950408889634f;
  float pmax = p0[0];
#pragma unroll
  for (int r = 1; r < 16; ++r) pmax = fmaxf(pmax, p0[r]);
#pragma unroll
  for (int r = 0; r < 16; ++r) pmax = fmaxf(pmax, p1[r]);
  { auto rr = __builtin_amdgcn_permlane32_swap(__float_as_uint(pmax), __float_as_uint(pmax), false, false);
    pmax = fmaxf(__uint_as_float(rr[0]), __uint_as_float(rr[1])); }
  if (__builtin_expect(__all(pmax - m_reg <= THR / SCALE), 1)) { mn = m_reg; alpha = 1.f; }
  else { mn = fmaxf(m_reg, pmax); alpha = __builtin_amdgcn_exp2f((m_reg - mn) * C); m_reg = mn; }
  float mnC = -mn * C;
#pragma unroll
  for (int r = 0; r < 16; ++r) p0[r] = fmaf(p0[r], C, mnC);
#pragma unroll
  for (int r = 0; r < 16; ++r) p1[r] = fmaf(p1[r], C, mnC);
#pragma unroll
  for (int r = 0; r < 16; ++r) p0[r] = __builtin_amdgcn_exp2f(p0[r]);
}
__device__ __forceinline__ void finishSM(f32x16& p0, f32x16& p1, float alpha, float& l_reg, bf16x8& pa0, bf16x8& pa1, bf16x8& pa2, bf16x8& pa3) {
#pragma unroll
  for (int r = 0; r < 16; ++r) p1[r] = __builtin_amdgcn_exp2f(p1[r]);
  float ps = 0;
#pragma unroll
  for (int r = 0; r < 16; ++r) ps += p0[r];
#pragma unroll
  for (int r = 0; r < 16; ++r) ps += p1[r];
  { auto rr = __builtin_amdgcn_permlane32_swap(__float_as_uint(ps), __float_as_uint(ps), false, false);
    ps = __uint_as_float(rr[0]) + __uint_as_float(rr[1]); }
  l_reg = l_reg * alpha + ps;
#define PK4(P, BASE, OUT) do { unsigned a0 = cvtpk(P[BASE + 0], P[BASE + 1]), a1 = cvtpk(P[BASE + 2], P[BASE + 3]);   \
    unsigned b0 = cvtpk(P[BASE + 4], P[BASE + 5]), b1 = cvtpk(P[BASE + 6], P[BASE + 7]);                              \
    auto r0 = __builtin_amdgcn_permlane32_swap(a0, b0, false, false); auto r1 = __builtin_amdgcn_permlane32_swap(a1, b1, false, false); \
    u32x4 w = {r0[0], r1[0], r0[1], r1[1]}; OUT = *reinterpret_cast<bf16x8*>(&w); } while (0)
  PK4(p0, 0, pa0); PK4(p0, 8, pa1); PK4(p1, 0, pa2); PK4(p1, 8, pa3);
#undef PK4
}
__device__ __forceinline__ void qkt(f32x16& p0, f32x16& p1, const bf16* Ks, const bf16x8* qr, int r32, int hi) {
  p0 = f32x16{}; p1 = f32x16{};
#pragma unroll
  for (int d0 = 0; d0 < 6; ++d0) { int cb = (d0 * 16 + hi * 8) * 2;
    bf16x8 b0 = *reinterpret_cast<const bf16x8*>((const char*)Ks + KSWZ(r32, cb));
    bf16x8 b1 = *reinterpret_cast<const bf16x8*>((const char*)Ks + KSWZ(32 + r32, cb));
    p0 = __builtin_amdgcn_mfma_f32_32x32x16_bf16(b0, qr[d0], p0, 0, 0, 0);
    p1 = __builtin_amdgcn_mfma_f32_32x32x16_bf16(b1, qr[d0], p1, 0, 0, 0); }
}
__device__ __forceinline__ int v_st(int k, int c) { const int kk = (k & ~0xC) | ((k & 4) << 1) | ((k & 8) >> 1); return ((kk >> 3) * 4 + (c >> 5)) * 512 + ((kk & 7) * 32 + (c & 31)) * 2; }
__device__ __forceinline__ int v_rd_base(int lane) { return ((lane & 3) << 3) | (((lane >> 2) & 3) << 6) | (((lane >> 4) & 1) << 5) | (((lane >> 5) & 1) << 8); }
constexpr int v_rd_off(int d0, int ks, int half) { return d0 * 512 + ks * 4096 + half * 2048; }
template <int OFF> __device__ __forceinline__ s16x4 tr_read(int vb) {
  s16x4 r; asm volatile("ds_read_b64_tr_b16 %0, %1 offset:%2" : "=&v"(r) : "v"(vb), "i"(OFF) : "memory"); return r;
}
template <int D0> __device__ __forceinline__ void pv_one(f32x16& od, int vb, bf16x8 pa0, bf16x8 pa1, bf16x8 pa2, bf16x8 pa3) {
  const s16x4 l0 = tr_read<v_rd_off(D0, 0, 0)>(vb), h0 = tr_read<v_rd_off(D0, 0, 1)>(vb), l1 = tr_read<v_rd_off(D0, 1, 0)>(vb), h1 = tr_read<v_rd_off(D0, 1, 1)>(vb);
  const s16x4 l2 = tr_read<v_rd_off(D0, 2, 0)>(vb), h2 = tr_read<v_rd_off(D0, 2, 1)>(vb), l3 = tr_read<v_rd_off(D0, 3, 0)>(vb), h3 = tr_read<v_rd_off(D0, 3, 1)>(vb);
  asm volatile("s_waitcnt lgkmcnt(0)" ::: "memory"); SBAR();
#define PK(L, H) (bf16x8){L[0], L[1], L[2], L[3], H[0], H[1], H[2], H[3]}
  od = __builtin_amdgcn_mfma_f32_32x32x16_bf16(pa0, PK(l0, h0), od, 0, 0, 0);
  od = __builtin_amdgcn_mfma_f32_32x32x16_bf16(pa1, PK(l1, h1), od, 0, 0, 0);
  od = __builtin_amdgcn_mfma_f32_32x32x16_bf16(pa2, PK(l2, h2), od, 0, 0, 0);
  od = __builtin_amdgcn_mfma_f32_32x32x16_bf16(pa3, PK(l3, h3), od, 0, 0, 0);
#undef PK
}
__device__ __forceinline__ void pv_d0(f32x16* o, int vb, bf16x8 pa0, bf16x8 pa1, bf16x8 pa2, bf16x8 pa3) {
  pv_one<0>(o[0], vb, pa0, pa1, pa2, pa3); pv_one<1>(o[1], vb, pa0, pa1, pa2, pa3);
}
__device__ __forceinline__ void attn_dense_body(const bf16* __restrict__ Qb, const bf16* __restrict__ Kh, const bf16* __restrict__ Vh, bf16* __restrict__ Ob, int seq, int tq0  , char* lds) {
  const int tid = threadIdx.x, wid = tid >> 6, lane = tid & 63, r32 = lane & 31, hi = lane >> 5;
  bf16* V_lds = (bf16*)lds; bf16* K_lds = (bf16*)(lds + 2 * SHM_V);
  float* ws = (float*)(lds + 2 * SHM_V + 2 * SHM_K) + wid * 64; float* li_l = ws; float* al_l = ws + 32;
  float m_reg = -1e30f, l_reg = 0; f32x16 o[2] = {}; bf16x8 qr[6];
  const bf16* Qw = Qb + (long)(wid * QBLK + r32) * LDQ + hi * 8;
#pragma unroll
  for (int d0 = 0; d0 < 6; ++d0) qr[d0] = *reinterpret_cast<const bf16x8*>(Qw + d0 * 16);
  {
    const int tq = tq0 + wid * QBLK + r32; const bool on = tq0 >= 0;
    constexpr float IF[8] = {1.0f, 0.316227766f, 0.1f, 0.0316227766f, 0.01f, 0.00316227766f, 0.001f, 0.000316227766f};
#pragma unroll
    for (int ax = 0; ax < 2; ++ax) { const float pos = (float)(ax == 0 ? (tq >> 6) : (tq & 63)) * 0.15915494309189535f;
      bf16x8 qv = qr[4 + ax]; bf16x8 qo;
#pragma unroll
      for (int i = 0; i < 8; ++i) { const float x = __uint_as_float(((unsigned)(unsigned short)qv[i]) << 16); const float other = __shfl_xor(x, 32);
        const float sn = __builtin_amdgcn_sinf(pos * IF[i]), cs = __builtin_amdgcn_cosf(pos * IF[i]);
        const float r = hi == 0 ? x * cs - other * sn : other * sn + x * cs;
        unsigned u = __float_as_uint(on ? r : x); u = (u + 0x7fffu + ((u >> 16) & 1u)) >> 16; qo[i] = (short)u; }
      qr[4 + ax] = qo; }
  }
  const int sr = tid >> 3, sc = (tid & 7) * 8, vst = v_st(sr, sc), kr2 = (tid >> 2) & 63, kc2 = 64 + (tid & 3) * 8; const bool kb2 = tid < 256;
  const int vb0 = (int)(uintptr_t)V_lds + v_rd_base(lane);
  struct { bf16x8 vs, ka, kb; } sr_[2];
#define SLOAD(i, k0) do { sr_[i].vs = *reinterpret_cast<const bf16x8*>(&Vh[(long)((k0) + sr) * LDV + sc]); \
    sr_[i].ka = *reinterpret_cast<const bf16x8*>(&Kh[(long)((k0) + sr) * LDK + sc]); \
    if (kb2) sr_[i].kb = *reinterpret_cast<const bf16x8*>(&Kh[(long)((k0) + kr2) * LDK + kc2]); } while (0)
#define SWRITE(b, i) do { *(bf16x8*)((char*)V_lds + (b) * SHM_V + vst) = sr_[i].vs;          \
    *(bf16x8*)((char*)K_lds + (b) * SHM_K + KSWZ(sr, sc * 2)) = sr_[i].ka;                       \
    if (kb2) *(bf16x8*)((char*)K_lds + (b) * SHM_K + KSWZ(kr2, kc2 * 2)) = sr_[i].kb; } while (0)
#define SWAIT() asm volatile("s_waitcnt vmcnt(3)" ::: "memory")
#define RESC(a) do { if (__any((a) < 1.f)) { if (hi == 0) al_l[r32] = (a); asm volatile("s_waitcnt lgkmcnt(0)" ::: "memory"); \
    _Pragma("unroll") for (int d = 0; d < 2; ++d) _Pragma("unroll") for (int r = 0; r < 16; ++r) o[d][r] *= al_l[crow(r, hi)]; } } while (0)
  f32x16 pA0, pA1, pB0, pB1; float mnA, mnB, alA, alB; bf16x8 pa0, pa1, pa2, pa3; const int NT = seq / KVBLK;
  constexpr int SE = 0, SO = 1;
  SLOAD(SE, 0); asm volatile("s_waitcnt vmcnt(0)" ::: "memory"); SWRITE(0, SE); __syncthreads();
  qkt(pA0, pA1, K_lds, qr, r32, hi); partialSM(pA0, pA1, m_reg, mnA, alA);
  SLOAD(SO, KVBLK); if (2 < NT) SLOAD(SE, 2 * KVBLK);
  SWAIT(); SWRITE(1, SO); __syncthreads();
#ifndef ATT_SKEW
#define ATT_SKEW 0
#endif
  const bool swp = ATT_SKEW > 0 && (__builtin_amdgcn_readfirstlane(wid) >= 4);
  for (int j = 1; j + 1 < NT; j += 2) {
    if (swp) __builtin_amdgcn_s_sleep(ATT_SKEW);
    SBAR(); qkt(pB0, pB1, (bf16*)((char*)K_lds + SHM_K), qr, r32, hi);
    finishSM(pA0, pA1, alA, l_reg, pa0, pa1, pa2, pa3); SBAR();
    SLOAD(SO, (j + 2) * KVBLK); SBAR();
    pv_d0(o, vb0, pa0, pa1, pa2, pa3); partialSM(pB0, pB1, m_reg, mnB, alB);
    __syncthreads(); SWAIT(); SWRITE(0, SE);
    RESC(alB); __syncthreads();
    if (swp) __builtin_amdgcn_s_sleep(ATT_SKEW);
    SBAR(); qkt(pA0, pA1, K_lds, qr, r32, hi);
    finishSM(pB0, pB1, alB, l_reg, pa0, pa1, pa2, pa3); SBAR();
    if (j + 3 < NT) SLOAD(SE, (j + 3) * KVBLK); SBAR();
    pv_d0(o, vb0 + (int)SHM_V, pa0, pa1, pa2, pa3); partialSM(pA0, pA1, m_reg, mnA, alA);
    __syncthreads(); SWAIT(); SWRITE(1, SO);
    RESC(alA); __syncthreads();
  }
  SBAR(); qkt(pB0, pB1, (bf16*)((char*)K_lds + SHM_K), qr, r32, hi);
  finishSM(pA0, pA1, alA, l_reg, pa0, pa1, pa2, pa3); SBAR();
  pv_d0(o, vb0, pa0, pa1, pa2, pa3); partialSM(pB0, pB1, m_reg, mnB, alB);
  __syncthreads(); RESC(alB);
  finishSM(pB0, pB1, alB, l_reg, pa0, pa1, pa2, pa3); SBAR();
  pv_d0(o, vb0 + (int)SHM_V, pa0, pa1, pa2, pa3);
  if (hi == 0) li_l[r32] = l_reg; asm volatile("s_waitcnt lgkmcnt(0)" ::: "memory");
  float rli[16];
#pragma unroll
  for (int r = 0; r < 16; ++r) rli[r] = __builtin_amdgcn_rcpf(li_l[crow(r, hi)]);
  bf16* Ow = Ob + (long)(wid * QBLK) * LDO;
#pragma unroll
  for (int r = 0; r < 16; ++r) { int orow = crow(r, hi);
#pragma unroll
    for (int d0 = 0; d0 < 2; ++d0) Ow[(long)orow * LDO + d0 * 32 + r32] = (bf16)f2bf(o[d0][r] * rli[r]); }
#undef SLOAD
#undef SWRITE
#undef SWAIT
#undef RESC
}

}

__device__ __forceinline__ void phase_attention(const Params& P, unsigned char* lds, int G) {
    const bf16* Q = (const bf16*)(P.ws + WS_Q); const bf16* K = (const bf16*)(P.ws + WS_K); const bf16* V = (const bf16*)(P.ws + WS_V); bf16* MIX = (bf16*)(P.ws + WS_RH);
    const int vcu = (G % 8 == 0) ? ((int)blockIdx.x % 8) * (G / 8) + (int)blockIdx.x / 8 : (int)blockIdx.x;
    for (int idx = vcu; idx < 1024 + 64; idx += G) {
        int b, h, seq; size_t qrow;
        if (idx < 1024) { const int bh = idx >> 4, qb = idx & 15; b = bh >> 3; h = bh & 7; qrow = (size_t)b * TC + CTXL + qb * 256; seq = TC; }
        else { const int j = idx - 1024; b = j >> 3; h = j & 7; qrow = (size_t)b * TC; seq = CTXL; }
        att::attn_dense_body(Q + qrow * 768 + h * 96, K + (size_t)b * TC * 768 + h * 96, V + (size_t)b * TC * 512 + h * 64, MIX + qrow * 1024 + h * 64, seq, idx < 1024 ? (idx & 15) * 256 : -1, (char*)lds);
        __syncthreads();
    }
}

typedef float cf __attribute__((ext_vector_type(2)));
__device__ __forceinline__ cf cmul(cf a, cf b) { return a * (cf){b.x, b.x} + (cf){a.y, a.x} * (cf){-b.y, b.y}; }
__device__ __forceinline__ cf cis_rev(float rev) { return cf{__builtin_amdgcn_cosf(rev), __builtin_amdgcn_sinf(rev)}; }
template <int S> __device__ __forceinline__ void dft4(cf& a, cf& b, cf& c, cf& d) {
    const cf t0 = a + c, t1 = a - c, t2 = b + d, t3 = b - d;
    const cf t3i = (cf){-(float)S * t3.y, (float)S * t3.x};
    a = t0 + t2; c = t0 - t2; b = t1 + t3i; d = t1 - t3i;
}
template <int S> __device__ __forceinline__ void dft16_tail(cf (&v)[16]);
template <int S> __device__ __forceinline__ void dft16(cf (&v)[16]) {
#pragma unroll
    for (int j0 = 0; j0 < 4; ++j0) dft4<S>(v[j0], v[j0 + 4], v[j0 + 8], v[j0 + 12]);
    dft16_tail<S>(v);
}
template <int S> __device__ __forceinline__ void dft16_tail(cf (&v)[16]) {
    constexpr float C1 = 0.9238795325112867f, S1 = 0.3826834323650898f, C2 = 0.7071067811865476f;
    v[5] = cmul(v[5], cf{C1, S * S1}); v[9] = cmul(v[9], cf{C2, S * C2}); v[13] = cmul(v[13], cf{S1, S * C1});
    v[6] = cmul(v[6], cf{C2, S * C2}); v[10] = (cf){-(float)S * v[10].y, (float)S * v[10].x}; v[14] = cmul(v[14], cf{-C2, S * C2});
    v[7] = cmul(v[7], cf{S1, S * C1}); v[11] = cmul(v[11], cf{-C2, S * C2}); v[15] = cmul(v[15], cf{-C1, -S * S1});
#pragma unroll
    for (int k1 = 0; k1 < 4; ++k1) dft4<S>(v[4 * k1], v[4 * k1 + 1], v[4 * k1 + 2], v[4 * k1 + 3]);
}
#define REV4(k) ((((k) >> 2) | (((k) & 3) << 2)))
__device__ __forceinline__ int fphys(int L) { return L + (L >> 4); }
constexpr int FFT_BUF = 4352 * 8;
constexpr int FFT_ZB = 2 * FFT_BUF;
constexpr int FFT_HB1 = FFT_ZB + 32768;
constexpr int FFT_W3 = FFT_HB1 + 32768;
constexpr int FFT_RED = FFT_W3 + 1024;
static_assert(FFT_RED + 64 <= LDSCTL_OFF, "fft lds");
template <int PAT> __device__ __forceinline__ int fbase(int tp) {
    if (PAT == 0) return tp + (tp >> 4);
    if (PAT == 1) return (tp & 15) + 272 * (tp >> 4);
    return 17 * (tp & 15) + 272 * (tp >> 4);
}
template <int PAT> struct FStr { static constexpr int v = PAT == 0 ? 272 : (PAT == 1 ? 17 : 1); };
__device__ __forceinline__ int hide(int x) { asm volatile("" : "+v"(x)); return x; }
#if defined(__HIP_DEVICE_COMPILE__)
template <int OFF> __device__ __forceinline__ cf lds_rd64(unsigned addr) { f32x2 r; asm volatile("ds_read_b64 %0, %1 offset:%2" : "=v"(r) : "v"(addr), "i"(OFF) : "memory"); return cf{r[0], r[1]}; }
template <int OFF> __device__ __forceinline__ void lds_wr64(unsigned addr, cf x) { f32x2 r = {x.x, x.y}; asm volatile("ds_write_b64 %0, %1 offset:%2" :: "v"(addr), "v"(r), "i"(OFF) : "memory"); }
#define FFT_LGKM0() asm volatile("s_waitcnt lgkmcnt(0)" ::: "memory")
#else
template <int OFF> __device__ __forceinline__ cf lds_rd64(const cf* p) { return *(const cf*)((const char*)p + OFF); }
template <int OFF> __device__ __forceinline__ void lds_wr64(cf* p, cf x) { *(cf*)((char*)p + OFF) = x; }
#define FFT_LGKM0()
#endif
template <int PAT> __device__ __forceinline__ void fload(cf (&v)[16], const cf* buf, int tp) {
    constexpr int ST = FStr<PAT>::v * 8;
#if defined(__HIP_DEVICE_COMPILE__)
    const unsigned p = (unsigned)(uintptr_t)(buf + fbase<PAT>(tp));
    f32x2 r0, r1, r2, r3, r4, r5, r6, r7, r8, r9, r10, r11, r12, r13, r14, r15;
#define FRD(R, J) asm volatile("ds_read_b64 %0, %1 offset:%2" : "=v"(R) : "v"(p), "i"((J) * ST) : "memory")
    FRD(r0, 0); FRD(r1, 1); FRD(r2, 2); FRD(r3, 3); FRD(r4, 4); FRD(r5, 5); FRD(r6, 6); FRD(r7, 7); FRD(r8, 8); FRD(r9, 9); FRD(r10, 10); FRD(r11, 11); FRD(r12, 12); FRD(r13, 13); FRD(r14, 14); FRD(r15, 15);
#undef FRD
    asm volatile("s_waitcnt lgkmcnt(0)" : "+v"(r0), "+v"(r1), "+v"(r2), "+v"(r3), "+v"(r4), "+v"(r5), "+v"(r6), "+v"(r7), "+v"(r8), "+v"(r9), "+v"(r10), "+v"(r11), "+v"(r12), "+v"(r13), "+v"(r14), "+v"(r15) :: "memory");
    v[0] = cf{r0[0], r0[1]}; v[1] = cf{r1[0], r1[1]}; v[2] = cf{r2[0], r2[1]}; v[3] = cf{r3[0], r3[1]}; v[4] = cf{r4[0], r4[1]}; v[5] = cf{r5[0], r5[1]}; v[6] = cf{r6[0], r6[1]}; v[7] = cf{r7[0], r7[1]};
    v[8] = cf{r8[0], r8[1]}; v[9] = cf{r9[0], r9[1]}; v[10] = cf{r10[0], r10[1]}; v[11] = cf{r11[0], r11[1]}; v[12] = cf{r12[0], r12[1]}; v[13] = cf{r13[0], r13[1]}; v[14] = cf{r14[0], r14[1]}; v[15] = cf{r15[0], r15[1]};
#else
    const cf* p = buf + fbase<PAT>(tp);
#pragma unroll
    for (int j = 0; j < 16; ++j) v[j] = *(const cf*)((const char*)p + j * ST);
#endif
}
template <int PAT, int S> __device__ __forceinline__ void fload_dft16(cf (&v)[16], const cf* buf, int tp) {
#if defined(__HIP_DEVICE_COMPILE__)
    constexpr int ST = FStr<PAT>::v * 8;
    const unsigned p = (unsigned)(uintptr_t)(buf + fbase<PAT>(tp));
    f32x2 r0, r1, r2, r3, r4, r5, r6, r7, r8, r9, r10, r11, r12, r13, r14, r15;
#define FRD(R, J) asm volatile("ds_read_b64 %0, %1 offset:%2" : "=v"(R) : "v"(p), "i"((J) * ST) : "memory")
    FRD(r0, 0); FRD(r4, 4); FRD(r8, 8); FRD(r12, 12); FRD(r1, 1); FRD(r5, 5); FRD(r9, 9); FRD(r13, 13);
    FRD(r2, 2); FRD(r6, 6); FRD(r10, 10); FRD(r14, 14); FRD(r3, 3); FRD(r7, 7); FRD(r11, 11); FRD(r15, 15);
#undef FRD
    asm volatile("s_waitcnt lgkmcnt(12)" : "+v"(r0), "+v"(r4), "+v"(r8), "+v"(r12) :: "memory");
    v[0] = cf{r0[0], r0[1]}; v[4] = cf{r4[0], r4[1]}; v[8] = cf{r8[0], r8[1]}; v[12] = cf{r12[0], r12[1]}; dft4<S>(v[0], v[4], v[8], v[12]);
    asm volatile("s_waitcnt lgkmcnt(8)" : "+v"(r1), "+v"(r5), "+v"(r9), "+v"(r13) :: "memory");
    v[1] = cf{r1[0], r1[1]}; v[5] = cf{r5[0], r5[1]}; v[9] = cf{r9[0], r9[1]}; v[13] = cf{r13[0], r13[1]}; dft4<S>(v[1], v[5], v[9], v[13]);
    asm volatile("s_waitcnt lgkmcnt(4)" : "+v"(r2), "+v"(r6), "+v"(r10), "+v"(r14) :: "memory");
    v[2] = cf{r2[0], r2[1]}; v[6] = cf{r6[0], r6[1]}; v[10] = cf{r10[0], r10[1]}; v[14] = cf{r14[0], r14[1]}; dft4<S>(v[2], v[6], v[10], v[14]);
    asm volatile("s_waitcnt lgkmcnt(0)" : "+v"(r3), "+v"(r7), "+v"(r11), "+v"(r15) :: "memory");
    v[3] = cf{r3[0], r3[1]}; v[7] = cf{r7[0], r7[1]}; v[11] = cf{r11[0], r11[1]}; v[15] = cf{r15[0], r15[1]}; dft4<S>(v[3], v[7], v[11], v[15]);
    dft16_tail<S>(v);
#else
    fload<PAT>(v, buf, tp); dft16<S>(v);
#endif
}
template <int PAT> __device__ __forceinline__ void fstore_raw(const cf (&x)[16], cf* buf, int tp) {
#if defined(__HIP_DEVICE_COMPILE__)
    const unsigned p = (unsigned)(uintptr_t)(buf + fbase<PAT>(tp));
#else
    cf* p = buf + fbase<PAT>(tp);
#endif
    constexpr int ST = FStr<PAT>::v * 8;
    lds_wr64<0>(p, x[0]); lds_wr64<ST>(p, x[1]); lds_wr64<2 * ST>(p, x[2]); lds_wr64<3 * ST>(p, x[3]); lds_wr64<4 * ST>(p, x[4]); lds_wr64<5 * ST>(p, x[5]); lds_wr64<6 * ST>(p, x[6]); lds_wr64<7 * ST>(p, x[7]);
    lds_wr64<8 * ST>(p, x[8]); lds_wr64<9 * ST>(p, x[9]); lds_wr64<10 * ST>(p, x[10]); lds_wr64<11 * ST>(p, x[11]); lds_wr64<12 * ST>(p, x[12]); lds_wr64<13 * ST>(p, x[13]); lds_wr64<14 * ST>(p, x[14]); lds_wr64<15 * ST>(p, x[15]);
    FFT_LGKM0();
}
template <int PAT> __device__ __forceinline__ void fstore_geo(cf (&v)[16], cf* buf, int tp, cf t0, cf r) {
    const cf r2 = cmul(r, r); cf te = t0, to = cmul(t0, r); cf x[16];
#pragma unroll
    for (int k = 0; k < 16; k += 2) { x[k] = cmul(v[REV4(k)], te); x[k + 1] = cmul(v[REV4(k + 1)], to); te = cmul(te, r2); to = cmul(to, r2); }
    fstore_raw<PAT>(x, buf, tp);
}
#ifndef FFT_GEO
#define FFT_GEO 1
#endif
template <int PAT> __device__ __forceinline__ void fstore_ang(cf (&v)[16], cf* buf, int tp, float a0, float ar) {
#if FFT_GEO
    fstore_geo<PAT>(v, buf, tp, cis_rev(a0), cis_rev(ar));
#else
    cf x[16];
#pragma unroll
    for (int k = 0; k < 16; ++k) x[k] = cmul(v[REV4(k)], cis_rev(a0 + (float)k * ar));
    fstore_raw<PAT>(x, buf, tp);
#endif
}
__device__ __forceinline__ void ftw_build(cf (&tw)[16], cf t0, cf r) {
    const cf r2 = cmul(r, r); cf te = t0, to = cmul(t0, r);
#pragma unroll
    for (int k = 0; k < 16; k += 2) { tw[k] = te; tw[k + 1] = to; te = cmul(te, r2); to = cmul(to, r2); }
}
template <int PAT> __device__ __forceinline__ void fstore_tw(cf (&v)[16], cf* buf, int tp, const cf (&tw)[16]) {
    cf x[16];
#pragma unroll
    for (int k = 0; k < 16; ++k) x[k] = cmul(v[REV4(k)], tw[k]);
    fstore_raw<PAT>(x, buf, tp);
}
#define W32C(j) ((j) == 0 ? 1.f : (j) == 1 ? 0.98078528f : (j) == 2 ? 0.92387953f : (j) == 3 ? 0.83146961f : (j) == 4 ? 0.70710678f : (j) == 5 ? 0.55557023f : (j) == 6 ? 0.38268343f : (j) == 7 ? 0.19509032f : (j) == 8 ? 0.f : \
                 (j) == 9 ? -0.19509032f : (j) == 10 ? -0.38268343f : (j) == 11 ? -0.55557023f : (j) == 12 ? -0.70710678f : (j) == 13 ? -0.83146961f : (j) == 14 ? -0.92387953f : -0.98078528f)
#define W32S(j) ((j) == 0 ? 0.f : (j) == 1 ? 0.19509032f : (j) == 2 ? 0.38268343f : (j) == 3 ? 0.55557023f : (j) == 4 ? 0.70710678f : (j) == 5 ? 0.83146961f : (j) == 6 ? 0.92387953f : (j) == 7 ? 0.98078528f : (j) == 8 ? 1.f : \
                 (j) == 9 ? 0.98078528f : (j) == 10 ? 0.92387953f : (j) == 11 ? 0.83146961f : (j) == 12 ? 0.70710678f : (j) == 13 ? 0.55557023f : (j) == 14 ? 0.38268343f : 0.19509032f)
__device__ __forceinline__ void fft_fwd_pass1(cf (&v)[16], cf* buf, int tp, int str) {
    if (str) {
#pragma unroll
        for (int j = 1; j < 16; ++j) v[j] = cmul(v[j], cf{W32C(j), -W32S(j)});
    }
    dft16<-1>(v);
    fstore_ang<0>(v, buf, tp, str ? -(float)tp * (1.f / 8192.f) : 0.f, -(float)(tp >> 4) * (1.f / 256.f));
}
__device__ __forceinline__ void fft_fwd_pass2(cf* buf, int tp0, const cf (&tw)[16]) {
    const int tp = hide(tp0);
    cf v[16]; fload_dft16<1, -1>(v, buf, tp);
    fstore_tw<1>(v, buf, tp, tw);
}
__device__ __forceinline__ void fft_inv_pass2(cf* buf, int tp0, int str) {
    const int tp = hide(tp0);
    cf v[16]; fload_dft16<1, 1>(v, buf, tp);
    const int n0 = tp & 15, k2 = tp >> 4;
    fstore_ang<1>(v, buf, tp, str ? (float)n0 * (1.f / 8192.f) : 0.f, (float)k2 * (1.f / 256.f) + (str ? (1.f / 512.f) : 0.f));
}
__device__ __forceinline__ void fft_inv_pass3(cf* buf, int tp0, int str) {
    const int tp = hide(tp0);
    cf v[16]; fload_dft16<0, 1>(v, buf, tp);
    cf x[16];
#pragma unroll
    for (int k = 0; k < 16; ++k) { x[k] = v[REV4(k)]; if (str && k > 0) x[k] = cmul(x[k], cf{W32C(k), W32S(k)}); }
    fstore_raw<0>(x, buf, tp);
}

struct Row8 { u32x4 a; unsigned short l, r; };
__device__ __forceinline__ void load_row8(const bf16* rowp, int n0, Row8& q) {
    q.a = *(const u32x4*)(rowp + n0); const unsigned short l = rowp[n0 > 0 ? n0 - 1 : 0], r = rowp[n0 + 8 < 4096 ? n0 + 8 : 4095]; q.l = n0 > 0 ? l : (unsigned short)0; q.r = n0 + 8 < 4096 ? r : (unsigned short)0;
}
__device__ __forceinline__ void conv3_row8(const Row8& q, float w0, float w1, float w2, float bb, float (&o)[8]) {
    const float r[10] = {bf2f(q.l), bflo(q.a.x), bfhi(q.a.x), bflo(q.a.y), bfhi(q.a.y), bflo(q.a.z), bfhi(q.a.z), bflo(q.a.w), bfhi(q.a.w), bf2f(q.r)};
#pragma unroll
    for (int i = 0; i < 8; ++i) o[i] = w0 * r[i] + w1 * r[i + 1] + w2 * r[i + 2] + bb;
}

__device__ __forceinline__ void phase_hyena_fft(const Params& P, unsigned char* lds, int tid, int lane, int wave, int G) {
    cf* bufE = (cf*)lds; cf* bufO = (cf*)(lds + FFT_BUF); cf* zbuf = (cf*)(lds + FFT_ZB);
    float* w3c = (float*)(lds + FFT_W3); float* red = (float*)(lds + FFT_RED);
    const int str = __builtin_amdgcn_readfirstlane(tid >> 8), tp0 = tid & 255; cf* buf = str ? bufO : bufE;
    const bf16* Pt = (const bf16*)(P.ws + WS_PT); bf16* Zt = (bf16*)(P.ws + WS_ZT);
    cf* Hs = (cf*)(P.ws + WS_HSPEC) + (size_t)blockIdx.x * 4 * 4096;
    const float* a2T = (const float*)(P.ws + WS_A2);
#ifndef FFT_SBAR
#define FFT_SBAR 1
#endif
    unsigned* sb = (unsigned*)(lds + FFT_RED + 64) + str; unsigned sgen = 0u;
    if (tid < 2) ((unsigned*)(lds + FFT_RED + 64))[tid] = 0u;
#if FFT_SBAR
#define STREAM_BAR() do { asm volatile("s_waitcnt vmcnt(0) lgkmcnt(0)" ::: "memory"); sgen += 4u; \
        if (lane == 0) __hip_atomic_fetch_add(sb, 1u, __ATOMIC_RELAXED, __HIP_MEMORY_SCOPE_WORKGROUP); \
        while ((unsigned)__builtin_amdgcn_readfirstlane((int)__hip_atomic_load(sb, __ATOMIC_RELAXED, __HIP_MEMORY_SCOPE_WORKGROUP)) < sgen) __builtin_amdgcn_s_sleep(0); \
        asm volatile("" ::: "memory"); } while (0)
#else
#define STREAM_BAR() __syncthreads()
#endif
    cf tw2[16];
    { const int n0 = tp0 & 15, k2 = tp0 >> 4;
      ftw_build(tw2, cis_rev(-(float)(n0 * k2) * (1.f / 4096.f)), cis_rev(-(float)n0 * (1.f / 256.f))); }
#pragma unroll 1
    for (int c = blockIdx.x; c < 1024; c += G) {
        __syncthreads();
        if (tid < 256) w3c[tid] = P.in[I_HW3][(size_t)(tid & 63) * 4096 + (tid >> 6) * 1024 + c];
#ifndef FFT_ROWPF
#define FFT_ROWPF 0
#endif
        Row8 va, vb;
#if FFT_ROWPF
        load_row8(Pt + (size_t)c * 32768, hide(tid) * 8, va); load_row8(Pt + (size_t)c * 32768 + 4096, hide(tid) * 8, vb);
#endif
        __syncthreads();
        {
            float d[8][4];
#pragma unroll
            for (int j = 0; j < 8; ++j) { d[j][0] = 0.f; d[j][1] = 0.f; d[j][2] = 0.f; d[j][3] = 0.f; }
#pragma unroll 2
            for (int i = 0; i < 64; ++i) { const float w0 = w3c[i], w1 = w3c[64 + i], w2 = w3c[128 + i], w3 = w3c[192 + i]; const float* ar = a2T + (size_t)i * 4096 + tid;
#pragma unroll
                for (int j = 0; j < 8; ++j) { const float a = ar[512 * j]; d[j][0] += a * w0; d[j][1] += a * w1; d[j][2] += a * w2; d[j][3] += a * w3; } }
            float dec[4];
#pragma unroll
            for (int q = 0; q < 4; ++q) dec[q] = fabsf(P.in[I_HDEC][q * 1024 + c]) * (1.4426950408889634f / 4095.f);
            float as0 = 0.f, as1 = 0.f;
#pragma unroll
            for (int j = 0; j < 8; ++j) { const int t = tid + 512 * j; const float tf = (float)t;
                const float h0 = d[j][0] * __builtin_amdgcn_exp2f(-tf * dec[0]), h1 = d[j][1] * __builtin_amdgcn_exp2f(-tf * dec[1]), h2 = d[j][2] * __builtin_amdgcn_exp2f(-tf * dec[2]), h3 = d[j][3] * __builtin_amdgcn_exp2f(-tf * dec[3]);
                float* hb0 = (float*)(lds + FFT_ZB); float* hb1 = (float*)(lds + FFT_HB1);
                hb0[t] = h0; hb0[4096 + t] = h1; hb1[t] = h2; hb1[4096 + t] = h3; as0 += fabsf(h0) + fabsf(h1); as1 += fabsf(h2) + fabsf(h3); }
            as0 = wave_sum(as0); as1 = wave_sum(as1); if (lane == 0) { red[wave] = as0; red[8 + wave] = as1; }
        }
        __syncthreads();
#pragma unroll 1
        for (int o = 0; o < 2; ++o) {
            const float* hbuf = (const float*)(lds + (o == 0 ? FFT_ZB : FFT_HB1));
            float tot = 0.f;
#pragma unroll
            for (int w = 0; w < 8; ++w) tot += red[8 * o + w];
            const float inv = 1.f / ((tot + 1e-6f) * 8192.f);
            { const int tp = hide(tp0); cf v[16];
#pragma unroll
              for (int j = 0; j < 16; ++j) { const int n = tp + 256 * j; const float ta = (hbuf[n] + (n == 0 ? hbuf[4096] : 0.f)) * inv, tb = (n == 0 ? 0.f : hbuf[4096 + 4096 - n]) * inv;
                  v[j] = cf{str ? ta - tb : ta + tb, 0.f}; }
              fft_fwd_pass1(v, buf, tp, str); }
            STREAM_BAR();
            fft_fwd_pass2(buf, tp0, tw2);
            STREAM_BAR();
            { const int tp = hide(tp0); cf v[16]; fload_dft16<2, -1>(v, buf, tp);
              cf* hp = Hs + (size_t)(o * 2 + str) * 4096 + tp;
#pragma unroll
              for (int k = 0; k < 16; ++k) hp[k * 256] = v[REV4(k)]; }
            __syncthreads();
        }
#pragma unroll 1
        for (int pr = 0; pr < 4; ++pr) {
            { const int n0 = hide(tid) * 8; float oa[8], ob[8];
#if !FFT_ROWPF
              load_row8(Pt + (size_t)c * 32768 + (2 * pr) * 4096, n0, va); load_row8(Pt + (size_t)c * 32768 + (2 * pr + 1) * 4096, n0, vb);
#endif
              const float w0 = P.in[I_HCW][c], w1 = P.in[I_HCW][3072 + c], w2 = P.in[I_HCW][6144 + c], bb = P.in[I_HCB][c];
              conv3_row8(va, w0, w1, w2, bb, oa); conv3_row8(vb, w0, w1, w2, bb, ob);
#pragma unroll
              for (int i = 0; i < 8; ++i) zbuf[n0 + i] = cf{oa[i], ob[i]}; }
            __syncthreads();
#pragma unroll 1
            for (int o = 0; o < 2; ++o) {
                Row8 ga, gb;
#if FFT_ROWPF
                { const int n0 = hide(tid) * 8; const size_t grow = (size_t)((o + 1) * 1024 + c) * 32768;
                    load_row8(Pt + grow + (2 * pr) * 4096, n0, ga); load_row8(Pt + grow + (2 * pr + 1) * 4096, n0, gb);
                    const int prn = pr < 3 ? pr + 1 : 3;
                    load_row8(Pt + (size_t)c * 32768 + (2 * prn) * 4096, n0, va); load_row8(Pt + (size_t)c * 32768 + (2 * prn + 1) * 4096, n0, vb); }
#endif
                { const int tp = hide(tp0); cf v[16];
#pragma unroll
                  for (int j = 0; j < 16; ++j) v[j] = zbuf[tp + 256 * j];
                  fft_fwd_pass1(v, buf, tp, str); }
                STREAM_BAR();
#ifndef FFT_PF
#define FFT_PF 1
#endif
                cf hq[16];
#if FFT_PF
                { const cf* hp = Hs + (size_t)(o * 2 + str) * 4096 + hide(tp0);
#pragma unroll
                  for (int k = 0; k < 16; ++k) hq[k] = hp[k * 256]; }
#endif
                fft_fwd_pass2(buf, tp0, tw2);
                STREAM_BAR();
                { const int tp = hide(tp0); cf v[16]; fload_dft16<2, -1>(v, buf, tp);
#if !FFT_PF
                  { const cf* hp = Hs + (size_t)(o * 2 + str) * 4096 + tp;
#pragma unroll
                  for (int k = 0; k < 16; ++k) hq[k] = hp[k * 256]; }
#endif
                  cf y[16];
#pragma unroll
                  for (int k = 0; k < 16; ++k) y[k] = cmul(v[REV4(k)], hq[k]);
                  dft16<1>(y);
                  fstore_ang<2>(y, buf, tp, 0.f, (float)((tp >> 4) + 16 * (tp & 15)) * (1.f / 4096.f)); }
                STREAM_BAR();
                fft_inv_pass2(buf, tp0, str);
                STREAM_BAR();
                fft_inv_pass3(buf, tp0, str);
                __syncthreads();
                { const int n0 = hide(tid) * 8;
#if !FFT_ROWPF
                  { const size_t grow = (size_t)((o + 1) * 1024 + c) * 32768; load_row8(Pt + grow + (2 * pr) * 4096, n0, ga); load_row8(Pt + grow + (2 * pr + 1) * 4096, n0, gb); }
#endif
                  const int gc = (o + 1) * 1024 + c;
                  const float w0 = P.in[I_HCW][gc], w1 = P.in[I_HCW][3072 + gc], w2 = P.in[I_HCW][6144 + gc], bb = P.in[I_HCB][gc];
                  const float sk = P.in[I_HSKIP][o * 1024 + c]; float g0[8], g1[8], oa[8], ob[8];
                  conv3_row8(ga, w0, w1, w2, bb, g0); conv3_row8(gb, w0, w1, w2, bb, g1);
#pragma unroll
                  for (int i = 0; i < 8; ++i) { const int n = n0 + i; const cf e = bufE[fphys(n)], q = bufO[fphys(n)], z = zbuf[n];
                      oa[i] = (e.x + q.x + sk * z.x) * g0[i]; ob[i] = (e.y + q.y + sk * z.y) * g1[i]; }
                  if (o == 0) {
#pragma unroll
                      for (int i = 0; i < 8; ++i) zbuf[n0 + i] = cf{oa[i], ob[i]};
                  } else {
                      u32x4 wa, wb; wa.x = pk2(oa[0], oa[1]); wa.y = pk2(oa[2], oa[3]); wa.z = pk2(oa[4], oa[5]); wa.w = pk2(oa[6], oa[7]);
                      wb.x = pk2(ob[0], ob[1]); wb.y = pk2(ob[2], ob[3]); wb.z = pk2(ob[4], ob[5]); wb.w = pk2(ob[6], ob[7]);
                      *(u32x4*)(Zt + (size_t)c * 32768 + (2 * pr) * 4096 + n0) = wa; *(u32x4*)(Zt + (size_t)c * 32768 + (2 * pr + 1) * 4096 + n0) = wb;
                  } }
                __syncthreads();
            }
        }
    }
}
__device__ __forceinline__ void phase_transpose(const Params& P, unsigned char* lds, int lane, int wave, int G) {
    bf16* tile = (bf16*)(lds + wave * 16384);
    const bf16* Zt = (const bf16*)(P.ws + WS_ZT); bf16* Z = (bf16*)(P.ws + WS_Z);
    for (int it = blockIdx.x * 8 + wave; it < 16 * 512; it += G * 8) {
        const int cb = it & 15, tb = it >> 4, c0 = cb * 64, t0 = tb * 64;
#pragma unroll
        for (int i = 0; i < 8; ++i) { const int ch = i * 8 + (lane >> 3), tq = (lane & 7) * 8;
            const u32x4 a = *(const u32x4*)(Zt + (size_t)(c0 + ch) * 32768 + t0 + tq);
            unsigned* d = (unsigned*)(tile + ch * 66 + tq); d[0] = a.x; d[1] = a.y; d[2] = a.z; d[3] = a.w; }
        LDS_WAIT(); asm volatile("" ::: "memory");
#pragma unroll
        for (int i = 0; i < 8; ++i) { const int tk = i * 8 + (lane >> 3), cq = (lane & 7) * 8;
            unsigned short e[8];
#pragma unroll
            for (int j = 0; j < 8; ++j) e[j] = tile[(cq + j) * 66 + tk];
            u32x4 w; w.x = e[0] | ((unsigned)e[1] << 16); w.y = e[2] | ((unsigned)e[3] << 16); w.z = e[4] | ((unsigned)e[5] << 16); w.w = e[6] | ((unsigned)e[7] << 16);
            *(u32x4*)(Z + (size_t)(t0 + tk) * 1024 + c0 + cq) = w; }
        LDS_WAIT(); asm volatile("" ::: "memory");
    }
}

constexpr int N_PHASES = 21;
__global__ void __launch_bounds__(512, 2) fwd_kernel(Params P0) {
    extern __shared__ __attribute__((aligned(16))) unsigned char lds[];
    const int tid = threadIdx.x, lane = tid & 63, wave = __builtin_amdgcn_readfirstlane(tid >> 6), G = gridDim.x;
    PG8_LAS unsigned char* ldsl = (PG8_LAS unsigned char*)lds;
    for (int u = tid; u < (LDS_BYTES - LDSCTL_OFF) / 4; u += 512) ((unsigned*)(lds + LDSCTL_OFF))[u] = 0u;
    __syncthreads();
#if MK_ONE_LAUNCH
    XcdBarrier bar = xcd_barrier_post((unsigned*)(P0.ws + WS_CTL) + CW_BAR, (volatile LAS unsigned*)(ldsl + MISC_OFF) + 8);
#define GRID_BAR() xcd_barrier(bar)
#else
#define GRID_BAR() do { } while (0)
#endif
    const int lo = P0.ph_lo, hi = P0.ph_hi;
#ifndef PHASE_MASK
#define PHASE_MASK 0xFFFFFFFFu
#endif
#define IN(k) ((((PHASE_MASK) >> (k)) & 1u) && lo <= (k) && (k) < hi)
#ifndef DELAY_MASK
#define DELAY_MASK 0u
#endif
#ifndef CLKP
#define CLKP -1
#endif
    unsigned long long clk_c0 = 0, clk_r0 = 0;
    unsigned long long t_ph = 0;
#define SEAM(k) do { if (IN(k) && IN((k) + 1)) GRID_BAR(); \
    if (((DELAY_MASK) >> (k)) & 1u) { const unsigned long long t1 = __builtin_amdgcn_s_memrealtime(); const unsigned long long dt = t1 - t_ph; while (__builtin_amdgcn_s_memrealtime() - t1 < dt) __builtin_amdgcn_s_sleep(8); __syncthreads(); } \
    if ((k) == CLKP) { const unsigned long long c1 = __builtin_readcyclecounter(), r1 = __builtin_amdgcn_s_memrealtime(); \
        const unsigned long long ticks = (c1 - clk_c0) * 1000ull / (r1 - clk_r0 + 1ull);   \
        while (__builtin_amdgcn_s_memrealtime() - r1 < ticks) __builtin_amdgcn_s_sleep(8); __syncthreads(); } \
    if ((k) + 1 == CLKP) { clk_c0 = __builtin_readcyclecounter(); clk_r0 = __builtin_amdgcn_s_memrealtime(); } \
    if (((DELAY_MASK) >> ((k) + 1)) & 1u) t_ph = __builtin_amdgcn_s_memrealtime(); } while (0)
#ifndef REPEAT_MASK
#define REPEAT_MASK 0u
#endif
#ifndef REPEAT_SUB
#define REPEAT_SUB 0u
#endif
#define REPS(k) for (int reps_ = 0; reps_ < ((((REPEAT_SUB) >> (k)) & 1u) ? 2 : 1); ++reps_)
#define REP(k) for (int rep_ = 0; rep_ < ((((REPEAT_MASK) >> (k)) & 1u) ? 2 : 1); ++rep_)

    if (DELAY_MASK & 1u) t_ph = __builtin_amdgcn_s_memrealtime();
    if (IN(0)) REP(0) { const Params P = load_params(); unsigned char* ws = P.ws; phase_prologue(P, lds, tid, lane, wave, G); } SEAM(0);
    if (IN(1)) REP(1) { const Params P = load_params(); unsigned char* ws = P.ws; phase_norm1_l0(P, lane, wave, G); } SEAM(1);
    if (IN(2)) REP(2) { const Params P = load_params(); unsigned char* ws = P.ws;
        pg8::Gemm g{(const bf16*)(ws + WS_RH), (const bf16*)(ws + WS_WIN), 1024, 1024, 1024, 0}; pg8::StaticOrder S; S.init(M0 / 256, 7, G, (int)blockIdx.x);
        EpiIn E{(bf16*)(ws + WS_CQ), (bf16*)(ws + WS_CKV), (bf16*)(ws + WS_UX), (bf16*)(ws + WS_UG), (bf16*)(ws + WS_K)};
        pg8::gemm_phase<EpiIn, pg8::StaticOrder, GP_ALIGN, GP_SP2>(ldsl, g, S, E);
    } SEAM(2);
    if (IN(3)) REP(3) { const Params P = load_params(); unsigned char* ws = P.ws; phase_rowstat(P, lane, wave, G); phase_lru_f1(P, lds, tid, lane, wave, G); } SEAM(3);
    if (IN(4)) REP(4) { const Params P = load_params(); unsigned char* ws = P.ws;
        phase_lru_carry(P, lane, wave, G);
        __syncthreads();
#ifndef NO_QUP
        REPS(0) { pg8::Gemm g{(const bf16*)(ws + WS_CQ), (const bf16*)(ws + WS_WUQ), 384, 384, 384, 0}; pg8::StaticOrder S; S.init(M0 / 256, 3, G, (int)blockIdx.x);
          EpiQ E{(bf16*)(ws + WS_Q), (const float*)(ws + WS_RQ)};
          pg8::gemm_phase<EpiQ, pg8::StaticOrder, GP_ALIGN, GP_SP2>(ldsl, g, S, E); }
#endif
        __syncthreads();
        REPS(1) { pg8::Gemm g{(const bf16*)(ws + WS_CKV), (const bf16*)(ws + WS_WUKV), 256, 256, 256, 0}; pg8::StaticOrder S; S.init(M0 / 256, 4, G, (int)blockIdx.x);
          EpiKV E{(bf16*)(ws + WS_K), (bf16*)(ws + WS_V), (const float*)(ws + WS_RKV)};
          pg8::gemm_phase<EpiKV, pg8::StaticOrder, GP_ALIGN, GP_SP2>(ldsl, g, S, E); }
        __syncthreads();
    } SEAM(4);
    if (IN(5)) REP(5) { const Params P = load_params(); unsigned char* ws = P.ws; REPS(2) phase_lru_f3(P, lds, tid, lane, wave, G); REPS(3) phase_attention(P, lds, G); } SEAM(5);
    if (IN(6)) REP(6) { const Params P = load_params(); unsigned char* ws = P.ws;
        pg8::Gemm g{(const bf16*)(ws + WS_RH), (const bf16*)(ws + WS_WOUT), 1024, 1024, 1024, 0}; pg8::StaticOrder S; S.init(M0 / 256, 4, G, (int)blockIdx.x);
        EpiRes<0> E{P.in[I_X], P.in[I_CTX], (const float*)(ws + WS_MOD), nullptr, (bf16*)P.out, (bf16*)(ws + WS_XC)};
        pg8::gemm_phase<EpiRes<0>, pg8::StaticOrder, GP_ALIGN, GP_SP2>(ldsl, g, S, E);
    } SEAM(6);
    if (IN(7)) REP(7) { const Params P = load_params(); unsigned char* ws = P.ws; phase_norm2_route<0>(P, lds, tid, lane, wave, G); } SEAM(7);
    if (IN(8)) REP(8) { const Params P = load_params(); unsigned char* ws = P.ws; phase_permute<0>(P, lds, tid, lane, wave, G); } SEAM(8);
    if (IN(9)) REP(9) { const Params P = load_params(); unsigned char* ws = P.ws;
        const int* te = (const int*)(ws + WS_TILEE); const int nmt = te[MAXTILES];
        { int* gl = (int*)(lds + RING_BYTES); const int* st = (const int*)(ws + WS_SLOTTOK);
          for (int i = 0; ; ++i) { const long L = (long)i * G + ((G % 8 == 0) ? ((int)blockIdx.x % 8) * (G / 8) + (int)blockIdx.x / 8 : (int)blockIdx.x); if (L >= (long)nmt * 4 || i >= 20) break; if (tid < 256) gl[i * 256 + tid] = st[(int)(L >> 2) * 256 + tid]; }
          __syncthreads(); }
        pg8::Gemm g{(const bf16*)(ws + WS_RH), (const bf16*)(ws + WS_W13), 1024, 1024, 1024, (size_t)1024 * 1024 * 2, RING_BYTES}; pg8::MoeOrder S{nmt, G, (G % 8 == 0) ? ((int)blockIdx.x % 8) * (G / 8) + (int)blockIdx.x / 8 : (int)blockIdx.x, te};
        EpiMoe1 E{(bf16*)(ws + WS_ACT)};
        pg8::gemm_phase<EpiMoe1, pg8::MoeOrder, GP_ALIGN, GP_SP2, true>(ldsl, g, S, E);
    } SEAM(9);
    if (IN(10)) REP(10) { const Params P = load_params(); unsigned char* ws = P.ws;
        const int* te = (const int*)(ws + WS_TILEE);
        pg8::Gemm g{(const bf16*)(ws + WS_ACT), (const bf16*)(ws + WS_W2), 512, 512, 512, (size_t)1024 * 512 * 2}; pg8::MoeOrder S{te[MAXTILES], G, (G % 8 == 0) ? ((int)blockIdx.x % 8) * (G / 8) + (int)blockIdx.x / 8 : (int)blockIdx.x, te};
        EpiStore E{(bf16*)(ws + WS_HPERM), 1024};
        pg8::gemm_phase<EpiStore, pg8::MoeOrder, GP_ALIGN, GP_SP2>(ldsl, g, S, E);
    } SEAM(10);
    if (IN(11)) REP(11) { const Params P = load_params(); unsigned char* ws = P.ws; phase_combine_norm1_l1(P, lane, wave, G); } SEAM(11);
    if (IN(12)) REP(12) { const Params P = load_params(); unsigned char* ws = P.ws;
        pg8::Gemm g{(const bf16*)(ws + WS_WHIN), (const bf16*)(ws + WS_RH), 1024, 1024, 1024, 0}; pg8::StaticOrder S; S.init(3072 / 256, M1 / 256, G, (int)blockIdx.x);
        EpiStore E{(bf16*)(ws + WS_PT), 32768};
        pg8::gemm_phase<EpiStore, pg8::StaticOrder, GP_ALIGN, GP_SP2>(ldsl, g, S, E);
    } SEAM(12);
    if (IN(13)) REP(13) { const Params P = load_params(); unsigned char* ws = P.ws; phase_hyena_fft(P, lds, tid, lane, wave, G); } SEAM(13);
    if (IN(14)) REP(14) { const Params P = load_params(); unsigned char* ws = P.ws; phase_transpose(P, lds, lane, wave, G); } SEAM(14);
    if (IN(15)) REP(15) { const Params P = load_params(); unsigned char* ws = P.ws;
        pg8::Gemm g{(const bf16*)(ws + WS_Z), (const bf16*)(ws + WS_WHOUT), 1024, 1024, 1024, 0}; pg8::StaticOrder S; S.init(M1 / 256, 4, G, (int)blockIdx.x);
        EpiRes<1> E{nullptr, nullptr, (const float*)(ws + WS_MOD), (const bf16*)((unsigned char*)P.out + X2_OFF), (bf16*)(ws + WS_X3), nullptr};
        pg8::gemm_phase<EpiRes<1>, pg8::StaticOrder, GP_ALIGN, GP_SP2>(ldsl, g, S, E);
    } SEAM(15);
    if (IN(16)) REP(16) { const Params P = load_params(); unsigned char* ws = P.ws; phase_norm2_route<1>(P, lds, tid, lane, wave, G); } SEAM(16);
    if (IN(17)) REP(17) { const Params P = load_params(); unsigned char* ws = P.ws; phase_permute<1>(P, lds, tid, lane, wave, G); } SEAM(17);
    if (IN(18)) REP(18) { const Params P = load_params(); unsigned char* ws = P.ws;
        const int* te = (const int*)(ws + WS_TILEE); const int nmt = te[MAXTILES];
        { int* gl = (int*)(lds + RING_BYTES); const int* st = (const int*)(ws + WS_SLOTTOK);
          for (int i = 0; ; ++i) { const long L = (long)i * G + ((G % 8 == 0) ? ((int)blockIdx.x % 8) * (G / 8) + (int)blockIdx.x / 8 : (int)blockIdx.x); if (L >= (long)nmt * 4 || i >= 20) break; if (tid < 256) gl[i * 256 + tid] = st[(int)(L >> 2) * 256 + tid]; }
          __syncthreads(); }
        pg8::Gemm g{(const bf16*)(ws + WS_RH), (const bf16*)(ws + WS_W13) + (size_t)16 * 1024 * 1024, 1024, 1024, 1024, (size_t)1024 * 1024 * 2, RING_BYTES}; pg8::MoeOrder S{nmt, G, (G % 8 == 0) ? ((int)blockIdx.x % 8) * (G / 8) + (int)blockIdx.x / 8 : (int)blockIdx.x, te};
        EpiMoe1 E{(bf16*)(ws + WS_ACT)};
        pg8::gemm_phase<EpiMoe1, pg8::MoeOrder, GP_ALIGN, GP_SP2, true>(ldsl, g, S, E);
    } SEAM(18);
    if (IN(19)) REP(19) { const Params P = load_params(); unsigned char* ws = P.ws;
        const int* te = (const int*)(ws + WS_TILEE);
        pg8::Gemm g{(const bf16*)(ws + WS_ACT), (const bf16*)(ws + WS_W2) + (size_t)16 * 1024 * 512, 512, 512, 512, (size_t)1024 * 512 * 2}; pg8::MoeOrder S{te[MAXTILES], G, (G % 8 == 0) ? ((int)blockIdx.x % 8) * (G / 8) + (int)blockIdx.x / 8 : (int)blockIdx.x, te};
        EpiStore E{(bf16*)(ws + WS_HPERM), 1024};
        pg8::gemm_phase<EpiStore, pg8::MoeOrder, GP_ALIGN, GP_SP2>(ldsl, g, S, E);
    } SEAM(19);
    if (IN(20)) REP(20) { const Params P = load_params(); unsigned char* ws = P.ws; phase_final(P, lane, wave, G); } SEAM(20);
#undef IN
#undef SEAM
}

extern "C" void kernel_launch(void* const* d_in, const int* in_sizes, int n_in, void* d_out, int out_size, void* d_ws, size_t ws_size, hipStream_t stream) {
    static int grid = 0;
    if (grid == 0) {
        if (n_in != N_IN || out_size != M1 * DM || ws_size < WS_END) { fprintf(stderr, "kernel_launch: unexpected shapes (n_in %d out %d ws %zu)\n", n_in, out_size, ws_size); grid = -1; return; }
        int dev = 0, cus = 0;
        if (hipGetDevice(&dev) != hipSuccess || hipDeviceGetAttribute(&cus, hipDeviceAttributeMultiprocessorCount, dev) != hipSuccess) { grid = -1; return; }
        if (hipFuncSetAttribute((const void*)fwd_kernel, hipFuncAttributeMaxDynamicSharedMemorySize, LDS_BYTES) != hipSuccess) { fprintf(stderr, "kernel_launch: hipFuncSetAttribute failed\n"); grid = -1; return; }
        int per_cu = 0;
        if (hipOccupancyMaxActiveBlocksPerMultiprocessor(&per_cu, (const void*)fwd_kernel, 512, LDS_BYTES) != hipSuccess || per_cu < 1) fprintf(stderr, "kernel_launch: occupancy query reports %d\n", per_cu);
        (void)hipGetLastError();
        grid = cus;
    }
    if (grid < 0) return;
    (void)hipMemsetAsync((char*)d_ws + WS_CTL, 0, CTL_ZERO_BYTES, stream);
    Params p{};
    for (int i = 0; i < N_IN; ++i) p.in[i] = (const float*)d_in[i];
    p.out = (float*)d_out; p.ws = (unsigned char*)d_ws;
#if MK_ONE_LAUNCH
    p.ph_lo = 0; p.ph_hi = N_PHASES;
    hipLaunchKernelGGL(fwd_kernel, dim3(grid), dim3(512), LDS_BYTES, stream, p);
#else
    for (int k = 0; k < N_PHASES; ++k) { p.ph_lo = k; p.ph_hi = k + 1; hipLaunchKernelGGL(fwd_kernel, dim3(grid), dim3(512), LDS_BYTES, stream, p); }
#endif
}
```

```cpp
#include <hip/hip_runtime.h>
#include <cstdio>
#include <cstdint>

#ifndef MK_ONE_LAUNCH
#define MK_ONE_LAUNCH 1
#endif

#define LAS __attribute__((address_space(3)))
#define GAS __attribute__((address_space(1)))
typedef unsigned short bf16;
typedef short bf16x8 __attribute__((ext_vector_type(8)));
typedef short s16x4 __attribute__((ext_vector_type(4)));
typedef float f32x2 __attribute__((ext_vector_type(2)));
typedef float f32x4 __attribute__((ext_vector_type(4)));
typedef float f32x16 __attribute__((ext_vector_type(16)));
typedef unsigned u32x2 __attribute__((ext_vector_type(2)));
typedef unsigned u32x4 __attribute__((ext_vector_type(4)));
#define LDS_WAIT() asm volatile("s_waitcnt lgkmcnt(0)" ::: "memory")
#define VM_WAIT() asm volatile("s_waitcnt vmcnt(0)" ::: "memory")

__device__ __forceinline__ unsigned f2bf(float f) { unsigned u = __builtin_bit_cast(unsigned, f); return (u + 0x7fffu + ((u >> 16) & 1u)) >> 16; }
__device__ __forceinline__ unsigned pk2(float lo, float hi) { return f2bf(lo) | (f2bf(hi) << 16); }
__device__ __forceinline__ float bf2f(unsigned b) { return __builtin_bit_cast(float, b << 16); }
__device__ __forceinline__ float bflo(unsigned w) { return __builtin_bit_cast(float, w << 16); }
__device__ __forceinline__ float bfhi(unsigned w) { return __builtin_bit_cast(float, w & 0xffff0000u); }
__device__ __forceinline__ float wave_sum(float v) {
#pragma unroll
    for (int o = 1; o < 64; o <<= 1) v += __shfl_xor(v, o);
    return v;
}
__device__ __forceinline__ float sigm(float x) { return 1.f / (1.f + expf(-x)); }

namespace pg8 {
#define PG8_LAS __attribute__((address_space(3)))
typedef unsigned short bf16_t;
constexpr int BM = 256, BK = 64, HALF = 128, HTB = HALF * BK * 2, STAGE_BYTES = 8 * HTB, NXCD = 8, WGM = 4;
__host__ __device__ __forceinline__ int lds_byte(int r, int c) { const int st = (r >> 4) * 2 + (c >> 5), rr = r & 15, cc = c & 31, ob = rr * 64 + cc * 2; return st * 1024 + (ob ^ (((ob >> 9) & 1) << 5)); }
__host__ __device__ __forceinline__ void stage_rc(int b, int& R, int& C) { const int st = b / 1024, sb = b % 1024, swz = sb ^ (((sb >> 9) & 1) << 5); R = (st >> 1) * 16 + swz / 64; C = (st & 1) * 32 + (swz % 64) / 2; }
__host__ __device__ __forceinline__ int perm32(int rho) { const int n = rho >> 4, i = rho & 15; return 8 * (i >> 2) + 4 * n + (i & 3); }

struct Unit { int pm, pn, bz; };
struct Gemm { const bf16_t* A; const bf16_t* Bt; int lda, ldb, K; size_t bz_stride; int gidx_off; };

struct StaticOrder {
    int nM, nN, nwg, G, c;
    __host__ __device__ void init(int nM_, int nN_, int G_, int c_) { nM = nM_; nN = nN_; nwg = nM * nN; G = G_; c = c_; }
    __host__ __device__ bool next(int i, Unit& u) const {
        const long L = (long)i * G + c; if (L >= nwg) return false;
        int wgid = (int)L; { const int q = nwg / NXCD, r = nwg % NXCD, xcd = wgid % NXCD, off = wgid / NXCD; wgid = (xcd < r ? xcd * (q + 1) : r * (q + 1) + (xcd - r) * q) + off; }
        const int nig = WGM * nN, gid = wgid / nig, fm = gid * WGM, gsz = (nM - fm) < WGM ? (nM - fm) : WGM;
        u.pm = fm + ((wgid % nig) % gsz); u.pn = (wgid % nig) / gsz; u.bz = 0; return true;
    }
    __device__ __forceinline__ void a_ready(const Unit&) const {}
    __device__ __forceinline__ void done(const Unit&) const {}
};
struct MoeOrder {
    int nM, G, c; const int* tile_e;
    __device__ bool next(int i, Unit& u) const {
        const long L = (long)i * G + c; if (L >= (long)nM * 4) return false;
        u.pm = (int)(L >> 2); u.pn = (int)(L & 3); u.bz = tile_e[u.pm]; return true;
    }
    __device__ __forceinline__ void a_ready(const Unit&) const {}
    __device__ __forceinline__ void done(const Unit&) const {}
};

__device__ __forceinline__ unsigned cvt_pk_bf16(float lo, float hi) { unsigned r; asm volatile("v_cvt_pk_bf16_f32 %0, %1, %2" : "=v"(r) : "v"(lo), "v"(hi)); return r; }

template <class Epi, class Sched, bool ALIGN_EPI = false, bool SP2 = false, bool GATHER = false>
__device__ __forceinline__ void gemm_phase(PG8_LAS unsigned char* lds, const Gemm g, const Sched& S, const Epi& E) {
    const int tid = threadIdx.x, wid = __builtin_amdgcn_readfirstlane(tid >> 6), lane = tid & 63, wr = wid >> 2, wc = wid & 3, fr = lane & 15, fq = lane >> 4;
    const int K = g.K, nt = K / BK;
    unsigned voffA[2], voffB[2];
#pragma unroll
    for (int i = 0; i < 2; ++i) { int R, C; stage_rc(tid * 16 + i * 8192, R, C); const int Rb = Epi::PERM ? ((R & ~31) + perm32(R & 31)) : R;
        voffA[i] = (unsigned)(R * g.lda + C) * 2u; voffB[i] = (unsigned)(Rb * g.ldb + C) * 2u; }
    unsigned vc0[2], vc1[2], vn0[2], vn1[2];
    const PG8_LAS int* gl = (const PG8_LAS int*)(lds + g.gidx_off);
#define PG8_GIDX(uix, v0, v1) do { _Pragma("unroll") for (int _i = 0; _i < 2; ++_i) { int _R, _C; stage_rc(tid * 16 + _i * 8192, _R, _C); \
        v0[_i] = (unsigned)(gl[(uix) * 256 + _R] * g.lda + _C) * 2u; v1[_i] = (unsigned)(gl[(uix) * 256 + 128 + _R] * g.lda + _C) * 2u; } } while (0)
    const size_t kstep = (size_t)(BK * 2);
    const size_t hstepA = (size_t)HALF * g.lda * 2, hstepB = (size_t)HALF * g.ldb * 2;
    const size_t tstepA = GATHER ? 0 : 2 * hstepA, tstepB = 2 * hstepB;
    const unsigned ldsw = (unsigned)wid * 1024u;
    const int aoff = lds_byte(wr * 64 + fr, fq * 8), boff = lds_byte(wc * 32 + fr, fq * 8);
#define PG8_SA(b, h) (((b) * 2 + (h)) * HTB)
#define PG8_SB(b, h) ((4 + (b) * 2 + (h)) * HTB)
#define PG8_STAGE(bufoff, gbase, voff) do { _Pragma("unroll") for (int _i = 0; _i < 2; ++_i) \
        __builtin_amdgcn_global_load_lds((const unsigned*)((const char*)(gbase) + (voff)[_i]), (PG8_LAS unsigned*)(lds + (bufoff) + ldsw + _i * 8192), 16, 0, 0); } while (0)
#define PG8_LDA(dst, b, h) do { _Pragma("unroll") for (int m = 0; m < 4; ++m) _Pragma("unroll") for (int k = 0; k < 2; ++k) dst[m][k] = *(const PG8_LAS bf16x8*)(lds + PG8_SA(b, h) + aoff + m * 2048 + k * 1024); } while (0)
#define PG8_LDB(dst, b, h) do { _Pragma("unroll") for (int n = 0; n < 2; ++n) _Pragma("unroll") for (int k = 0; k < 2; ++k) dst[n][k] = *(const PG8_LAS bf16x8*)(lds + PG8_SB(b, h) + boff + n * 2048 + k * 1024); } while (0)
#define PG8_MMA(ai, bj, At, Bt) do { __builtin_amdgcn_s_setprio(1); _Pragma("unroll") for (int m = 0; m < 4; ++m) _Pragma("unroll") for (int n = 0; n < 2; ++n) _Pragma("unroll") for (int k = 0; k < 2; ++k) \
        acc[ai][bj][m][n] = __builtin_amdgcn_mfma_f32_16x16x32_bf16(Bt[n][k], At[m][k], acc[ai][bj][m][n], 0, 0, 0); __builtin_amdgcn_s_setprio(0); } while (0)
#define PG8_WAIT_V(n) asm volatile("s_waitcnt vmcnt(" #n ")" ::: "memory")
#define PG8_WAIT_L(n) asm volatile("s_waitcnt lgkmcnt(" #n ")" ::: "memory")
#define PG8_BAR __builtin_amdgcn_s_barrier()
#define PG8_SCHED __builtin_amdgcn_sched_barrier(0)
    Unit cur, nxt; int ui = 0;
    if (!S.next(0, cur)) return;
    f32x4 acc[2][2][4][2];
#pragma unroll
    for (int a = 0; a < 2; ++a)
#pragma unroll
        for (int b = 0; b < 2; ++b)
#pragma unroll
            for (int m = 0; m < 4; ++m)
#pragma unroll
                for (int n = 0; n < 2; ++n) acc[a][b][m][n] = (f32x4){0.f, 0.f, 0.f, 0.f};
    bf16x8 At[4][2], B0[2][2], B1[2][2];
    const char* cA = (const char*)g.A + (size_t)cur.pm * tstepA; const char* cB = (const char*)g.Bt + (size_t)cur.bz * g.bz_stride + (size_t)cur.pn * tstepB;
    S.a_ready(cur);
    if constexpr (GATHER) { PG8_GIDX(0, vc0, vc1); vn0[0] = vc0[0]; vn0[1] = vc0[1]; vn1[0] = vc1[0]; vn1[1] = vc1[1]; }
#define PG8_STAGE_A0(bufoff, p, NX) do { if constexpr (GATHER) { unsigned _v[2] = {(NX) ? vn0[0] : vc0[0], (NX) ? vn0[1] : vc0[1]}; PG8_STAGE(bufoff, p, _v); } else PG8_STAGE(bufoff, p, voffA); } while (0)
#define PG8_STAGE_A1(bufoff, p, NX) do { if constexpr (GATHER) { unsigned _v[2] = {(NX) ? vn1[0] : vc1[0], (NX) ? vn1[1] : vc1[1]}; PG8_STAGE(bufoff, p, _v); } else PG8_STAGE(bufoff, (p) + hstepA, voffA); } while (0)
    if constexpr (SP2) {
        PG8_STAGE(PG8_SB(0, 0), cB, voffB); PG8_STAGE(PG8_SB(0, 1), cB + hstepB, voffB); PG8_STAGE_A0(PG8_SA(0, 0), cA, false); PG8_STAGE_A1(PG8_SA(0, 1), cA, false);
        if (wr == 1) PG8_BAR;
        PG8_WAIT_V(2); PG8_BAR;
        PG8_STAGE(PG8_SB(1, 0), cB + kstep, voffB); PG8_STAGE_A0(PG8_SA(1, 0), cA + kstep, false); PG8_STAGE(PG8_SB(1, 1), cB + hstepB + kstep, voffB);
        PG8_WAIT_V(6); PG8_BAR;
    } else {
        PG8_STAGE(PG8_SB(0, 0), cB, voffB); PG8_STAGE_A0(PG8_SA(0, 0), cA, false); PG8_STAGE(PG8_SB(0, 1), cB + hstepB, voffB); PG8_STAGE_A1(PG8_SA(0, 1), cA, false);
        if (wr == 1) PG8_BAR;
        PG8_WAIT_V(4); PG8_BAR;
        PG8_STAGE(PG8_SB(1, 0), cB + kstep, voffB); PG8_STAGE_A0(PG8_SA(1, 0), cA + kstep, false); PG8_STAGE(PG8_SB(1, 1), cB + hstepB + kstep, voffB);
        PG8_WAIT_V(6); PG8_BAR;
    }
    for (;;) {
        const bool has_next = S.next(ui + 1, nxt);
        const char* nA = has_next ? (const char*)g.A + (size_t)nxt.pm * tstepA : cA;
        const char* nB = has_next ? (const char*)g.Bt + (size_t)nxt.bz * g.bz_stride + (size_t)nxt.pn * tstepB : cB;
        if constexpr (GATHER) { if (has_next) PG8_GIDX(ui + 1, vn0, vn1); }
#pragma unroll 1
        for (int t = 0; t < nt; t += 2) {
            const bool last = (t == nt - 2);
            const char* a1 = cA + (size_t)(t + 1) * kstep;
            const char* a2 = last ? nA : cA + (size_t)(t + 2) * kstep; const char* b2 = last ? nB : cB + (size_t)(t + 2) * kstep;
            const char* a3 = a2 + kstep; const char* b3 = b2 + kstep;
            if (last && has_next) S.a_ready(nxt);
            if constexpr (SP2) {
            PG8_LDB(B0, 0, 0); PG8_LDB(B1, 0, 1); PG8_SCHED; PG8_LDA(At, 0, 0); PG8_STAGE_A1(PG8_SA(1, 1), a1, false);
            PG8_WAIT_V(8); PG8_WAIT_L(0); PG8_BAR; PG8_MMA(0, 0, At, B0); PG8_MMA(0, 1, At, B1); PG8_BAR; PG8_SCHED;
            PG8_LDA(At, 0, 1); PG8_STAGE(PG8_SB(0, 0), b2, voffB); PG8_STAGE(PG8_SB(0, 1), b2 + hstepB, voffB); PG8_STAGE_A0(PG8_SA(0, 0), a2, last);
            PG8_WAIT_V(8); PG8_WAIT_L(0); PG8_BAR; PG8_MMA(1, 0, At, B0); PG8_MMA(1, 1, At, B1); PG8_BAR; PG8_SCHED;
            PG8_LDB(B0, 1, 0); PG8_LDB(B1, 1, 1); PG8_SCHED; PG8_LDA(At, 1, 0); PG8_STAGE_A1(PG8_SA(0, 1), a2, last);
            PG8_WAIT_V(8); PG8_WAIT_L(0); PG8_BAR; PG8_MMA(0, 0, At, B0); PG8_MMA(0, 1, At, B1); PG8_BAR; PG8_SCHED;
            PG8_LDA(At, 1, 1); PG8_STAGE(PG8_SB(1, 0), b3, voffB); PG8_STAGE(PG8_SB(1, 1), b3 + hstepB, voffB); PG8_STAGE_A0(PG8_SA(1, 0), a3, last);
            PG8_WAIT_V(8); PG8_WAIT_L(0); PG8_BAR; PG8_MMA(1, 0, At, B0); PG8_MMA(1, 1, At, B1); PG8_BAR; PG8_SCHED;
            } else {
            PG8_LDB(B0, 0, 0); PG8_SCHED; PG8_LDA(At, 0, 0); PG8_STAGE_A1(PG8_SA(1, 1), a1, false);
            PG8_WAIT_L(8); PG8_BAR; PG8_WAIT_L(0); PG8_MMA(0, 0, At, B0); PG8_BAR; PG8_SCHED;
            PG8_LDB(B1, 0, 1); PG8_STAGE(PG8_SB(0, 0), b2, voffB);
            PG8_BAR; PG8_WAIT_L(0); PG8_MMA(0, 1, At, B1); PG8_BAR;
            PG8_LDA(At, 0, 1); PG8_STAGE_A0(PG8_SA(0, 0), a2, last);
            PG8_BAR; PG8_WAIT_L(0); PG8_MMA(1, 0, At, B0); PG8_BAR; PG8_SCHED;
            PG8_STAGE(PG8_SB(0, 1), b2 + hstepB, voffB);
            PG8_WAIT_V(6); PG8_BAR; PG8_MMA(1, 1, At, B1); PG8_BAR;
            PG8_LDB(B0, 1, 0); PG8_SCHED; PG8_LDA(At, 1, 0); PG8_STAGE_A1(PG8_SA(0, 1), a2, last);
            PG8_WAIT_L(8); PG8_BAR; PG8_WAIT_L(0); PG8_MMA(0, 0, At, B0); PG8_BAR; PG8_SCHED;
            PG8_LDB(B1, 1, 1); PG8_STAGE(PG8_SB(1, 0), b3, voffB);
            PG8_BAR; PG8_WAIT_L(0); PG8_MMA(0, 1, At, B1); PG8_BAR;
            PG8_LDA(At, 1, 1); PG8_STAGE_A0(PG8_SA(1, 0), a3, last);
            PG8_BAR; PG8_WAIT_L(0); PG8_MMA(1, 0, At, B0); PG8_BAR; PG8_SCHED;
            PG8_STAGE(PG8_SB(1, 1), b3 + hstepB, voffB);
            PG8_WAIT_V(6); PG8_BAR; PG8_MMA(1, 1, At, B1); PG8_BAR;
            }
        }
        if constexpr (ALIGN_EPI) { if (wr == 0) PG8_BAR; }
        E(acc, cur, wr, wc, fr, fq); S.done(cur);
        if (!has_next) break;
#pragma unroll
        for (int a = 0; a < 2; ++a)
#pragma unroll
            for (int b = 0; b < 2; ++b)
#pragma unroll
                for (int m = 0; m < 4; ++m)
#pragma unroll
                    for (int n = 0; n < 2; ++n) acc[a][b][m][n] = (f32x4){0.f, 0.f, 0.f, 0.f};
        cur = nxt; cA = nA; cB = nB; ++ui;
        if constexpr (GATHER) { vc0[0] = vn0[0]; vc0[1] = vn0[1]; vc1[0] = vn1[0]; vc1[1] = vn1[1]; }
        if constexpr (ALIGN_EPI) { if (wr == 1) PG8_BAR; }
    }
    PG8_WAIT_V(0);
    if constexpr (!ALIGN_EPI) { if (wr == 0) PG8_BAR; }
    PG8_BAR;
#undef PG8_SA
#undef PG8_SB
#undef PG8_STAGE
#undef PG8_STAGE_A0
#undef PG8_STAGE_A1
#undef PG8_GIDX
#undef PG8_LDA
#undef PG8_LDB
#undef PG8_MMA
#undef PG8_WAIT_V
#undef PG8_WAIT_L
#undef PG8_BAR
#undef PG8_SCHED
}
}
#define GP_ALIGN true
#define GP_SP2 true

constexpr int DM = 1024, NB = 8, SEQ = 4096, CTXL = 256, TC = SEQ + CTXL  ;
constexpr int M0 = NB * TC  , M1 = NB * SEQ  ;
constexpr int NEXP = 16;
constexpr float RMS_EPS = 1e-6f;
constexpr int NCHUNK = 256;
constexpr int MAXTILES = 288;
constexpr int LCH = 68;

enum { I_X = 0, I_C, I_CTX, I_CCTX, I_ADAW, I_ADAB, I_N1G, I_N2G, I_FING, I_EVWIN, I_QNG, I_KVNG, I_WUQ, I_WUKV, I_LCW, I_LCB, I_LWA, I_LBA, I_LWX, I_LBX, I_LLAM, I_EVWOUT,
       I_ODWIN, I_HCW, I_HCB, I_HW1, I_HB1, I_HF1, I_HW2, I_HB2, I_HF2, I_HW3, I_HDEC, I_HSKIP, I_ODWOUT, I_RW, I_RB, I_MW1, I_MW3, I_MW2, N_IN };

constexpr size_t MiB = 1u << 20;
constexpr size_t WS_CTL = 0, CTL_ZERO_BYTES = 32768;
constexpr size_t WS_MOD = 1 * MiB;
constexpr size_t WS_RQ = WS_MOD + 2 * 9 * 6144 * 4;
constexpr size_t WS_RKV = WS_RQ + (size_t)M0 * 4;
constexpr size_t WS_A2 = 2 * MiB;
constexpr size_t WS_ROUTE_E = 3 * MiB;
constexpr size_t WS_ROUTE_W = WS_ROUTE_E + (size_t)M0 * 4;
constexpr size_t WS_ROUTE_S = WS_ROUTE_W + (size_t)M0 * 8;
constexpr size_t WS_CNT = WS_ROUTE_S + (size_t)M0 * 8;
constexpr size_t WS_TILEE = WS_CNT + 256 * 16 * 4;
static_assert(WS_TILEE + (MAXTILES + 64) * 4 <= 4 * MiB, "route region");
constexpr size_t WS_CP = 4 * MiB;
constexpr size_t WS_CS = WS_CP + (size_t)2 * 8 * LCH * 512 * 4;
static_assert(WS_CS + (size_t)2 * 8 * LCH * 512 * 4 <= 10 * MiB, "lru carries");
constexpr size_t WS_WIN = 10 * MiB;
constexpr size_t WS_WUQ = 14 * MiB;
constexpr size_t WS_WUKV = 15 * MiB;
constexpr size_t WS_WOUT = 16 * MiB;
constexpr size_t WS_WHIN = 18 * MiB;
constexpr size_t WS_WHOUT = 24 * MiB;
constexpr size_t WS_WG = 26 * MiB;
constexpr size_t WS_W13 = 27 * MiB;
constexpr size_t WS_W2 = 91 * MiB;
constexpr size_t WS_RH = 124 * MiB;
constexpr size_t WS_XC = 192 * MiB;
constexpr size_t X2_OFF = 64 * MiB;
constexpr size_t WS_R2 = 200 * MiB;
constexpr size_t WS_CQ = WS_R2;
constexpr size_t WS_CKV = WS_R2 + 26 * MiB;
constexpr size_t WS_UX = WS_R2 + 43 * MiB;
constexpr size_t WS_UG = WS_R2 + 77 * MiB;
constexpr size_t WS_Q = WS_R2 + 111 * MiB;
constexpr size_t WS_K = WS_R2 + 162 * MiB;
constexpr size_t WS_V = WS_R2 + 213 * MiB;
constexpr size_t WS_HPERM = WS_R2;
constexpr size_t WS_ACT = WS_R2 + 144 * MiB;
constexpr size_t WS_PT = WS_R2;
constexpr size_t WS_ZT = WS_R2 + 192 * MiB;
constexpr size_t WS_Z = WS_R2;
constexpr size_t WS_HSPEC = 456 * MiB;
constexpr size_t WS_X3 = 416 * MiB;
constexpr size_t WS_HIN = 488 * MiB;
constexpr size_t WS_SLOTTOK = 491 * MiB;
constexpr size_t WS_END = 492 * MiB;
static_assert(WS_V + (size_t)M0 * 512 * 2 <= WS_HSPEC && WS_ZT + (size_t)1024 * 32768 * 2 <= WS_HSPEC && WS_ACT + (size_t)73728 * 512 * 2 <= WS_HSPEC, "ws map");

constexpr int CW_TMO = 0, CW_BAR = 4096;

constexpr int RING_BYTES = 131072, LDS_BYTES = 155648, LDSCTL_OFF = LDS_BYTES - 1024, MISC_OFF = LDSCTL_OFF + 320;

#define XB_TMO      128
#define XB_XCNT(j)  (256  + 64 * (j))
#define XB_XSUB(j)  (1280 + 64 * (j))
#define XB_XGEN(j)  (2304 + 64 * (j))
#define XB_TOP      3328
#define XB_TOPGEN   3392
#define XCD_BAR_WORDS 3456
#define XB_SPIN_CAP (1u << 18)
__device__ __forceinline__ unsigned xb_ld(unsigned* p)              { return __hip_atomic_load(p, __ATOMIC_RELAXED, __HIP_MEMORY_SCOPE_AGENT); }
__device__ __forceinline__ unsigned xb_add(unsigned* p, unsigned v) { return __hip_atomic_fetch_add(p, v, __ATOMIC_RELAXED, __HIP_MEMORY_SCOPE_AGENT); }
__device__ __forceinline__ unsigned xb_xcc_id() { return (unsigned)__builtin_amdgcn_s_getreg((3 << 11) | 20) & 0xFu; }
#define XB_SPIN(cond, bar) do { unsigned _sp = 0; while (cond) { __builtin_amdgcn_s_sleep(1); \
    if ((++_sp & 255u) == 0u) { if (xb_ld(&(bar)[XB_TMO])) break; if (_sp > XB_SPIN_CAP) { atomicAdd(&(bar)[XB_TMO], 1u); break; } } } } while (0)
struct XcdBarrier { unsigned* bar; unsigned x; volatile LAS unsigned* st; };
__device__ __forceinline__ XcdBarrier xcd_barrier_post(unsigned* bar, volatile LAS unsigned* st) {
    XcdBarrier b; b.bar = bar; b.x = xb_xcc_id(); b.st = st;
    if (threadIdx.x == 0) (void)xb_add(&bar[XB_XCNT(b.x)], 1u);
    return b;
}
__device__ __forceinline__ void xcd_barrier_complete(unsigned* bar, unsigned x, unsigned& nloc, unsigned& nx) {
    const unsigned G = gridDim.x * gridDim.y * gridDim.z;
    unsigned sum, cnt, mine, sp = 0u;
    for (;;) {
        sum = 0u; cnt = 0u; mine = 0u;
#pragma unroll
        for (unsigned j = 0; j < 16; ++j) { const unsigned c = xb_ld(&bar[XB_XCNT(j)]); sum += c; cnt += (c > 0u) ? 1u : 0u; mine = (j == x) ? c : mine; }
        if (sum == G) break;
        __builtin_amdgcn_s_sleep(1);
        if ((++sp & 255u) == 0u) { if (xb_ld(&bar[XB_TMO])) break; if (sp > XB_SPIN_CAP) { atomicAdd(&bar[XB_TMO], 1u); break; } }
    }
    nloc = mine > 0u ? mine : 1u; nx = cnt > 0u ? cnt : 1u;
}
__device__ __forceinline__ void xcd_barrier(const XcdBarrier& b) {
    asm volatile("s_waitcnt vmcnt(0)" ::: "memory");
    __syncthreads();
    if (threadIdx.x == 0) {
        unsigned* bar = b.bar;
        __builtin_amdgcn_s_waitcnt(0);
        unsigned nloc = b.st[0], nx = b.st[1];
        if (nloc == 0u) { xcd_barrier_complete(bar, b.x, nloc, nx); b.st[0] = nloc; b.st[1] = nx; }
        const unsigned old = xb_add(&bar[XB_XSUB(b.x)], 1u);
        const unsigned gen = old / nloc;
        if (old + 1u == (gen + 1u) * nloc) {
            __builtin_amdgcn_fence(__ATOMIC_RELEASE, "agent");
            asm volatile("s_waitcnt vmcnt(0)" ::: "memory");
            const unsigned og = xb_add(&bar[XB_TOP], 1u);
            const unsigned tg = og / nx;
            if (og + 1u == (tg + 1u) * nx) xb_add(&bar[XB_TOPGEN], 1u);
            else XB_SPIN(xb_ld(&bar[XB_TOPGEN]) == tg, bar);
            __builtin_amdgcn_fence(__ATOMIC_ACQUIRE, "agent");
            xb_add(&bar[XB_XGEN(b.x)], 1u);
            asm volatile("s_waitcnt vmcnt(0)" ::: "memory");
        } else {
            XB_SPIN(xb_ld(&bar[XB_XGEN(b.x)]) == gen, bar);
            __builtin_amdgcn_fence(__ATOMIC_ACQUIRE, "agent");
            asm volatile("s_waitcnt vmcnt(0)" ::: "memory");
        }
    }
    __syncthreads();
}

struct Params { const float* in[N_IN]; float* out; unsigned char* ws; int ph_lo, ph_hi; };
typedef const __attribute__((address_space(4))) Params* ParamsK;
__device__ __forceinline__ Params load_params() {
#if defined(__HIP_DEVICE_COMPILE__)
    unsigned long long v = (unsigned long long)__builtin_amdgcn_kernarg_segment_ptr(); asm volatile("" : "+s"(v)); return *(ParamsK)v;
#else
    return Params{};
#endif
}

__device__ __forceinline__ u32x4 pack8(const f32x4 a, const f32x4 b) {
    u32x4 w; w.x = pg8::cvt_pk_bf16(a[0], a[1]); w.y = pg8::cvt_pk_bf16(a[2], a[3]); w.z = pg8::cvt_pk_bf16(b[0], b[1]); w.w = pg8::cvt_pk_bf16(b[2], b[3]); return w;
}
__device__ __forceinline__ void rope8(f32x4& v0, f32x4& v1, int fq, int tt  , bool on) {
    const int axis = fq >> 1, half = fq & 1; const float pos = (float)(axis == 0 ? (tt >> 6) : (tt & 63)) * 0.15915494309189535f;
    constexpr float IF[8] = {1.0f, 0.316227766f, 0.1f, 0.0316227766f, 0.01f, 0.00316227766f, 0.001f, 0.000316227766f};
#pragma unroll
    for (int i = 0; i < 4; ++i) {
        { const float x = v0[i], other = __shfl_xor(x, 16); const float sn = __builtin_amdgcn_sinf(pos * IF[i]), cs = __builtin_amdgcn_cosf(pos * IF[i]);
          const float r = half == 0 ? x * cs - other * sn : other * sn + x * cs; v0[i] = on ? r : x; }
        { const float x = v1[i], other = __shfl_xor(x, 16); const float sn = __builtin_amdgcn_sinf(pos * IF[4 + i]), cs = __builtin_amdgcn_cosf(pos * IF[4 + i]);
          const float r = half == 0 ? x * cs - other * sn : other * sn + x * cs; v1[i] = on ? r : x; }
    }
}

struct EpiIn {
    static constexpr bool PERM = true;
    bf16 *CQ, *CKV, *UX, *UG, *KB;
    __device__ __forceinline__ void operator()(const f32x4 (&acc)[2][2][4][2], const pg8::Unit& u, int wr, int wc, int fr, int fq) const {
        const int row0 = u.pm * 256 + wr * 64 + fr;
        const bool is_ctx = (u.pm % 17) == 0; const int bb = u.pm / 17;
#pragma unroll
        for (int bj = 0; bj < 2; ++bj) {
            const int blk = u.pn * 2 + bj;
            if (blk < 13) {
                bf16* dst; int ld, cb;
                if (blk < 3) { dst = CQ; ld = 384; cb = blk * 128; }
                else if (blk < 5) { dst = CKV; ld = 256; cb = (blk - 3) * 128; }
                else if (blk < 9) { dst = UX; ld = 512; cb = (blk - 5) * 128; }
                else { dst = UG; ld = 512; cb = (blk - 9) * 128; }
                const int col = cb + wc * 32 + 8 * fq;
#pragma unroll
                for (int ai = 0; ai < 2; ++ai)
#pragma unroll
                    for (int m = 0; m < 4; ++m) { const int row = row0 + ai * 128 + m * 16;
                        *(u32x4*)(dst + (size_t)row * ld + col) = pack8(acc[ai][bj][m][0], acc[ai][bj][m][1]); }
            } else if (wc == 0) {
#pragma unroll
                for (int ai = 0; ai < 2; ++ai)
#pragma unroll
                    for (int m = 0; m < 4; ++m) { const int row = row0 + ai * 128 + m * 16; const int tt = row - bb * TC - CTXL;
                        f32x4 v0 = acc[ai][bj][m][0], v1 = acc[ai][bj][m][1];
                        rope8(v0, v1, fq, tt, !is_ctx);
                        const u32x4 w = pack8(v0, v1);
#pragma unroll
                        for (int h = 0; h < 8; ++h) *(u32x4*)(KB + (size_t)row * 768 + h * 96 + 64 + 8 * fq) = w; }
            }
        }
    }
};
struct EpiQ {
    static constexpr bool PERM = true;
    bf16* Q; const float* rq;
    __device__ __forceinline__ void operator()(const f32x4 (&acc)[2][2][4][2], const pg8::Unit& u, int wr, int wc, int fr, int fq) const {
        const int row0 = u.pm * 256 + wr * 64 + fr;
#pragma unroll
        for (int ai = 0; ai < 2; ++ai)
#pragma unroll
            for (int m = 0; m < 4; ++m) { const int row = row0 + ai * 128 + m * 16; const float s = rq[row];
#pragma unroll
                for (int bj = 0; bj < 2; ++bj) {
                    const u32x4 w = pack8(acc[ai][bj][m][0] * s, acc[ai][bj][m][1] * s);
                    int off;
                    if (u.pn < 2) { const int c = u.pn * 256 + bj * 128 + wc * 32 + 8 * fq; off = (c >> 6) * 96 + (c & 63); }
                    else off = (4 * bj + wc) * 96 + 64 + 8 * fq;
                    *(u32x4*)(Q + (size_t)row * 768 + off) = w;
                } }
    }
};
struct EpiKV {
    static constexpr bool PERM = true;
    bf16 *K, *V; const float* rkv;
    __device__ __forceinline__ void operator()(const f32x4 (&acc)[2][2][4][2], const pg8::Unit& u, int wr, int wc, int fr, int fq) const {
        const int row0 = u.pm * 256 + wr * 64 + fr;
#pragma unroll
        for (int ai = 0; ai < 2; ++ai)
#pragma unroll
            for (int m = 0; m < 4; ++m) { const int row = row0 + ai * 128 + m * 16; const float s = rkv[row];
#pragma unroll
                for (int bj = 0; bj < 2; ++bj) { const int h = u.pn * 2 + bj;
                    const u32x4 w = pack8(acc[ai][bj][m][0] * s, acc[ai][bj][m][1] * s);
                    if (wc < 2) *(u32x4*)(K + (size_t)row * 768 + h * 96 + wc * 32 + 8 * fq) = w;
                    else *(u32x4*)(V + (size_t)row * 512 + h * 64 + (wc - 2) * 32 + 8 * fq) = w; } }
    }
};
template <int LAYER> struct EpiRes {
    static constexpr bool PERM = true;
    const float *x, *ctx, *mod; const bf16* xin; bf16 *xout, *xc;
    __device__ __forceinline__ void operator()(const f32x4 (&acc)[2][2][4][2], const pg8::Unit& u, int wr, int wc, int fr, int fq) const {
        const int row0 = u.pm * 256 + wr * 64 + fr, col0 = u.pn * 256 + wc * 32 + 8 * fq;
        const bool is_ctx = LAYER == 0 && (u.pm % 17) == 0; const int bb = LAYER == 0 ? u.pm / 17 : u.pm / 16;
        const float* g = mod + (size_t)(LAYER * 9 + (is_ctx ? 8 : bb)) * 6144 + 2048;
        f32x4 gv[2][2];
#pragma unroll
        for (int bj = 0; bj < 2; ++bj)
#pragma unroll
            for (int n = 0; n < 2; ++n) gv[bj][n] = *(const f32x4*)(g + col0 + bj * 128 + n * 4);
#pragma unroll
        for (int ai = 0; ai < 2; ++ai)
#pragma unroll
            for (int m = 0; m < 4; ++m) { const int row = row0 + ai * 128 + m * 16;
                if (LAYER == 0) { const int t = row - bb * TC; const float* res; bf16* dst;
                    if (is_ctx) { res = ctx + (size_t)(bb * CTXL + t) * DM; dst = xc + (size_t)(bb * CTXL + t) * DM; }
                    else { res = x + (size_t)(bb * SEQ + t - CTXL) * DM; dst = xout + (size_t)(bb * SEQ + t - CTXL) * DM; }
#pragma unroll
                    for (int bj = 0; bj < 2; ++bj) { const int c = col0 + bj * 128;
                        const f32x4 r0 = *(const f32x4*)(res + c), r1 = *(const f32x4*)(res + c + 4);
                        *(u32x4*)(dst + c) = pack8(r0 + gv[bj][0] * acc[ai][bj][m][0], r1 + gv[bj][1] * acc[ai][bj][m][1]); } }
                else {
#pragma unroll
                    for (int bj = 0; bj < 2; ++bj) { const int c = col0 + bj * 128; const u32x4 q = *(const u32x4*)(xin + (size_t)row * DM + c);
                        const f32x4 r0 = {bflo(q.x), bfhi(q.x), bflo(q.y), bfhi(q.y)}, r1 = {bflo(q.z), bfhi(q.z), bflo(q.w), bfhi(q.w)};
                        *(u32x4*)(xout + (size_t)row * DM + c) = pack8(r0 + gv[bj][0] * acc[ai][bj][m][0], r1 + gv[bj][1] * acc[ai][bj][m][1]); } } }
    }
};
struct EpiMoe1 {
    static constexpr bool PERM = true;
    bf16* ACT;
    __device__ __forceinline__ void operator()(const f32x4 (&acc)[2][2][4][2], const pg8::Unit& u, int wr, int wc, int fr, int fq) const {
        const int row0 = u.pm * 256 + wr * 64 + fr, col = u.pn * 128 + wc * 32 + 8 * fq;
#pragma unroll
        for (int ai = 0; ai < 2; ++ai)
#pragma unroll
            for (int m = 0; m < 4; ++m) { const int row = row0 + ai * 128 + m * 16;
                f32x4 r[2];
#pragma unroll
                for (int n = 0; n < 2; ++n)
#pragma unroll
                    for (int i = 0; i < 4; ++i) { const float a = acc[ai][0][m][n][i], b = acc[ai][1][m][n][i]; r[n][i] = a / (1.f + __expf(-a)) * b; }
                *(u32x4*)(ACT + (size_t)row * 512 + col) = pack8(r[0], r[1]); }
    }
};
struct EpiStore {
    static constexpr bool PERM = true;
    bf16* O; int ldc;
    __device__ __forceinline__ void operator()(const f32x4 (&acc)[2][2][4][2], const pg8::Unit& u, int wr, int wc, int fr, int fq) const {
        const int row0 = u.pm * 256 + wr * 64 + fr, col0 = u.pn * 256 + wc * 32 + 8 * fq;
#pragma unroll
        for (int ai = 0; ai < 2; ++ai)
#pragma unroll
            for (int m = 0; m < 4; ++m) { bf16* rowp = O + (size_t)(row0 + ai * 128 + m * 16) * ldc + col0;
#pragma unroll
                for (int bj = 0; bj < 2; ++bj) *(u32x4*)(rowp + bj * 128) = pack8(acc[ai][bj][m][0], acc[ai][bj][m][1]); }
    }
};

__device__ __forceinline__ void cvt_item(const float* W, int ldw, int col0, const float* gk, bf16* WTrow0, int ldk, int k0, float* scr, int lane) {
    if (col0 >= 0) {
        float v[32];
#pragma unroll
        for (int i = 0; i < 32; ++i) v[i] = W[(size_t)(k0 + 2 * i + (lane >> 5)) * ldw + col0 + (lane & 31)];
        if (gk) {
#pragma unroll
            for (int i = 0; i < 32; ++i) v[i] *= gk[k0 + 2 * i + (lane >> 5)];
        }
#pragma unroll
        for (int i = 0; i < 32; ++i) scr[(2 * i + (lane >> 5)) * 33 + (lane & 31)] = v[i];
    } else {
#pragma unroll 8
        for (int i = 0; i < 32; ++i) { const int kk = 2 * i + (lane >> 5); scr[kk * 33 + (lane & 31)] = 0.f; }
    }
    LDS_WAIT(); asm volatile("" ::: "memory");
    const int c = lane & 7;
#pragma unroll
    for (int j = 0; j < 4; ++j) { const int n = (lane >> 3) + 8 * j; const float* s = scr + (8 * c) * 33 + n;
        u32x4 o; o.x = pk2(s[0 * 33], s[1 * 33]); o.y = pk2(s[2 * 33], s[3 * 33]); o.z = pk2(s[4 * 33], s[5 * 33]); o.w = pk2(s[6 * 33], s[7 * 33]);
        *(u32x4*)(WTrow0 + (size_t)n * ldk + k0 + 8 * c) = o; }
    LDS_WAIT(); asm volatile("" ::: "memory");
}

__device__ __forceinline__ void phase_prologue(const Params& P, unsigned char* lds, int tid, int lane, int wave, int G) {
    unsigned char* ws = P.ws;
    __syncthreads();
    {
        float* sl = (float*)lds;
        float* red = (float*)(lds + 40960);
        float* mod = (float*)(ws + WS_MOD);
        bool loaded = false;
        for (int u = blockIdx.x; u < 192; u += G) {
            if (!loaded) { for (int i = tid; i < 9 * 1024; i += 512) { const float v = i < 8192 ? P.in[I_C][i] : P.in[I_CCTX][i - 8192]; sl[i] = v / (1.f + expf(-v)); } loaded = true; __syncthreads(); }
            const int l = u / 96, col = (u % 96) * 64 + lane;
            const float* W = P.in[I_ADAW] + (size_t)l * 1024 * 6144 + col;
            float a[9];
#pragma unroll
            for (int b = 0; b < 9; ++b) a[b] = 0.f;
            const int kb = wave * 128;
#pragma unroll 16
            for (int k = 0; k < 128; ++k) { const float w = W[(size_t)(kb + k) * 6144];
#pragma unroll
                for (int b = 0; b < 9; ++b) a[b] += sl[b * 1024 + kb + k] * w; }
#pragma unroll
            for (int b = 0; b < 9; ++b) red[(wave * 9 + b) * 64 + lane] = a[b];
            __syncthreads();
            for (int i = tid; i < 9 * 64; i += 512) { const int b = i >> 6, cc = i & 63; float s = 0.f;
#pragma unroll
                for (int w = 0; w < 8; ++w) s += red[(w * 9 + b) * 64 + cc];
                const int c2 = (u % 96) * 64 + cc;
                mod[(size_t)(l * 9 + b) * 6144 + c2] = s + P.in[I_ADAB][l * 6144 + c2]; }
            __syncthreads();
        }
        __syncthreads();
    }
    {
        float* scr = (float*)(lds + wave * 16384);
        const int gw = blockIdx.x * 8 + wave, NGW = G * 8;
        constexpr int I_WIN = 16 * 56, I_UQ = 6 * 24, I_UKV = 4 * 32, I_OUT = 16 * 32, I_HIN = 16 * 96, I_HOUT = 16 * 32, I_WG = 64, I_M13 = 32 * 512, I_M2 = 32 * 256;
        constexpr int NITEMS = I_WIN + I_UQ + I_UKV + I_OUT + I_HIN + I_HOUT + I_WG + I_M13 + I_M2;
        for (int it = gw; it < NITEMS; it += NGW) {
            int r = it;
            if (r < I_M13) { const int le = r >> 9, q = r & 511, kb = q >> 5, nb = q & 31, n0 = 32 * nb, pn = n0 >> 8, j = n0 & 255;
                const float* src = (j < 128 ? P.in[I_MW1] : P.in[I_MW3]) + (size_t)le * 1024 * 512;
                cvt_item(src, 512, 128 * pn + (j & 127), nullptr, (bf16*)(ws + WS_W13) + ((size_t)le * 1024 + n0) * 1024, 1024, 64 * kb, scr, lane); continue; } r -= I_M13;
            if (r < I_M2) { const int le = r >> 8, q = r & 255, kb = q >> 5, nb = q & 31, n0 = 32 * nb;
                cvt_item(P.in[I_MW2] + (size_t)le * 512 * 1024, 1024, n0, nullptr, (bf16*)(ws + WS_W2) + ((size_t)le * 1024 + n0) * 512, 512, 64 * kb, scr, lane); continue; } r -= I_M2;
            if (r < I_WIN) { const int kb = r / 56, nb = r % 56, n0 = 32 * nb; const int col0 = n0 < 640 ? n0 : (n0 < 1664 ? n0 + 32 : (n0 < 1696 ? n0 - 1024 : -1));
                cvt_item(P.in[I_EVWIN], 1696, col0, nullptr, (bf16*)(ws + WS_WIN) + (size_t)n0 * 1024, 1024, 64 * kb, scr, lane); continue; } r -= I_WIN;
            if (r < I_UQ) { const int kb = r / 24, nb = r % 24, n0 = 32 * nb; const int col0 = n0 < 512 ? (n0 >> 6) * 96 + (n0 & 63) : ((n0 - 512) >> 5) * 96 + 64;
                cvt_item(P.in[I_WUQ], 768, col0, P.in[I_QNG], (bf16*)(ws + WS_WUQ) + (size_t)n0 * 384, 384, 64 * kb, scr, lane); continue; } r -= I_UQ;
            if (r < I_UKV) { const int kb = r / 32, nb = r % 32, n0 = 32 * nb;
                cvt_item(P.in[I_WUKV], 1024, n0, P.in[I_KVNG], (bf16*)(ws + WS_WUKV) + (size_t)n0 * 256, 256, 64 * kb, scr, lane); continue; } r -= I_UKV;
            if (r < I_OUT) { const int kb = r / 32, nb = r % 32, n0 = 32 * nb;
                cvt_item(P.in[I_EVWOUT], 1024, n0, nullptr, (bf16*)(ws + WS_WOUT) + (size_t)n0 * 1024, 1024, 64 * kb, scr, lane); continue; } r -= I_OUT;
            if (r < I_HIN) { const int kb = r / 96, nb = r % 96, n0 = 32 * nb;
                cvt_item(P.in[I_ODWIN], 3072, n0, nullptr, (bf16*)(ws + WS_WHIN) + (size_t)n0 * 1024, 1024, 64 * kb, scr, lane); continue; } r -= I_HIN;
            if (r < I_HOUT) { const int kb = r / 32, nb = r % 32, n0 = 32 * nb;
                cvt_item(P.in[I_ODWOUT], 1024, n0, nullptr, (bf16*)(ws + WS_WHOUT) + (size_t)n0 * 1024, 1024, 64 * kb, scr, lane); continue; } r -= I_HOUT;
            { const int mat = r >> 1, nb = r & 1, d = mat >> 4, gsel = (mat >> 3) & 1, h = mat & 7;
                const float* src = (gsel ? P.in[I_LWX] : P.in[I_LWA]) + (size_t)(d * 8 + h) * 4096;
                cvt_item(src, 64, 32 * nb, nullptr, (bf16*)(ws + WS_WG) + (size_t)(h * 256 + d * 128 + gsel * 64 + 32 * nb) * 64, 64, 0, scr, lane); }
        }
    }
    {
        const int gw = blockIdx.x * 8 + wave, NGW = G * 8;
        float* a2 = (float*)(ws + WS_A2);
        const float *w1 = P.in[I_HW1], *b1 = P.in[I_HB1], *f1 = P.in[I_HF1], *w2 = P.in[I_HW2], *b2 = P.in[I_HB2], *f2 = P.in[I_HF2];
        for (int t = gw; t < 4096; t += NGW) {
            const float tl = (float)t / 4095.f, w = (6.283185307179586f / 4096.f) * (float)t;
            float zi = 0.f;
            if (lane == 0) zi = tl;
            else if (lane <= 16) { const float f = 1e-4f + (float)(lane - 1) * ((15.f - 1e-4f) / 15.f); zi = cosf(f * w); }
            else if (lane <= 32) { const float f = 1e-4f + (float)(lane - 17) * ((15.f - 1e-4f) / 15.f); zi = -sinf(f * w); }
            float acc = b1[lane];
            for (int i = 0; i < 33; ++i) acc += __shfl(zi, i) * w1[i * 64 + lane];
            const float a1 = sinf(f1[lane] * acc);
            float acc2 = b2[lane];
            for (int i = 0; i < 64; ++i) acc2 += __shfl(a1, i) * w2[i * 64 + lane];
            a2[(size_t)lane * 4096 + t] = sinf(f2[lane] * acc2);
        }
    }
}

__device__ __forceinline__ void store_row_bf16(bf16* orow, const f32x4 (&v)[4], int lane) {
    unsigned long long* o8 = (unsigned long long*)orow + lane;
#pragma unroll
    for (int j = 0; j < 4; ++j) o8[64 * j] = (unsigned long long)pk2(v[j][0], v[j][1]) | ((unsigned long long)pk2(v[j][2], v[j][3]) << 32);
}
__device__ __forceinline__ void load_xrow(const bf16* row, int lane, u32x2 (&q)[4]) {
#pragma unroll
    for (int j = 0; j < 4; ++j) q[j] = ((const u32x2*)row)[lane + 64 * j];
}
__device__ __forceinline__ void cvt_xrow(const u32x2 (&q)[4], f32x4 (&v)[4]) {
#pragma unroll
    for (int j = 0; j < 4; ++j) v[j] = (f32x4){bflo(q[j].x), bfhi(q[j].x), bflo(q[j].y), bfhi(q[j].y)};
}
__device__ __forceinline__ void norm_mod(f32x4 (&v)[4], const float* g, const float* sh, const float* sc, int lane) {
    float ss = 0.f;
#pragma unroll
    for (int j = 0; j < 4; ++j) ss += (v[j][0] * v[j][0] + v[j][1] * v[j][1]) + (v[j][2] * v[j][2] + v[j][3] * v[j][3]);
    const float rr = rsqrtf(wave_sum(ss) * (1.f / 1024.f) + RMS_EPS);
#pragma unroll
    for (int j = 0; j < 4; ++j) { const f32x4 gg = ((const f32x4*)g)[lane + 64 * j], s1 = ((const f32x4*)sc)[lane + 64 * j], s0 = ((const f32x4*)sh)[lane + 64 * j];
        v[j] = (v[j] * rr * gg) * (1.f + s1) + s0; }
}
struct CombIdx { int s0, s1; float w0, w1; };
struct CombData { u32x2 x[4], y0[4], y1[4]; };
__device__ __forceinline__ void comb_load_idx(const int* rs, const float* rw, int r, CombIdx& I) { I.s0 = rs[2 * r]; I.s1 = rs[2 * r + 1]; I.w0 = rw[2 * r]; I.w1 = rw[2 * r + 1]; }
__device__ __forceinline__ void comb_load_data(const bf16* xrow, const bf16* Y, const CombIdx& I, int lane, CombData& D) {
    const u32x2* y0 = (const u32x2*)(Y + (size_t)I.s0 * 1024) + lane; const u32x2* y1 = (const u32x2*)(Y + (size_t)I.s1 * 1024) + lane;
#pragma unroll
    for (int j = 0; j < 4; ++j) { D.x[j] = ((const u32x2*)xrow)[lane + 64 * j]; D.y0[j] = y0[64 * j]; D.y1[j] = y1[64 * j]; }
}
__device__ __forceinline__ void comb_apply(f32x4 (&v)[4], const CombData& D, const CombIdx& I, const float* g2, int lane) {
#pragma unroll
    for (int j = 0; j < 4; ++j) { const u32x2 a = D.y0[j], b = D.y1[j]; const f32x4 gg = ((const f32x4*)g2)[lane + 64 * j];
        f32x4 m; m[0] = I.w0 * bflo(a.x) + I.w1 * bflo(b.x); m[1] = I.w0 * bfhi(a.x) + I.w1 * bfhi(b.x); m[2] = I.w0 * bflo(a.y) + I.w1 * bflo(b.y); m[3] = I.w0 * bfhi(a.y) + I.w1 * bfhi(b.y);
        v[j] = (f32x4){bflo(D.x[j].x), bfhi(D.x[j].x), bflo(D.x[j].y), bfhi(D.x[j].y)} + gg * m; }
}
__device__ __forceinline__ float route_scores(const f32x4 (&v)[4], const float* rwT  , int lane) {
    float p[16];
#pragma unroll
    for (int e = 0; e < 16; ++e) { f32x2 a2 = {0.f, 0.f};
#pragma unroll
        for (int j = 0; j < 4; ++j) { const f32x4 w = ((const f32x4*)(rwT + e * 1024))[lane + 64 * j];
            a2 = __builtin_elementwise_fma((f32x2){v[j][0], v[j][1]}, (f32x2){w[0], w[1]}, a2); a2 = __builtin_elementwise_fma((f32x2){v[j][2], v[j][3]}, (f32x2){w[2], w[3]}, a2); }
        p[e] = a2[0] + a2[1]; }
    const bool h32 = lane & 32, h16 = lane & 16, h8 = lane & 8, h4 = lane & 4;
    float q8[8], q4[4], q2[2], q1;
#pragma unroll
    for (int e = 0; e < 8; ++e) { const float send = h32 ? p[e] : p[e + 8], keep = h32 ? p[e + 8] : p[e]; q8[e] = keep + __shfl_xor(send, 32); }
#pragma unroll
    for (int e = 0; e < 4; ++e) { const float send = h16 ? q8[e] : q8[e + 4], keep = h16 ? q8[e + 4] : q8[e]; q4[e] = keep + __shfl_xor(send, 16); }
#pragma unroll
    for (int e = 0; e < 2; ++e) { const float send = h8 ? q4[e] : q4[e + 2], keep = h8 ? q4[e + 2] : q4[e]; q2[e] = keep + __shfl_xor(send, 8); }
    { const float send = h4 ? q2[0] : q2[1], keep = h4 ? q2[1] : q2[0]; q1 = keep + __shfl_xor(send, 4); }
    q1 += __shfl_xor(q1, 1); q1 += __shfl_xor(q1, 2);
    return __builtin_amdgcn_rcpf(1.f + __expf(-q1));
}
__device__ __forceinline__ void route_select(const float (&s)[16], const float* rb, int& e0o, int& e1o, float& w0o, float& w1o) {
    float sel[16];
#pragma unroll
    for (int e = 0; e < 16; ++e) sel[e] = s[e] + rb[e];
    float gbest = -1e30f; int gi = 0;
#pragma unroll
    for (int g = 0; g < 4; ++g) { float m1 = -1e30f, m2 = -1e30f;
#pragma unroll
        for (int i = 0; i < 4; ++i) { const float x = sel[4 * g + i]; if (x > m1) { m2 = m1; m1 = x; } else if (x > m2) m2 = x; }
        const float gs = m1 + m2; if (gs > gbest) { gbest = gs; gi = g; } }
    float b0 = -1e30f, b1 = -1e30f; int e0 = 0, e1 = 0; float s0 = 0.f, s1 = 0.f;
#pragma unroll
    for (int e = 0; e < 16; ++e) { const bool in = (e >> 2) == gi; const float x = sel[e];
        if (in && x > b0) { b1 = b0; e1 = e0; s1 = s0; b0 = x; e0 = e; s0 = s[e]; } else if (in && x > b1) { b1 = x; e1 = e; s1 = s[e]; } }
    e0o = e0; e1o = e1; const float den = s0 + s1; w0o = s0 / den; w1o = s1 / den;
}

__device__ __forceinline__ const float* l0_row_ptr(const Params& P, int row) {
    const int b = row / TC, t = row - b * TC;
    return t < CTXL ? P.in[I_CTX] + (size_t)(b * CTXL + t) * DM : P.in[I_X] + (size_t)(b * SEQ + t - CTXL) * DM;
}
__device__ __forceinline__ const bf16* l0_xrow_ptr(const Params& P, int row) {
    const int b = row / TC, t = row - b * TC;
    return t < CTXL ? (const bf16*)(P.ws + WS_XC) + (size_t)(b * CTXL + t) * DM : (const bf16*)P.out + (size_t)(b * SEQ + t - CTXL) * DM;
}
__device__ __forceinline__ void phase_norm1_l0(const Params& P, int lane, int wave, int G) {
    const float* mod = (const float*)(P.ws + WS_MOD); bf16* H = (bf16*)(P.ws + WS_RH);
    int row = blockIdx.x * 8 + wave; if (row >= M0) return;
    f32x4 nx[4];
    { const float* xr = l0_row_ptr(P, row);
#pragma unroll
      for (int j = 0; j < 4; ++j) nx[j] = ((const f32x4*)xr)[lane + 64 * j]; }
    for (; row < M0; row += G * 8) {
        f32x4 v[4];
#pragma unroll
        for (int j = 0; j < 4; ++j) v[j] = nx[j];
        if (row + G * 8 < M0) { const float* xr = l0_row_ptr(P, row + G * 8);
#pragma unroll
            for (int j = 0; j < 4; ++j) nx[j] = ((const f32x4*)xr)[lane + 64 * j]; }
        const int b = row / TC, t = row - b * TC;
        const float* md = mod + (size_t)(t < CTXL ? 8 : b) * 6144;
        norm_mod(v, P.in[I_N1G], md, md + 1024, lane);
        store_row_bf16(H + (size_t)row * DM, v, lane);
    }
}
template <int LAYER> __device__ __forceinline__ void phase_norm2_route(const Params& P, unsigned char* lds, int tid, int lane, int wave, int G) {
    constexpr int ROWS = LAYER == 0 ? 136 : 128;
    float* rwT = (float*)lds;
    int* cntl = (int*)(lds + 65536);
    float* slog = (float*)(lds + 65536 + 1024) + wave * (17 * 16);
    const float* mod = (const float*)(P.ws + WS_MOD) + (size_t)LAYER * 9 * 6144; bf16* H = (bf16*)(P.ws + WS_RH);
    int* route_e = (int*)(P.ws + WS_ROUTE_E); float* route_w = (float*)(P.ws + WS_ROUTE_W); int* cnt = (int*)(P.ws + WS_CNT);
    for (int i = tid; i < 16384; i += 512) { const int k = i >> 4, e = i & 15; rwT[e * 1024 + k] = P.in[I_RW][i]; }
    for (int ch = blockIdx.x; ch < NCHUNK; ch += G) {
        if (tid < 16) cntl[tid] = 0;
        __syncthreads();
        u32x2 nx[4];
        { const int row = ch * ROWS + wave; load_xrow(LAYER == 0 ? l0_xrow_ptr(P, row) : (const bf16*)(P.ws + WS_X3) + (size_t)row * DM, lane, nx); }
        for (int rl = wave; rl < ROWS; rl += 8) {
            const int row = ch * ROWS + rl; const float* md;
            if (LAYER == 0) { const int b = row / TC, t = row - b * TC; md = mod + (size_t)(t < CTXL ? 8 : b) * 6144; }
            else md = mod + (size_t)(row >> 12) * 6144;
            f32x4 v[4]; cvt_xrow(nx, v);
            if (rl + 8 < ROWS) load_xrow(LAYER == 0 ? l0_xrow_ptr(P, row + 8) : (const bf16*)(P.ws + WS_X3) + (size_t)(row + 8) * DM, lane, nx);
            norm_mod(v, P.in[I_N2G] + LAYER * 1024, md + 3072, md + 4096, lane);
            store_row_bf16(H + (size_t)row * DM, v, lane);
            const float sl = route_scores(v, rwT, lane);
            if ((lane & 3) == 0) slog[(rl >> 3) * 16 + 8 * ((lane >> 5) & 1) + 4 * ((lane >> 4) & 1) + 2 * ((lane >> 3) & 1) + ((lane >> 2) & 1)] = sl;
        }
        LDS_WAIT();
        if (lane < (ROWS - wave + 7) / 8) {
            const int rl = wave + 8 * lane, row = ch * ROWS + rl;
            float sc[16];
#pragma unroll
            for (int e = 0; e < 16; ++e) sc[e] = slog[lane * 16 + e];
            int e0, e1; float w0, w1; route_select(sc, P.in[I_RB], e0, e1, w0, w1);
            route_e[row] = e0 | (e1 << 8); route_w[2 * row] = w0; route_w[2 * row + 1] = w1; atomicAdd(&cntl[e0], 1); atomicAdd(&cntl[e1], 1);
        }
        __syncthreads();
        if (tid < 16) cnt[ch * 16 + tid] = cntl[tid];
        __syncthreads();
    }
}
template <int LAYER> __device__ __forceinline__ void phase_permute(const Params& P, unsigned char* lds, int tid, int lane, int wave, int G) {
    constexpr int ROWS = LAYER == 0 ? 136 : 128;
    int* part_tot = (int*)lds;
    int* part_base = part_tot + 512;
    int* slot0 = part_base + 512;
    int* loc = slot0 + 16;
    int* slots = loc + 16;
    int* tstart = slots + 2 * 136;
    int* rel = tstart + 32;
    int* etot = rel + 136;
    const int* cnt = (const int*)(P.ws + WS_CNT); const int* route_e = (const int*)(P.ws + WS_ROUTE_E); int* route_s = (int*)(P.ws + WS_ROUTE_S);
    int* tile_e = (int*)(P.ws + WS_TILEE); int* slot_tok = (int*)(P.ws + WS_SLOTTOK);
    for (int ch = blockIdx.x; ch < NCHUNK; ch += G) {
        { const int e = tid & 15, part = tid >> 4; int tot = 0, bs = 0;
#pragma unroll
          for (int i = 0; i < 8; ++i) { const int c = part * 8 + i; const int x = cnt[c * 16 + e]; tot += x; bs += (c < ch) ? x : 0; }
          part_tot[part * 16 + e] = tot; part_base[part * 16 + e] = bs; }
        if (tid < ROWS) rel[tid] = route_e[ch * ROWS + tid];
        __syncthreads();
        if (tid == 0) {
            int ts = 0;
            for (int e = 0; e < 16; ++e) { int tot = 0, bs = 0; for (int p = 0; p < 32; ++p) { tot += part_tot[p * 16 + e]; bs += part_base[p * 16 + e]; }
                tstart[e] = ts; slot0[e] = ts * 256 + bs; loc[e] = 0; etot[e] = tot; ts += (tot + 255) >> 8; }
            tstart[16] = ts;
            if (ch == 0) { for (int e = 0; e < 16; ++e) for (int i = tstart[e]; i < tstart[e + 1]; ++i) tile_e[i] = e; tile_e[MAXTILES] = ts; }
            for (int rl = 0; rl < ROWS; ++rl) { const int row = ch * ROWS + rl; const int ee = rel[rl]; const int e0 = ee & 255, e1 = ee >> 8;
                const int s0 = slot0[e0] + loc[e0]; loc[e0] = loc[e0] + 1; const int s1 = slot0[e1] + loc[e1]; loc[e1] = loc[e1] + 1;
                slots[2 * rl] = s0; slots[2 * rl + 1] = s1; route_s[2 * row] = s0; route_s[2 * row + 1] = s1; }
        }
        __syncthreads();
        if (tid < 2 * ROWS) slot_tok[slots[tid]] = ch * ROWS + (tid >> 1);
        if (ch == 0) {
            for (int e = 0; e < 16; ++e) { const int lo = tstart[e] * 256 + etot[e], hi = tstart[e + 1] * 256; for (int sidx = lo + tid; sidx < hi; sidx += 512) slot_tok[sidx] = 0; }
        }
        __syncthreads();
    }
}
__device__ __forceinline__ void phase_combine_norm1_l1(const Params& P, int lane, int wave, int G) {
    const float* mod = (const float*)(P.ws + WS_MOD); bf16* H = (bf16*)(P.ws + WS_RH); const bf16* Y = (const bf16*)(P.ws + WS_HPERM);
    const int* rs = (const int*)(P.ws + WS_ROUTE_S); const float* rw = (const float*)(P.ws + WS_ROUTE_W);
    const bf16* X1 = (const bf16*)P.out; bf16* X2 = (bf16*)((unsigned char*)P.out + X2_OFF);
    const int st = G * 8; int row = blockIdx.x * 8 + wave; if (row >= M1) return;
#define L0ROW(r) (((r) >> 12) * TC + CTXL + ((r) & 4095))
    CombIdx ic, in; CombData dc, dn;
    comb_load_idx(rs, rw, L0ROW(row), ic); comb_load_data(X1 + (size_t)row * DM, Y, ic, lane, dc);
    { const int r1 = row + st < M1 ? row + st : row; comb_load_idx(rs, rw, L0ROW(r1), in); }
    for (; row < M1; row += st) {
        const int r1 = row + st < M1 ? row + st : row, r2 = row + 2 * st < M1 ? row + 2 * st : r1;
        comb_load_data(X1 + (size_t)r1 * DM, Y, in, lane, dn);
        CombIdx i2; comb_load_idx(rs, rw, L0ROW(r2), i2);
        const int b = row >> 12;
        f32x4 v[4]; comb_apply(v, dc, ic, mod + (size_t)b * 6144 + 5120, lane);
        store_row_bf16(X2 + (size_t)row * DM, v, lane);
        const float* md = mod + (size_t)(9 + b) * 6144;
        norm_mod(v, P.in[I_N1G] + 1024, md, md + 1024, lane);
        store_row_bf16(H + (size_t)row * DM, v, lane);
        dc = dn; ic = in; in = i2;
    }
#undef L0ROW
}
__device__ __forceinline__ void phase_final(const Params& P, int lane, int wave, int G) {
    const float* mod = (const float*)(P.ws + WS_MOD); const bf16* Y = (const bf16*)(P.ws + WS_HPERM);
    const int* rs = (const int*)(P.ws + WS_ROUTE_S); const float* rw = (const float*)(P.ws + WS_ROUTE_W);
    const bf16* X3 = (const bf16*)(P.ws + WS_X3);
    const int st = G * 8; int row = blockIdx.x * 8 + wave; if (row >= M1) return;
    CombIdx ic, in; CombData dc, dn;
    comb_load_idx(rs, rw, row, ic); comb_load_data(X3 + (size_t)row * DM, Y, ic, lane, dc);
    { const int r1 = row + st < M1 ? row + st : row; comb_load_idx(rs, rw, r1, in); }
    for (; row < M1; row += st) {
        const int r1 = row + st < M1 ? row + st : row, r2 = row + 2 * st < M1 ? row + 2 * st : r1;
        comb_load_data(X3 + (size_t)r1 * DM, Y, in, lane, dn);
        CombIdx i2; comb_load_idx(rs, rw, r2, i2);
        const int b = row >> 12;
        float* xr = P.out + (size_t)row * DM;
        f32x4 v[4]; comb_apply(v, dc, ic, mod + (size_t)(9 + b) * 6144 + 5120, lane);
        float ss = 0.f;
#pragma unroll
        for (int j = 0; j < 4; ++j) ss += (v[j][0] * v[j][0] + v[j][1] * v[j][1]) + (v[j][2] * v[j][2] + v[j][3] * v[j][3]);
        const float rr = rsqrtf(wave_sum(ss) * (1.f / 1024.f) + RMS_EPS);
#pragma unroll
        for (int j = 0; j < 4; ++j) ((f32x4*)xr)[lane + 64 * j] = v[j] * rr * ((const f32x4*)P.in[I_FING])[lane + 64 * j];
        dc = dn; ic = in; in = i2;
    }
}
__device__ __forceinline__ void phase_rowstat(const Params& P, int lane, int wave, int G) {
    const bf16* CQ = (const bf16*)(P.ws + WS_CQ); const bf16* CKV = (const bf16*)(P.ws + WS_CKV); float* rq = (float*)(P.ws + WS_RQ); float* rkv = (float*)(P.ws + WS_RKV);
    for (int row = blockIdx.x * 8 + wave; row < M0; row += G * 8) {
        float sq = 0.f, sk = 0.f;
        if (lane < 48) { const u32x4 a = ((const u32x4*)(CQ + (size_t)row * 384))[lane];
            sq = (bflo(a.x) * bflo(a.x) + bfhi(a.x) * bfhi(a.x)) + (bflo(a.y) * bflo(a.y) + bfhi(a.y) * bfhi(a.y)) + (bflo(a.z) * bflo(a.z) + bfhi(a.z) * bfhi(a.z)) + (bflo(a.w) * bflo(a.w) + bfhi(a.w) * bfhi(a.w)); }
        if (lane < 32) { const u32x4 a = ((const u32x4*)(CKV + (size_t)row * 256))[lane];
            sk = (bflo(a.x) * bflo(a.x) + bfhi(a.x) * bfhi(a.x)) + (bflo(a.y) * bflo(a.y) + bfhi(a.y) * bfhi(a.y)) + (bflo(a.z) * bflo(a.z) + bfhi(a.z) * bfhi(a.z)) + (bflo(a.w) * bflo(a.w) + bfhi(a.w) * bfhi(a.w)); }
        sq = wave_sum(sq); sk = wave_sum(sk);
        if (lane == 0) { rq[row] = rsqrtf(sq * (1.f / 384.f) + RMS_EPS); rkv[row] = rsqrtf(sk * (1.f / 256.f) + RMS_EPS); }
    }
}

constexpr int LRU_UXF = 0;
constexpr int LRU_UF = 17408;
constexpr int LRU_UB = LRU_UF + 16384;
constexpr int LRU_G = LRU_UB + 8192;
__device__ __forceinline__ int crow32(int r, int hi) { return (r & 3) + 8 * (r >> 2) + 4 * hi; }
struct LruK { float cw[4][8]; float cb[8]; float ba, bx, sp; bf16x8 bf[4]; int h; };
struct LruTile { u32x4 a, b; };
__device__ __forceinline__ void lru_load_consts(const Params& P, int h, int tid, int lane, int wave, LruK& K) {
    const int c0 = (tid & 7) * 8; const float* cw = P.in[I_LCW]; const float* cb = P.in[I_LCB];
#pragma unroll
    for (int i = 0; i < 8; ++i) { const int ch = h * 64 + c0 + i; K.cb[i] = cb[ch];
#pragma unroll
        for (int j = 0; j < 4; ++j) K.cw[j][i] = cw[j * 512 + ch]; }
    { const int c = tid & 63, d = (tid >> 6) & 1, ch = h * 64 + c; K.ba = P.in[I_LBA][d * 512 + ch]; K.bx = P.in[I_LBX][d * 512 + ch]; K.sp = log1pf(expf(-P.in[I_LLAM][d * 512 + ch])); }
    { const bf16* WgT = (const bf16*)(P.ws + WS_WG) + (size_t)h * 256 * 64; const int n = wave * 32 + (lane & 31), hi = lane >> 5;
#pragma unroll
      for (int ks = 0; ks < 4; ++ks) K.bf[ks] = *(const bf16x8*)(WgT + (size_t)n * 64 + 16 * ks + 8 * hi); }
    K.h = h;
}
__device__ __forceinline__ void lru_tile_load(const bf16* UX, int b, int ck, int h, int tid, LruTile& T) {
    const int seg_lo = ck < 4 ? 0 : CTXL, seg_hi = ck < 4 ? CTXL : TC, p0 = ck * 64 - 2, c8 = (tid & 7) * 8;
    T.a = (u32x4){0u, 0u, 0u, 0u}; T.b = (u32x4){0u, 0u, 0u, 0u};
    { const int pos = p0 + (tid >> 3); if (pos >= seg_lo && pos < seg_hi) T.a = *(const u32x4*)(UX + (size_t)(b * TC + pos) * 512 + h * 64 + c8); }
    if (tid < 24) { const int pos = p0 + 64 + (tid >> 3); if (pos >= seg_lo && pos < seg_hi) T.b = *(const u32x4*)(UX + (size_t)(b * TC + pos) * 512 + h * 64 + c8); }
}
__device__ __forceinline__ void st8f(float* d, const u32x4 a) { d[0] = bflo(a.x); d[1] = bfhi(a.x); d[2] = bflo(a.y); d[3] = bfhi(a.y); d[4] = bflo(a.z); d[5] = bfhi(a.z); d[6] = bflo(a.w); d[7] = bfhi(a.w); }
constexpr int LRU_QP = LRU_G + 65536;
constexpr int LRU_QS = LRU_QP + 2048;
constexpr int LRU_HQ = LRU_QS + 2048;
template <int MODE> __device__ __forceinline__ void lru_coeffs(unsigned char* lds, const LruTile& T, const LruK& K, int tid, int lane, int wave) {
    float* uxf = (float*)(lds + LRU_UXF); float* uf = (float*)(lds + LRU_UF); bf16* ub = (bf16*)(lds + LRU_UB); float* Gm = (float*)(lds + LRU_G);
    __syncthreads();
    st8f(uxf + (tid >> 3) * 64 + (tid & 7) * 8, T.a);
    if (tid < 24) st8f(uxf + (64 + (tid >> 3)) * 64 + (tid & 7) * 8, T.b);
    __syncthreads();
    { const int t = tid >> 3, c0 = (tid & 7) * 8; float uo[8];
#pragma unroll
      for (int i = 0; i < 8; ++i) { float u = K.cb[i];
#pragma unroll
          for (int j = 0; j < 4; ++j) u += K.cw[j][i] * uxf[(t + j) * 64 + c0 + i];
          uo[i] = u; uf[t * 64 + c0 + i] = u; }
      u32x4 w; w.x = pk2(uo[0], uo[1]); w.y = pk2(uo[2], uo[3]); w.z = pk2(uo[4], uo[5]); w.w = pk2(uo[6], uo[7]);
      *(u32x4*)(ub + t * 64 + c0) = w; }
    __syncthreads();
    {
        const int r32 = lane & 31, hi = lane >> 5, n = wave * 32 + r32;
        f32x16 acc0 = {}, acc1 = {};
#pragma unroll
        for (int ks = 0; ks < 4; ++ks) {
            const bf16x8 a0 = *(const bf16x8*)(ub + (r32) * 64 + 16 * ks + 8 * hi), a1 = *(const bf16x8*)(ub + (32 + r32) * 64 + 16 * ks + 8 * hi);
            acc0 = __builtin_amdgcn_mfma_f32_32x32x16_bf16(a0, K.bf[ks], acc0, 0, 0, 0);
            acc1 = __builtin_amdgcn_mfma_f32_32x32x16_bf16(a1, K.bf[ks], acc1, 0, 0, 0);
        }
#pragma unroll
        for (int r = 0; r < 16; ++r) { Gm[crow32(r, hi) * 256 + n] = acc0[r]; Gm[(32 + crow32(r, hi)) * 256 + n] = acc1[r]; }
    }
    __syncthreads();
    { const int c = tid & 63, d = (tid >> 6) & 1, tg = tid >> 7;
      constexpr float L2E = 1.4426950408889634f; const float kba = K.ba, kbx = K.bx, ksp8 = -8.f * K.sp;
      float* g0 = Gm + (tg * 16) * 256 + d * 128 + c; const float* u0 = uf + (tg * 16) * 64 + c;
      float hh = 0.f, pp = 1.f;
#pragma unroll 2
      for (int k = 0; k < 8; ++k) { const int i = d ? 14 - 2 * k : 2 * k;
          const f32x2 ga = (f32x2){g0[i * 256] + kba, g0[(i + 1) * 256] + kba}, gx = (f32x2){g0[i * 256 + 64] + kbx, g0[(i + 1) * 256 + 64] + kbx};
          const f32x2 ta = ga * (-L2E), tx = gx * (-L2E);
          const f32x2 ea = (f32x2){__builtin_amdgcn_exp2f(ta[0]), __builtin_amdgcn_exp2f(ta[1])} + 1.f, ex = (f32x2){__builtin_amdgcn_exp2f(tx[0]), __builtin_amdgcn_exp2f(tx[1])} + 1.f;
          const f32x2 r = {__builtin_amdgcn_rcpf(ea[0]), __builtin_amdgcn_rcpf(ea[1])}, ii = {__builtin_amdgcn_rcpf(ex[0]), __builtin_amdgcn_rcpf(ex[1])};
          const f32x2 la = r * ksp8, tl = la * L2E;
          const f32x2 a = {__builtin_amdgcn_exp2f(tl[0]), __builtin_amdgcn_exp2f(tl[1])};
          const f32x2 x2 = la + la;
          const f32x2 emp = -x2 * (x2 * (x2 * (x2 * 0.041666668f + 0.16666667f) + 0.5f) + 1.f);
          const f32x2 ema = 1.f - a * a;
          const f32x2 em = {x2[0] > -0.25f ? emp[0] : ema[0], x2[1] > -0.25f ? emp[1] : ema[1]};
          const f32x2 sq = {__builtin_amdgcn_sqrtf(em[0]), __builtin_amdgcn_sqrtf(em[1])};
          const f32x2 bb = sq * (ii * (f32x2){u0[i * 64], u0[(i + 1) * 64]});
          const float a_f = d ? a[1] : a[0], a_s = d ? a[0] : a[1], b_f = d ? bb[1] : bb[0], b_s = d ? bb[0] : bb[1];
          hh = a_f * hh + b_f; pp *= a_f; const float h_f = hh, p_f = pp;
          hh = a_s * hh + b_s; pp *= a_s;
          if (MODE == 3) { const int of = d ? i + 1 : i, os = d ? i : i + 1;
              g0[of * 256] = h_f; g0[of * 256 + 64] = p_f; g0[os * 256] = hh; g0[os * 256 + 64] = pp; } }
      ((float*)(lds + LRU_QP))[(d * 4 + tg) * 64 + c] = pp; ((float*)(lds + LRU_QS))[(d * 4 + tg) * 64 + c] = hh; }
    __syncthreads();
}
__device__ __forceinline__ void lru_unit(int u, int& b, int& ck, int& h) { h = u & 7; ck = (u >> 3) % LCH; b = u / (8 * LCH); }
__device__ __forceinline__ void phase_lru_f1(const Params& P, unsigned char* lds, int tid, int lane, int wave, int G) {
    float* Gm = (float*)(lds + LRU_G); float* CP = (float*)(P.ws + WS_CP); float* CS = (float*)(P.ws + WS_CS); const bf16* UX = (const bf16*)(P.ws + WS_UX);
    constexpr int NU = NB * LCH * 8;
    int u = blockIdx.x; if (u >= NU) return;
    int b, ck, h; lru_unit(u, b, ck, h);
    LruK K; lru_load_consts(P, h, tid, lane, wave, K);
    LruTile T; lru_tile_load(UX, b, ck, h, tid, T);
    for (;;) {
        if (h != K.h) lru_load_consts(P, h, tid, lane, wave, K);
        lru_coeffs<1>(lds, T, K, tid, lane, wave);
        const int un = u + G; int bn = 0, ckn = 0, hn = h;
        if (un < NU) { lru_unit(un, bn, ckn, hn); lru_tile_load(UX, bn, ckn, hn, tid, T); }
        if (tid < 128) { const int d = tid >> 6, c = tid & 63; float hh = 0.f, pp = 1.f;
            const float* QP = (const float*)(lds + LRU_QP); const float* QS = (const float*)(lds + LRU_QS);
#pragma unroll
            for (int k = 0; k < 4; ++k) { const int q = d ? 3 - k : k; const float a = QP[(d * 4 + q) * 64 + c], bb = QS[(d * 4 + q) * 64 + c]; hh = a * hh + bb; pp *= a; }
            const size_t o = ((size_t)(d * 8 + b) * LCH + ck) * 512 + h * 64 + c; CP[o] = pp; CS[o] = hh; }
        if (un >= NU) break;
        u = un; b = bn; ck = ckn; h = hn;
    }
    __syncthreads();
}
__device__ __forceinline__ void phase_lru_carry(const Params& P, int lane, int wave, int G) {
    const float* CP = (const float*)(P.ws + WS_CP); const float* CS = (const float*)(P.ws + WS_CS); float* HIN = (float*)(P.ws + WS_HIN);
    if (wave != 0) return;
    for (int sb = blockIdx.x; sb < 128; sb += G) {
        const int s = sb * 64 + lane, d = s >> 12, b = (s >> 9) & 7, ch = s & 511; const size_t base = ((size_t)(d * 8 + b) * LCH) * 512 + ch;
        float hh = 0.f;
#pragma unroll 1
        for (int st = 0; st < LCH; st += 17) { float cp[17], cs[17]; int q[17];
#pragma unroll
            for (int i = 0; i < 17; ++i) { const int step = st + i; q[i] = d == 0 ? step : (step < 4 ? 3 - step : 71 - step); cp[i] = CP[base + (size_t)q[i] * 512]; cs[i] = CS[base + (size_t)q[i] * 512]; }
#pragma unroll
            for (int i = 0; i < 17; ++i) { HIN[base + (size_t)q[i] * 512] = hh; hh = cp[i] * hh + cs[i]; } }
    }
}
__device__ __forceinline__ float gelu_tanh(float x) { const float u = 0.7978845608028654f * (x + 0.044715f * x * x * x); return x * __builtin_amdgcn_rcpf(1.f + __expf(-2.f * u)); }
__device__ __forceinline__ void phase_lru_f3(const Params& P, unsigned char* lds, int tid, int lane, int wave, int G) {
    float* Gm = (float*)(lds + LRU_G); const bf16* UX = (const bf16*)(P.ws + WS_UX);
    const bf16* UG = (const bf16*)(P.ws + WS_UG); bf16* MIX = (bf16*)(P.ws + WS_RH); const float* HIN = (const float*)(P.ws + WS_HIN);
    constexpr int NU = NB * LCH * 8;
    int u = blockIdx.x; if (u >= NU) return;
    int b, ck, h; lru_unit(u, b, ck, h);
    LruK K; lru_load_consts(P, h, tid, lane, wave, K);
    LruTile T; lru_tile_load(UX, b, ck, h, tid, T);
    const int t = tid >> 3, c0 = (tid & 7) * 8;
    u32x4 gq = *(const u32x4*)(UG + ((size_t)b * TC + ck * 64 + t) * 512 + h * 64 + c0);
    float hin = 0.f; if (tid < 128) hin = HIN[((size_t)((tid >> 6) * 8 + b) * LCH + ck) * 512 + h * 64 + (tid & 63)];
    for (;;) {
        if (h != K.h) lru_load_consts(P, h, tid, lane, wave, K);
        lru_coeffs<3>(lds, T, K, tid, lane, wave);
        const u32x4 g = gq; const float hh0 = hin;
        const int un = u + G; int bn = 0, ckn = 0, hn = h;
        if (un < NU) { lru_unit(un, bn, ckn, hn); lru_tile_load(UX, bn, ckn, hn, tid, T);
            gq = *(const u32x4*)(UG + ((size_t)bn * TC + ckn * 64 + t) * 512 + hn * 64 + c0);
            if (tid < 128) hin = HIN[((size_t)((tid >> 6) * 8 + bn) * LCH + ckn) * 512 + hn * 64 + (tid & 63)]; }
        float* HQ = (float*)(lds + LRU_HQ);
        if (tid < 128) { const int d = tid >> 6, c = tid & 63; float hh = hh0;
            const float* QP = (const float*)(lds + LRU_QP); const float* QS = (const float*)(lds + LRU_QS);
#pragma unroll
            for (int k = 0; k < 4; ++k) { const int q = d ? 3 - k : k; HQ[(d * 4 + q) * 64 + c] = hh; hh = QP[(d * 4 + q) * 64 + c] * hh + QS[(d * 4 + q) * 64 + c]; } }
        __syncthreads();
        { const size_t row = (size_t)b * TC + ck * 64 + t; const int q = t >> 4;
          const float gv[8] = {bflo(g.x), bfhi(g.x), bflo(g.y), bfhi(g.y), bflo(g.z), bfhi(g.z), bflo(g.w), bfhi(g.w)};
          float o[8];
#pragma unroll
          for (int i = 0; i < 8; ++i) { const int cc = c0 + i;
              const float y = (Gm[t * 256 + cc] + Gm[t * 256 + 64 + cc] * HQ[q * 64 + cc]) + (Gm[t * 256 + 128 + cc] + Gm[t * 256 + 192 + cc] * HQ[(4 + q) * 64 + cc]);
              o[i] = y * gelu_tanh(gv[i]); }
          u32x4 w; w.x = pk2(o[0], o[1]); w.y = pk2(o[2], o[3]); w.z = pk2(o[4], o[5]); w.w = pk2(o[6], o[7]);
          *(u32x4*)(MIX + row * 1024 + 512 + h * 64 + c0) = w; }
        if (un >= NU) break;
        u = un; b = bn; ck = ckn; h = hn;
    }
    __syncthreads();
}

namespace att {
constexpr int NW = 8, QBLK = 32, KVBLK = 64;
constexpr float SCALE = 0.10206207261596575f;
constexpr float THR = 8.f;
constexpr int LDQ = 768, LDK = 768, LDV = 512, LDO = 1024;
constexpr int SHM_V = 16384, SHM_K = 16384, SHM_ATTN = 2 * SHM_V + 2 * SHM_K + NW * 64 * 4;
#define KSWZ(row, colB) ((row) * 256 + ((colB) ^ (((row) & 7) << 4)))
#define SBAR() __builtin_amdgcn_sched_barrier(0)
__device__ __forceinline__ int crow(int r, int hi) { return (r & 3) + 8 * (r >> 2) + 4 * hi; }
__device__ __forceinline__ unsigned cvtpk(float lo, float hi) { unsigned r; asm volatile("v_cvt_pk_bf16_f32 %0, %1, %2" : "=v"(r) : "v"(lo), "v"(hi)); return r; }
__device__ __forceinline__ void partialSM(f32x16& p0, f32x16& p1, float& m_reg, float& mn, float& alpha) {
  constexpr float C = SCALE * 1.4426950408889634f;
  float pmax = p0[0];
#pragma unroll
  for (int r = 1; r < 16; ++r) pmax = fmaxf(pmax, p0[r]);
#pragma unroll
  for (int r = 0; r < 16; ++r) pmax = fmaxf(pmax, p1[r]);
  { auto rr = __builtin_amdgcn_permlane32_swap(__float_as_uint(pmax), __float_as_uint(pmax), false, false);
    pmax = fmaxf(__uint_as_float(rr[0]), __uint_as_float(rr[1])); }
  if (__builtin_expect(__all(pmax - m_reg <= THR / SCALE), 1)) { mn = m_reg; alpha = 1.f; }
  else { mn = fmaxf(m_reg, pmax); alpha = __builtin_amdgcn_exp2f((m_reg - mn) * C); m_reg = mn; }
  float mnC = -mn * C;
#pragma unroll
  for (int r = 0; r < 16; ++r) p0[r] = fmaf(p0[r], C, mnC);
#pragma unroll
  for (int r = 0; r < 16; ++r) p1[r] = fmaf(p1[r], C, mnC);
#pragma unroll
  for (int r = 0; r < 16; ++r) p0[r] = __builtin_amdgcn_exp2f(p0[r]);
}
__device__ __forceinline__ void finishSM(f32x16& p0, f32x16& p1, float alpha, float& l_reg, bf16x8& pa0, bf16x8& pa1, bf16x8& pa2, bf16x8& pa3) {
#pragma unroll
  for (int r = 0; r < 16; ++r) p1[r] = __builtin_amdgcn_exp2f(p1[r]);
  float ps = 0;
#pragma unroll
  for (int r = 0; r < 16; ++r) ps += p0[r];
#pragma unroll
  for (int r = 0; r < 16; ++r) ps += p1[r];
  { auto rr = __builtin_amdgcn_permlane32_swap(__float_as_uint(ps), __float_as_uint(ps), false, false);
    ps = __uint_as_float(rr[0]) + __uint_as_float(rr[1]); }
  l_reg = l_reg * alpha + ps;
#define PK4(P, BASE, OUT) do { unsigned a0 = cvtpk(P[BASE + 0], P[BASE + 1]), a1 = cvtpk(P[BASE + 2], P[BASE + 3]);   \
    unsigned b0 = cvtpk(P[BASE + 4], P[BASE + 5]), b1 = cvtpk(P[BASE + 6], P[BASE + 7]);                              \
    auto r0 = __builtin_amdgcn_permlane32_swap(a0, b0, false, false); auto r1 = __builtin_amdgcn_permlane32_swap(a1, b1, false, false); \
    u32x4 w = {r0[0], r1[0], r0[1], r1[1]}; OUT = *reinterpret_cast<bf16x8*>(&w); } while (0)
  PK4(p0, 0, pa0); PK4(p0, 8, pa1); PK4(p1, 0, pa2); PK4(p1, 8, pa3);
#undef PK4
}
__device__ __forceinline__ void qkt(f32x16& p0, f32x16& p1, const bf16* Ks, const bf16x8* qr, int r32, int hi) {
  p0 = f32x16{}; p1 = f32x16{};
#pragma unroll
  for (int d0 = 0; d0 < 6; ++d0) { int cb = (d0 * 16 + hi * 8) * 2;
    bf16x8 b0 = *reinterpret_cast<const bf16x8*>((const char*)Ks + KSWZ(r32, cb));
    bf16x8 b1 = *reinterpret_cast<const bf16x8*>((const char*)Ks + KSWZ(32 + r32, cb));
    p0 = __builtin_amdgcn_mfma_f32_32x32x16_bf16(b0, qr[d0], p0, 0, 0, 0);
    p1 = __builtin_amdgcn_mfma_f32_32x32x16_bf16(b1, qr[d0], p1, 0, 0, 0); }
}
__device__ __forceinline__ int v_st(int k, int c) { const int kk = (k & ~0xC) | ((k & 4) << 1) | ((k & 8) >> 1); return ((kk >> 3) * 4 + (c >> 5)) * 512 + ((kk & 7) * 32 + (c & 31)) * 2; }
__device__ __forceinline__ int v_rd_base(int lane) { return ((lane & 3) << 3) | (((lane >> 2) & 3) << 6) | (((lane >> 4) & 1) << 5) | (((lane >> 5) & 1) << 8); }
constexpr int v_rd_off(int d0, int ks, int half) { return d0 * 512 + ks * 4096 + half * 2048; }
template <int OFF> __device__ __forceinline__ s16x4 tr_read(int vb) {
  s16x4 r; asm volatile("ds_read_b64_tr_b16 %0, %1 offset:%2" : "=&v"(r) : "v"(vb), "i"(OFF) : "memory"); return r;
}
template <int D0> __device__ __forceinline__ void pv_one(f32x16& od, int vb, bf16x8 pa0, bf16x8 pa1, bf16x8 pa2, bf16x8 pa3) {
  const s16x4 l0 = tr_read<v_rd_off(D0, 0, 0)>(vb), h0 = tr_read<v_rd_off(D0, 0, 1)>(vb), l1 = tr_read<v_rd_off(D0, 1, 0)>(vb), h1 = tr_read<v_rd_off(D0, 1, 1)>(vb);
  const s16x4 l2 = tr_read<v_rd_off(D0, 2, 0)>(vb), h2 = tr_read<v_rd_off(D0, 2, 1)>(vb), l3 = tr_read<v_rd_off(D0, 3, 0)>(vb), h3 = tr_read<v_rd_off(D0, 3, 1)>(vb);
  asm volatile("s_waitcnt lgkmcnt(0)" ::: "memory"); SBAR();
#define PK(L, H) (bf16x8){L[0], L[1], L[2], L[3], H[0], H[1], H[2], H[3]}
  od = __builtin_amdgcn_mfma_f32_32x32x16_bf16(pa0, PK(l0, h0), od, 0, 0, 0);
  od = __builtin_amdgcn_mfma_f32_32x32x16_bf16(pa1, PK(l1, h1), od, 0, 0, 0);
  od = __builtin_amdgcn_mfma_f32_32x32x16_bf16(pa2, PK(l2, h2), od, 0, 0, 0);
  od = __builtin_amdgcn_mfma_f32_32x32x16_bf16(pa3, PK(l3, h3), od, 0, 0, 0);
#undef PK
}
__device__ __forceinline__ void pv_d0(f32x16* o, int vb, bf16x8 pa0, bf16x8 pa1, bf16x8 pa2, bf16x8 pa3) {
  pv_one<0>(o[0], vb, pa0, pa1, pa2, pa3); pv_one<1>(o[1], vb, pa0, pa1, pa2, pa3);
}
__device__ __forceinline__ void attn_dense_body(const bf16* __restrict__ Qb, const bf16* __restrict__ Kh, const bf16* __restrict__ Vh, bf16* __restrict__ Ob, int seq, int tq0  , char* lds) {
  const int tid = threadIdx.x, wid = tid >> 6, lane = tid & 63, r32 = lane & 31, hi = lane >> 5;
  bf16* V_lds = (bf16*)lds; bf16* K_lds = (bf16*)(lds + 2 * SHM_V);
  float* ws = (float*)(lds + 2 * SHM_V + 2 * SHM_K) + wid * 64; float* li_l = ws; float* al_l = ws + 32;
  float m_reg = -1e30f, l_reg = 0; f32x16 o[2] = {}; bf16x8 qr[6];
  const bf16* Qw = Qb + (long)(wid * QBLK + r32) * LDQ + hi * 8;
#pragma unroll
  for (int d0 = 0; d0 < 6; ++d0) qr[d0] = *reinterpret_cast<const bf16x8*>(Qw + d0 * 16);
  {
    const int tq = tq0 + wid * QBLK + r32; const bool on = tq0 >= 0;
    constexpr float IF[8] = {1.0f, 0.316227766f, 0.1f, 0.0316227766f, 0.01f, 0.00316227766f, 0.001f, 0.000316227766f};
#pragma unroll
    for (int ax = 0; ax < 2; ++ax) { const float pos = (float)(ax == 0 ? (tq >> 6) : (tq & 63)) * 0.15915494309189535f;
      bf16x8 qv = qr[4 + ax]; bf16x8 qo;
#pragma unroll
      for (int i = 0; i < 8; ++i) { const float x = __uint_as_float(((unsigned)(unsigned short)qv[i]) << 16); const float other = __shfl_xor(x, 32);
        const float sn = __builtin_amdgcn_sinf(pos * IF[i]), cs = __builtin_amdgcn_cosf(pos * IF[i]);
        const float r = hi == 0 ? x * cs - other * sn : other * sn + x * cs;
        unsigned u = __float_as_uint(on ? r : x); u = (u + 0x7fffu + ((u >> 16) & 1u)) >> 16; qo[i] = (short)u; }
      qr[4 + ax] = qo; }
  }
  const int sr = tid >> 3, sc = (tid & 7) * 8, vst = v_st(sr, sc), kr2 = (tid >> 2) & 63, kc2 = 64 + (tid & 3) * 8; const bool kb2 = tid < 256;
  const int vb0 = (int)(uintptr_t)V_lds + v_rd_base(lane);
  struct { bf16x8 vs, ka, kb; } sr_[2];
#define SLOAD(i, k0) do { sr_[i].vs = *reinterpret_cast<const bf16x8*>(&Vh[(long)((k0) + sr) * LDV + sc]); \
    sr_[i].ka = *reinterpret_cast<const bf16x8*>(&Kh[(long)((k0) + sr) * LDK + sc]); \
    if (kb2) sr_[i].kb = *reinterpret_cast<const bf16x8*>(&Kh[(long)((k0) + kr2) * LDK + kc2]); } while (0)
#define SWRITE(b, i) do { *(bf16x8*)((char*)V_lds + (b) * SHM_V + vst) = sr_[i].vs;          \
    *(bf16x8*)((char*)K_lds + (b) * SHM_K + KSWZ(sr, sc * 2)) = sr_[i].ka;                       \
    if (kb2) *(bf16x8*)((char*)K_lds + (b) * SHM_K + KSWZ(kr2, kc2 * 2)) = sr_[i].kb; } while (0)
#define SWAIT() asm volatile("s_waitcnt vmcnt(3)" ::: "memory")
#define RESC(a) do { if (__any((a) < 1.f)) { if (hi == 0) al_l[r32] = (a); asm volatile("s_waitcnt lgkmcnt(0)" ::: "memory"); \
    _Pragma("unroll") for (int d = 0; d < 2; ++d) _Pragma("unroll") for (int r = 0; r < 16; ++r) o[d][r] *= al_l[crow(r, hi)]; } } while (0)
  f32x16 pA0, pA1, pB0, pB1; float mnA, mnB, alA, alB; bf16x8 pa0, pa1, pa2, pa3; const int NT = seq / KVBLK;
  constexpr int SE = 0, SO = 1;
  SLOAD(SE, 0); asm volatile("s_waitcnt vmcnt(0)" ::: "memory"); SWRITE(0, SE); __syncthreads();
  qkt(pA0, pA1, K_lds, qr, r32, hi); partialSM(pA0, pA1, m_reg, mnA, alA);
  SLOAD(SO, KVBLK); if (2 < NT) SLOAD(SE, 2 * KVBLK);
  SWAIT(); SWRITE(1, SO); __syncthreads();
#ifndef ATT_SKEW
#define ATT_SKEW 0
#endif
  const bool swp = ATT_SKEW > 0 && (__builtin_amdgcn_readfirstlane(wid) >= 4);
  for (int j = 1; j + 1 < NT; j += 2) {
    if (swp) __builtin_amdgcn_s_sleep(ATT_SKEW);
    SBAR(); qkt(pB0, pB1, (bf16*)((char*)K_lds + SHM_K), qr, r32, hi);
    finishSM(pA0, pA1, alA, l_reg, pa0, pa1, pa2, pa3); SBAR();
    SLOAD(SO, (j + 2) * KVBLK); SBAR();
    pv_d0(o, vb0, pa0, pa1, pa2, pa3); partialSM(pB0, pB1, m_reg, mnB, alB);
    __syncthreads(); SWAIT(); SWRITE(0, SE);
    RESC(alB); __syncthreads();
    if (swp) __builtin_amdgcn_s_sleep(ATT_SKEW);
    SBAR(); qkt(pA0, pA1, K_lds, qr, r32, hi);
    finishSM(pB0, pB1, alB, l_reg, pa0, pa1, pa2, pa3); SBAR();
    if (j + 3 < NT) SLOAD(SE, (j + 3) * KVBLK); SBAR();
    pv_d0(o, vb0 + (int)SHM_V, pa0, pa1, pa2, pa3); partialSM(pA0, pA1, m_reg, mnA, alA);
    __syncthreads(); SWAIT(); SWRITE(1, SO);
    RESC(alA); __syncthreads();
  }
  SBAR(); qkt(pB0, pB1, (bf16*)((char*)K_lds + SHM_K), qr, r32, hi);
  finishSM(pA0, pA1, alA, l_reg, pa0, pa1, pa2, pa3); SBAR();
  pv_d0(o, vb0, pa0, pa1, pa2, pa3); partialSM(pB0, pB1, m_reg, mnB, alB);
  __syncthreads(); RESC(alB);
  finishSM(pB0, pB1, alB, l_reg, pa0, pa1, pa2, pa3); SBAR();
  pv_d0(o, vb0 + (int)SHM_V, pa0, pa1, pa2, pa3);
  if (hi == 0) li_l[r32] = l_reg; asm volatile("s_waitcnt lgkmcnt(0)" ::: "memory");
  float rli[16];
#pragma unroll
  for (int r = 0; r < 16; ++r) rli[r] = __builtin_amdgcn_rcpf(li_l[crow(r, hi)]);
  bf16* Ow = Ob + (long)(wid * QBLK) * LDO;
#pragma unroll
  for (int r = 0; r < 16; ++r) { int orow = crow(r, hi);
#pragma unroll
    for (int d0 = 0; d0 < 2; ++d0) Ow[(long)orow * LDO + d0 * 32 + r32] = (bf16)f2bf(o[d0][r] * rli[r]); }
#undef SLOAD
#undef SWRITE
#undef SWAIT
#undef RESC
}

}

__device__ __forceinline__ void phase_attention(const Params& P, unsigned char* lds, int G) {
    const bf16* Q = (const bf16*)(P.ws + WS_Q); const bf16* K = (const bf16*)(P.ws + WS_K); const bf16* V = (const bf16*)(P.ws + WS_V); bf16* MIX = (bf16*)(P.ws + WS_RH);
    const int vcu = (G % 8 == 0) ? ((int)blockIdx.x % 8) * (G / 8) + (int)blockIdx.x / 8 : (int)blockIdx.x;
    for (int idx = vcu; idx < 1024 + 64; idx += G) {
        int b, h, seq; size_t qrow;
        if (idx < 1024) { const int bh = idx >> 4, qb = idx & 15; b = bh >> 3; h = bh & 7; qrow = (size_t)b * TC + CTXL + qb * 256; seq = TC; }
        else { const int j = idx - 1024; b = j >> 3; h = j & 7; qrow = (size_t)b * TC; seq = CTXL; }
        att::attn_dense_body(Q + qrow * 768 + h * 96, K + (size_t)b * TC * 768 + h * 96, V + (size_t)b * TC * 512 + h * 64, MIX + qrow * 1024 + h * 64, seq, idx < 1024 ? (idx & 15) * 256 : -1, (char*)lds);
        __syncthreads();
    }
}

typedef float cf __attribute__((ext_vector_type(2)));
__device__ __forceinline__ cf cmul(cf a, cf b) { return a * (cf){b.x, b.x} + (cf){a.y, a.x} * (cf){-b.y, b.y}; }
__device__ __forceinline__ cf cis_rev(float rev) { return cf{__builtin_amdgcn_cosf(rev), __builtin_amdgcn_sinf(rev)}; }
template <int S> __device__ __forceinline__ void dft4(cf& a, cf& b, cf& c, cf& d) {
    const cf t0 = a + c, t1 = a - c, t2 = b + d, t3 = b - d;
    const cf t3i = (cf){-(float)S * t3.y, (float)S * t3.x};
    a = t0 + t2; c = t0 - t2; b = t1 + t3i; d = t1 - t3i;
}
template <int S> __device__ __forceinline__ void dft16_tail(cf (&v)[16]);
template <int S> __device__ __forceinline__ void dft16(cf (&v)[16]) {
#pragma unroll
    for (int j0 = 0; j0 < 4; ++j0) dft4<S>(v[j0], v[j0 + 4], v[j0 + 8], v[j0 + 12]);
    dft16_tail<S>(v);
}
template <int S> __device__ __forceinline__ void dft16_tail(cf (&v)[16]) {
    constexpr float C1 = 0.9238795325112867f, S1 = 0.3826834323650898f, C2 = 0.7071067811865476f;
    v[5] = cmul(v[5], cf{C1, S * S1}); v[9] = cmul(v[9], cf{C2, S * C2}); v[13] = cmul(v[13], cf{S1, S * C1});
    v[6] = cmul(v[6], cf{C2, S * C2}); v[10] = (cf){-(float)S * v[10].y, (float)S * v[10].x}; v[14] = cmul(v[14], cf{-C2, S * C2});
    v[7] = cmul(v[7], cf{S1, S * C1}); v[11] = cmul(v[11], cf{-C2, S * C2}); v[15] = cmul(v[15], cf{-C1, -S * S1});
#pragma unroll
    for (int k1 = 0; k1 < 4; ++k1) dft4<S>(v[4 * k1], v[4 * k1 + 1], v[4 * k1 + 2], v[4 * k1 + 3]);
}
#define REV4(k) ((((k) >> 2) | (((k) & 3) << 2)))
__device__ __forceinline__ int fphys(int L) { return L + (L >> 4); }
constexpr int FFT_BUF = 4352 * 8;
constexpr int FFT_ZB = 2 * FFT_BUF;
constexpr int FFT_HB1 = FFT_ZB + 32768;
constexpr int FFT_W3 = FFT_HB1 + 32768;
constexpr int FFT_RED = FFT_W3 + 1024;
static_assert(FFT_RED + 64 <= LDSCTL_OFF, "fft lds");
template <int PAT> __device__ __forceinline__ int fbase(int tp) {
    if (PAT == 0) return tp + (tp >> 4);
    if (PAT == 1) return (tp & 15) + 272 * (tp >> 4);
    return 17 * (tp & 15) + 272 * (tp >> 4);
}
template <int PAT> struct FStr { static constexpr int v = PAT == 0 ? 272 : (PAT == 1 ? 17 : 1); };
__device__ __forceinline__ int hide(int x) { asm volatile("" : "+v"(x)); return x; }
#if defined(__HIP_DEVICE_COMPILE__)
template <int OFF> __device__ __forceinline__ cf lds_rd64(unsigned addr) { f32x2 r; asm volatile("ds_read_b64 %0, %1 offset:%2" : "=v"(r) : "v"(addr), "i"(OFF) : "memory"); return cf{r[0], r[1]}; }
template <int OFF> __device__ __forceinline__ void lds_wr64(unsigned addr, cf x) { f32x2 r = {x.x, x.y}; asm volatile("ds_write_b64 %0, %1 offset:%2" :: "v"(addr), "v"(r), "i"(OFF) : "memory"); }
#define FFT_LGKM0() asm volatile("s_waitcnt lgkmcnt(0)" ::: "memory")
#else
template <int OFF> __device__ __forceinline__ cf lds_rd64(const cf* p) { return *(const cf*)((const char*)p + OFF); }
template <int OFF> __device__ __forceinline__ void lds_wr64(cf* p, cf x) { *(cf*)((char*)p + OFF) = x; }
#define FFT_LGKM0()
#endif
template <int PAT> __device__ __forceinline__ void fload(cf (&v)[16], const cf* buf, int tp) {
    constexpr int ST = FStr<PAT>::v * 8;
#if defined(__HIP_DEVICE_COMPILE__)
    const unsigned p = (unsigned)(uintptr_t)(buf + fbase<PAT>(tp));
    f32x2 r0, r1, r2, r3, r4, r5, r6, r7, r8, r9, r10, r11, r12, r13, r14, r15;
#define FRD(R, J) asm volatile("ds_read_b64 %0, %1 offset:%2" : "=v"(R) : "v"(p), "i"((J) * ST) : "memory")
    FRD(r0, 0); FRD(r1, 1); FRD(r2, 2); FRD(r3, 3); FRD(r4, 4); FRD(r5, 5); FRD(r6, 6); FRD(r7, 7); FRD(r8, 8); FRD(r9, 9); FRD(r10, 10); FRD(r11, 11); FRD(r12, 12); FRD(r13, 13); FRD(r14, 14); FRD(r15, 15);
#undef FRD
    asm volatile("s_waitcnt lgkmcnt(0)" : "+v"(r0), "+v"(r1), "+v"(r2), "+v"(r3), "+v"(r4), "+v"(r5), "+v"(r6), "+v"(r7), "+v"(r8), "+v"(r9), "+v"(r10), "+v"(r11), "+v"(r12), "+v"(r13), "+v"(r14), "+v"(r15) :: "memory");
    v[0] = cf{r0[0], r0[1]}; v[1] = cf{r1[0], r1[1]}; v[2] = cf{r2[0], r2[1]}; v[3] = cf{r3[0], r3[1]}; v[4] = cf{r4[0], r4[1]}; v[5] = cf{r5[0], r5[1]}; v[6] = cf{r6[0], r6[1]}; v[7] = cf{r7[0], r7[1]};
    v[8] = cf{r8[0], r8[1]}; v[9] = cf{r9[0], r9[1]}; v[10] = cf{r10[0], r10[1]}; v[11] = cf{r11[0], r11[1]}; v[12] = cf{r12[0], r12[1]}; v[13] = cf{r13[0], r13[1]}; v[14] = cf{r14[0], r14[1]}; v[15] = cf{r15[0], r15[1]};
#else
    const cf* p = buf + fbase<PAT>(tp);
#pragma unroll
    for (int j = 0; j < 16; ++j) v[j] = *(const cf*)((const char*)p + j * ST);
#endif
}
template <int PAT, int S> __device__ __forceinline__ void fload_dft16(cf (&v)[16], const cf* buf, int tp) {
#if defined(__HIP_DEVICE_COMPILE__)
    constexpr int ST = FStr<PAT>::v * 8;
    const unsigned p = (unsigned)(uintptr_t)(buf + fbase<PAT>(tp));
    f32x2 r0, r1, r2, r3, r4, r5, r6, r7, r8, r9, r10, r11, r12, r13, r14, r15;
#define FRD(R, J) asm volatile("ds_read_b64 %0, %1 offset:%2" : "=v"(R) : "v"(p), "i"((J) * ST) : "memory")
    FRD(r0, 0); FRD(r4, 4); FRD(r8, 8); FRD(r12, 12); FRD(r1, 1); FRD(r5, 5); FRD(r9, 9); FRD(r13, 13);
    FRD(r2, 2); FRD(r6, 6); FRD(r10, 10); FRD(r14, 14); FRD(r3, 3); FRD(r7, 7); FRD(r11, 11); FRD(r15, 15);
#undef FRD
    asm volatile("s_waitcnt lgkmcnt(12)" : "+v"(r0), "+v"(r4), "+v"(r8), "+v"(r12) :: "memory");
    v[0] = cf{r0[0], r0[1]}; v[4] = cf{r4[0], r4[1]}; v[8] = cf{r8[0], r8[1]}; v[12] = cf{r12[0], r12[1]}; dft4<S>(v[0], v[4], v[8], v[12]);
    asm volatile("s_waitcnt lgkmcnt(8)" : "+v"(r1), "+v"(r5), "+v"(r9), "+v"(r13) :: "memory");
    v[1] = cf{r1[0], r1[1]}; v[5] = cf{r5[0], r5[1]}; v[9] = cf{r9[0], r9[1]}; v[13] = cf{r13[0], r13[1]}; dft4<S>(v[1], v[5], v[9], v[13]);
    asm volatile("s_waitcnt lgkmcnt(4)" : "+v"(r2), "+v"(r6), "+v"(r10), "+v"(r14) :: "memory");
    v[2] = cf{r2[0], r2[1]}; v[6] = cf{r6[0], r6[1]}; v[10] = cf{r10[0], r10[1]}; v[14] = cf{r14[0], r14[1]}; dft4<S>(v[2], v[6], v[10], v[14]);
    asm volatile("s_waitcnt lgkmcnt(0)" : "+v"(r3), "+v"(r7), "+v"(r11), "+v"(r15) :: "memory");
    v[3] = cf{r3[0], r3[1]}; v[7] = cf{r7[0], r7[1]}; v[11] = cf{r11[0], r11[1]}; v[15] = cf{r15[0], r15[1]}; dft4<S>(v[3], v[7], v[11], v[15]);
    dft16_tail<S>(v);
#else
    fload<PAT>(v, buf, tp); dft16<S>(v);
#endif
}
template <int PAT> __device__ __forceinline__ void fstore_raw(const cf (&x)[16], cf* buf, int tp) {
#if defined(__HIP_DEVICE_COMPILE__)
    const unsigned p = (unsigned)(uintptr_t)(buf + fbase<PAT>(tp));
#else
    cf* p = buf + fbase<PAT>(tp);
#endif
    constexpr int ST = FStr<PAT>::v * 8;
    lds_wr64<0>(p, x[0]); lds_wr64<ST>(p, x[1]); lds_wr64<2 * ST>(p, x[2]); lds_wr64<3 * ST>(p, x[3]); lds_wr64<4 * ST>(p, x[4]); lds_wr64<5 * ST>(p, x[5]); lds_wr64<6 * ST>(p, x[6]); lds_wr64<7 * ST>(p, x[7]);
    lds_wr64<8 * ST>(p, x[8]); lds_wr64<9 * ST>(p, x[9]); lds_wr64<10 * ST>(p, x[10]); lds_wr64<11 * ST>(p, x[11]); lds_wr64<12 * ST>(p, x[12]); lds_wr64<13 * ST>(p, x[13]); lds_wr64<14 * ST>(p, x[14]); lds_wr64<15 * ST>(p, x[15]);
    FFT_LGKM0();
}
template <int PAT> __device__ __forceinline__ void fstore_geo(cf (&v)[16], cf* buf, int tp, cf t0, cf r) {
    const cf r2 = cmul(r, r); cf te = t0, to = cmul(t0, r); cf x[16];
#pragma unroll
    for (int k = 0; k < 16; k += 2) { x[k] = cmul(v[REV4(k)], te); x[k + 1] = cmul(v[REV4(k + 1)], to); te = cmul(te, r2); to = cmul(to, r2); }
    fstore_raw<PAT>(x, buf, tp);
}
#ifndef FFT_GEO
#define FFT_GEO 1
#endif
template <int PAT> __device__ __forceinline__ void fstore_ang(cf (&v)[16], cf* buf, int tp, float a0, float ar) {
#if FFT_GEO
    fstore_geo<PAT>(v, buf, tp, cis_rev(a0), cis_rev(ar));
#else
    cf x[16];
#pragma unroll
    for (int k = 0; k < 16; ++k) x[k] = cmul(v[REV4(k)], cis_rev(a0 + (float)k * ar));
    fstore_raw<PAT>(x, buf, tp);
#endif
}
__device__ __forceinline__ void ftw_build(cf (&tw)[16], cf t0, cf r) {
    const cf r2 = cmul(r, r); cf te = t0, to = cmul(t0, r);
#pragma unroll
    for (int k = 0; k < 16; k += 2) { tw[k] = te; tw[k + 1] = to; te = cmul(te, r2); to = cmul(to, r2); }
}
template <int PAT> __device__ __forceinline__ void fstore_tw(cf (&v)[16], cf* buf, int tp, const cf (&tw)[16]) {
    cf x[16];
#pragma unroll
    for (int k = 0; k < 16; ++k) x[k] = cmul(v[REV4(k)], tw[k]);
    fstore_raw<PAT>(x, buf, tp);
}
#define W32C(j) ((j) == 0 ? 1.f : (j) == 1 ? 0.98078528f : (j) == 2 ? 0.92387953f : (j) == 3 ? 0.83146961f : (j) == 4 ? 0.70710678f : (j) == 5 ? 0.55557023f : (j) == 6 ? 0.38268343f : (j) == 7 ? 0.19509032f : (j) == 8 ? 0.f : \
                 (j) == 9 ? -0.19509032f : (j) == 10 ? -0.38268343f : (j) == 11 ? -0.55557023f : (j) == 12 ? -0.70710678f : (j) == 13 ? -0.83146961f : (j) == 14 ? -0.92387953f : -0.98078528f)
#define W32S(j) ((j) == 0 ? 0.f : (j) == 1 ? 0.19509032f : (j) == 2 ? 0.38268343f : (j) == 3 ? 0.55557023f : (j) == 4 ? 0.70710678f : (j) == 5 ? 0.83146961f : (j) == 6 ? 0.92387953f : (j) == 7 ? 0.98078528f : (j) == 8 ? 1.f : \
                 (j) == 9 ? 0.98078528f : (j) == 10 ? 0.92387953f : (j) == 11 ? 0.83146961f : (j) == 12 ? 0.70710678f : (j) == 13 ? 0.55557023f : (j) == 14 ? 0.38268343f : 0.19509032f)
__device__ __forceinline__ void fft_fwd_pass1(cf (&v)[16], cf* buf, int tp, int str) {
    if (str) {
#pragma unroll
        for (int j = 1; j < 16; ++j) v[j] = cmul(v[j], cf{W32C(j), -W32S(j)});
    }
    dft16<-1>(v);
    fstore_ang<0>(v, buf, tp, str ? -(float)tp * (1.f / 8192.f) : 0.f, -(float)(tp >> 4) * (1.f / 256.f));
}
__device__ __forceinline__ void fft_fwd_pass2(cf* buf, int tp0, const cf (&tw)[16]) {
    const int tp = hide(tp0);
    cf v[16]; fload_dft16<1, -1>(v, buf, tp);
    fstore_tw<1>(v, buf, tp, tw);
}
__device__ __forceinline__ void fft_inv_pass2(cf* buf, int tp0, int str) {
    const int tp = hide(tp0);
    cf v[16]; fload_dft16<1, 1>(v, buf, tp);
    const int n0 = tp & 15, k2 = tp >> 4;
    fstore_ang<1>(v, buf, tp, str ? (float)n0 * (1.f / 8192.f) : 0.f, (float)k2 * (1.f / 256.f) + (str ? (1.f / 512.f) : 0.f));
}
__device__ __forceinline__ void fft_inv_pass3(cf* buf, int tp0, int str) {
    const int tp = hide(tp0);
    cf v[16]; fload_dft16<0, 1>(v, buf, tp);
    cf x[16];
#pragma unroll
    for (int k = 0; k < 16; ++k) { x[k] = v[REV4(k)]; if (str && k > 0) x[k] = cmul(x[k], cf{W32C(k), W32S(k)}); }
    fstore_raw<0>(x, buf, tp);
}

struct Row8 { u32x4 a; unsigned short l, r; };
__device__ __forceinline__ void load_row8(const bf16* rowp, int n0, Row8& q) {
    q.a = *(const u32x4*)(rowp + n0); const unsigned short l = rowp[n0 > 0 ? n0 - 1 : 0], r = rowp[n0 + 8 < 4096 ? n0 + 8 : 4095]; q.l = n0 > 0 ? l : (unsigned short)0; q.r = n0 + 8 < 4096 ? r : (unsigned short)0;
}
__device__ __forceinline__ void conv3_row8(const Row8& q, float w0, float w1, float w2, float bb, float (&o)[8]) {
    const float r[10] = {bf2f(q.l), bflo(q.a.x), bfhi(q.a.x), bflo(q.a.y), bfhi(q.a.y), bflo(q.a.z), bfhi(q.a.z), bflo(q.a.w), bfhi(q.a.w), bf2f(q.r)};
#pragma unroll
    for (int i = 0; i < 8; ++i) o[i] = w0 * r[i] + w1 * r[i + 1] + w2 * r[i + 2] + bb;
}

__device__ __forceinline__ void phase_hyena_fft(const Params& P, unsigned char* lds, int tid, int lane, int wave, int G) {
    cf* bufE = (cf*)lds; cf* bufO = (cf*)(lds + FFT_BUF); cf* zbuf = (cf*)(lds + FFT_ZB);
    float* w3c = (float*)(lds + FFT_W3); float* red = (float*)(lds + FFT_RED);
    const int str = __builtin_amdgcn_readfirstlane(tid >> 8), tp0 = tid & 255; cf* buf = str ? bufO : bufE;
    const bf16* Pt = (const bf16*)(P.ws + WS_PT); bf16* Zt = (bf16*)(P.ws + WS_ZT);
    cf* Hs = (cf*)(P.ws + WS_HSPEC) + (size_t)blockIdx.x * 4 * 4096;
    const float* a2T = (const float*)(P.ws + WS_A2);
#ifndef FFT_SBAR
#define FFT_SBAR 1
#endif
    unsigned* sb = (unsigned*)(lds + FFT_RED + 64) + str; unsigned sgen = 0u;
    if (tid < 2) ((unsigned*)(lds + FFT_RED + 64))[tid] = 0u;
#if FFT_SBAR
#define STREAM_BAR() do { asm volatile("s_waitcnt vmcnt(0) lgkmcnt(0)" ::: "memory"); sgen += 4u; \
        if (lane == 0) __hip_atomic_fetch_add(sb, 1u, __ATOMIC_RELAXED, __HIP_MEMORY_SCOPE_WORKGROUP); \
        while ((unsigned)__builtin_amdgcn_readfirstlane((int)__hip_atomic_load(sb, __ATOMIC_RELAXED, __HIP_MEMORY_SCOPE_WORKGROUP)) < sgen) __builtin_amdgcn_s_sleep(0); \
        asm volatile("" ::: "memory"); } while (0)
#else
#define STREAM_BAR() __syncthreads()
#endif
    cf tw2[16];
    { const int n0 = tp0 & 15, k2 = tp0 >> 4;
      ftw_build(tw2, cis_rev(-(float)(n0 * k2) * (1.f / 4096.f)), cis_rev(-(float)n0 * (1.f / 256.f))); }
#pragma unroll 1
    for (int c = blockIdx.x; c < 1024; c += G) {
        __syncthreads();
        if (tid < 256) w3c[tid] = P.in[I_HW3][(size_t)(tid & 63) * 4096 + (tid >> 6) * 1024 + c];
#ifndef FFT_ROWPF
#define FFT_ROWPF 0
#endif
        Row8 va, vb;
#if FFT_ROWPF
        load_row8(Pt + (size_t)c * 32768, hide(tid) * 8, va); load_row8(Pt + (size_t)c * 32768 + 4096, hide(tid) * 8, vb);
#endif
        __syncthreads();
        {
            float d[8][4];
#pragma unroll
            for (int j = 0; j < 8; ++j) { d[j][0] = 0.f; d[j][1] = 0.f; d[j][2] = 0.f; d[j][3] = 0.f; }
#pragma unroll 2
            for (int i = 0; i < 64; ++i) { const float w0 = w3c[i], w1 = w3c[64 + i], w2 = w3c[128 + i], w3 = w3c[192 + i]; const float* ar = a2T + (size_t)i * 4096 + tid;
#pragma unroll
                for (int j = 0; j < 8; ++j) { const float a = ar[512 * j]; d[j][0] += a * w0; d[j][1] += a * w1; d[j][2] += a * w2; d[j][3] += a * w3; } }
            float dec[4];
#pragma unroll
            for (int q = 0; q < 4; ++q) dec[q] = fabsf(P.in[I_HDEC][q * 1024 + c]) * (1.4426950408889634f / 4095.f);
            float as0 = 0.f, as1 = 0.f;
#pragma unroll
            for (int j = 0; j < 8; ++j) { const int t = tid + 512 * j; const float tf = (float)t;
                const float h0 = d[j][0] * __builtin_amdgcn_exp2f(-tf * dec[0]), h1 = d[j][1] * __builtin_amdgcn_exp2f(-tf * dec[1]), h2 = d[j][2] * __builtin_amdgcn_exp2f(-tf * dec[2]), h3 = d[j][3] * __builtin_amdgcn_exp2f(-tf * dec[3]);
                float* hb0 = (float*)(lds + FFT_ZB); float* hb1 = (float*)(lds + FFT_HB1);
                hb0[t] = h0; hb0[4096 + t] = h1; hb1[t] = h2; hb1[4096 + t] = h3; as0 += fabsf(h0) + fabsf(h1); as1 += fabsf(h2) + fabsf(h3); }
            as0 = wave_sum(as0); as1 = wave_sum(as1); if (lane == 0) { red[wave] = as0; red[8 + wave] = as1; }
        }
        __syncthreads();
#pragma unroll 1
        for (int o = 0; o < 2; ++o) {
            const float* hbuf = (const float*)(lds + (o == 0 ? FFT_ZB : FFT_HB1));
            float tot = 0.f;
#pragma unroll
            for (int w = 0; w < 8; ++w) tot += red[8 * o + w];
            const float inv = 1.f / ((tot + 1e-6f) * 8192.f);
            { const int tp = hide(tp0); cf v[16];
#pragma unroll
              for (int j = 0; j < 16; ++j) { const int n = tp + 256 * j; const float ta = (hbuf[n] + (n == 0 ? hbuf[4096] : 0.f)) * inv, tb = (n == 0 ? 0.f : hbuf[4096 + 4096 - n]) * inv;
                  v[j] = cf{str ? ta - tb : ta + tb, 0.f}; }
              fft_fwd_pass1(v, buf, tp, str); }
            STREAM_BAR();
            fft_fwd_pass2(buf, tp0, tw2);
            STREAM_BAR();
            { const int tp = hide(tp0); cf v[16]; fload_dft16<2, -1>(v, buf, tp);
              cf* hp = Hs + (size_t)(o * 2 + str) * 4096 + tp;
#pragma unroll
              for (int k = 0; k < 16; ++k) hp[k * 256] = v[REV4(k)]; }
            __syncthreads();
        }
#pragma unroll 1
        for (int pr = 0; pr < 4; ++pr) {
            { const int n0 = hide(tid) * 8; float oa[8], ob[8];
#if !FFT_ROWPF
              load_row8(Pt + (size_t)c * 32768 + (2 * pr) * 4096, n0, va); load_row8(Pt + (size_t)c * 32768 + (2 * pr + 1) * 4096, n0, vb);
#endif
              const float w0 = P.in[I_HCW][c], w1 = P.in[I_HCW][3072 + c], w2 = P.in[I_HCW][6144 + c], bb = P.in[I_HCB][c];
              conv3_row8(va, w0, w1, w2, bb, oa); conv3_row8(vb, w0, w1, w2, bb, ob);
#pragma unroll
              for (int i = 0; i < 8; ++i) zbuf[n0 + i] = cf{oa[i], ob[i]}; }
            __syncthreads();
#pragma unroll 1
            for (int o = 0; o < 2; ++o) {
                Row8 ga, gb;
#if FFT_ROWPF
                { const int n0 = hide(tid) * 8; const size_t grow = (size_t)((o + 1) * 1024 + c) * 32768;
                    load_row8(Pt + grow + (2 * pr) * 4096, n0, ga); load_row8(Pt + grow + (2 * pr + 1) * 4096, n0, gb);
                    const int prn = pr < 3 ? pr + 1 : 3;
                    load_row8(Pt + (size_t)c * 32768 + (2 * prn) * 4096, n0, va); load_row8(Pt + (size_t)c * 32768 + (2 * prn + 1) * 4096, n0, vb); }
#endif
                { const int tp = hide(tp0); cf v[16];
#pragma unroll
                  for (int j = 0; j < 16; ++j) v[j] = zbuf[tp + 256 * j];
                  fft_fwd_pass1(v, buf, tp, str); }
                STREAM_BAR();
#ifndef FFT_PF
#define FFT_PF 1
#endif
                cf hq[16];
#if FFT_PF
                { const cf* hp = Hs + (size_t)(o * 2 + str) * 4096 + hide(tp0);
#pragma unroll
                  for (int k = 0; k < 16; ++k) hq[k] = hp[k * 256]; }
#endif
                fft_fwd_pass2(buf, tp0, tw2);
                STREAM_BAR();
                { const int tp = hide(tp0); cf v[16]; fload_dft16<2, -1>(v, buf, tp);
#if !FFT_PF
                  { const cf* hp = Hs + (size_t)(o * 2 + str) * 4096 + tp;
#pragma unroll
                  for (int k = 0; k < 16; ++k) hq[k] = hp[k * 256]; }
#endif
                  cf y[16];
#pragma unroll
                  for (int k = 0; k < 16; ++k) y[k] = cmul(v[REV4(k)], hq[k]);
                  dft16<1>(y);
                  fstore_ang<2>(y, buf, tp, 0.f, (float)((tp >> 4) + 16 * (tp & 15)) * (1.f / 4096.f)); }
                STREAM_BAR();
                fft_inv_pass2(buf, tp0, str);
                STREAM_BAR();
                fft_inv_pass3(buf, tp0, str);
                __syncthreads();
                { const int n0 = hide(tid) * 8;
#if !FFT_ROWPF
                  { const size_t grow = (size_t)((o + 1) * 1024 + c) * 32768; load_row8(Pt + grow + (2 * pr) * 4096, n0, ga); load_row8(Pt + grow + (2 * pr + 1) * 4096, n0, gb); }
#endif
                  const int gc = (o + 1) * 1024 + c;
                  const float w0 = P.in[I_HCW][gc], w1 = P.in[I_HCW][3072 + gc], w2 = P.in[I_HCW][6144 + gc], bb = P.in[I_HCB][gc];
                  const float sk = P.in[I_HSKIP][o * 1024 + c]; float g0[8], g1[8], oa[8], ob[8];
                  conv3_row8(ga, w0, w1, w2, bb, g0); conv3_row8(gb, w0, w1, w2, bb, g1);
#pragma unroll
                  for (int i = 0; i < 8; ++i) { const int n = n0 + i; const cf e = bufE[fphys(n)], q = bufO[fphys(n)], z = zbuf[n];
                      oa[i] = (e.x + q.x + sk * z.x) * g0[i]; ob[i] = (e.y + q.y + sk * z.y) * g1[i]; }
                  if (o == 0) {
#pragma unroll
                      for (int i = 0; i < 8; ++i) zbuf[n0 + i] = cf{oa[i], ob[i]};
                  } else {
                      u32x4 wa, wb; wa.x = pk2(oa[0], oa[1]); wa.y = pk2(oa[2], oa[3]); wa.z = pk2(oa[4], oa[5]); wa.w = pk2(oa[6], oa[7]);
                      wb.x = pk2(ob[0], ob[1]); wb.y = pk2(ob[2], ob[3]); wb.z = pk2(ob[4], ob[5]); wb.w = pk2(ob[6], ob[7]);
                      *(u32x4*)(Zt + (size_t)c * 32768 + (2 * pr) * 4096 + n0) = wa; *(u32x4*)(Zt + (size_t)c * 32768 + (2 * pr + 1) * 4096 + n0) = wb;
                  } }
                __syncthreads();
            }
        }
    }
}
__device__ __forceinline__ void phase_transpose(const Params& P, unsigned char* lds, int lane, int wave, int G) {
    bf16* tile = (bf16*)(lds + wave * 16384);
    const bf16* Zt = (const bf16*)(P.ws + WS_ZT); bf16* Z = (bf16*)(P.ws + WS_Z);
    for (int it = blockIdx.x * 8 + wave; it < 16 * 512; it += G * 8) {
        const int cb = it & 15, tb = it >> 4, c0 = cb * 64, t0 = tb * 64;
#pragma unroll
        for (int i = 0; i < 8; ++i) { const int ch = i * 8 + (lane >> 3), tq = (lane & 7) * 8;
            const u32x4 a = *(const u32x4*)(Zt + (size_t)(c0 + ch) * 32768 + t0 + tq);
            unsigned* d = (unsigned*)(tile + ch * 66 + tq); d[0] = a.x; d[1] = a.y; d[2] = a.z; d[3] = a.w; }
        LDS_WAIT(); asm volatile("" ::: "memory");
#pragma unroll
        for (int i = 0; i < 8; ++i) { const int tk = i * 8 + (lane >> 3), cq = (lane & 7) * 8;
            unsigned short e[8];
#pragma unroll
            for (int j = 0; j < 8; ++j) e[j] = tile[(cq + j) * 66 + tk];
            u32x4 w; w.x = e[0] | ((unsigned)e[1] << 16); w.y = e[2] | ((unsigned)e[3] << 16); w.z = e[4] | ((unsigned)e[5] << 16); w.w = e[6] | ((unsigned)e[7] << 16);
            *(u32x4*)(Z + (size_t)(t0 + tk) * 1024 + c0 + cq) = w; }
        LDS_WAIT(); asm volatile("" ::: "memory");
    }
}

constexpr int N_PHASES = 21;
__global__ void __launch_bounds__(512, 2) fwd_kernel(Params P0) {
    extern __shared__ __attribute__((aligned(16))) unsigned char lds[];
    const int tid = threadIdx.x, lane = tid & 63, wave = __builtin_amdgcn_readfirstlane(tid >> 6), G = gridDim.x;
    PG8_LAS unsigned char* ldsl = (PG8_LAS unsigned char*)lds;
    for (int u = tid; u < (LDS_BYTES - LDSCTL_OFF) / 4; u += 512) ((unsigned*)(lds + LDSCTL_OFF))[u] = 0u;
    __syncthreads();
#if MK_ONE_LAUNCH
    XcdBarrier bar = xcd_barrier_post((unsigned*)(P0.ws + WS_CTL) + CW_BAR, (volatile LAS unsigned*)(ldsl + MISC_OFF) + 8);
#define GRID_BAR() xcd_barrier(bar)
#else
#define GRID_BAR() do { } while (0)
#endif
    const int lo = P0.ph_lo, hi = P0.ph_hi;
#ifndef PHASE_MASK
#define PHASE_MASK 0xFFFFFFFFu
#endif
#define IN(k) ((((PHASE_MASK) >> (k)) & 1u) && lo <= (k) && (k) < hi)
#ifndef DELAY_MASK
#define DELAY_MASK 0u
#endif
#ifndef CLKP
#define CLKP -1
#endif
    unsigned long long clk_c0 = 0, clk_r0 = 0;
    unsigned long long t_ph = 0;
#define SEAM(k) do { if (IN(k) && IN((k) + 1)) GRID_BAR(); \
    if (((DELAY_MASK) >> (k)) & 1u) { const unsigned long long t1 = __builtin_amdgcn_s_memrealtime(); const unsigned long long dt = t1 - t_ph; while (__builtin_amdgcn_s_memrealtime() - t1 < dt) __builtin_amdgcn_s_sleep(8); __syncthreads(); } \
    if ((k) == CLKP) { const unsigned long long c1 = __builtin_readcyclecounter(), r1 = __builtin_amdgcn_s_memrealtime(); \
        const unsigned long long ticks = (c1 - clk_c0) * 1000ull / (r1 - clk_r0 + 1ull);   \
        while (__builtin_amdgcn_s_memrealtime() - r1 < ticks) __builtin_amdgcn_s_sleep(8); __syncthreads(); } \
    if ((k) + 1 == CLKP) { clk_c0 = __builtin_readcyclecounter(); clk_r0 = __builtin_amdgcn_s_memrealtime(); } \
    if (((DELAY_MASK) >> ((k) + 1)) & 1u) t_ph = __builtin_amdgcn_s_memrealtime(); } while (0)
#ifndef REPEAT_MASK
#define REPEAT_MASK 0u
#endif
#ifndef REPEAT_SUB
#define REPEAT_SUB 0u
#endif
#define REPS(k) for (int reps_ = 0; reps_ < ((((REPEAT_SUB) >> (k)) & 1u) ? 2 : 1); ++reps_)
#define REP(k) for (int rep_ = 0; rep_ < ((((REPEAT_MASK) >> (k)) & 1u) ? 2 : 1); ++rep_)

    if (DELAY_MASK & 1u) t_ph = __builtin_amdgcn_s_memrealtime();
    if (IN(0)) REP(0) { const Params P = load_params(); unsigned char* ws = P.ws; phase_prologue(P, lds, tid, lane, wave, G); } SEAM(0);
    if (IN(1)) REP(1) { const Params P = load_params(); unsigned char* ws = P.ws; phase_norm1_l0(P, lane, wave, G); } SEAM(1);
    if (IN(2)) REP(2) { const Params P = load_params(); unsigned char* ws = P.ws;
        pg8::Gemm g{(const bf16*)(ws + WS_RH), (const bf16*)(ws + WS_WIN), 1024, 1024, 1024, 0}; pg8::StaticOrder S; S.init(M0 / 256, 7, G, (int)blockIdx.x);
        EpiIn E{(bf16*)(ws + WS_CQ), (bf16*)(ws + WS_CKV), (bf16*)(ws + WS_UX), (bf16*)(ws + WS_UG), (bf16*)(ws + WS_K)};
        pg8::gemm_phase<EpiIn, pg8::StaticOrder, GP_ALIGN, GP_SP2>(ldsl, g, S, E);
    } SEAM(2);
    if (IN(3)) REP(3) { const Params P = load_params(); unsigned char* ws = P.ws; phase_rowstat(P, lane, wave, G); phase_lru_f1(P, lds, tid, lane, wave, G); } SEAM(3);
    if (IN(4)) REP(4) { const Params P = load_params(); unsigned char* ws = P.ws;
        phase_lru_carry(P, lane, wave, G);
        __syncthreads();
#ifndef NO_QUP
        REPS(0) { pg8::Gemm g{(const bf16*)(ws + WS_CQ), (const bf16*)(ws + WS_WUQ), 384, 384, 384, 0}; pg8::StaticOrder S; S.init(M0 / 256, 3, G, (int)blockIdx.x);
          EpiQ E{(bf16*)(ws + WS_Q), (const float*)(ws + WS_RQ)};
          pg8::gemm_phase<EpiQ, pg8::StaticOrder, GP_ALIGN, GP_SP2>(ldsl, g, S, E); }
#endif
        __syncthreads();
        REPS(1) { pg8::Gemm g{(const bf16*)(ws + WS_CKV), (const bf16*)(ws + WS_WUKV), 256, 256, 256, 0}; pg8::StaticOrder S; S.init(M0 / 256, 4, G, (int)blockIdx.x);
          EpiKV E{(bf16*)(ws + WS_K), (bf16*)(ws + WS_V), (const float*)(ws + WS_RKV)};
          pg8::gemm_phase<EpiKV, pg8::StaticOrder, GP_ALIGN, GP_SP2>(ldsl, g, S, E); }
        __syncthreads();
    } SEAM(4);
    if (IN(5)) REP(5) { const Params P = load_params(); unsigned char* ws = P.ws; REPS(2) phase_lru_f3(P, lds, tid, lane, wave, G); REPS(3) phase_attention(P, lds, G); } SEAM(5);
    if (IN(6)) REP(6) { const Params P = load_params(); unsigned char* ws = P.ws;
        pg8::Gemm g{(const bf16*)(ws + WS_RH), (const bf16*)(ws + WS_WOUT), 1024, 1024, 1024, 0}; pg8::StaticOrder S; S.init(M0 / 256, 4, G, (int)blockIdx.x);
        EpiRes<0> E{P.in[I_X], P.in[I_CTX], (const float*)(ws + WS_MOD), nullptr, (bf16*)P.out, (bf16*)(ws + WS_XC)};
        pg8::gemm_phase<EpiRes<0>, pg8::StaticOrder, GP_ALIGN, GP_SP2>(ldsl, g, S, E);
    } SEAM(6);
    if (IN(7)) REP(7) { const Params P = load_params(); unsigned char* ws = P.ws; phase_norm2_route<0>(P, lds, tid, lane, wave, G); } SEAM(7);
    if (IN(8)) REP(8) { const Params P = load_params(); unsigned char* ws = P.ws; phase_permute<0>(P, lds, tid, lane, wave, G); } SEAM(8);
    if (IN(9)) REP(9) { const Params P = load_params(); unsigned char* ws = P.ws;
        const int* te = (const int*)(ws + WS_TILEE); const int nmt = te[MAXTILES];
        { int* gl = (int*)(lds + RING_BYTES); const int* st = (const int*)(ws + WS_SLOTTOK);
          for (int i = 0; ; ++i) { const long L = (long)i * G + ((G % 8 == 0) ? ((int)blockIdx.x % 8) * (G / 8) + (int)blockIdx.x / 8 : (int)blockIdx.x); if (L >= (long)nmt * 4 || i >= 20) break; if (tid < 256) gl[i * 256 + tid] = st[(int)(L >> 2) * 256 + tid]; }
          __syncthreads(); }
        pg8::Gemm g{(const bf16*)(ws + WS_RH), (const bf16*)(ws + WS_W13), 1024, 1024, 1024, (size_t)1024 * 1024 * 2, RING_BYTES}; pg8::MoeOrder S{nmt, G, (G % 8 == 0) ? ((int)blockIdx.x % 8) * (G / 8) + (int)blockIdx.x / 8 : (int)blockIdx.x, te};
        EpiMoe1 E{(bf16*)(ws + WS_ACT)};
        pg8::gemm_phase<EpiMoe1, pg8::MoeOrder, GP_ALIGN, GP_SP2, true>(ldsl, g, S, E);
    } SEAM(9);
    if (IN(10)) REP(10) { const Params P = load_params(); unsigned char* ws = P.ws;
        const int* te = (const int*)(ws + WS_TILEE);
        pg8::Gemm g{(const bf16*)(ws + WS_ACT), (const bf16*)(ws + WS_W2), 512, 512, 512, (size_t)1024 * 512 * 2}; pg8::MoeOrder S{te[MAXTILES], G, (G % 8 == 0) ? ((int)blockIdx.x % 8) * (G / 8) + (int)blockIdx.x / 8 : (int)blockIdx.x, te};
        EpiStore E{(bf16*)(ws + WS_HPERM), 1024};
        pg8::gemm_phase<EpiStore, pg8::MoeOrder, GP_ALIGN, GP_SP2>(ldsl, g, S, E);
    } SEAM(10);
    if (IN(11)) REP(11) { const Params P = load_params(); unsigned char* ws = P.ws; phase_combine_norm1_l1(P, lane, wave, G); } SEAM(11);
    if (IN(12)) REP(12) { const Params P = load_params(); unsigned char* ws = P.ws;
        pg8::Gemm g{(const bf16*)(ws + WS_WHIN), (const bf16*)(ws + WS_RH), 1024, 1024, 1024, 0}; pg8::StaticOrder S; S.init(3072 / 256, M1 / 256, G, (int)blockIdx.x);
        EpiStore E{(bf16*)(ws + WS_PT), 32768};
        pg8::gemm_phase<EpiStore, pg8::StaticOrder, GP_ALIGN, GP_SP2>(ldsl, g, S, E);
    } SEAM(12);
    if (IN(13)) REP(13) { const Params P = load_params(); unsigned char* ws = P.ws; phase_hyena_fft(P, lds, tid, lane, wave, G); } SEAM(13);
    if (IN(14)) REP(14) { const Params P = load_params(); unsigned char* ws = P.ws; phase_transpose(P, lds, lane, wave, G); } SEAM(14);
    if (IN(15)) REP(15) { const Params P = load_params(); unsigned char* ws = P.ws;
        pg8::Gemm g{(const bf16*)(ws + WS_Z), (const bf16*)(ws + WS_WHOUT), 1024, 1024, 1024, 0}; pg8::StaticOrder S; S.init(M1 / 256, 4, G, (int)blockIdx.x);
        EpiRes<1> E{nullptr, nullptr, (const float*)(ws + WS_MOD), (const bf16*)((unsigned char*)P.out + X2_OFF), (bf16*)(ws + WS_X3), nullptr};
        pg8::gemm_phase<EpiRes<1>, pg8::StaticOrder, GP_ALIGN, GP_SP2>(ldsl, g, S, E);
    } SEAM(15);
    if (IN(16)) REP(16) { const Params P = load_params(); unsigned char* ws = P.ws; phase_norm2_route<1>(P, lds, tid, lane, wave, G); } SEAM(16);
    if (IN(17)) REP(17) { const Params P = load_params(); unsigned char* ws = P.ws; phase_permute<1>(P, lds, tid, lane, wave, G); } SEAM(17);
    if (IN(18)) REP(18) { const Params P = load_params(); unsigned char* ws = P.ws;
        const int* te = (const int*)(ws + WS_TILEE); const int nmt = te[MAXTILES];
        { int* gl = (int*)(lds + RING_BYTES); const int* st = (const int*)(ws + WS_SLOTTOK);
          for (int i = 0; ; ++i) { const long L = (long)i * G + ((G % 8 == 0) ? ((int)blockIdx.x % 8) * (G / 8) + (int)blockIdx.x / 8 : (int)blockIdx.x); if (L >= (long)nmt * 4 || i >= 20) break; if (tid < 256) gl[i * 256 + tid] = st[(int)(L >> 2) * 256 + tid]; }
          __syncthreads(); }
        pg8::Gemm g{(const bf16*)(ws + WS_RH), (const bf16*)(ws + WS_W13) + (size_t)16 * 1024 * 1024, 1024, 1024, 1024, (size_t)1024 * 1024 * 2, RING_BYTES}; pg8::MoeOrder S{nmt, G, (G % 8 == 0) ? ((int)blockIdx.x % 8) * (G / 8) + (int)blockIdx.x / 8 : (int)blockIdx.x, te};
        EpiMoe1 E{(bf16*)(ws + WS_ACT)};
        pg8::gemm_phase<EpiMoe1, pg8::MoeOrder, GP_ALIGN, GP_SP2, true>(ldsl, g, S, E);
    } SEAM(18);
    if (IN(19)) REP(19) { const Params P = load_params(); unsigned char* ws = P.ws;
        const int* te = (const int*)(ws + WS_TILEE);
        pg8::Gemm g{(const bf16*)(ws + WS_ACT), (const bf16*)(ws + WS_W2) + (size_t)16 * 1024 * 512, 512, 512, 512, (size_t)1024 * 512 * 2}; pg8::MoeOrder S{te[MAXTILES], G, (G % 8 == 0) ? ((int)blockIdx.x % 8) * (G / 8) + (int)blockIdx.x / 8 : (int)blockIdx.x, te};
        EpiStore E{(bf16*)(ws + WS_HPERM), 1024};
        pg8::gemm_phase<EpiStore, pg8::MoeOrder, GP_ALIGN, GP_SP2>(ldsl, g, S, E);
    } SEAM(19);
    if (IN(20)) REP(20) { const Params P = load_params(); unsigned char* ws = P.ws; phase_final(P, lane, wave, G); } SEAM(20);
#undef IN
#undef SEAM
}

extern "C" void kernel_launch(void* const* d_in, const int* in_sizes, int n_in, void* d_out, int out_size, void* d_ws, size_t ws_size, hipStream_t stream) {
    static int grid = 0;
    if (grid == 0) {
        if (n_in != N_IN || out_size != M1 * DM || ws_size < WS_END) { fprintf(stderr, "kernel_launch: unexpected shapes (n_in %d out %d ws %zu)\n", n_in, out_size, ws_size); grid = -1; return; }
        int dev = 0, cus = 0;
        if (hipGetDevice(&dev) != hipSuccess || hipDeviceGetAttribute(&cus, hipDeviceAttributeMultiprocessorCount, dev) != hipSuccess) { grid = -1; return; }
        if (hipFuncSetAttribute((const void*)fwd_kernel, hipFuncAttributeMaxDynamicSharedMemorySize, LDS_BYTES) != hipSuccess) { fprintf(stderr, "kernel_launch: hipFuncSetAttribute failed\n"); grid = -1; return; }
        int per_cu = 0;
        if (hipOccupancyMaxActiveBlocksPerMultiprocessor(&per_cu, (const void*)fwd_kernel, 512, LDS_BYTES) != hipSuccess || per_cu < 1) fprintf(stderr, "kernel_launch: occupancy query reports %d\n", per_cu);
        (void)hipGetLastError();
        grid = cus;
    }
    if (grid < 0) return;
    (void)hipMemsetAsync((char*)d_ws + WS_CTL, 0, CTL_ZERO_BYTES, stream);
    Params p{};
    for (int i = 0; i < N_IN; ++i) p.in[i] = (const float*)d_in[i];
    p.out = (float*)d_out; p.ws = (unsigned char*)d_ws;
#if MK_ONE_LAUNCH
    p.ph_lo = 0; p.ph_hi = N_PHASES;
    hipLaunchKernelGGL(fwd_kernel, dim3(grid), dim3(512), LDS_BYTES, stream, p);
#else
    for (int k = 0; k < N_PHASES; ++k) { p.ph_lo = k; p.ph_hi = k + 1; hipLaunchKernelGGL(fwd_kernel, dim3(grid), dim3(512), LDS_BYTES, stream, p); }
#endif
}
```

```cpp
#include <hip/hip_runtime.h>
#include <cstdio>
#include <cstdint>

#ifndef MK_ONE_LAUNCH
#define MK_ONE_LAUNCH 1
#endif

#define LAS __attribute__((address_space(3)))
#define GAS __attribute__((address_space(1)))
typedef unsigned short bf16;
typedef short bf16x8 __attribute__((ext_vector_type(8)));
typedef short s16x4 __attribute__((ext_vector_type(4)));
typedef float f32x2 __attribute__((ext_vector_type(2)));
typedef float f32x4 __attribute__((ext_vector_type(4)));
typedef float f32x16 __attribute__((ext_vector_type(16)));
typedef unsigned u32x2 __attribute__((ext_vector_type(2)));
typedef unsigned u32x4 __attribute__((ext_vector_type(4)));
#define LDS_WAIT() asm volatile("s_waitcnt lgkmcnt(0)" ::: "memory")
#define VM_WAIT() asm volatile("s_waitcnt vmcnt(0)" ::: "memory")

__device__ __forceinline__ unsigned f2bf(float f) { unsigned u = __builtin_bit_cast(unsigned, f); return (u + 0x7fffu + ((u >> 16) & 1u)) >> 16; }
__device__ __forceinline__ unsigned pk2(float lo, float hi) { return f2bf(lo) | (f2bf(hi) << 16); }
__device__ __forceinline__ float bf2f(unsigned b) { return __builtin_bit_cast(float, b << 16); }
__device__ __forceinline__ float bflo(unsigned w) { return __builtin_bit_cast(float, w << 16); }
__device__ __forceinline__ float bfhi(unsigned w) { return __builtin_bit_cast(float, w & 0xffff0000u); }
__device__ __forceinline__ float wave_sum(float v) {
#pragma unroll
    for (int o = 1; o < 64; o <<= 1) v += __shfl_xor(v, o);
    return v;
}
__device__ __forceinline__ float sigm(float x) { return 1.f / (1.f + expf(-x)); }

namespace pg8 {
#define PG8_LAS __attribute__((address_space(3)))
typedef unsigned short bf16_t;
constexpr int BM = 256, BK = 64, HALF = 128, HTB = HALF * BK * 2, STAGE_BYTES = 8 * HTB, NXCD = 8, WGM = 4;
__host__ __device__ __forceinline__ int lds_byte(int r, int c) { const int st = (r >> 4) * 2 + (c >> 5), rr = r & 15, cc = c & 31, ob = rr * 64 + cc * 2; return st * 1024 + (ob ^ (((ob >> 9) & 1) << 5)); }
__host__ __device__ __forceinline__ void stage_rc(int b, int& R, int& C) { const int st = b / 1024, sb = b % 1024, swz = sb ^ (((sb >> 9) & 1) << 5); R = (st >> 1) * 16 + swz / 64; C = (st & 1) * 32 + (swz % 64) / 2; }
__host__ __device__ __forceinline__ int perm32(int rho) { const int n = rho >> 4, i = rho & 15; return 8 * (i >> 2) + 4 * n + (i & 3); }

struct Unit { int pm, pn, bz; };
struct Gemm { const bf16_t* A; const bf16_t* Bt; int lda, ldb, K; size_t bz_stride; int gidx_off; };

struct StaticOrder {
    int nM, nN, nwg, G, c;
    __host__ __device__ void init(int nM_, int nN_, int G_, int c_) { nM = nM_; nN = nN_; nwg = nM * nN; G = G_; c = c_; }
    __host__ __device__ bool next(int i, Unit& u) const {
        const long L = (long)i * G + c; if (L >= nwg) return false;
        int wgid = (int)L; { const int q = nwg / NXCD, r = nwg % NXCD, xcd = wgid % NXCD, off = wgid / NXCD; wgid = (xcd < r ? xcd * (q + 1) : r * (q + 1) + (xcd - r) * q) + off; }
        const int nig = WGM * nN, gid = wgid / nig, fm = gid * WGM, gsz = (nM - fm) < WGM ? (nM - fm) : WGM;
        u.pm = fm + ((wgid % nig) % gsz); u.pn = (wgid % nig) / gsz; u.bz = 0; return true;
    }
    __device__ __forceinline__ void a_ready(const Unit&) const {}
    __device__ __forceinline__ void done(const Unit&) const {}
};
struct MoeOrder {
    int nM, G, c; const int* tile_e;
    __device__ bool next(int i, Unit& u) const {
        const long L = (long)i * G + c; if (L >= (long)nM * 4) return false;
        u.pm = (int)(L >> 2); u.pn = (int)(L & 3); u.bz = tile_e[u.pm]; return true;
    }
    __device__ __forceinline__ void a_ready(const Unit&) const {}
    __device__ __forceinline__ void done(const Unit&) const {}
};

__device__ __forceinline__ unsigned cvt_pk_bf16(float lo, float hi) { unsigned r; asm volatile("v_cvt_pk_bf16_f32 %0, %1, %2" : "=v"(r) : "v"(lo), "v"(hi)); return r; }

template <class Epi, class Sched, bool ALIGN_EPI = false, bool SP2 = false, bool GATHER = false>
__device__ __forceinline__ void gemm_phase(PG8_LAS unsigned char* lds, const Gemm g, const Sched& S, const Epi& E) {
    const int tid = threadIdx.x, wid = __builtin_amdgcn_readfirstlane(tid >> 6), lane = tid & 63, wr = wid >> 2, wc = wid & 3, fr = lane & 15, fq = lane >> 4;
    const int K = g.K, nt = K / BK;
    unsigned voffA[2], voffB[2];
#pragma unroll
    for (int i = 0; i < 2; ++i) { int R, C; stage_rc(tid * 16 + i * 8192, R, C); const int Rb = Epi::PERM ? ((R & ~31) + perm32(R & 31)) : R;
        voffA[i] = (unsigned)(R * g.lda + C) * 2u; voffB[i] = (unsigned)(Rb * g.ldb + C) * 2u; }
    unsigned vc0[2], vc1[2], vn0[2], vn1[2];
    const PG8_LAS int* gl = (const PG8_LAS int*)(lds + g.gidx_off);
#define PG8_GIDX(uix, v0, v1) do { _Pragma("unroll") for (int _i = 0; _i < 2; ++_i) { int _R, _C; stage_rc(tid * 16 + _i * 8192, _R, _C); \
        v0[_i] = (unsigned)(gl[(uix) * 256 + _R] * g.lda + _C) * 2u; v1[_i] = (unsigned)(gl[(uix) * 256 + 128 + _R] * g.lda + _C) * 2u; } } while (0)
    const size_t kstep = (size_t)(BK * 2);
    const size_t hstepA = (size_t)HALF * g.lda * 2, hstepB = (size_t)HALF * g.ldb * 2;
    const size_t tstepA = GATHER ? 0 : 2 * hstepA, tstepB = 2 * hstepB;
    const unsigned ldsw = (unsigned)wid * 1024u;
    const int aoff = lds_byte(wr * 64 + fr, fq * 8), boff = lds_byte(wc * 32 + fr, fq * 8);
#define PG8_SA(b, h) (((b) * 2 + (h)) * HTB)
#define PG8_SB(b, h) ((4 + (b) * 2 + (h)) * HTB)
#define PG8_STAGE(bufoff, gbase, voff) do { _Pragma("unroll") for (int _i = 0; _i < 2; ++_i) \
        __builtin_amdgcn_global_load_lds((const unsigned*)((const char*)(gbase) + (voff)[_i]), (PG8_LAS unsigned*)(lds + (bufoff) + ldsw + _i * 8192), 16, 0, 0); } while (0)
#define PG8_LDA(dst, b, h) do { _Pragma("unroll") for (int m = 0; m < 4; ++m) _Pragma("unroll") for (int k = 0; k < 2; ++k) dst[m][k] = *(const PG8_LAS bf16x8*)(lds + PG8_SA(b, h) + aoff + m * 2048 + k * 1024); } while (0)
#define PG8_LDB(dst, b, h) do { _Pragma("unroll") for (int n = 0; n < 2; ++n) _Pragma("unroll") for (int k = 0; k < 2; ++k) dst[n][k] = *(const PG8_LAS bf16x8*)(lds + PG8_SB(b, h) + boff + n * 2048 + k * 1024); } while (0)
#define PG8_MMA(ai, bj, At, Bt) do { __builtin_amdgcn_s_setprio(1); _Pragma("unroll") for (int m = 0; m < 4; ++m) _Pragma("unroll") for (int n = 0; n < 2; ++n) _Pragma("unroll") for (int k = 0; k < 2; ++k) \
        acc[ai][bj][m][n] = __builtin_amdgcn_mfma_f32_16x16x32_bf16(Bt[n][k], At[m][k], acc[ai][bj][m][n], 0, 0, 0); __builtin_amdgcn_s_setprio(0); } while (0)
#define PG8_WAIT_V(n) asm volatile("s_waitcnt vmcnt(" #n ")" ::: "memory")
#define PG8_WAIT_L(n) asm volatile("s_waitcnt lgkmcnt(" #n ")" ::: "memory")
#define PG8_BAR __builtin_amdgcn_s_barrier()
#define PG8_SCHED __builtin_amdgcn_sched_barrier(0)
    Unit cur, nxt; int ui = 0;
    if (!S.next(0, cur)) return;
    f32x4 acc[2][2][4][2];
#pragma unroll
    for (int a = 0; a < 2; ++a)
#pragma unroll
        for (int b = 0; b < 2; ++b)
#pragma unroll
            for (int m = 0; m < 4; ++m)
#pragma unroll
                for (int n = 0; n < 2; ++n) acc[a][b][m][n] = (f32x4){0.f, 0.f, 0.f, 0.f};
    bf16x8 At[4][2], B0[2][2], B1[2][2];
    const char* cA = (const char*)g.A + (size_t)cur.pm * tstepA; const char* cB = (const char*)g.Bt + (size_t)cur.bz * g.bz_stride + (size_t)cur.pn * tstepB;
    S.a_ready(cur);
    if constexpr (GATHER) { PG8_GIDX(0, vc0, vc1); vn0[0] = vc0[0]; vn0[1] = vc0[1]; vn1[0] = vc1[0]; vn1[1] = vc1[1]; }
#define PG8_STAGE_A0(bufoff, p, NX) do { if constexpr (GATHER) { unsigned _v[2] = {(NX) ? vn0[0] : vc0[0], (NX) ? vn0[1] : vc0[1]}; PG8_STAGE(bufoff, p, _v); } else PG8_STAGE(bufoff, p, voffA); } while (0)
#define PG8_STAGE_A1(bufoff, p, NX) do { if constexpr (GATHER) { unsigned _v[2] = {(NX) ? vn1[0] : vc1[0], (NX) ? vn1[1] : vc1[1]}; PG8_STAGE(bufoff, p, _v); } else PG8_STAGE(bufoff, (p) + hstepA, voffA); } while (0)
    if constexpr (SP2) {
        PG8_STAGE(PG8_SB(0, 0), cB, voffB); PG8_STAGE(PG8_SB(0, 1), cB + hstepB, voffB); PG8_STAGE_A0(PG8_SA(0, 0), cA, false); PG8_STAGE_A1(PG8_SA(0, 1), cA, false);
        if (wr == 1) PG8_BAR;
        PG8_WAIT_V(2); PG8_BAR;
        PG8_STAGE(PG8_SB(1, 0), cB + kstep, voffB); PG8_STAGE_A0(PG8_SA(1, 0), cA + kstep, false); PG8_STAGE(PG8_SB(1, 1), cB + hstepB + kstep, voffB);
        PG8_WAIT_V(6); PG8_BAR;
    } else {
        PG8_STAGE(PG8_SB(0, 0), cB, voffB); PG8_STAGE_A0(PG8_SA(0, 0), cA, false); PG8_STAGE(PG8_SB(0, 1), cB + hstepB, voffB); PG8_STAGE_A1(PG8_SA(0, 1), cA, false);
        if (wr == 1) PG8_BAR;
        PG8_WAIT_V(4); PG8_BAR;
        PG8_STAGE(PG8_SB(1, 0), cB + kstep, voffB); PG8_STAGE_A0(PG8_SA(1, 0), cA + kstep, false); PG8_STAGE(PG8_SB(1, 1), cB + hstepB + kstep, voffB);
        PG8_WAIT_V(6); PG8_BAR;
    }
    for (;;) {
        const bool has_next = S.next(ui + 1, nxt);
        const char* nA = has_next ? (const char*)g.A + (size_t)nxt.pm * tstepA : cA;
        const char* nB = has_next ? (const char*)g.Bt + (size_t)nxt.bz * g.bz_stride + (size_t)nxt.pn * tstepB : cB;
        if constexpr (GATHER) { if (has_next) PG8_GIDX(ui + 1, vn0, vn1); }
#pragma unroll 1
        for (int t = 0; t < nt; t += 2) {
            const bool last = (t == nt - 2);
            const char* a1 = cA + (size_t)(t + 1) * kstep;
            const char* a2 = last ? nA : cA + (size_t)(t + 2) * kstep; const char* b2 = last ? nB : cB + (size_t)(t + 2) * kstep;
            const char* a3 = a2 + kstep; const char* b3 = b2 + kstep;
            if (last && has_next) S.a_ready(nxt);
            if constexpr (SP2) {
            PG8_LDB(B0, 0, 0); PG8_LDB(B1, 0, 1); PG8_SCHED; PG8_LDA(At, 0, 0); PG8_STAGE_A1(PG8_SA(1, 1), a1, false);
            PG8_WAIT_V(8); PG8_WAIT_L(0); PG8_BAR; PG8_MMA(0, 0, At, B0); PG8_MMA(0, 1, At, B1); PG8_BAR; PG8_SCHED;
            PG8_LDA(At, 0, 1); PG8_STAGE(PG8_SB(0, 0), b2, voffB); PG8_STAGE(PG8_SB(0, 1), b2 + hstepB, voffB); PG8_STAGE_A0(PG8_SA(0, 0), a2, last);
            PG8_WAIT_V(8); PG8_WAIT_L(0); PG8_BAR; PG8_MMA(1, 0, At, B0); PG8_MMA(1, 1, At, B1); PG8_BAR; PG8_SCHED;
            PG8_LDB(B0, 1, 0); PG8_LDB(B1, 1, 1); PG8_SCHED; PG8_LDA(At, 1, 0); PG8_STAGE_A1(PG8_SA(0, 1), a2, last);
            PG8_WAIT_V(8); PG8_WAIT_L(0); PG8_BAR; PG8_MMA(0, 0, At, B0); PG8_MMA(0, 1, At, B1); PG8_BAR; PG8_SCHED;
            PG8_LDA(At, 1, 1); PG8_STAGE(PG8_SB(1, 0), b3, voffB); PG8_STAGE(PG8_SB(1, 1), b3 + hstepB, voffB); PG8_STAGE_A0(PG8_SA(1, 0), a3, last);
            PG8_WAIT_V(8); PG8_WAIT_L(0); PG8_BAR; PG8_MMA(1, 0, At, B0); PG8_MMA(1, 1, At, B1); PG8_BAR; PG8_SCHED;
            } else {
            PG8_LDB(B0, 0, 0); PG8_SCHED; PG8_LDA(At, 0, 0); PG8_STAGE_A1(PG8_SA(1, 1), a1, false);
            PG8_WAIT_L(8); PG8_BAR; PG8_WAIT_L(0); PG8_MMA(0, 0, At, B0); PG8_BAR; PG8_SCHED;
            PG8_LDB(B1, 0, 1); PG8_STAGE(PG8_SB(0, 0), b2, voffB);
            PG8_BAR; PG8_WAIT_L(0); PG8_MMA(0, 1, At, B1); PG8_BAR;
            PG8_LDA(At, 0, 1); PG8_STAGE_A0(PG8_SA(0, 0), a2, last);
            PG8_BAR; PG8_WAIT_L(0); PG8_MMA(1, 0, At, B0); PG8_BAR; PG8_SCHED;
            PG8_STAGE(PG8_SB(0, 1), b2 + hstepB, voffB);
            PG8_WAIT_V(6); PG8_BAR; PG8_MMA(1, 1, At, B1); PG8_BAR;
            PG8_LDB(B0, 1, 0); PG8_SCHED; PG8_LDA(At, 1, 0); PG8_STAGE_A1(PG8_SA(0, 1), a2, last);
            PG8_WAIT_L(8); PG8_BAR; PG8_WAIT_L(0); PG8_MMA(0, 0, At, B0); PG8_BAR; PG8_SCHED;
            PG8_LDB(B1, 1, 1); PG8_STAGE(PG8_SB(1, 0), b3, voffB);
            PG8_BAR; PG8_WAIT_L(0); PG8_MMA(0, 1, At, B1); PG8_BAR;
            PG8_LDA(At, 1, 1); PG8_STAGE_A0(PG8_SA(1, 0), a3, last);
            PG8_BAR; PG8_WAIT_L(0); PG8_MMA(1, 0, At, B0); PG8_BAR; PG8_SCHED;
            PG8_STAGE(PG8_SB(1, 1), b3 + hstepB, voffB);
            PG8_WAIT_V(6); PG8_BAR; PG8_MMA(1, 1, At, B1); PG8_BAR;
            }
        }
        if constexpr (ALIGN_EPI) { if (wr == 0) PG8_BAR; }
        E(acc, cur, wr, wc, fr, fq); S.done(cur);
        if (!has_next) break;
#pragma unroll
        for (int a = 0; a < 2; ++a)
#pragma unroll
            for (int b = 0; b < 2; ++b)
#pragma unroll
                for (int m = 0; m < 4; ++m)
#pragma unroll
                    for (int n = 0; n < 2; ++n) acc[a][b][m][n] = (f32x4){0.f, 0.f, 0.f, 0.f};
        cur = nxt; cA = nA; cB = nB; ++ui;
        if constexpr (GATHER) { vc0[0] = vn0[0]; vc0[1] = vn0[1]; vc1[0] = vn1[0]; vc1[1] = vn1[1]; }
        if constexpr (ALIGN_EPI) { if (wr == 1) PG8_BAR; }
    }
    PG8_WAIT_V(0);
    if constexpr (!ALIGN_EPI) { if (wr == 0) PG8_BAR; }
    PG8_BAR;
#undef PG8_SA
#undef PG8_SB
#undef PG8_STAGE
#undef PG8_STAGE_A0
#undef PG8_STAGE_A1
#undef PG8_GIDX
#undef PG8_LDA
#undef PG8_LDB
#undef PG8_MMA
#undef PG8_WAIT_V
#undef PG8_WAIT_L
#undef PG8_BAR
#undef PG8_SCHED
}
}
#define GP_ALIGN true
#define GP_SP2 true

constexpr int DM = 1024, NB = 8, SEQ = 4096, CTXL = 256, TC = SEQ + CTXL  ;
constexpr int M0 = NB * TC  , M1 = NB * SEQ  ;
constexpr int NEXP = 16;
constexpr float RMS_EPS = 1e-6f;
constexpr int NCHUNK = 256;
constexpr int MAXTILES = 288;
constexpr int LCH = 68;

enum { I_X = 0, I_C, I_CTX, I_CCTX, I_ADAW, I_ADAB, I_N1G, I_N2G, I_FING, I_EVWIN, I_QNG, I_KVNG, I_WUQ, I_WUKV, I_LCW, I_LCB, I_LWA, I_LBA, I_LWX, I_LBX, I_LLAM, I_EVWOUT,
       I_ODWIN, I_HCW, I_HCB, I_HW1, I_HB1, I_HF1, I_HW2, I_HB2, I_HF2, I_HW3, I_HDEC, I_HSKIP, I_ODWOUT, I_RW, I_RB, I_MW1, I_MW3, I_MW2, N_IN };

constexpr size_t MiB = 1u << 20;
constexpr size_t WS_CTL = 0, CTL_ZERO_BYTES = 32768;
constexpr size_t WS_MOD = 1 * MiB;
constexpr size_t WS_RQ = WS_MOD + 2 * 9 * 6144 * 4;
constexpr size_t WS_RKV = WS_RQ + (size_t)M0 * 4;
constexpr size_t WS_A2 = 2 * MiB;
constexpr size_t WS_ROUTE_E = 3 * MiB;
constexpr size_t WS_ROUTE_W = WS_ROUTE_E + (size_t)M0 * 4;
constexpr size_t WS_ROUTE_S = WS_ROUTE_W + (size_t)M0 * 8;
constexpr size_t WS_CNT = WS_ROUTE_S + (size_t)M0 * 8;
constexpr size_t WS_TILEE = WS_CNT + 256 * 16 * 4;
static_assert(WS_TILEE + (MAXTILES + 64) * 4 <= 4 * MiB, "route region");
constexpr size_t WS_CP = 4 * MiB;
constexpr size_t WS_CS = WS_CP + (size_t)2 * 8 * LCH * 512 * 4;
static_assert(WS_CS + (size_t)2 * 8 * LCH * 512 * 4 <= 10 * MiB, "lru carries");
constexpr size_t WS_WIN = 10 * MiB;
constexpr size_t WS_WUQ = 14 * MiB;
constexpr size_t WS_WUKV = 15 * MiB;
constexpr size_t WS_WOUT = 16 * MiB;
constexpr size_t WS_WHIN = 18 * MiB;
constexpr size_t WS_WHOUT = 24 * MiB;
constexpr size_t WS_WG = 26 * MiB;
constexpr size_t WS_W13 = 27 * MiB;
constexpr size_t WS_W2 = 91 * MiB;
constexpr size_t WS_RH = 124 * MiB;
constexpr size_t WS_XC = 192 * MiB;
constexpr size_t X2_OFF = 64 * MiB;
constexpr size_t WS_R2 = 200 * MiB;
constexpr size_t WS_CQ = WS_R2;
constexpr size_t WS_CKV = WS_R2 + 26 * MiB;
constexpr size_t WS_UX = WS_R2 + 43 * MiB;
constexpr size_t WS_UG = WS_R2 + 77 * MiB;
constexpr size_t WS_Q = WS_R2 + 111 * MiB;
constexpr size_t WS_K = WS_R2 + 162 * MiB;
constexpr size_t WS_V = WS_R2 + 213 * MiB;
constexpr size_t WS_HPERM = WS_R2;
constexpr size_t WS_ACT = WS_R2 + 144 * MiB;
constexpr size_t WS_PT = WS_R2;
constexpr size_t WS_ZT = WS_R2 + 192 * MiB;
constexpr size_t WS_Z = WS_R2;
constexpr size_t WS_HSPEC = 456 * MiB;
constexpr size_t WS_X3 = 416 * MiB;
constexpr size_t WS_HIN = 488 * MiB;
constexpr size_t WS_SLOTTOK = 491 * MiB;
constexpr size_t WS_END = 492 * MiB;
static_assert(WS_V + (size_t)M0 * 512 * 2 <= WS_HSPEC && WS_ZT + (size_t)1024 * 32768 * 2 <= WS_HSPEC && WS_ACT + (size_t)73728 * 512 * 2 <= WS_HSPEC, "ws map");

constexpr int CW_TMO = 0, CW_BAR = 4096;

constexpr int RING_BYTES = 131072, LDS_BYTES = 155648, LDSCTL_OFF = LDS_BYTES - 1024, MISC_OFF = LDSCTL_OFF + 320;

#define XB_TMO      128
#define XB_XCNT(j)  (256  + 64 * (j))
#define XB_XSUB(j)  (1280 + 64 * (j))
#define XB_XGEN(j)  (2304 + 64 * (j))
#define XB_TOP      3328
#define XB_TOPGEN   3392
#define XCD_BAR_WORDS 3456
#define XB_SPIN_CAP (1u << 18)
__device__ __forceinline__ unsigned xb_ld(unsigned* p)              { return __hip_atomic_load(p, __ATOMIC_RELAXED, __HIP_MEMORY_SCOPE_AGENT); }
__device__ __forceinline__ unsigned xb_add(unsigned* p, unsigned v) { return __hip_atomic_fetch_add(p, v, __ATOMIC_RELAXED, __HIP_MEMORY_SCOPE_AGENT); }
__device__ __forceinline__ unsigned xb_xcc_id() { return (unsigned)__builtin_amdgcn_s_getreg((3 << 11) | 20) & 0xFu; }
#define XB_SPIN(cond, bar) do { unsigned _sp = 0; while (cond) { __builtin_amdgcn_s_sleep(1); \
    if ((++_sp & 255u) == 0u) { if (xb_ld(&(bar)[XB_TMO])) break; if (_sp > XB_SPIN_CAP) { atomicAdd(&(bar)[XB_TMO], 1u); break; } } } } while (0)
struct XcdBarrier { unsigned* bar; unsigned x; volatile LAS unsigned* st; };
__device__ __forceinline__ XcdBarrier xcd_barrier_post(unsigned* bar, volatile LAS unsigned* st) {
    XcdBarrier b; b.bar = bar; b.x = xb_xcc_id(); b.st = st;
    if (threadIdx.x == 0) (void)xb_add(&bar[XB_XCNT(b.x)], 1u);
    return b;
}
__device__ __forceinline__ void xcd_barrier_complete(unsigned* bar, unsigned x, unsigned& nloc, unsigned& nx) {
    const unsigned G = gridDim.x * gridDim.y * gridDim.z;
    unsigned sum, cnt, mine, sp = 0u;
    for (;;) {
        sum = 0u; cnt = 0u; mine = 0u;
#pragma unroll
        for (unsigned j = 0; j < 16; ++j) { const unsigned c = xb_ld(&bar[XB_XCNT(j)]); sum += c; cnt += (c > 0u) ? 1u : 0u; mine = (j == x) ? c : mine; }
        if (sum == G) break;
        __builtin_amdgcn_s_sleep(1);
        if ((++sp & 255u) == 0u) { if (xb_ld(&bar[XB_TMO])) break; if (sp > XB_SPIN_CAP) { atomicAdd(&bar[XB_TMO], 1u); break; } }
    }
    nloc = mine > 0u ? mine : 1u; nx = cnt > 0u ? cnt : 1u;
}
__device__ __forceinline__ void xcd_barrier(const XcdBarrier& b) {
    asm volatile("s_waitcnt vmcnt(0)" ::: "memory");
    __syncthreads();
    if (threadIdx.x == 0) {
        unsigned* bar = b.bar;
        __builtin_amdgcn_s_waitcnt(0);
        unsigned nloc = b.st[0], nx = b.st[1];
        if (nloc == 0u) { xcd_barrier_complete(bar, b.x, nloc, nx); b.st[0] = nloc; b.st[1] = nx; }
        const unsigned old = xb_add(&bar[XB_XSUB(b.x)], 1u);
        const unsigned gen = old / nloc;
        if (old + 1u == (gen + 1u) * nloc) {
            __builtin_amdgcn_fence(__ATOMIC_RELEASE, "agent");
            asm volatile("s_waitcnt vmcnt(0)" ::: "memory");
            const unsigned og = xb_add(&bar[XB_TOP], 1u);
            const unsigned tg = og / nx;
            if (og + 1u == (tg + 1u) * nx) xb_add(&bar[XB_TOPGEN], 1u);
            else XB_SPIN(xb_ld(&bar[XB_TOPGEN]) == tg, bar);
            __builtin_amdgcn_fence(__ATOMIC_ACQUIRE, "agent");
            xb_add(&bar[XB_XGEN(b.x)], 1u);
            asm volatile("s_waitcnt vmcnt(0)" ::: "memory");
        } else {
            XB_SPIN(xb_ld(&bar[XB_XGEN(b.x)]) == gen, bar);
            __builtin_amdgcn_fence(__ATOMIC_ACQUIRE, "agent");
            asm volatile("s_waitcnt vmcnt(0)" ::: "memory");
        }
    }
    __syncthreads();
}

struct Params { const float* in[N_IN]; float* out; unsigned char* ws; int ph_lo, ph_hi; };
typedef const __attribute__((address_space(4))) Params* ParamsK;
__device__ __forceinline__ Params load_params() {
#if defined(__HIP_DEVICE_COMPILE__)
    unsigned long long v = (unsigned long long)__builtin_amdgcn_kernarg_segment_ptr(); asm volatile("" : "+s"(v)); return *(ParamsK)v;
#else
    return Params{};
#endif
}

__device__ __forceinline__ u32x4 pack8(const f32x4 a, const f32x4 b) {
    u32x4 w; w.x = pg8::cvt_pk_bf16(a[0], a[1]); w.y = pg8::cvt_pk_bf16(a[2], a[3]); w.z = pg8::cvt_pk_bf16(b[0], b[1]); w.w = pg8::cvt_pk_bf16(b[2], b[3]); return w;
}
__device__ __forceinline__ void rope8(f32x4& v0, f32x4& v1, int fq, int tt  , bool on) {
    const int axis = fq >> 1, half = fq & 1; const float pos = (float)(axis == 0 ? (tt >> 6) : (tt & 63)) * 0.15915494309189535f;
    constexpr float IF[8] = {1.0f, 0.316227766f, 0.1f, 0.0316227766f, 0.01f, 0.00316227766f, 0.001f, 0.000316227766f};
#pragma unroll
    for (int i = 0; i < 4; ++i) {
        { const float x = v0[i], other = __shfl_xor(x, 16); const float sn = __builtin_amdgcn_sinf(pos * IF[i]), cs = __builtin_amdgcn_cosf(pos * IF[i]);
          const float r = half == 0 ? x * cs - other * sn : other * sn + x * cs; v0[i] = on ? r : x; }
        { const float x = v1[i], other = __shfl_xor(x, 16); const float sn = __builtin_amdgcn_sinf(pos * IF[4 + i]), cs = __builtin_amdgcn_cosf(pos * IF[4 + i]);
          const float r = half == 0 ? x * cs - other * sn : other * sn + x * cs; v1[i] = on ? r : x; }
    }
}

struct EpiIn {
    static constexpr bool PERM = true;
    bf16 *CQ, *CKV, *UX, *UG, *KB;
    __device__ __forceinline__ void operator()(const f32x4 (&acc)[2][2][4][2], const pg8::Unit& u, int wr, int wc, int fr, int fq) const {
        const int row0 = u.pm * 256 + wr * 64 + fr;
        const bool is_ctx = (u.pm % 17) == 0; const int bb = u.pm / 17;
#pragma unroll
        for (int bj = 0; bj < 2; ++bj) {
            const int blk = u.pn * 2 + bj;
            if (blk < 13) {
                bf16* dst; int ld, cb;
                if (blk < 3) { dst = CQ; ld = 384; cb = blk * 128; }
                else if (blk < 5) { dst = CKV; ld = 256; cb = (blk - 3) * 128; }
                else if (blk < 9) { dst = UX; ld = 512; cb = (blk - 5) * 128; }
                else { dst = UG; ld = 512; cb = (blk - 9) * 128; }
                const int col = cb + wc * 32 + 8 * fq;
#pragma unroll
                for (int ai = 0; ai < 2; ++ai)
#pragma unroll
                    for (int m = 0; m < 4; ++m) { const int row = row0 + ai * 128 + m * 16;
                        *(u32x4*)(dst + (size_t)row * ld + col) = pack8(acc[ai][bj][m][0], acc[ai][bj][m][1]); }
            } else if (wc == 0) {
#pragma unroll
                for (int ai = 0; ai < 2; ++ai)
#pragma unroll
                    for (int m = 0; m < 4; ++m) { const int row = row0 + ai * 128 + m * 16; const int tt = row - bb * TC - CTXL;
                        f32x4 v0 = acc[ai][bj][m][0], v1 = acc[ai][bj][m][1];
                        rope8(v0, v1, fq, tt, !is_ctx);
                        const u32x4 w = pack8(v0, v1);
#pragma unroll
                        for (int h = 0; h < 8; ++h) *(u32x4*)(KB + (size_t)row * 768 + h * 96 + 64 + 8 * fq) = w; }
            }
        }
    }
};
struct EpiQ {
    static constexpr bool PERM = true;
    bf16* Q; const float* rq;
    __device__ __forceinline__ void operator()(const f32x4 (&acc)[2][2][4][2], const pg8::Unit& u, int wr, int wc, int fr, int fq) const {
        const int row0 = u.pm * 256 + wr * 64 + fr;
#pragma unroll
        for (int ai = 0; ai < 2; ++ai)
#pragma unroll
            for (int m = 0; m < 4; ++m) { const int row = row0 + ai * 128 + m * 16; const float s = rq[row];
#pragma unroll
                for (int bj = 0; bj < 2; ++bj) {
                    const u32x4 w = pack8(acc[ai][bj][m][0] * s, acc[ai][bj][m][1] * s);
                    int off;
                    if (u.pn < 2) { const int c = u.pn * 256 + bj * 128 + wc * 32 + 8 * fq; off = (c >> 6) * 96 + (c & 63); }
                    else off = (4 * bj + wc) * 96 + 64 + 8 * fq;
                    *(u32x4*)(Q + (size_t)row * 768 + off) = w;
                } }
    }
};
struct EpiKV {
    static constexpr bool PERM = true;
    bf16 *K, *V; const float* rkv;
    __device__ __forceinline__ void operator()(const f32x4 (&acc)[2][2][4][2], const pg8::Unit& u, int wr, int wc, int fr, int fq) const {
        const int row0 = u.pm * 256 + wr * 64 + fr;
#pragma unroll
        for (int ai = 0; ai < 2; ++ai)
#pragma unroll
            for (int m = 0; m < 4; ++m) { const int row = row0 + ai * 128 + m * 16; const float s = rkv[row];
#pragma unroll
                for (int bj = 0; bj < 2; ++bj) { const int h = u.pn * 2 + bj;
                    const u32x4 w = pack8(acc[ai][bj][m][0] * s, acc[ai][bj][m][1] * s);
                    if (wc < 2) *(u32x4*)(K + (size_t)row * 768 + h * 96 + wc * 32 + 8 * fq) = w;
                    else *(u32x4*)(V + (size_t)row * 512 + h * 64 + (wc - 2) * 32 + 8 * fq) = w; } }
    }
};
template <int LAYER> struct EpiRes {
    static constexpr bool PERM = true;
    const float *x, *ctx, *mod; const bf16* xin; bf16 *xout, *xc;
    __device__ __forceinline__ void operator()(const f32x4 (&acc)[2][2][4][2], const pg8::Unit& u, int wr, int wc, int fr, int fq) const {
        const int row0 = u.pm * 256 + wr * 64 + fr, col0 = u.pn * 256 + wc * 32 + 8 * fq;
        const bool is_ctx = LAYER == 0 && (u.pm % 17) == 0; const int bb = LAYER == 0 ? u.pm / 17 : u.pm / 16;
        const float* g = mod + (size_t)(LAYER * 9 + (is_ctx ? 8 : bb)) * 6144 + 2048;
        f32x4 gv[2][2];
#pragma unroll
        for (int bj = 0; bj < 2; ++bj)
#pragma unroll
            for (int n = 0; n < 2; ++n) gv[bj][n] = *(const f32x4*)(g + col0 + bj * 128 + n * 4);
#pragma unroll
        for (int ai = 0; ai < 2; ++ai)
#pragma unroll
            for (int m = 0; m < 4; ++m) { const int row = row0 + ai * 128 + m * 16;
                if (LAYER == 0) { const int t = row - bb * TC; const float* res; bf16* dst;
                    if (is_ctx) { res = ctx + (size_t)(bb * CTXL + t) * DM; dst = xc + (size_t)(bb * CTXL + t) * DM; }
                    else { res = x + (size_t)(bb * SEQ + t - CTXL) * DM; dst = xout + (size_t)(bb * SEQ + t - CTXL) * DM; }
#pragma unroll
                    for (int bj = 0; bj < 2; ++bj) { const int c = col0 + bj * 128;
                        const f32x4 r0 = *(const f32x4*)(res + c), r1 = *(const f32x4*)(res + c + 4);
                        *(u32x4*)(dst + c) = pack8(r0 + gv[bj][0] * acc[ai][bj][m][0], r1 + gv[bj][1] * acc[ai][bj][m][1]); } }
                else {
#pragma unroll
                    for (int bj = 0; bj < 2; ++bj) { const int c = col0 + bj * 128; const u32x4 q = *(const u32x4*)(xin + (size_t)row * DM + c);
                        const f32x4 r0 = {bflo(q.x), bfhi(q.x), bflo(q.y), bfhi(q.y)}, r1 = {bflo(q.z), bfhi(q.z), bflo(q.w), bfhi(q.w)};
                        *(u32x4*)(xout + (size_t)row * DM + c) = pack8(r0 + gv[bj][0] * acc[ai][bj][m][0], r1 + gv[bj][1] * acc[ai][bj][m][1]); } } }
    }
};
struct EpiMoe1 {
    static constexpr bool PERM = true;
    bf16* ACT;
    __device__ __forceinline__ void operator()(const f32x4 (&acc)[2][2][4][2], const pg8::Unit& u, int wr, int wc, int fr, int fq) const {
        const int row0 = u.pm * 256 + wr * 64 + fr, col = u.pn * 128 + wc * 32 + 8 * fq;
#pragma unroll
        for (int ai = 0; ai < 2; ++ai)
#pragma unroll
            for (int m = 0; m < 4; ++m) { const int row = row0 + ai * 128 + m * 16;
                f32x4 r[2];
#pragma unroll
                for (int n = 0; n < 2; ++n)
#pragma unroll
                    for (int i = 0; i < 4; ++i) { const float a = acc[ai][0][m][n][i], b = acc[ai][1][m][n][i]; r[n][i] = a / (1.f + __expf(-a)) * b; }
                *(u32x4*)(ACT + (size_t)row * 512 + col) = pack8(r[0], r[1]); }
    }
};
struct EpiStore {
    static constexpr bool PERM = true;
    bf16* O; int ldc;
    __device__ __forceinline__ void operator()(const f32x4 (&acc)[2][2][4][2], const pg8::Unit& u, int wr, int wc, int fr, int fq) const {
        const int row0 = u.pm * 256 + wr * 64 + fr, col0 = u.pn * 256 + wc * 32 + 8 * fq;
#pragma unroll
        for (int ai = 0; ai < 2; ++ai)
#pragma unroll
            for (int m = 0; m < 4; ++m) { bf16* rowp = O + (size_t)(row0 + ai * 128 + m * 16) * ldc + col0;
#pragma unroll
                for (int bj = 0; bj < 2; ++bj) *(u32x4*)(rowp + bj * 128) = pack8(acc[ai][bj][m][0], acc[ai][bj][m][1]); }
    }
};

__device__ __forceinline__ void cvt_item(const float* W, int ldw, int col0, const float* gk, bf16* WTrow0, int ldk, int k0, float* scr, int lane) {
    if (col0 >= 0) {
        float v[32];
#pragma unroll
        for (int i = 0; i < 32; ++i) v[i] = W[(size_t)(k0 + 2 * i + (lane >> 5)) * ldw + col0 + (lane & 31)];
        if (gk) {
#pragma unroll
            for (int i = 0; i < 32; ++i) v[i] *= gk[k0 + 2 * i + (lane >> 5)];
        }
#pragma unroll
        for (int i = 0; i < 32; ++i) scr[(2 * i + (lane >> 5)) * 33 + (lane & 31)] = v[i];
    } else {
#pragma unroll 8
        for (int i = 0; i < 32; ++i) { const int kk = 2 * i + (lane >> 5); scr[kk * 33 + (lane & 31)] = 0.f; }
    }
    LDS_WAIT(); asm volatile("" ::: "memory");
    const int c = lane & 7;
#pragma unroll
    for (int j = 0; j < 4; ++j) { const int n = (lane >> 3) + 8 * j; const float* s = scr + (8 * c) * 33 + n;
        u32x4 o; o.x = pk2(s[0 * 33], s[1 * 33]); o.y = pk2(s[2 * 33], s[3 * 33]); o.z = pk2(s[4 * 33], s[5 * 33]); o.w = pk2(s[6 * 33], s[7 * 33]);
        *(u32x4*)(WTrow0 + (size_t)n * ldk + k0 + 8 * c) = o; }
    LDS_WAIT(); asm volatile("" ::: "memory");
}

__device__ __forceinline__ void phase_prologue(const Params& P, unsigned char* lds, int tid, int lane, int wave, int G) {
    unsigned char* ws = P.ws;
    __syncthreads();
    {
        float* sl = (float*)lds;
        float* red = (float*)(lds + 40960);
        float* mod = (float*)(ws + WS_MOD);
        bool loaded = false;
        for (int u = blockIdx.x; u < 192; u += G) {
            if (!loaded) { for (int i = tid; i < 9 * 1024; i += 512) { const float v = i < 8192 ? P.in[I_C][i] : P.in[I_CCTX][i - 8192]; sl[i] = v / (1.f + expf(-v)); } loaded = true; __syncthreads(); }
            const int l = u / 96, col = (u % 96) * 64 + lane;
            const float* W = P.in[I_ADAW] + (size_t)l * 1024 * 6144 + col;
            float a[9];
#pragma unroll
            for (int b = 0; b < 9; ++b) a[b] = 0.f;
            const int kb = wave * 128;
#pragma unroll 16
            for (int k = 0; k < 128; ++k) { const float w = W[(size_t)(kb + k) * 6144];
#pragma unroll
                for (int b = 0; b < 9; ++b) a[b] += sl[b * 1024 + kb + k] * w; }
#pragma unroll
            for (int b = 0; b < 9; ++b) red[(wave * 9 + b) * 64 + lane] = a[b];
            __syncthreads();
            for (int i = tid; i < 9 * 64; i += 512) { const int b = i >> 6, cc = i & 63; float s = 0.f;
#pragma unroll
                for (int w = 0; w < 8; ++w) s += red[(w * 9 + b) * 64 + cc];
                const int c2 = (u % 96) * 64 + cc;
                mod[(size_t)(l * 9 + b) * 6144 + c2] = s + P.in[I_ADAB][l * 6144 + c2]; }
            __syncthreads();
        }
        __syncthreads();
    }
    {
        float* scr = (float*)(lds + wave * 16384);
        const int gw = blockIdx.x * 8 + wave, NGW = G * 8;
        constexpr int I_WIN = 16 * 56, I_UQ = 6 * 24, I_UKV = 4 * 32, I_OUT = 16 * 32, I_HIN = 16 * 96, I_HOUT = 16 * 32, I_WG = 64, I_M13 = 32 * 512, I_M2 = 32 * 256;
        constexpr int NITEMS = I_WIN + I_UQ + I_UKV + I_OUT + I_HIN + I_HOUT + I_WG + I_M13 + I_M2;
        for (int it = gw; it < NITEMS; it += NGW) {
            int r = it;
            if (r < I_M13) { const int le = r >> 9, q = r & 511, kb = q >> 5, nb = q & 31, n0 = 32 * nb, pn = n0 >> 8, j = n0 & 255;
                const float* src = (j < 128 ? P.in[I_MW1] : P.in[I_MW3]) + (size_t)le * 1024 * 512;
                cvt_item(src, 512, 128 * pn + (j & 127), nullptr, (bf16*)(ws + WS_W13) + ((size_t)le * 1024 + n0) * 1024, 1024, 64 * kb, scr, lane); continue; } r -= I_M13;
            if (r < I_M2) { const int le = r >> 8, q = r & 255, kb = q >> 5, nb = q & 31, n0 = 32 * nb;
                cvt_item(P.in[I_MW2] + (size_t)le * 512 * 1024, 1024, n0, nullptr, (bf16*)(ws + WS_W2) + ((size_t)le * 1024 + n0) * 512, 512, 64 * kb, scr, lane); continue; } r -= I_M2;
            if (r < I_WIN) { const int kb = r / 56, nb = r % 56, n0 = 32 * nb; const int col0 = n0 < 640 ? n0 : (n0 < 1664 ? n0 + 32 : (n0 < 1696 ? n0 - 1024 : -1));
                cvt_item(P.in[I_EVWIN], 1696, col0, nullptr, (bf16*)(ws + WS_WIN) + (size_t)n0 * 1024, 1024, 64 * kb, scr, lane); continue; } r -= I_WIN;
            if (r < I_UQ) { const int kb = r / 24, nb = r % 24, n0 = 32 * nb; const int col0 = n0 < 512 ? (n0 >> 6) * 96 + (n0 & 63) : ((n0 - 512) >> 5) * 96 + 64;
                cvt_item(P.in[I_WUQ], 768, col0, P.in[I_QNG], (bf16*)(ws + WS_WUQ) + (size_t)n0 * 384, 384, 64 * kb, scr, lane); continue; } r -= I_UQ;
            if (r < I_UKV) { const int kb = r / 32, nb = r % 32, n0 = 32 * nb;
                cvt_item(P.in[I_WUKV], 1024, n0, P.in[I_KVNG], (bf16*)(ws + WS_WUKV) + (size_t)n0 * 256, 256, 64 * kb, scr, lane); continue; } r -= I_UKV;
            if (r < I_OUT) { const int kb = r / 32, nb = r % 32, n0 = 32 * nb;
                cvt_item(P.in[I_EVWOUT], 1024, n0, nullptr, (bf16*)(ws + WS_WOUT) + (size_t)n0 * 1024, 1024, 64 * kb, scr, lane); continue; } r -= I_OUT;
            if (r < I_HIN) { const int kb = r / 96, nb = r % 96, n0 = 32 * nb;
                cvt_item(P.in[I_ODWIN], 3072, n0, nullptr, (bf16*)(ws + WS_WHIN) + (size_t)n0 * 1024, 1024, 64 * kb, scr, lane); continue; } r -= I_HIN;
            if (r < I_HOUT) { const int kb = r / 32, nb = r % 32, n0 = 32 * nb;
                cvt_item(P.in[I_ODWOUT], 1024, n0, nullptr, (bf16*)(ws + WS_WHOUT) + (size_t)n0 * 1024, 1024, 64 * kb, scr, lane); continue; } r -= I_HOUT;
            { const int mat = r >> 1, nb = r & 1, d = mat >> 4, gsel = (mat >> 3) & 1, h = mat & 7;
                const float* src = (gsel ? P.in[I_LWX] : P.in[I_LWA]) + (size_t)(d * 8 + h) * 4096;
                cvt_item(src, 64, 32 * nb, nullptr, (bf16*)(ws + WS_WG) + (size_t)(h * 256 + d * 128 + gsel * 64 + 32 * nb) * 64, 64, 0, scr, lane); }
        }
    }
    {
        const int gw = blockIdx.x * 8 + wave, NGW = G * 8;
        float* a2 = (float*)(ws + WS_A2);
        const float *w1 = P.in[I_HW1], *b1 = P.in[I_HB1], *f1 = P.in[I_HF1], *w2 = P.in[I_HW2], *b2 = P.in[I_HB2], *f2 = P.in[I_HF2];
        for (int t = gw; t < 4096; t += NGW) {
            const float tl = (float)t / 4095.f, w = (6.283185307179586f / 4096.f) * (float)t;
            float zi = 0.f;
            if (lane == 0) zi = tl;
            else if (lane <= 16) { const float f = 1e-4f + (float)(lane - 1) * ((15.f - 1e-4f) / 15.f); zi = cosf(f * w); }
            else if (lane <= 32) { const float f = 1e-4f + (float)(lane - 17) * ((15.f - 1e-4f) / 15.f); zi = -sinf(f * w); }
            float acc = b1[lane];
            for (int i = 0; i < 33; ++i) acc += __shfl(zi, i) * w1[i * 64 + lane];
            const float a1 = sinf(f1[lane] * acc);
            float acc2 = b2[lane];
            for (int i = 0; i < 64; ++i) acc2 += __shfl(a1, i) * w2[i * 64 + lane];
            a2[(size_t)lane * 4096 + t] = sinf(f2[lane] * acc2);
        }
    }
}

__device__ __forceinline__ void store_row_bf16(bf16* orow, const f32x4 (&v)[4], int lane) {
    unsigned long long* o8 = (unsigned long long*)orow + lane;
#pragma unroll
    for (int j = 0; j < 4; ++j) o8[64 * j] = (unsigned long long)pk2(v[j][0], v[j][1]) | ((unsigned long long)pk2(v[j][2], v[j][3]) << 32);
}
__device__ __forceinline__ void load_xrow(const bf16* row, int lane, u32x2 (&q)[4]) {
#pragma unroll
    for (int j = 0; j < 4; ++j) q[j] = ((const u32x2*)row)[lane + 64 * j];
}
__device__ __forceinline__ void cvt_xrow(const u32x2 (&q)[4], f32x4 (&v)[4]) {
#pragma unroll
    for (int j = 0; j < 4; ++j) v[j] = (f32x4){bflo(q[j].x), bfhi(q[j].x), bflo(q[j].y), bfhi(q[j].y)};
}
__device__ __forceinline__ void norm_mod(f32x4 (&v)[4], const float* g, const float* sh, const float* sc, int lane) {
    float ss = 0.f;
#pragma unroll
    for (int j = 0; j < 4; ++j) ss += (v[j][0] * v[j][0] + v[j][1] * v[j][1]) + (v[j][2] * v[j][2] + v[j][3] * v[j][3]);
    const float rr = rsqrtf(wave_sum(ss) * (1.f / 1024.f) + RMS_EPS);
#pragma unroll
    for (int j = 0; j < 4; ++j) { const f32x4 gg = ((const f32x4*)g)[lane + 64 * j], s1 = ((const f32x4*)sc)[lane + 64 * j], s0 = ((const f32x4*)sh)[lane + 64 * j];
        v[j] = (v[j] * rr * gg) * (1.f + s1) + s0; }
}
struct CombIdx { int s0, s1; float w0, w1; };
struct CombData { u32x2 x[4], y0[4], y1[4]; };
__device__ __forceinline__ void comb_load_idx(const int* rs, const float* rw, int r, CombIdx& I) { I.s0 = rs[2 * r]; I.s1 = rs[2 * r + 1]; I.w0 = rw[2 * r]; I.w1 = rw[2 * r + 1]; }
__device__ __forceinline__ void comb_load_data(const bf16* xrow, const bf16* Y, const CombIdx& I, int lane, CombData& D) {
    const u32x2* y0 = (const u32x2*)(Y + (size_t)I.s0 * 1024) + lane; const u32x2* y1 = (const u32x2*)(Y + (size_t)I.s1 * 1024) + lane;
#pragma unroll
    for (int j = 0; j < 4; ++j) { D.x[j] = ((const u32x2*)xrow)[lane + 64 * j]; D.y0[j] = y0[64 * j]; D.y1[j] = y1[64 * j]; }
}
__device__ __forceinline__ void comb_apply(f32x4 (&v)[4], const CombData& D, const CombIdx& I, const float* g2, int lane) {
#pragma unroll
    for (int j = 0; j < 4; ++j) { const u32x2 a = D.y0[j], b = D.y1[j]; const f32x4 gg = ((const f32x4*)g2)[lane + 64 * j];
        f32x4 m; m[0] = I.w0 * bflo(a.x) + I.w1 * bflo(b.x); m[1] = I.w0 * bfhi(a.x) + I.w1 * bfhi(b.x); m[2] = I.w0 * bflo(a.y) + I.w1 * bflo(b.y); m[3] = I.w0 * bfhi(a.y) + I.w1 * bfhi(b.y);
        v[j] = (f32x4){bflo(D.x[j].x), bfhi(D.x[j].x), bflo(D.x[j].y), bfhi(D.x[j].y)} + gg * m; }
}
__device__ __forceinline__ float route_scores(const f32x4 (&v)[4], const float* rwT  , int lane) {
    float p[16];
#pragma unroll
    for (int e = 0; e < 16; ++e) { f32x2 a2 = {0.f, 0.f};
#pragma unroll
        for (int j = 0; j < 4; ++j) { const f32x4 w = ((const f32x4*)(rwT + e * 1024))[lane + 64 * j];
            a2 = __builtin_elementwise_fma((f32x2){v[j][0], v[j][1]}, (f32x2){w[0], w[1]}, a2); a2 = __builtin_elementwise_fma((f32x2){v[j][2], v[j][3]}, (f32x2){w[2], w[3]}, a2); }
        p[e] = a2[0] + a2[1]; }
    const bool h32 = lane & 32, h16 = lane & 16, h8 = lane & 8, h4 = lane & 4;
    float q8[8], q4[4], q2[2], q1;
#pragma unroll
    for (int e = 0; e < 8; ++e) { const float send = h32 ? p[e] : p[e + 8], keep = h32 ? p[e + 8] : p[e]; q8[e] = keep + __shfl_xor(send, 32); }
#pragma unroll
    for (int e = 0; e < 4; ++e) { const float send = h16 ? q8[e] : q8[e + 4], keep = h16 ? q8[e + 4] : q8[e]; q4[e] = keep + __shfl_xor(send, 16); }
#pragma unroll
    for (int e = 0; e < 2; ++e) { const float send = h8 ? q4[e] : q4[e + 2], keep = h8 ? q4[e + 2] : q4[e]; q2[e] = keep + __shfl_xor(send, 8); }
    { const float send = h4 ? q2[0] : q2[1], keep = h4 ? q2[1] : q2[0]; q1 = keep + __shfl_xor(send, 4); }
    q1 += __shfl_xor(q1, 1); q1 += __shfl_xor(q1, 2);
    return __builtin_amdgcn_rcpf(1.f + __expf(-q1));
}
__device__ __forceinline__ void route_select(const float (&s)[16], const float* rb, int& e0o, int& e1o, float& w0o, float& w1o) {
    float sel[16];
#pragma unroll
    for (int e = 0; e < 16; ++e) sel[e] = s[e] + rb[e];
    float gbest = -1e30f; int gi = 0;
#pragma unroll
    for (int g = 0; g < 4; ++g) { float m1 = -1e30f, m2 = -1e30f;
#pragma unroll
        for (int i = 0; i < 4; ++i) { const float x = sel[4 * g + i]; if (x > m1) { m2 = m1; m1 = x; } else if (x > m2) m2 = x; }
        const float gs = m1 + m2; if (gs > gbest) { gbest = gs; gi = g; } }
    float b0 = -1e30f, b1 = -1e30f; int e0 = 0, e1 = 0; float s0 = 0.f, s1 = 0.f;
#pragma unroll
    for (int e = 0; e < 16; ++e) { const bool in = (e >> 2) == gi; const float x = sel[e];
        if (in && x > b0) { b1 = b0; e1 = e0; s1 = s0; b0 = x; e0 = e; s0 = s[e]; } else if (in && x > b1) { b1 = x; e1 = e; s1 = s[e]; } }
    e0o = e0; e1o = e1; const float den = s0 + s1; w0o = s0 / den; w1o = s1 / den;
}

__device__ __forceinline__ const float* l0_row_ptr(const Params& P, int row) {
    const int b = row / TC, t = row - b * TC;
    return t < CTXL ? P.in[I_CTX] + (size_t)(b * CTXL + t) * DM : P.in[I_X] + (size_t)(b * SEQ + t - CTXL) * DM;
}
__device__ __forceinline__ const bf16* l0_xrow_ptr(const Params& P, int row) {
    const int b = row / TC, t = row - b * TC;
    return t < CTXL ? (const bf16*)(P.ws + WS_XC) + (size_t)(b * CTXL + t) * DM : (const bf16*)P.out + (size_t)(b * SEQ + t - CTXL) * DM;
}
__device__ __forceinline__ void phase_norm1_l0(const Params& P, int lane, int wave, int G) {
    const float* mod = (const float*)(P.ws + WS_MOD); bf16* H = (bf16*)(P.ws + WS_RH);
    int row = blockIdx.x * 8 + wave; if (row >= M0) return;
    f32x4 nx[4];
    { const float* xr = l0_row_ptr(P, row);
#pragma unroll
      for (int j = 0; j < 4; ++j) nx[j] = ((const f32x4*)xr)[lane + 64 * j]; }
    for (; row < M0; row += G * 8) {
        f32x4 v[4];
#pragma unroll
        for (int j = 0; j < 4; ++j) v[j] = nx[j];
        if (row + G * 8 < M0) { const float* xr = l0_row_ptr(P, row + G * 8);
#pragma unroll
            for (int j = 0; j < 4; ++j) nx[j] = ((const f32x4*)xr)[lane + 64 * j]; }
        const int b = row / TC, t = row - b * TC;
        const float* md = mod + (size_t)(t < CTXL ? 8 : b) * 6144;
        norm_mod(v, P.in[I_N1G], md, md + 1024, lane);
        store_row_bf16(H + (size_t)row * DM, v, lane);
    }
}
template <int LAYER> __device__ __forceinline__ void phase_norm2_route(const Params& P, unsigned char* lds, int tid, int lane, int wave, int G) {
    constexpr int ROWS = LAYER == 0 ? 136 : 128;
    float* rwT = (float*)lds;
    int* cntl = (int*)(lds + 65536);
    float* slog = (float*)(lds + 65536 + 1024) + wave * (17 * 16);
    const float* mod = (const float*)(P.ws + WS_MOD) + (size_t)LAYER * 9 * 6144; bf16* H = (bf16*)(P.ws + WS_RH);
    int* route_e = (int*)(P.ws + WS_ROUTE_E); float* route_w = (float*)(P.ws + WS_ROUTE_W); int* cnt = (int*)(P.ws + WS_CNT);
    for (int i = tid; i < 16384; i += 512) { const int k = i >> 4, e = i & 15; rwT[e * 1024 + k] = P.in[I_RW][i]; }
    for (int ch = blockIdx.x; ch < NCHUNK; ch += G) {
        if (tid < 16) cntl[tid] = 0;
        __syncthreads();
        u32x2 nx[4];
        { const int row = ch * ROWS + wave; load_xrow(LAYER == 0 ? l0_xrow_ptr(P, row) : (const bf16*)(P.ws + WS_X3) + (size_t)row * DM, lane, nx); }
        for (int rl = wave; rl < ROWS; rl += 8) {
            const int row = ch * ROWS + rl; const float* md;
            if (LAYER == 0) { const int b = row / TC, t = row - b * TC; md = mod + (size_t)(t < CTXL ? 8 : b) * 6144; }
            else md = mod + (size_t)(row >> 12) * 6144;
            f32x4 v[4]; cvt_xrow(nx, v);
            if (rl + 8 < ROWS) load_xrow(LAYER == 0 ? l0_xrow_ptr(P, row + 8) : (const bf16*)(P.ws + WS_X3) + (size_t)(row + 8) * DM, lane, nx);
            norm_mod(v, P.in[I_N2G] + LAYER * 1024, md + 3072, md + 4096, lane);
            store_row_bf16(H + (size_t)row * DM, v, lane);
            const float sl = route_scores(v, rwT, lane);
            if ((lane & 3) == 0) slog[(rl >> 3) * 16 + 8 * ((lane >> 5) & 1) + 4 * ((lane >> 4) & 1) + 2 * ((lane >> 3) & 1) + ((lane >> 2) & 1)] = sl;
        }
        LDS_WAIT();
        if (lane < (ROWS - wave + 7) / 8) {
            const int rl = wave + 8 * lane, row = ch * ROWS + rl;
            float sc[16];
#pragma unroll
            for (int e = 0; e < 16; ++e) sc[e] = slog[lane * 16 + e];
            int e0, e1; float w0, w1; route_select(sc, P.in[I_RB], e0, e1, w0, w1);
            route_e[row] = e0 | (e1 << 8); route_w[2 * row] = w0; route_w[2 * row + 1] = w1; atomicAdd(&cntl[e0], 1); atomicAdd(&cntl[e1], 1);
        }
        __syncthreads();
        if (tid < 16) cnt[ch * 16 + tid] = cntl[tid];
        __syncthreads();
    }
}
template <int LAYER> __device__ __forceinline__ void phase_permute(const Params& P, unsigned char* lds, int tid, int lane, int wave, int G) {
    constexpr int ROWS = LAYER == 0 ? 136 : 128;
    int* part_tot = (int*)lds;
    int* part_base = part_tot + 512;
    int* slot0 = part_base + 512;
    int* loc = slot0 + 16;
    int* slots = loc + 16;
    int* tstart = slots + 2 * 136;
    int* rel = tstart + 32;
    int* etot = rel + 136;
    const int* cnt = (const int*)(P.ws + WS_CNT); const int* route_e = (const int*)(P.ws + WS_ROUTE_E); int* route_s = (int*)(P.ws + WS_ROUTE_S);
    int* tile_e = (int*)(P.ws + WS_TILEE); int* slot_tok = (int*)(P.ws + WS_SLOTTOK);
    for (int ch = blockIdx.x; ch < NCHUNK; ch += G) {
        { const int e = tid & 15, part = tid >> 4; int tot = 0, bs = 0;
#pragma unroll
          for (int i = 0; i < 8; ++i) { const int c = part * 8 + i; const int x = cnt[c * 16 + e]; tot += x; bs += (c < ch) ? x : 0; }
          part_tot[part * 16 + e] = tot; part_base[part * 16 + e] = bs; }
        if (tid < ROWS) rel[tid] = route_e[ch * ROWS + tid];
        __syncthreads();
        if (tid == 0) {
            int ts = 0;
            for (int e = 0; e < 16; ++e) { int tot = 0, bs = 0; for (int p = 0; p < 32; ++p) { tot += part_tot[p * 16 + e]; bs += part_base[p * 16 + e]; }
                tstart[e] = ts; slot0[e] = ts * 256 + bs; loc[e] = 0; etot[e] = tot; ts += (tot + 255) >> 8; }
            tstart[16] = ts;
            if (ch == 0) { for (int e = 0; e < 16; ++e) for (int i = tstart[e]; i < tstart[e + 1]; ++i) tile_e[i] = e; tile_e[MAXTILES] = ts; }
            for (int rl = 0; rl < ROWS; ++rl) { const int row = ch * ROWS + rl; const int ee = rel[rl]; const int e0 = ee & 255, e1 = ee >> 8;
                const int s0 = slot0[e0] + loc[e0]; loc[e0] = loc[e0] + 1; const int s1 = slot0[e1] + loc[e1]; loc[e1] = loc[e1] + 1;
                slots[2 * rl] = s0; slots[2 * rl + 1] = s1; route_s[2 * row] = s0; route_s[2 * row + 1] = s1; }
        }
        __syncthreads();
        if (tid < 2 * ROWS) slot_tok[slots[tid]] = ch * ROWS + (tid >> 1);
        if (ch == 0) {
            for (int e = 0; e < 16; ++e) { const int lo = tstart[e] * 256 + etot[e], hi = tstart[e + 1] * 256; for (int sidx = lo + tid; sidx < hi; sidx += 512) slot_tok[sidx] = 0; }
        }
        __syncthreads();
    }
}
__device__ __forceinline__ void phase_combine_norm1_l1(const Params& P, int lane, int wave, int G) {
    const float* mod = (const float*)(P.ws + WS_MOD); bf16* H = (bf16*)(P.ws + WS_RH); const bf16* Y = (const bf16*)(P.ws + WS_HPERM);
    const int* rs = (const int*)(P.ws + WS_ROUTE_S); const float* rw = (const float*)(P.ws + WS_ROUTE_W);
    const bf16* X1 = (const bf16*)P.out; bf16* X2 = (bf16*)((unsigned char*)P.out + X2_OFF);
    const int st = G * 8; int row = blockIdx.x * 8 + wave; if (row >= M1) return;
#define L0ROW(r) (((r) >> 12) * TC + CTXL + ((r) & 4095))
    CombIdx ic, in; CombData dc, dn;
    comb_load_idx(rs, rw, L0ROW(row), ic); comb_load_data(X1 + (size_t)row * DM, Y, ic, lane, dc);
    { const int r1 = row + st < M1 ? row + st : row; comb_load_idx(rs, rw, L0ROW(r1), in); }
    for (; row < M1; row += st) {
        const int r1 = row + st < M1 ? row + st : row, r2 = row + 2 * st < M1 ? row + 2 * st : r1;
        comb_load_data(X1 + (size_t)r1 * DM, Y, in, lane, dn);
        CombIdx i2; comb_load_idx(rs, rw, L0ROW(r2), i2);
        const int b = row >> 12;
        f32x4 v[4]; comb_apply(v, dc, ic, mod + (size_t)b * 6144 + 5120, lane);
        store_row_bf16(X2 + (size_t)row * DM, v, lane);
        const float* md = mod + (size_t)(9 + b) * 6144;
        norm_mod(v, P.in[I_N1G] + 1024, md, md + 1024, lane);
        store_row_bf16(H + (size_t)row * DM, v, lane);
        dc = dn; ic = in; in = i2;
    }
#undef L0ROW
}
__device__ __forceinline__ void phase_final(const Params& P, int lane, int wave, int G) {
    const float* mod = (const float*)(P.ws + WS_MOD); const bf16* Y = (const bf16*)(P.ws + WS_HPERM);
    const int* rs = (const int*)(P.ws + WS_ROUTE_S); const float* rw = (const float*)(P.ws + WS_ROUTE_W);
    const bf16* X3 = (const bf16*)(P.ws + WS_X3);
    const int st = G * 8; int row = blockIdx.x * 8 + wave; if (row >= M1) return;
    CombIdx ic, in; CombData dc, dn;
    comb_load_idx(rs, rw, row, ic); comb_load_data(X3 + (size_t)row * DM, Y, ic, lane, dc);
    { const int r1 = row + st < M1 ? row + st : row; comb_load_idx(rs, rw, r1, in); }
    for (; row < M1; row += st) {
        const int r1 = row + st < M1 ? row + st : row, r2 = row + 2 * st < M1 ? row + 2 * st : r1;
        comb_load_data(X3 + (size_t)r1 * DM, Y, in, lane, dn);
        CombIdx i2; comb_load_idx(rs, rw, r2, i2);
        const int b = row >> 12;
        float* xr = P.out + (size_t)row * DM;
        f32x4 v[4]; comb_apply(v, dc, ic, mod + (size_t)(9 + b) * 6144 + 5120, lane);
        float ss = 0.f;
#pragma unroll
        for (int j = 0; j < 4; ++j) ss += (v[j][0] * v[j][0] + v[j][1] * v[j][1]) + (v[j][2] * v[j][2] + v[j][3] * v[j][3]);
        const float rr = rsqrtf(wave_sum(ss) * (1.f / 1024.f) + RMS_EPS);
#pragma unroll
        for (int j = 0; j < 4; ++j) ((f32x4*)xr)[lane + 64 * j] = v[j] * rr * ((const f32x4*)P.in[I_FING])[lane + 64 * j];
        dc = dn; ic = in; in = i2;
    }
}
__device__ __forceinline__ void phase_rowstat(const Params& P, int lane, int wave, int G) {
    const bf16* CQ = (const bf16*)(P.ws + WS_CQ); const bf16* CKV = (const bf16*)(P.ws + WS_CKV); float* rq = (float*)(P.ws + WS_RQ); float* rkv = (float*)(P.ws + WS_RKV);
    for (int row = blockIdx.x * 8 + wave; row < M0; row += G * 8) {
        float sq = 0.f, sk = 0.f;
        if (lane < 48) { const u32x4 a = ((const u32x4*)(CQ + (size_t)row * 384))[lane];
            sq = (bflo(a.x) * bflo(a.x) + bfhi(a.x) * bfhi(a.x)) + (bflo(a.y) * bflo(a.y) + bfhi(a.y) * bfhi(a.y)) + (bflo(a.z) * bflo(a.z) + bfhi(a.z) * bfhi(a.z)) + (bflo(a.w) * bflo(a.w) + bfhi(a.w) * bfhi(a.w)); }
        if (lane < 32) { const u32x4 a = ((const u32x4*)(CKV + (size_t)row * 256))[lane];
            sk = (bflo(a.x) * bflo(a.x) + bfhi(a.x) * bfhi(a.x)) + (bflo(a.y) * bflo(a.y) + bfhi(a.y) * bfhi(a.y)) + (bflo(a.z) * bflo(a.z) + bfhi(a.z) * bfhi(a.z)) + (bflo(a.w) * bflo(a.w) + bfhi(a.w) * bfhi(a.w)); }
        sq = wave_sum(sq); sk = wave_sum(sk);
        if (lane == 0) { rq[row] = rsqrtf(sq * (1.f / 384.f) + RMS_EPS); rkv[row] = rsqrtf(sk * (1.f / 256.f) + RMS_EPS); }
    }
}

constexpr int LRU_UXF = 0;
constexpr int LRU_UF = 17408;
constexpr int LRU_UB = LRU_UF + 16384;
constexpr int LRU_G = LRU_UB + 8192;
__device__ __forceinline__ int crow32(int r, int hi) { return (r & 3) + 8 * (r >> 2) + 4 * hi; }
struct LruK { float cw[4][8]; float cb[8]; float ba, bx, sp; bf16x8 bf[4]; int h; };
struct LruTile { u32x4 r[4]; };
__device__ __forceinline__ void lru_load_consts(const Params& P, int h, int tid, int lane, int wave, LruK& K) {
    const int c0 = (tid & 7) * 8; const float* cw = P.in[I_LCW]; const float* cb = P.in[I_LCB];
#pragma unroll
    for (int i = 0; i < 8; ++i) { const int ch = h * 64 + c0 + i; K.cb[i] = cb[ch];
#pragma unroll
        for (int j = 0; j < 4; ++j) K.cw[j][i] = cw[j * 512 + ch]; }
    { const int c = tid & 63, d = (tid >> 6) & 1, ch = h * 64 + c; K.ba = P.in[I_LBA][d * 512 + ch]; K.bx = P.in[I_LBX][d * 512 + ch]; K.sp = log1pf(expf(-P.in[I_LLAM][d * 512 + ch])); }
    { const bf16* WgT = (const bf16*)(P.ws + WS_WG) + (size_t)h * 256 * 64; const int n = wave * 32 + (lane & 31), hi = lane >> 5;
#pragma unroll
      for (int ks = 0; ks < 4; ++ks) K.bf[ks] = *(const bf16x8*)(WgT + (size_t)n * 64 + 16 * ks + 8 * hi); }
    K.h = h;
}
__device__ __forceinline__ void lru_tile_load(const bf16* UX, int b, int ck, int h, int tid, LruTile& T) {
    const int seg_lo = ck < 4 ? 0 : CTXL, seg_hi = ck < 4 ? CTXL : TC, p0 = ck * 64 - 2 + (tid >> 3), c8 = (tid & 7) * 8;
#pragma unroll
    for (int j = 0; j < 4; ++j) { const int pos = p0 + j; const bool ok = pos >= seg_lo && pos < seg_hi; const int pc = pos < seg_lo ? seg_lo : (pos >= seg_hi ? seg_hi - 1 : pos);
        const u32x4 v = *(const u32x4*)(UX + (size_t)(b * TC + pc) * 512 + h * 64 + c8);
        T.r[j] = ok ? v : (u32x4){0u, 0u, 0u, 0u}; }
}
__device__ __forceinline__ void st8f(float* d, const u32x4 a) { d[0] = bflo(a.x); d[1] = bfhi(a.x); d[2] = bflo(a.y); d[3] = bfhi(a.y); d[4] = bflo(a.z); d[5] = bfhi(a.z); d[6] = bflo(a.w); d[7] = bfhi(a.w); }
constexpr int LRU_QP = LRU_G + 65536;
constexpr int LRU_QS = LRU_QP + 2048;
constexpr int LRU_HQ = LRU_QS + 2048;
template <int MODE> __device__ __forceinline__ void lru_coeffs(unsigned char* lds, const LruTile& T, const LruK& K, int tid, int lane, int wave) {
    float* uf = (float*)(lds + LRU_UF); bf16* ub = (bf16*)(lds + LRU_UB); float* Gm = (float*)(lds + LRU_G);
    __syncthreads();
    { const int t = tid >> 3, c0 = (tid & 7) * 8; float uo[8];
#pragma unroll
      for (int i = 0; i < 8; ++i) uo[i] = K.cb[i];
#pragma unroll
      for (int j = 0; j < 4; ++j) { const u32x4 a = T.r[j]; const float x[8] = {bflo(a.x), bfhi(a.x), bflo(a.y), bfhi(a.y), bflo(a.z), bfhi(a.z), bflo(a.w), bfhi(a.w)};
#pragma unroll
          for (int i = 0; i < 8; ++i) uo[i] += K.cw[j][i] * x[i]; }
#pragma unroll
      for (int i = 0; i < 8; ++i) uf[t * 64 + c0 + i] = uo[i];
      u32x4 w; w.x = pk2(uo[0], uo[1]); w.y = pk2(uo[2], uo[3]); w.z = pk2(uo[4], uo[5]); w.w = pk2(uo[6], uo[7]);
      *(u32x4*)(ub + t * 64 + c0) = w; }
    __syncthreads();
    {
        const int r32 = lane & 31, hi = lane >> 5, n = wave * 32 + r32;
        f32x16 acc0 = {}, acc1 = {};
#pragma unroll
        for (int ks = 0; ks < 4; ++ks) {
            const bf16x8 a0 = *(const bf16x8*)(ub + (r32) * 64 + 16 * ks + 8 * hi), a1 = *(const bf16x8*)(ub + (32 + r32) * 64 + 16 * ks + 8 * hi);
            acc0 = __builtin_amdgcn_mfma_f32_32x32x16_bf16(a0, K.bf[ks], acc0, 0, 0, 0);
            acc1 = __builtin_amdgcn_mfma_f32_32x32x16_bf16(a1, K.bf[ks], acc1, 0, 0, 0);
        }
#pragma unroll
        for (int r = 0; r < 16; ++r) { Gm[crow32(r, hi) * 256 + n] = acc0[r]; Gm[(32 + crow32(r, hi)) * 256 + n] = acc1[r]; }
    }
    __syncthreads();
    { const int c = tid & 63, d = (tid >> 6) & 1, tg = tid >> 7;
      constexpr float L2E = 1.4426950408889634f; const float kba = K.ba, kbx = K.bx, ksp8 = -8.f * K.sp;
      float* g0 = Gm + (tg * 16) * 256 + d * 128 + c; const float* u0 = uf + (tg * 16) * 64 + c;
      float hh = 0.f, pp = 1.f;
#pragma unroll 2
      for (int k = 0; k < 8; ++k) { const int i = d ? 14 - 2 * k : 2 * k;
          const f32x2 ga = (f32x2){g0[i * 256] + kba, g0[(i + 1) * 256] + kba}, gx = (f32x2){g0[i * 256 + 64] + kbx, g0[(i + 1) * 256 + 64] + kbx};
          const f32x2 ta = ga * (-L2E), tx = gx * (-L2E);
          const f32x2 ea = (f32x2){__builtin_amdgcn_exp2f(ta[0]), __builtin_amdgcn_exp2f(ta[1])} + 1.f, ex = (f32x2){__builtin_amdgcn_exp2f(tx[0]), __builtin_amdgcn_exp2f(tx[1])} + 1.f;
          const f32x2 r = {__builtin_amdgcn_rcpf(ea[0]), __builtin_amdgcn_rcpf(ea[1])}, ii = {__builtin_amdgcn_rcpf(ex[0]), __builtin_amdgcn_rcpf(ex[1])};
          const f32x2 la = r * ksp8, tl = la * L2E;
          const f32x2 a = {__builtin_amdgcn_exp2f(tl[0]), __builtin_amdgcn_exp2f(tl[1])};
          const f32x2 x2 = la + la;
          const f32x2 emp = -x2 * (x2 * (x2 * (x2 * 0.041666668f + 0.16666667f) + 0.5f) + 1.f);
          const f32x2 ema = 1.f - a * a;
          const f32x2 em = {x2[0] > -0.25f ? emp[0] : ema[0], x2[1] > -0.25f ? emp[1] : ema[1]};
          const f32x2 sq = {__builtin_amdgcn_sqrtf(em[0]), __builtin_amdgcn_sqrtf(em[1])};
          const f32x2 bb = sq * (ii * (f32x2){u0[i * 64], u0[(i + 1) * 64]});
          const float a_f = d ? a[1] : a[0], a_s = d ? a[0] : a[1], b_f = d ? bb[1] : bb[0], b_s = d ? bb[0] : bb[1];
          hh = a_f * hh + b_f; pp *= a_f; const float h_f = hh, p_f = pp;
          hh = a_s * hh + b_s; pp *= a_s;
          if (MODE == 3) { const int of = d ? i + 1 : i, os = d ? i : i + 1;
              g0[of * 256] = h_f; g0[of * 256 + 64] = p_f; g0[os * 256] = hh; g0[os * 256 + 64] = pp; } }
      ((float*)(lds + LRU_QP))[(d * 4 + tg) * 64 + c] = pp; ((float*)(lds + LRU_QS))[(d * 4 + tg) * 64 + c] = hh; }
    __syncthreads();
}
__device__ __forceinline__ void lru_unit(int u, int& b, int& ck, int& h) { h = u & 7; ck = (u >> 3) % LCH; b = u / (8 * LCH); }
__device__ __forceinline__ void phase_lru_f1(const Params& P, unsigned char* lds, int tid, int lane, int wave, int G) {
    float* Gm = (float*)(lds + LRU_G); float* CP = (float*)(P.ws + WS_CP); float* CS = (float*)(P.ws + WS_CS); const bf16* UX = (const bf16*)(P.ws + WS_UX);
    constexpr int NU = NB * LCH * 8;
    int u = blockIdx.x; if (u >= NU) return;
    int b, ck, h; lru_unit(u, b, ck, h);
    LruK K; lru_load_consts(P, h, tid, lane, wave, K);
    LruTile T; lru_tile_load(UX, b, ck, h, tid, T);
    for (;;) {
        if (h != K.h) lru_load_consts(P, h, tid, lane, wave, K);
        lru_coeffs<1>(lds, T, K, tid, lane, wave);
        const int un = u + G; int bn = 0, ckn = 0, hn = h;
        if (un < NU) { lru_unit(un, bn, ckn, hn); lru_tile_load(UX, bn, ckn, hn, tid, T); }
        if (tid < 128) { const int d = tid >> 6, c = tid & 63; float hh = 0.f, pp = 1.f;
            const float* QP = (const float*)(lds + LRU_QP); const float* QS = (const float*)(lds + LRU_QS);
#pragma unroll
            for (int k = 0; k < 4; ++k) { const int q = d ? 3 - k : k; const float a = QP[(d * 4 + q) * 64 + c], bb = QS[(d * 4 + q) * 64 + c]; hh = a * hh + bb; pp *= a; }
            const size_t o = ((size_t)(d * 8 + b) * LCH + ck) * 512 + h * 64 + c; CP[o] = pp; CS[o] = hh; }
        if (un >= NU) break;
        u = un; b = bn; ck = ckn; h = hn;
    }
    __syncthreads();
}
__device__ __forceinline__ void phase_lru_carry(const Params& P, int lane, int wave, int G) {
    const float* CP = (const float*)(P.ws + WS_CP); const float* CS = (const float*)(P.ws + WS_CS); float* HIN = (float*)(P.ws + WS_HIN);
    if (wave != 0) return;
    for (int sb = blockIdx.x; sb < 128; sb += G) {
        const int s = sb * 64 + lane, d = s >> 12, b = (s >> 9) & 7, ch = s & 511; const size_t base = ((size_t)(d * 8 + b) * LCH) * 512 + ch;
        float hh = 0.f;
#pragma unroll 1
        for (int st = 0; st < LCH; st += 17) { float cp[17], cs[17]; int q[17];
#pragma unroll
            for (int i = 0; i < 17; ++i) { const int step = st + i; q[i] = d == 0 ? step : (step < 4 ? 3 - step : 71 - step); cp[i] = CP[base + (size_t)q[i] * 512]; cs[i] = CS[base + (size_t)q[i] * 512]; }
#pragma unroll
            for (int i = 0; i < 17; ++i) { HIN[base + (size_t)q[i] * 512] = hh; hh = cp[i] * hh + cs[i]; } }
    }
}
__device__ __forceinline__ float gelu_tanh(float x) { const float u = 0.7978845608028654f * (x + 0.044715f * x * x * x); return x * __builtin_amdgcn_rcpf(1.f + __expf(-2.f * u)); }
__device__ __forceinline__ void phase_lru_f3(const Params& P, unsigned char* lds, int tid, int lane, int wave, int G) {
    float* Gm = (float*)(lds + LRU_G); const bf16* UX = (const bf16*)(P.ws + WS_UX);
    const bf16* UG = (const bf16*)(P.ws + WS_UG); bf16* MIX = (bf16*)(P.ws + WS_RH); const float* HIN = (const float*)(P.ws + WS_HIN);
    constexpr int NU = NB * LCH * 8;
    int u = blockIdx.x; if (u >= NU) return;
    int b, ck, h; lru_unit(u, b, ck, h);
    LruK K; lru_load_consts(P, h, tid, lane, wave, K);
    LruTile T; lru_tile_load(UX, b, ck, h, tid, T);
    const int t = tid >> 3, c0 = (tid & 7) * 8;
    u32x4 gq = *(const u32x4*)(UG + ((size_t)b * TC + ck * 64 + t) * 512 + h * 64 + c0);
    float hin = 0.f; if (tid < 128) hin = HIN[((size_t)((tid >> 6) * 8 + b) * LCH + ck) * 512 + h * 64 + (tid & 63)];
    for (;;) {
        if (h != K.h) lru_load_consts(P, h, tid, lane, wave, K);
        lru_coeffs<3>(lds, T, K, tid, lane, wave);
        const u32x4 g = gq; const float hh0 = hin;
        const int un = u + G; int bn = 0, ckn = 0, hn = h;
        if (un < NU) { lru_unit(un, bn, ckn, hn); lru_tile_load(UX, bn, ckn, hn, tid, T);
            gq = *(const u32x4*)(UG + ((size_t)bn * TC + ckn * 64 + t) * 512 + hn * 64 + c0);
            if (tid < 128) hin = HIN[((size_t)((tid >> 6) * 8 + bn) * LCH + ckn) * 512 + hn * 64 + (tid & 63)]; }
        float* HQ = (float*)(lds + LRU_HQ);
        if (tid < 128) { const int d = tid >> 6, c = tid & 63; float hh = hh0;
            const float* QP = (const float*)(lds + LRU_QP); const float* QS = (const float*)(lds + LRU_QS);
#pragma unroll
            for (int k = 0; k < 4; ++k) { const int q = d ? 3 - k : k; HQ[(d * 4 + q) * 64 + c] = hh; hh = QP[(d * 4 + q) * 64 + c] * hh + QS[(d * 4 + q) * 64 + c]; } }
        __syncthreads();
        { const size_t row = (size_t)b * TC + ck * 64 + t; const int q = t >> 4;
          const float gv[8] = {bflo(g.x), bfhi(g.x), bflo(g.y), bfhi(g.y), bflo(g.z), bfhi(g.z), bflo(g.w), bfhi(g.w)};
          float o[8];
#pragma unroll
          for (int i = 0; i < 8; ++i) { const int cc = c0 + i;
              const float y = (Gm[t * 256 + cc] + Gm[t * 256 + 64 + cc] * HQ[q * 64 + cc]) + (Gm[t * 256 + 128 + cc] + Gm[t * 256 + 192 + cc] * HQ[(4 + q) * 64 + cc]);
              o[i] = y * gelu_tanh(gv[i]); }
          u32x4 w; w.x = pk2(o[0], o[1]); w.y = pk2(o[2], o[3]); w.z = pk2(o[4], o[5]); w.w = pk2(o[6], o[7]);
          *(u32x4*)(MIX + row * 1024 + 512 + h * 64 + c0) = w; }
        if (un >= NU) break;
        u = un; b = bn; ck = ckn; h = hn;
    }
    __syncthreads();
}

namespace att {
constexpr int NW = 8, QBLK = 32, KVBLK = 64;
constexpr float SCALE = 0.10206207261596575f;
constexpr float THR = 8.f;
constexpr int LDQ = 768, LDK = 768, LDV = 512, LDO = 1024;
constexpr int SHM_V = 16384, SHM_K = 16384, SHM_ATTN = 2 * SHM_V + 2 * SHM_K + NW * 64 * 4;
#define KSWZ(row, colB) ((row) * 256 + ((colB) ^ (((row) & 7) << 4)))
#define SBAR() __builtin_amdgcn_sched_barrier(0)
__device__ __forceinline__ int crow(int r, int hi) { return (r & 3) + 8 * (r >> 2) + 4 * hi; }
__device__ __forceinline__ unsigned cvtpk(float lo, float hi) { unsigned r; asm volatile("v_cvt_pk_bf16_f32 %0, %1, %2" : "=v"(r) : "v"(lo), "v"(hi)); return r; }
__device__ __forceinline__ void partialSM(f32x16& p0, f32x16& p1, float& m_reg, float& mn, float& alpha) {
  constexpr float C = SCALE * 1.4426950408889634f;
  float pmax = p0[0];
#pragma unroll
  for (int r = 1; r < 16; ++r) pmax = fmaxf(pmax, p0[r]);
#pragma unroll
  for (int r = 0; r < 16; ++r) pmax = fmaxf(pmax, p1[r]);
  { auto rr = __builtin_amdgcn_permlane32_swap(__float_as_uint(pmax), __float_as_uint(pmax), false, false);
    pmax = fmaxf(__uint_as_float(rr[0]), __uint_as_float(rr[1])); }
  if (__builtin_expect(__all(pmax - m_reg <= THR / SCALE), 1)) { mn = m_reg; alpha = 1.f; }
  else { mn = fmaxf(m_reg, pmax); alpha = __builtin_amdgcn_exp2f((m_reg - mn) * C); m_reg = mn; }
  float mnC = -mn * C;
#pragma unroll
  for (int r = 0; r < 16; ++r) p0[r] = fmaf(p0[r], C, mnC);
#pragma unroll
  for (int r = 0; r < 16; ++r) p1[r] = fmaf(p1[r], C, mnC);
#pragma unroll
  for (int r = 0; r < 16; ++r) p0[r] = __builtin_amdgcn_exp2f(p0[r]);
}
__device__ __forceinline__ void finishSM(f32x16& p0, f32x16& p1, float alpha, float& l_reg, bf16x8& pa0, bf16x8& pa1, bf16x8& pa2, bf16x8& pa3) {
#pragma unroll
  for (int r = 0; r < 16; ++r) p1[r] = __builtin_amdgcn_exp2f(p1[r]);
  float ps = 0;
#pragma unroll
  for (int r = 0; r < 16; ++r) ps += p0[r];
#pragma unroll
  for (int r = 0; r < 16; ++r) ps += p1[r];
  { auto rr = __builtin_amdgcn_permlane32_swap(__float_as_uint(ps), __float_as_uint(ps), false, false);
    ps = __uint_as_float(rr[0]) + __uint_as_float(rr[1]); }
  l_reg = l_reg * alpha + ps;
#define PK4(P, BASE, OUT) do { unsigned a0 = cvtpk(P[BASE + 0], P[BASE + 1]), a1 = cvtpk(P[BASE + 2], P[BASE + 3]);   \
    unsigned b0 = cvtpk(P[BASE + 4], P[BASE + 5]), b1 = cvtpk(P[BASE + 6], P[BASE + 7]);                              \
    auto r0 = __builtin_amdgcn_permlane32_swap(a0, b0, false, false); auto r1 = __builtin_amdgcn_permlane32_swap(a1, b1, false, false); \
    u32x4 w = {r0[0], r1[0], r0[1], r1[1]}; OUT = *reinterpret_cast<bf16x8*>(&w); } while (0)
  PK4(p0, 0, pa0); PK4(p0, 8, pa1); PK4(p1, 0, pa2); PK4(p1, 8, pa3);
#undef PK4
}
__device__ __forceinline__ void qkt(f32x16& p0, f32x16& p1, const bf16* Ks, const bf16x8* qr, int r32, int hi) {
  p0 = f32x16{}; p1 = f32x16{};
#pragma unroll
  for (int d0 = 0; d0 < 6; ++d0) { int cb = (d0 * 16 + hi * 8) * 2;
    bf16x8 b0 = *reinterpret_cast<const bf16x8*>((const char*)Ks + KSWZ(r32, cb));
    bf16x8 b1 = *reinterpret_cast<const bf16x8*>((const char*)Ks + KSWZ(32 + r32, cb));
    p0 = __builtin_amdgcn_mfma_f32_32x32x16_bf16(b0, qr[d0], p0, 0, 0, 0);
    p1 = __builtin_amdgcn_mfma_f32_32x32x16_bf16(b1, qr[d0], p1, 0, 0, 0); }
}
__device__ __forceinline__ int v_st(int k, int c) { const int kk = (k & ~0xC) | ((k & 4) << 1) | ((k & 8) >> 1); return ((kk >> 3) * 4 + (c >> 5)) * 512 + ((kk & 7) * 32 + (c & 31)) * 2; }
__device__ __forceinline__ int v_rd_base(int lane) { return ((lane & 3) << 3) | (((lane >> 2) & 3) << 6) | (((lane >> 4) & 1) << 5) | (((lane >> 5) & 1) << 8); }
constexpr int v_rd_off(int d0, int ks, int half) { return d0 * 512 + ks * 4096 + half * 2048; }
template <int OFF> __device__ __forceinline__ s16x4 tr_read(int vb) {
  s16x4 r; asm volatile("ds_read_b64_tr_b16 %0, %1 offset:%2" : "=&v"(r) : "v"(vb), "i"(OFF) : "memory"); return r;
}
template <int D0> __device__ __forceinline__ void pv_one(f32x16& od, int vb, bf16x8 pa0, bf16x8 pa1, bf16x8 pa2, bf16x8 pa3) {
  const s16x4 l0 = tr_read<v_rd_off(D0, 0, 0)>(vb), h0 = tr_read<v_rd_off(D0, 0, 1)>(vb), l1 = tr_read<v_rd_off(D0, 1, 0)>(vb), h1 = tr_read<v_rd_off(D0, 1, 1)>(vb);
  const s16x4 l2 = tr_read<v_rd_off(D0, 2, 0)>(vb), h2 = tr_read<v_rd_off(D0, 2, 1)>(vb), l3 = tr_read<v_rd_off(D0, 3, 0)>(vb), h3 = tr_read<v_rd_off(D0, 3, 1)>(vb);
  asm volatile("s_waitcnt lgkmcnt(0)" ::: "memory"); SBAR();
#define PK(L, H) (bf16x8){L[0], L[1], L[2], L[3], H[0], H[1], H[2], H[3]}
  od = __builtin_amdgcn_mfma_f32_32x32x16_bf16(pa0, PK(l0, h0), od, 0, 0, 0);
  od = __builtin_amdgcn_mfma_f32_32x32x16_bf16(pa1, PK(l1, h1), od, 0, 0, 0);
  od = __builtin_amdgcn_mfma_f32_32x32x16_bf16(pa2, PK(l2, h2), od, 0, 0, 0);
  od = __builtin_amdgcn_mfma_f32_32x32x16_bf16(pa3, PK(l3, h3), od, 0, 0, 0);
#undef PK
}
__device__ __forceinline__ void pv_d0(f32x16* o, int vb, bf16x8 pa0, bf16x8 pa1, bf16x8 pa2, bf16x8 pa3) {
  pv_one<0>(o[0], vb, pa0, pa1, pa2, pa3); pv_one<1>(o[1], vb, pa0, pa1, pa2, pa3);
}
__device__ __forceinline__ void attn_dense_body(const bf16* __restrict__ Qb, const bf16* __restrict__ Kh, const bf16* __restrict__ Vh, bf16* __restrict__ Ob, int seq, int tq0  , char* lds) {
  const int tid = threadIdx.x, wid = tid >> 6, lane = tid & 63, r32 = lane & 31, hi = lane >> 5;
  bf16* V_lds = (bf16*)lds; bf16* K_lds = (bf16*)(lds + 2 * SHM_V);
  float* ws = (float*)(lds + 2 * SHM_V + 2 * SHM_K) + wid * 64; float* li_l = ws; float* al_l = ws + 32;
  float m_reg = -1e30f, l_reg = 0; f32x16 o[2] = {}; bf16x8 qr[6];
  const bf16* Qw = Qb + (long)(wid * QBLK + r32) * LDQ + hi * 8;
#pragma unroll
  for (int d0 = 0; d0 < 6; ++d0) qr[d0] = *reinterpret_cast<const bf16x8*>(Qw + d0 * 16);
  {
    const int tq = tq0 + wid * QBLK + r32; const bool on = tq0 >= 0;
    constexpr float IF[8] = {1.0f, 0.316227766f, 0.1f, 0.0316227766f, 0.01f, 0.00316227766f, 0.001f, 0.000316227766f};
#pragma unroll
    for (int ax = 0; ax < 2; ++ax) { const float pos = (float)(ax == 0 ? (tq >> 6) : (tq & 63)) * 0.15915494309189535f;
      bf16x8 qv = qr[4 + ax]; bf16x8 qo;
#pragma unroll
      for (int i = 0; i < 8; ++i) { const float x = __uint_as_float(((unsigned)(unsigned short)qv[i]) << 16); const float other = __shfl_xor(x, 32);
        const float sn = __builtin_amdgcn_sinf(pos * IF[i]), cs = __builtin_amdgcn_cosf(pos * IF[i]);
        const float r = hi == 0 ? x * cs - other * sn : other * sn + x * cs;
        unsigned u = __float_as_uint(on ? r : x); u = (u + 0x7fffu + ((u >> 16) & 1u)) >> 16; qo[i] = (short)u; }
      qr[4 + ax] = qo; }
  }
  const int sr = tid >> 3, sc = (tid & 7) * 8, vst = v_st(sr, sc), kr2 = (tid >> 2) & 63, kc2 = 64 + (tid & 3) * 8; const bool kb2 = tid < 256;
  const int vb0 = (int)(uintptr_t)V_lds + v_rd_base(lane);
  struct { bf16x8 vs, ka, kb; } sr_[2];
#define SLOAD(i, k0) do { sr_[i].vs = *reinterpret_cast<const bf16x8*>(&Vh[(long)((k0) + sr) * LDV + sc]); \
    sr_[i].ka = *reinterpret_cast<const bf16x8*>(&Kh[(long)((k0) + sr) * LDK + sc]); \
    if (kb2) sr_[i].kb = *reinterpret_cast<const bf16x8*>(&Kh[(long)((k0) + kr2) * LDK + kc2]); } while (0)
#define SWRITE(b, i) do { *(bf16x8*)((char*)V_lds + (b) * SHM_V + vst) = sr_[i].vs;          \
    *(bf16x8*)((char*)K_lds + (b) * SHM_K + KSWZ(sr, sc * 2)) = sr_[i].ka;                       \
    if (kb2) *(bf16x8*)((char*)K_lds + (b) * SHM_K + KSWZ(kr2, kc2 * 2)) = sr_[i].kb; } while (0)
#define SWAIT() asm volatile("s_waitcnt vmcnt(3)" ::: "memory")
#define RESC(a) do { if (__any((a) < 1.f)) { if (hi == 0) al_l[r32] = (a); asm volatile("s_waitcnt lgkmcnt(0)" ::: "memory"); \
    _Pragma("unroll") for (int d = 0; d < 2; ++d) _Pragma("unroll") for (int r = 0; r < 16; ++r) o[d][r] *= al_l[crow(r, hi)]; } } while (0)
  f32x16 pA0, pA1, pB0, pB1; float mnA, mnB, alA, alB; bf16x8 pa0, pa1, pa2, pa3; const int NT = seq / KVBLK;
  constexpr int SE = 0, SO = 1;
  SLOAD(SE, 0); asm volatile("s_waitcnt vmcnt(0)" ::: "memory"); SWRITE(0, SE); __syncthreads();
  qkt(pA0, pA1, K_lds, qr, r32, hi); partialSM(pA0, pA1, m_reg, mnA, alA);
  SLOAD(SO, KVBLK); if (2 < NT) SLOAD(SE, 2 * KVBLK);
  SWAIT(); SWRITE(1, SO); __syncthreads();
#ifndef ATT_SKEW
#define ATT_SKEW 0
#endif
  const bool swp = ATT_SKEW > 0 && (__builtin_amdgcn_readfirstlane(wid) >= 4);
  for (int j = 1; j + 1 < NT; j += 2) {
    if (swp) __builtin_amdgcn_s_sleep(ATT_SKEW);
    SBAR(); qkt(pB0, pB1, (bf16*)((char*)K_lds + SHM_K), qr, r32, hi);
    finishSM(pA0, pA1, alA, l_reg, pa0, pa1, pa2, pa3); SBAR();
    SLOAD(SO, (j + 2) * KVBLK); SBAR();
    pv_d0(o, vb0, pa0, pa1, pa2, pa3); partialSM(pB0, pB1, m_reg, mnB, alB);
    __syncthreads(); SWAIT(); SWRITE(0, SE);
    RESC(alB); __syncthreads();
    if (swp) __builtin_amdgcn_s_sleep(ATT_SKEW);
    SBAR(); qkt(pA0, pA1, K_lds, qr, r32, hi);
    finishSM(pB0, pB1, alB, l_reg, pa0, pa1, pa2, pa3); SBAR();
    if (j + 3 < NT) SLOAD(SE, (j + 3) * KVBLK); SBAR();
    pv_d0(o, vb0 + (int)SHM_V, pa0, pa1, pa2, pa3); partialSM(pA0, pA1, m_reg, mnA, alA);
    __syncthreads(); SWAIT(); SWRITE(1, SO);
    RESC(alA); __syncthreads();
  }
  SBAR(); qkt(pB0, pB1, (bf16*)((char*)K_lds + SHM_K), qr, r32, hi);
  finishSM(pA0, pA1, alA, l_reg, pa0, pa1, pa2, pa3); SBAR();
  pv_d0(o, vb0, pa0, pa1, pa2, pa3); partialSM(pB0, pB1, m_reg, mnB, alB);
  __syncthreads(); RESC(alB);
  finishSM(pB0, pB1, alB, l_reg, pa0, pa1, pa2, pa3); SBAR();
  pv_d0(o, vb0 + (int)SHM_V, pa0, pa1, pa2, pa3);
  if (hi == 0) li_l[r32] = l_reg; asm volatile("s_waitcnt lgkmcnt(0)" ::: "memory");
  float rli[16];
#pragma unroll
  for (int r = 0; r < 16; ++r) rli[r] = __builtin_amdgcn_rcpf(li_l[crow(r, hi)]);
  bf16* Ow = Ob + (long)(wid * QBLK) * LDO;
#pragma unroll
  for (int r = 0; r < 16; ++r) { int orow = crow(r, hi);
#pragma unroll
    for (int d0 = 0; d0 < 2; ++d0) Ow[(long)orow * LDO + d0 * 32 + r32] = (bf16)f2bf(o[d0][r] * rli[r]); }
#undef SLOAD
#undef SWRITE
#undef SWAIT
#undef RESC
}

}

__device__ __forceinline__ void phase_attention(const Params& P, unsigned char* lds, int G) {
    const bf16* Q = (const bf16*)(P.ws + WS_Q); const bf16* K = (const bf16*)(P.ws + WS_K); const bf16* V = (const bf16*)(P.ws + WS_V); bf16* MIX = (bf16*)(P.ws + WS_RH);
    const int vcu = (G % 8 == 0) ? ((int)blockIdx.x % 8) * (G / 8) + (int)blockIdx.x / 8 : (int)blockIdx.x;
    for (int idx = vcu; idx < 1024 + 64; idx += G) {
        int b, h, seq; size_t qrow;
        if (idx < 1024) { const int bh = idx >> 4, qb = idx & 15; b = bh >> 3; h = bh & 7; qrow = (size_t)b * TC + CTXL + qb * 256; seq = TC; }
        else { const int j = idx - 1024; b = j >> 3; h = j & 7; qrow = (size_t)b * TC; seq = CTXL; }
        att::attn_dense_body(Q + qrow * 768 + h * 96, K + (size_t)b * TC * 768 + h * 96, V + (size_t)b * TC * 512 + h * 64, MIX + qrow * 1024 + h * 64, seq, idx < 1024 ? (idx & 15) * 256 : -1, (char*)lds);
        __syncthreads();
    }
}

typedef float cf __attribute__((ext_vector_type(2)));
__device__ __forceinline__ cf cmul(cf a, cf b) { return a * (cf){b.x, b.x} + (cf){a.y, a.x} * (cf){-b.y, b.y}; }
__device__ __forceinline__ cf cis_rev(float rev) { return cf{__builtin_amdgcn_cosf(rev), __builtin_amdgcn_sinf(rev)}; }
template <int S> __device__ __forceinline__ void dft4(cf& a, cf& b, cf& c, cf& d) {
    const cf t0 = a + c, t1 = a - c, t2 = b + d, t3 = b - d;
    const cf t3i = (cf){-(float)S * t3.y, (float)S * t3.x};
    a = t0 + t2; c = t0 - t2; b = t1 + t3i; d = t1 - t3i;
}
template <int S> __device__ __forceinline__ void dft16_tail(cf (&v)[16]);
template <int S> __device__ __forceinline__ void dft16(cf (&v)[16]) {
#pragma unroll
    for (int j0 = 0; j0 < 4; ++j0) dft4<S>(v[j0], v[j0 + 4], v[j0 + 8], v[j0 + 12]);
    dft16_tail<S>(v);
}
template <int S> __device__ __forceinline__ void dft16_tail(cf (&v)[16]) {
    constexpr float C1 = 0.9238795325112867f, S1 = 0.3826834323650898f, C2 = 0.7071067811865476f;
    v[5] = cmul(v[5], cf{C1, S * S1}); v[9] = cmul(v[9], cf{C2, S * C2}); v[13] = cmul(v[13], cf{S1, S * C1});
    v[6] = cmul(v[6], cf{C2, S * C2}); v[10] = (cf){-(float)S * v[10].y, (float)S * v[10].x}; v[14] = cmul(v[14], cf{-C2, S * C2});
    v[7] = cmul(v[7], cf{S1, S * C1}); v[11] = cmul(v[11], cf{-C2, S * C2}); v[15] = cmul(v[15], cf{-C1, -S * S1});
#pragma unroll
    for (int k1 = 0; k1 < 4; ++k1) dft4<S>(v[4 * k1], v[4 * k1 + 1], v[4 * k1 + 2], v[4 * k1 + 3]);
}
#define REV4(k) ((((k) >> 2) | (((k) & 3) << 2)))
__device__ __forceinline__ int fphys(int L) { return L + (L >> 4); }
constexpr int FFT_BUF = 4352 * 8;
constexpr int FFT_ZB = 2 * FFT_BUF;
constexpr int FFT_HB1 = FFT_ZB + 32768;
constexpr int FFT_W3 = FFT_HB1 + 32768;
constexpr int FFT_RED = FFT_W3 + 1024;
static_assert(FFT_RED + 64 <= LDSCTL_OFF, "fft lds");
template <int PAT> __device__ __forceinline__ int fbase(int tp) {
    if (PAT == 0) return tp + (tp >> 4);
    if (PAT == 1) return (tp & 15) + 272 * (tp >> 4);
    return 17 * (tp & 15) + 272 * (tp >> 4);
}
template <int PAT> struct FStr { static constexpr int v = PAT == 0 ? 272 : (PAT == 1 ? 17 : 1); };
__device__ __forceinline__ int hide(int x) { asm volatile("" : "+v"(x)); return x; }
#if defined(__HIP_DEVICE_COMPILE__)
template <int OFF> __device__ __forceinline__ cf lds_rd64(unsigned addr) { f32x2 r; asm volatile("ds_read_b64 %0, %1 offset:%2" : "=v"(r) : "v"(addr), "i"(OFF) : "memory"); return cf{r[0], r[1]}; }
template <int OFF> __device__ __forceinline__ void lds_wr64(unsigned addr, cf x) { f32x2 r = {x.x, x.y}; asm volatile("ds_write_b64 %0, %1 offset:%2" :: "v"(addr), "v"(r), "i"(OFF) : "memory"); }
#define FFT_LGKM0() asm volatile("s_waitcnt lgkmcnt(0)" ::: "memory")
#else
template <int OFF> __device__ __forceinline__ cf lds_rd64(const cf* p) { return *(const cf*)((const char*)p + OFF); }
template <int OFF> __device__ __forceinline__ void lds_wr64(cf* p, cf x) { *(cf*)((char*)p + OFF) = x; }
#define FFT_LGKM0()
#endif
template <int PAT> __device__ __forceinline__ void fload(cf (&v)[16], const cf* buf, int tp) {
    constexpr int ST = FStr<PAT>::v * 8;
#if defined(__HIP_DEVICE_COMPILE__)
    const unsigned p = (unsigned)(uintptr_t)(buf + fbase<PAT>(tp));
    f32x2 r0, r1, r2, r3, r4, r5, r6, r7, r8, r9, r10, r11, r12, r13, r14, r15;
#define FRD(R, J) asm volatile("ds_read_b64 %0, %1 offset:%2" : "=v"(R) : "v"(p), "i"((J) * ST) : "memory")
    FRD(r0, 0); FRD(r1, 1); FRD(r2, 2); FRD(r3, 3); FRD(r4, 4); FRD(r5, 5); FRD(r6, 6); FRD(r7, 7); FRD(r8, 8); FRD(r9, 9); FRD(r10, 10); FRD(r11, 11); FRD(r12, 12); FRD(r13, 13); FRD(r14, 14); FRD(r15, 15);
#undef FRD
    asm volatile("s_waitcnt lgkmcnt(0)" : "+v"(r0), "+v"(r1), "+v"(r2), "+v"(r3), "+v"(r4), "+v"(r5), "+v"(r6), "+v"(r7), "+v"(r8), "+v"(r9), "+v"(r10), "+v"(r11), "+v"(r12), "+v"(r13), "+v"(r14), "+v"(r15) :: "memory");
    v[0] = cf{r0[0], r0[1]}; v[1] = cf{r1[0], r1[1]}; v[2] = cf{r2[0], r2[1]}; v[3] = cf{r3[0], r3[1]}; v[4] = cf{r4[0], r4[1]}; v[5] = cf{r5[0], r5[1]}; v[6] = cf{r6[0], r6[1]}; v[7] = cf{r7[0], r7[1]};
    v[8] = cf{r8[0], r8[1]}; v[9] = cf{r9[0], r9[1]}; v[10] = cf{r10[0], r10[1]}; v[11] = cf{r11[0], r11[1]}; v[12] = cf{r12[0], r12[1]}; v[13] = cf{r13[0], r13[1]}; v[14] = cf{r14[0], r14[1]}; v[15] = cf{r15[0], r15[1]};
#else
    const cf* p = buf + fbase<PAT>(tp);
#pragma unroll
    for (int j = 0; j < 16; ++j) v[j] = *(const cf*)((const char*)p + j * ST);
#endif
}
template <int PAT, int S> __device__ __forceinline__ void fload_dft16(cf (&v)[16], const cf* buf, int tp) {
#if defined(__HIP_DEVICE_COMPILE__)
    constexpr int ST = FStr<PAT>::v * 8;
    const unsigned p = (unsigned)(uintptr_t)(buf + fbase<PAT>(tp));
    f32x2 r0, r1, r2, r3, r4, r5, r6, r7, r8, r9, r10, r11, r12, r13, r14, r15;
#define FRD(R, J) asm volatile("ds_read_b64 %0, %1 offset:%2" : "=v"(R) : "v"(p), "i"((J) * ST) : "memory")
    FRD(r0, 0); FRD(r4, 4); FRD(r8, 8); FRD(r12, 12); FRD(r1, 1); FRD(r5, 5); FRD(r9, 9); FRD(r13, 13);
    FRD(r2, 2); FRD(r6, 6); FRD(r10, 10); FRD(r14, 14); FRD(r3, 3); FRD(r7, 7); FRD(r11, 11); FRD(r15, 15);
#undef FRD
    asm volatile("s_waitcnt lgkmcnt(12)" : "+v"(r0), "+v"(r4), "+v"(r8), "+v"(r12) :: "memory");
    v[0] = cf{r0[0], r0[1]}; v[4] = cf{r4[0], r4[1]}; v[8] = cf{r8[0], r8[1]}; v[12] = cf{r12[0], r12[1]}; dft4<S>(v[0], v[4], v[8], v[12]);
    asm volatile("s_waitcnt lgkmcnt(8)" : "+v"(r1), "+v"(r5), "+v"(r9), "+v"(r13) :: "memory");
    v[1] = cf{r1[0], r1[1]}; v[5] = cf{r5[0], r5[1]}; v[9] = cf{r9[0], r9[1]}; v[13] = cf{r13[0], r13[1]}; dft4<S>(v[1], v[5], v[9], v[13]);
    asm volatile("s_waitcnt lgkmcnt(4)" : "+v"(r2), "+v"(r6), "+v"(r10), "+v"(r14) :: "memory");
    v[2] = cf{r2[0], r2[1]}; v[6] = cf{r6[0], r6[1]}; v[10] = cf{r10[0], r10[1]}; v[14] = cf{r14[0], r14[1]}; dft4<S>(v[2], v[6], v[10], v[14]);
    asm volatile("s_waitcnt lgkmcnt(0)" : "+v"(r3), "+v"(r7), "+v"(r11), "+v"(r15) :: "memory");
    v[3] = cf{r3[0], r3[1]}; v[7] = cf{r7[0], r7[1]}; v[11] = cf{r11[0], r11[1]}; v[15] = cf{r15[0], r15[1]}; dft4<S>(v[3], v[7], v[11], v[15]);
    dft16_tail<S>(v);
#else
    fload<PAT>(v, buf, tp); dft16<S>(v);
#endif
}
template <int PAT> __device__ __forceinline__ void fstore_raw(const cf (&x)[16], cf* buf, int tp) {
#if defined(__HIP_DEVICE_COMPILE__)
    const unsigned p = (unsigned)(uintptr_t)(buf + fbase<PAT>(tp));
#else
    cf* p = buf + fbase<PAT>(tp);
#endif
    constexpr int ST = FStr<PAT>::v * 8;
    lds_wr64<0>(p, x[0]); lds_wr64<ST>(p, x[1]); lds_wr64<2 * ST>(p, x[2]); lds_wr64<3 * ST>(p, x[3]); lds_wr64<4 * ST>(p, x[4]); lds_wr64<5 * ST>(p, x[5]); lds_wr64<6 * ST>(p, x[6]); lds_wr64<7 * ST>(p, x[7]);
    lds_wr64<8 * ST>(p, x[8]); lds_wr64<9 * ST>(p, x[9]); lds_wr64<10 * ST>(p, x[10]); lds_wr64<11 * ST>(p, x[11]); lds_wr64<12 * ST>(p, x[12]); lds_wr64<13 * ST>(p, x[13]); lds_wr64<14 * ST>(p, x[14]); lds_wr64<15 * ST>(p, x[15]);
    FFT_LGKM0();
}
template <int PAT> __device__ __forceinline__ void fstore_geo(cf (&v)[16], cf* buf, int tp, cf t0, cf r) {
    const cf r2 = cmul(r, r); cf te = t0, to = cmul(t0, r); cf x[16];
#pragma unroll
    for (int k = 0; k < 16; k += 2) { x[k] = cmul(v[REV4(k)], te); x[k + 1] = cmul(v[REV4(k + 1)], to); te = cmul(te, r2); to = cmul(to, r2); }
    fstore_raw<PAT>(x, buf, tp);
}
#ifndef FFT_GEO
#define FFT_GEO 1
#endif
template <int PAT> __device__ __forceinline__ void fstore_ang(cf (&v)[16], cf* buf, int tp, float a0, float ar) {
#if FFT_GEO
    fstore_geo<PAT>(v, buf, tp, cis_rev(a0), cis_rev(ar));
#else
    cf x[16];
#pragma unroll
    for (int k = 0; k < 16; ++k) x[k] = cmul(v[REV4(k)], cis_rev(a0 + (float)k * ar));
    fstore_raw<PAT>(x, buf, tp);
#endif
}
__device__ __forceinline__ void ftw_build(cf (&tw)[16], cf t0, cf r) {
    const cf r2 = cmul(r, r); cf te = t0, to = cmul(t0, r);
#pragma unroll
    for (int k = 0; k < 16; k += 2) { tw[k] = te; tw[k + 1] = to; te = cmul(te, r2); to = cmul(to, r2); }
}
template <int PAT> __device__ __forceinline__ void fstore_tw(cf (&v)[16], cf* buf, int tp, const cf (&tw)[16]) {
    cf x[16];
#pragma unroll
    for (int k = 0; k < 16; ++k) x[k] = cmul(v[REV4(k)], tw[k]);
    fstore_raw<PAT>(x, buf, tp);
}
#define W32C(j) ((j) == 0 ? 1.f : (j) == 1 ? 0.98078528f : (j) == 2 ? 0.92387953f : (j) == 3 ? 0.83146961f : (j) == 4 ? 0.70710678f : (j) == 5 ? 0.55557023f : (j) == 6 ? 0.38268343f : (j) == 7 ? 0.19509032f : (j) == 8 ? 0.f : \
                 (j) == 9 ? -0.19509032f : (j) == 10 ? -0.38268343f : (j) == 11 ? -0.55557023f : (j) == 12 ? -0.70710678f : (j) == 13 ? -0.83146961f : (j) == 14 ? -0.92387953f : -0.98078528f)
#define W32S(j) ((j) == 0 ? 0.f : (j) == 1 ? 0.19509032f : (j) == 2 ? 0.38268343f : (j) == 3 ? 0.55557023f : (j) == 4 ? 0.70710678f : (j) == 5 ? 0.83146961f : (j) == 6 ? 0.92387953f : (j) == 7 ? 0.98078528f : (j) == 8 ? 1.f : \
                 (j) == 9 ? 0.98078528f : (j) == 10 ? 0.92387953f : (j) == 11 ? 0.83146961f : (j) == 12 ? 0.70710678f : (j) == 13 ? 0.55557023f : (j) == 14 ? 0.38268343f : 0.19509032f)
__device__ __forceinline__ void fft_fwd_pass1(cf (&v)[16], cf* buf, int tp, int str) {
    if (str) {
#pragma unroll
        for (int j = 1; j < 16; ++j) v[j] = cmul(v[j], cf{W32C(j), -W32S(j)});
    }
    dft16<-1>(v);
    fstore_ang<0>(v, buf, tp, str ? -(float)tp * (1.f / 8192.f) : 0.f, -(float)(tp >> 4) * (1.f / 256.f));
}
__device__ __forceinline__ void fft_fwd_pass2(cf* buf, int tp0, const cf (&tw)[16]) {
    const int tp = hide(tp0);
    cf v[16]; fload_dft16<1, -1>(v, buf, tp);
    fstore_tw<1>(v, buf, tp, tw);
}
__device__ __forceinline__ void fft_inv_pass2(cf* buf, int tp0, int str) {
    const int tp = hide(tp0);
    cf v[16]; fload_dft16<1, 1>(v, buf, tp);
    const int n0 = tp & 15, k2 = tp >> 4;
    fstore_ang<1>(v, buf, tp, str ? (float)n0 * (1.f / 8192.f) : 0.f, (float)k2 * (1.f / 256.f) + (str ? (1.f / 512.f) : 0.f));
}
__device__ __forceinline__ void fft_inv_pass3(cf* buf, int tp0, int str) {
    const int tp = hide(tp0);
    cf v[16]; fload_dft16<0, 1>(v, buf, tp);
    cf x[16];
#pragma unroll
    for (int k = 0; k < 16; ++k) { x[k] = v[REV4(k)]; if (str && k > 0) x[k] = cmul(x[k], cf{W32C(k), W32S(k)}); }
    fstore_raw<0>(x, buf, tp);
}

struct Row8 { u32x4 a; unsigned short l, r; };
__device__ __forceinline__ void load_row8(const bf16* rowp, int n0, Row8& q) {
    q.a = *(const u32x4*)(rowp + n0); const unsigned short l = rowp[n0 > 0 ? n0 - 1 : 0], r = rowp[n0 + 8 < 4096 ? n0 + 8 : 4095]; q.l = n0 > 0 ? l : (unsigned short)0; q.r = n0 + 8 < 4096 ? r : (unsigned short)0;
}
__device__ __forceinline__ void conv3_row8(const Row8& q, float w0, float w1, float w2, float bb, float (&o)[8]) {
    const float r[10] = {bf2f(q.l), bflo(q.a.x), bfhi(q.a.x), bflo(q.a.y), bfhi(q.a.y), bflo(q.a.z), bfhi(q.a.z), bflo(q.a.w), bfhi(q.a.w), bf2f(q.r)};
#pragma unroll
    for (int i = 0; i < 8; ++i) o[i] = w0 * r[i] + w1 * r[i + 1] + w2 * r[i + 2] + bb;
}

__device__ __forceinline__ void phase_hyena_fft(const Params& P, unsigned char* lds, int tid, int lane, int wave, int G) {
    cf* bufE = (cf*)lds; cf* bufO = (cf*)(lds + FFT_BUF); cf* zbuf = (cf*)(lds + FFT_ZB);
    float* w3c = (float*)(lds + FFT_W3); float* red = (float*)(lds + FFT_RED);
    const int str = __builtin_amdgcn_readfirstlane(tid >> 8), tp0 = tid & 255; cf* buf = str ? bufO : bufE;
    const bf16* Pt = (const bf16*)(P.ws + WS_PT); bf16* Zt = (bf16*)(P.ws + WS_ZT);
    cf* Hs = (cf*)(P.ws + WS_HSPEC) + (size_t)blockIdx.x * 4 * 4096;
    const float* a2T = (const float*)(P.ws + WS_A2);
#ifndef FFT_SBAR
#define FFT_SBAR 1
#endif
    unsigned* sb = (unsigned*)(lds + FFT_RED + 64) + str; unsigned sgen = 0u;
    if (tid < 2) ((unsigned*)(lds + FFT_RED + 64))[tid] = 0u;
#if FFT_SBAR
#define STREAM_BAR() do { asm volatile("s_waitcnt vmcnt(0) lgkmcnt(0)" ::: "memory"); sgen += 4u; \
        if (lane == 0) __hip_atomic_fetch_add(sb, 1u, __ATOMIC_RELAXED, __HIP_MEMORY_SCOPE_WORKGROUP); \
        while ((unsigned)__builtin_amdgcn_readfirstlane((int)__hip_atomic_load(sb, __ATOMIC_RELAXED, __HIP_MEMORY_SCOPE_WORKGROUP)) < sgen) __builtin_amdgcn_s_sleep(0); \
        asm volatile("" ::: "memory"); } while (0)
#else
#define STREAM_BAR() __syncthreads()
#endif
    cf tw2[16];
    { const int n0 = tp0 & 15, k2 = tp0 >> 4;
      ftw_build(tw2, cis_rev(-(float)(n0 * k2) * (1.f / 4096.f)), cis_rev(-(float)n0 * (1.f / 256.f))); }
#pragma unroll 1
    for (int c = blockIdx.x; c < 1024; c += G) {
        __syncthreads();
        if (tid < 256) w3c[tid] = P.in[I_HW3][(size_t)(tid & 63) * 4096 + (tid >> 6) * 1024 + c];
#ifndef FFT_ROWPF
#define FFT_ROWPF 0
#endif
        Row8 va, vb;
#if FFT_ROWPF
        load_row8(Pt + (size_t)c * 32768, hide(tid) * 8, va); load_row8(Pt + (size_t)c * 32768 + 4096, hide(tid) * 8, vb);
#endif
        __syncthreads();
        {
            float d[8][4];
#pragma unroll
            for (int j = 0; j < 8; ++j) { d[j][0] = 0.f; d[j][1] = 0.f; d[j][2] = 0.f; d[j][3] = 0.f; }
#pragma unroll 2
            for (int i = 0; i < 64; ++i) { const float w0 = w3c[i], w1 = w3c[64 + i], w2 = w3c[128 + i], w3 = w3c[192 + i]; const float* ar = a2T + (size_t)i * 4096 + tid;
#pragma unroll
                for (int j = 0; j < 8; ++j) { const float a = ar[512 * j]; d[j][0] += a * w0; d[j][1] += a * w1; d[j][2] += a * w2; d[j][3] += a * w3; } }
            float dec[4];
#pragma unroll
            for (int q = 0; q < 4; ++q) dec[q] = fabsf(P.in[I_HDEC][q * 1024 + c]) * (1.4426950408889634f / 4095.f);
            float as0 = 0.f, as1 = 0.f;
#pragma unroll
            for (int j = 0; j < 8; ++j) { const int t = tid + 512 * j; const float tf = (float)t;
                const float h0 = d[j][0] * __builtin_amdgcn_exp2f(-tf * dec[0]), h1 = d[j][1] * __builtin_amdgcn_exp2f(-tf * dec[1]), h2 = d[j][2] * __builtin_amdgcn_exp2f(-tf * dec[2]), h3 = d[j][3] * __builtin_amdgcn_exp2f(-tf * dec[3]);
                float* hb0 = (float*)(lds + FFT_ZB); float* hb1 = (float*)(lds + FFT_HB1);
                hb0[t] = h0; hb0[4096 + t] = h1; hb1[t] = h2; hb1[4096 + t] = h3; as0 += fabsf(h0) + fabsf(h1); as1 += fabsf(h2) + fabsf(h3); }
            as0 = wave_sum(as0); as1 = wave_sum(as1); if (lane == 0) { red[wave] = as0; red[8 + wave] = as1; }
        }
        __syncthreads();
#pragma unroll 1
        for (int o = 0; o < 2; ++o) {
            const float* hbuf = (const float*)(lds + (o == 0 ? FFT_ZB : FFT_HB1));
            float tot = 0.f;
#pragma unroll
            for (int w = 0; w < 8; ++w) tot += red[8 * o + w];
            const float inv = 1.f / ((tot + 1e-6f) * 8192.f);
            { const int tp = hide(tp0); cf v[16];
#pragma unroll
              for (int j = 0; j < 16; ++j) { const int n = tp + 256 * j; const float ta = (hbuf[n] + (n == 0 ? hbuf[4096] : 0.f)) * inv, tb = (n == 0 ? 0.f : hbuf[4096 + 4096 - n]) * inv;
                  v[j] = cf{str ? ta - tb : ta + tb, 0.f}; }
              fft_fwd_pass1(v, buf, tp, str); }
            STREAM_BAR();
            fft_fwd_pass2(buf, tp0, tw2);
            STREAM_BAR();
            { const int tp = hide(tp0); cf v[16]; fload_dft16<2, -1>(v, buf, tp);
              cf* hp = Hs + (size_t)(o * 2 + str) * 4096 + tp;
#pragma unroll
              for (int k = 0; k < 16; ++k) hp[k * 256] = v[REV4(k)]; }
            __syncthreads();
        }
#pragma unroll 1
        for (int pr = 0; pr < 4; ++pr) {
            { const int n0 = hide(tid) * 8; float oa[8], ob[8];
#if !FFT_ROWPF
              load_row8(Pt + (size_t)c * 32768 + (2 * pr) * 4096, n0, va); load_row8(Pt + (size_t)c * 32768 + (2 * pr + 1) * 4096, n0, vb);
#endif
              const float w0 = P.in[I_HCW][c], w1 = P.in[I_HCW][3072 + c], w2 = P.in[I_HCW][6144 + c], bb = P.in[I_HCB][c];
              conv3_row8(va, w0, w1, w2, bb, oa); conv3_row8(vb, w0, w1, w2, bb, ob);
#pragma unroll
              for (int i = 0; i < 8; ++i) zbuf[n0 + i] = cf{oa[i], ob[i]}; }
            __syncthreads();
#pragma unroll 1
            for (int o = 0; o < 2; ++o) {
                Row8 ga, gb;
#if FFT_ROWPF
                { const int n0 = hide(tid) * 8; const size_t grow = (size_t)((o + 1) * 1024 + c) * 32768;
                    load_row8(Pt + grow + (2 * pr) * 4096, n0, ga); load_row8(Pt + grow + (2 * pr + 1) * 4096, n0, gb);
                    const int prn = pr < 3 ? pr + 1 : 3;
                    load_row8(Pt + (size_t)c * 32768 + (2 * prn) * 4096, n0, va); load_row8(Pt + (size_t)c * 32768 + (2 * prn + 1) * 4096, n0, vb); }
#endif
                { const int tp = hide(tp0); cf v[16];
#pragma unroll
                  for (int j = 0; j < 16; ++j) v[j] = zbuf[tp + 256 * j];
                  fft_fwd_pass1(v, buf, tp, str); }
                STREAM_BAR();
#ifndef FFT_PF
#define FFT_PF 1
#endif
                cf hq[16];
#if FFT_PF
                { const cf* hp = Hs + (size_t)(o * 2 + str) * 4096 + hide(tp0);
#pragma unroll
                  for (int k = 0; k < 16; ++k) hq[k] = hp[k * 256]; }
#endif
                fft_fwd_pass2(buf, tp0, tw2);
                STREAM_BAR();
                { const int tp = hide(tp0); cf v[16]; fload_dft16<2, -1>(v, buf, tp);
#if !FFT_PF
                  { const cf* hp = Hs + (size_t)(o * 2 + str) * 4096 + tp;
#pragma unroll
                  for (int k = 0; k < 16; ++k) hq[k] = hp[k * 256]; }
#endif
                  cf y[16];
#pragma unroll
                  for (int k = 0; k < 16; ++k) y[k] = cmul(v[REV4(k)], hq[k]);
                  dft16<1>(y);
                  fstore_ang<2>(y, buf, tp, 0.f, (float)((tp >> 4) + 16 * (tp & 15)) * (1.f / 4096.f)); }
                STREAM_BAR();
                fft_inv_pass2(buf, tp0, str);
                STREAM_BAR();
                fft_inv_pass3(buf, tp0, str);
                __syncthreads();
                { const int n0 = hide(tid) * 8;
#if !FFT_ROWPF
                  { const size_t grow = (size_t)((o + 1) * 1024 + c) * 32768; load_row8(Pt + grow + (2 * pr) * 4096, n0, ga); load_row8(Pt + grow + (2 * pr + 1) * 4096, n0, gb); }
#endif
                  const int gc = (o + 1) * 1024 + c;
                  const float w0 = P.in[I_HCW][gc], w1 = P.in[I_HCW][3072 + gc], w2 = P.in[I_HCW][6144 + gc], bb = P.in[I_HCB][gc];
                  const float sk = P.in[I_HSKIP][o * 1024 + c]; float g0[8], g1[8], oa[8], ob[8];
                  conv3_row8(ga, w0, w1, w2, bb, g0); conv3_row8(gb, w0, w1, w2, bb, g1);
#pragma unroll
                  for (int i = 0; i < 8; ++i) { const int n = n0 + i; const cf e = bufE[fphys(n)], q = bufO[fphys(n)], z = zbuf[n];
                      oa[i] = (e.x + q.x + sk * z.x) * g0[i]; ob[i] = (e.y + q.y + sk * z.y) * g1[i]; }
                  if (o == 0) {
#pragma unroll
                      for (int i = 0; i < 8; ++i) zbuf[n0 + i] = cf{oa[i], ob[i]};
                  } else {
                      u32x4 wa, wb; wa.x = pk2(oa[0], oa[1]); wa.y = pk2(oa[2], oa[3]); wa.z = pk2(oa[4], oa[5]); wa.w = pk2(oa[6], oa[7]);
                      wb.x = pk2(ob[0], ob[1]); wb.y = pk2(ob[2], ob[3]); wb.z = pk2(ob[4], ob[5]); wb.w = pk2(ob[6], ob[7]);
                      *(u32x4*)(Zt + (size_t)c * 32768 + (2 * pr) * 4096 + n0) = wa; *(u32x4*)(Zt + (size_t)c * 32768 + (2 * pr + 1) * 4096 + n0) = wb;
                  } }
                __syncthreads();
            }
        }
    }
}
__device__ __forceinline__ void phase_transpose(const Params& P, unsigned char* lds, int lane, int wave, int G) {
    bf16* tile = (bf16*)(lds + wave * 16384);
    const bf16* Zt = (const bf16*)(P.ws + WS_ZT); bf16* Z = (bf16*)(P.ws + WS_Z);
    for (int it = blockIdx.x * 8 + wave; it < 16 * 512; it += G * 8) {
        const int cb = it & 15, tb = it >> 4, c0 = cb * 64, t0 = tb * 64;
#pragma unroll
        for (int i = 0; i < 8; ++i) { const int ch = i * 8 + (lane >> 3), tq = (lane & 7) * 8;
            const u32x4 a = *(const u32x4*)(Zt + (size_t)(c0 + ch) * 32768 + t0 + tq);
            unsigned* d = (unsigned*)(tile + ch * 66 + tq); d[0] = a.x; d[1] = a.y; d[2] = a.z; d[3] = a.w; }
        LDS_WAIT(); asm volatile("" ::: "memory");
#pragma unroll
        for (int i = 0; i < 8; ++i) { const int tk = i * 8 + (lane >> 3), cq = (lane & 7) * 8;
            unsigned short e[8];
#pragma unroll
            for (int j = 0; j < 8; ++j) e[j] = tile[(cq + j) * 66 + tk];
            u32x4 w; w.x = e[0] | ((unsigned)e[1] << 16); w.y = e[2] | ((unsigned)e[3] << 16); w.z = e[4] | ((unsigned)e[5] << 16); w.w = e[6] | ((unsigned)e[7] << 16);
            *(u32x4*)(Z + (size_t)(t0 + tk) * 1024 + c0 + cq) = w; }
        LDS_WAIT(); asm volatile("" ::: "memory");
    }
}

constexpr int N_PHASES = 21;
__global__ void __launch_bounds__(512, 2) fwd_kernel(Params P0) {
    extern __shared__ __attribute__((aligned(16))) unsigned char lds[];
    const int tid = threadIdx.x, lane = tid & 63, wave = __builtin_amdgcn_readfirstlane(tid >> 6), G = gridDim.x;
    PG8_LAS unsigned char* ldsl = (PG8_LAS unsigned char*)lds;
    for (int u = tid; u < (LDS_BYTES - LDSCTL_OFF) / 4; u += 512) ((unsigned*)(lds + LDSCTL_OFF))[u] = 0u;
    __syncthreads();
#if MK_ONE_LAUNCH
    XcdBarrier bar = xcd_barrier_post((unsigned*)(P0.ws + WS_CTL) + CW_BAR, (volatile LAS unsigned*)(ldsl + MISC_OFF) + 8);
#define GRID_BAR() xcd_barrier(bar)
#else
#define GRID_BAR() do { } while (0)
#endif
    const int lo = P0.ph_lo, hi = P0.ph_hi;
#ifndef PHASE_MASK
#define PHASE_MASK 0xFFFFFFFFu
#endif
#define IN(k) ((((PHASE_MASK) >> (k)) & 1u) && lo <= (k) && (k) < hi)
#ifndef DELAY_MASK
#define DELAY_MASK 0u
#endif
#ifndef CLKP
#define CLKP -1
#endif
    unsigned long long clk_c0 = 0, clk_r0 = 0;
    unsigned long long t_ph = 0;
#define SEAM(k) do { if (IN(k) && IN((k) + 1)) GRID_BAR(); \
    if (((DELAY_MASK) >> (k)) & 1u) { const unsigned long long t1 = __builtin_amdgcn_s_memrealtime(); const unsigned long long dt = t1 - t_ph; while (__builtin_amdgcn_s_memrealtime() - t1 < dt) __builtin_amdgcn_s_sleep(8); __syncthreads(); } \
    if ((k) == CLKP) { const unsigned long long c1 = __builtin_readcyclecounter(), r1 = __builtin_amdgcn_s_memrealtime(); \
        const unsigned long long ticks = (c1 - clk_c0) * 1000ull / (r1 - clk_r0 + 1ull);   \
        while (__builtin_amdgcn_s_memrealtime() - r1 < ticks) __builtin_amdgcn_s_sleep(8); __syncthreads(); } \
    if ((k) + 1 == CLKP) { clk_c0 = __builtin_readcyclecounter(); clk_r0 = __builtin_amdgcn_s_memrealtime(); } \
    if (((DELAY_MASK) >> ((k) + 1)) & 1u) t_ph = __builtin_amdgcn_s_memrealtime(); } while (0)
#ifndef REPEAT_MASK
#define REPEAT_MASK 0u
#endif
#ifndef REPEAT_SUB
#define REPEAT_SUB 0u
#endif
#define REPS(k) for (int reps_ = 0; reps_ < ((((REPEAT_SUB) >> (k)) & 1u) ? 2 : 1); ++reps_)
#define REP(k) for (int rep_ = 0; rep_ < ((((REPEAT_MASK) >> (k)) & 1u) ? 2 : 1); ++rep_)

    if (DELAY_MASK & 1u) t_ph = __builtin_amdgcn_s_memrealtime();
    if (IN(0)) REP(0) { const Params P = load_params(); unsigned char* ws = P.ws; phase_prologue(P, lds, tid, lane, wave, G); } SEAM(0);
    if (IN(1)) REP(1) { const Params P = load_params(); unsigned char* ws = P.ws; phase_norm1_l0(P, lane, wave, G); } SEAM(1);
    if (IN(2)) REP(2) { const Params P = load_params(); unsigned char* ws = P.ws;
        pg8::Gemm g{(const bf16*)(ws + WS_RH), (const bf16*)(ws + WS_WIN), 1024, 1024, 1024, 0}; pg8::StaticOrder S; S.init(M0 / 256, 7, G, (int)blockIdx.x);
        EpiIn E{(bf16*)(ws + WS_CQ), (bf16*)(ws + WS_CKV), (bf16*)(ws + WS_UX), (bf16*)(ws + WS_UG), (bf16*)(ws + WS_K)};
        pg8::gemm_phase<EpiIn, pg8::StaticOrder, GP_ALIGN, GP_SP2>(ldsl, g, S, E);
    } SEAM(2);
    if (IN(3)) REP(3) { const Params P = load_params(); unsigned char* ws = P.ws; phase_rowstat(P, lane, wave, G); phase_lru_f1(P, lds, tid, lane, wave, G); } SEAM(3);
    if (IN(4)) REP(4) { const Params P = load_params(); unsigned char* ws = P.ws;
        phase_lru_carry(P, lane, wave, G);
        __syncthreads();
#ifndef NO_QUP
        REPS(0) { pg8::Gemm g{(const bf16*)(ws + WS_CQ), (const bf16*)(ws + WS_WUQ), 384, 384, 384, 0}; pg8::StaticOrder S; S.init(M0 / 256, 3, G, (int)blockIdx.x);
          EpiQ E{(bf16*)(ws + WS_Q), (const float*)(ws + WS_RQ)};
          pg8::gemm_phase<EpiQ, pg8::StaticOrder, GP_ALIGN, GP_SP2>(ldsl, g, S, E); }
#endif
        __syncthreads();
        REPS(1) { pg8::Gemm g{(const bf16*)(ws + WS_CKV), (const bf16*)(ws + WS_WUKV), 256, 256, 256, 0}; pg8::StaticOrder S; S.init(M0 / 256, 4, G, (int)blockIdx.x);
          EpiKV E{(bf16*)(ws + WS_K), (bf16*)(ws + WS_V), (const float*)(ws + WS_RKV)};
          pg8::gemm_phase<EpiKV, pg8::StaticOrder, GP_ALIGN, GP_SP2>(ldsl, g, S, E); }
        __syncthreads();
    } SEAM(4);
    if (IN(5)) REP(5) { const Params P = load_params(); unsigned char* ws = P.ws; REPS(2) phase_lru_f3(P, lds, tid, lane, wave, G); REPS(3) phase_attention(P, lds, G); } SEAM(5);
    if (IN(6)) REP(6) { const Params P = load_params(); unsigned char* ws = P.ws;
        pg8::Gemm g{(const bf16*)(ws + WS_RH), (const bf16*)(ws + WS_WOUT), 1024, 1024, 1024, 0}; pg8::StaticOrder S; S.init(M0 / 256, 4, G, (int)blockIdx.x);
        EpiRes<0> E{P.in[I_X], P.in[I_CTX], (const float*)(ws + WS_MOD), nullptr, (bf16*)P.out, (bf16*)(ws + WS_XC)};
        pg8::gemm_phase<EpiRes<0>, pg8::StaticOrder, GP_ALIGN, GP_SP2>(ldsl, g, S, E);
    } SEAM(6);
    if (IN(7)) REP(7) { const Params P = load_params(); unsigned char* ws = P.ws; phase_norm2_route<0>(P, lds, tid, lane, wave, G); } SEAM(7);
    if (IN(8)) REP(8) { const Params P = load_params(); unsigned char* ws = P.ws; phase_permute<0>(P, lds, tid, lane, wave, G); } SEAM(8);
    if (IN(9)) REP(9) { const Params P = load_params(); unsigned char* ws = P.ws;
        const int* te = (const int*)(ws + WS_TILEE); const int nmt = te[MAXTILES];
        { int* gl = (int*)(lds + RING_BYTES); const int* st = (const int*)(ws + WS_SLOTTOK);
          for (int i = 0; ; ++i) { const long L = (long)i * G + ((G % 8 == 0) ? ((int)blockIdx.x % 8) * (G / 8) + (int)blockIdx.x / 8 : (int)blockIdx.x); if (L >= (long)nmt * 4 || i >= 20) break; if (tid < 256) gl[i * 256 + tid] = st[(int)(L >> 2) * 256 + tid]; }
          __syncthreads(); }
        pg8::Gemm g{(const bf16*)(ws + WS_RH), (const bf16*)(ws + WS_W13), 1024, 1024, 1024, (size_t)1024 * 1024 * 2, RING_BYTES}; pg8::MoeOrder S{nmt, G, (G % 8 == 0) ? ((int)blockIdx.x % 8) * (G / 8) + (int)blockIdx.x / 8 : (int)blockIdx.x, te};
        EpiMoe1 E{(bf16*)(ws + WS_ACT)};
        pg8::gemm_phase<EpiMoe1, pg8::MoeOrder, GP_ALIGN, GP_SP2, true>(ldsl, g, S, E);
    } SEAM(9);
    if (IN(10)) REP(10) { const Params P = load_params(); unsigned char* ws = P.ws;
        const int* te = (const int*)(ws + WS_TILEE);
        pg8::Gemm g{(const bf16*)(ws + WS_ACT), (const bf16*)(ws + WS_W2), 512, 512, 512, (size_t)1024 * 512 * 2}; pg8::MoeOrder S{te[MAXTILES], G, (G % 8 == 0) ? ((int)blockIdx.x % 8) * (G / 8) + (int)blockIdx.x / 8 : (int)blockIdx.x, te};
        EpiStore E{(bf16*)(ws + WS_HPERM), 1024};
        pg8::gemm_phase<EpiStore, pg8::MoeOrder, GP_ALIGN, GP_SP2>(ldsl, g, S, E);
    } SEAM(10);
    if (IN(11)) REP(11) { const Params P = load_params(); unsigned char* ws = P.ws; phase_combine_norm1_l1(P, lane, wave, G); } SEAM(11);
    if (IN(12)) REP(12) { const Params P = load_params(); unsigned char* ws = P.ws;
        pg8::Gemm g{(const bf16*)(ws + WS_WHIN), (const bf16*)(ws + WS_RH), 1024, 1024, 1024, 0}; pg8::StaticOrder S; S.init(3072 / 256, M1 / 256, G, (int)blockIdx.x);
        EpiStore E{(bf16*)(ws + WS_PT), 32768};
        pg8::gemm_phase<EpiStore, pg8::StaticOrder, GP_ALIGN, GP_SP2>(ldsl, g, S, E);
    } SEAM(12);
    if (IN(13)) REP(13) { const Params P = load_params(); unsigned char* ws = P.ws; phase_hyena_fft(P, lds, tid, lane, wave, G); } SEAM(13);
    if (IN(14)) REP(14) { const Params P = load_params(); unsigned char* ws = P.ws; phase_transpose(P, lds, lane, wave, G); } SEAM(14);
    if (IN(15)) REP(15) { const Params P = load_params(); unsigned char* ws = P.ws;
        pg8::Gemm g{(const bf16*)(ws + WS_Z), (const bf16*)(ws + WS_WHOUT), 1024, 1024, 1024, 0}; pg8::StaticOrder S; S.init(M1 / 256, 4, G, (int)blockIdx.x);
        EpiRes<1> E{nullptr, nullptr, (const float*)(ws + WS_MOD), (const bf16*)((unsigned char*)P.out + X2_OFF), (bf16*)(ws + WS_X3), nullptr};
        pg8::gemm_phase<EpiRes<1>, pg8::StaticOrder, GP_ALIGN, GP_SP2>(ldsl, g, S, E);
    } SEAM(15);
    if (IN(16)) REP(16) { const Params P = load_params(); unsigned char* ws = P.ws; phase_norm2_route<1>(P, lds, tid, lane, wave, G); } SEAM(16);
    if (IN(17)) REP(17) { const Params P = load_params(); unsigned char* ws = P.ws; phase_permute<1>(P, lds, tid, lane, wave, G); } SEAM(17);
    if (IN(18)) REP(18) { const Params P = load_params(); unsigned char* ws = P.ws;
        const int* te = (const int*)(ws + WS_TILEE); const int nmt = te[MAXTILES];
        { int* gl = (int*)(lds + RING_BYTES); const int* st = (const int*)(ws + WS_SLOTTOK);
          for (int i = 0; ; ++i) { const long L = (long)i * G + ((G % 8 == 0) ? ((int)blockIdx.x % 8) * (G / 8) + (int)blockIdx.x / 8 : (int)blockIdx.x); if (L >= (long)nmt * 4 || i >= 20) break; if (tid < 256) gl[i * 256 + tid] = st[(int)(L >> 2) * 256 + tid]; }
          __syncthreads(); }
        pg8::Gemm g{(const bf16*)(ws + WS_RH), (const bf16*)(ws + WS_W13) + (size_t)16 * 1024 * 1024, 1024, 1024, 1024, (size_t)1024 * 1024 * 2, RING_BYTES}; pg8::MoeOrder S{nmt, G, (G % 8 == 0) ? ((int)blockIdx.x % 8) * (G / 8) + (int)blockIdx.x / 8 : (int)blockIdx.x, te};
        EpiMoe1 E{(bf16*)(ws + WS_ACT)};
        pg8::gemm_phase<EpiMoe1, pg8::MoeOrder, GP_ALIGN, GP_SP2, true>(ldsl, g, S, E);
    } SEAM(18);
    if (IN(19)) REP(19) { const Params P = load_params(); unsigned char* ws = P.ws;
        const int* te = (const int*)(ws + WS_TILEE);
        pg8::Gemm g{(const bf16*)(ws + WS_ACT), (const bf16*)(ws + WS_W2) + (size_t)16 * 1024 * 512, 512, 512, 512, (size_t)1024 * 512 * 2}; pg8::MoeOrder S{te[MAXTILES], G, (G % 8 == 0) ? ((int)blockIdx.x % 8) * (G / 8) + (int)blockIdx.x / 8 : (int)blockIdx.x, te};
        EpiStore E{(bf16*)(ws + WS_HPERM), 1024};
        pg8::gemm_phase<EpiStore, pg8::MoeOrder, GP_ALIGN, GP_SP2>(ldsl, g, S, E);
    } SEAM(19);
    if (IN(20)) REP(20) { const Params P = load_params(); unsigned char* ws = P.ws; phase_final(P, lane, wave, G); } SEAM(20);
#undef IN
#undef SEAM
}

extern "C" void kernel_launch(void* const* d_in, const int* in_sizes, int n_in, void* d_out, int out_size, void* d_ws, size_t ws_size, hipStream_t stream) {
    static int grid = 0;
    if (grid == 0) {
        if (n_in != N_IN || out_size != M1 * DM || ws_size < WS_END) { fprintf(stderr, "kernel_launch: unexpected shapes (n_in %d out %d ws %zu)\n", n_in, out_size, ws_size); grid = -1; return; }
        int dev = 0, cus = 0;
        if (hipGetDevice(&dev) != hipSuccess || hipDeviceGetAttribute(&cus, hipDeviceAttributeMultiprocessorCount, dev) != hipSuccess) { grid = -1; return; }
        if (hipFuncSetAttribute((const void*)fwd_kernel, hipFuncAttributeMaxDynamicSharedMemorySize, LDS_BYTES) != hipSuccess) { fprintf(stderr, "kernel_launch: hipFuncSetAttribute failed\n"); grid = -1; return; }
        int per_cu = 0;
        if (hipOccupancyMaxActiveBlocksPerMultiprocessor(&per_cu, (const void*)fwd_kernel, 512, LDS_BYTES) != hipSuccess || per_cu < 1) fprintf(stderr, "kernel_launch: occupancy query reports %d\n", per_cu);
        (void)hipGetLastError();
        grid = cus;
    }
    if (grid < 0) return;
    (void)hipMemsetAsync((char*)d_ws + WS_CTL, 0, CTL_ZERO_BYTES, stream);
    Params p{};
    for (int i = 0; i < N_IN; ++i) p.in[i] = (const float*)d_in[i];
    p.out = (float*)d_out; p.ws = (unsigned char*)d_ws;
#if MK_ONE_LAUNCH
    p.ph_lo = 0; p.ph_hi = N_PHASES;
    hipLaunchKernelGGL(fwd_kernel, dim3(grid), dim3(512), LDS_BYTES, stream, p);
#else
    for (int k = 0; k < N_PHASES; ++k) { p.ph_lo = k; p.ph_hi = k + 1; hipLaunchKernelGGL(fwd_kernel, dim3(grid), dim3(512), LDS_BYTES, stream, p); }
#endif
}
```
